# Optimizing an MI355X kernel written in HIP

```python
import math
import jax, jax.numpy as jnp
from jax import lax
import numpy as np

D_MODEL = 1024
BATCH = 1
SEQ = 16384
DEPTH = 2

GRID_W = 64
CTX_LEN = 256
RMS_EPS = 1e-6
ROPE_BASE = 10000.0

FNET_GROUPS = 4
FNET_GROUP_DIM = 64
FNET_WIDTH = FNET_GROUPS * FNET_GROUP_DIM
NA_HEADS = 12
NA_HEAD_DIM = 64
NA_WIDTH = NA_HEADS * NA_HEAD_DIM
NA_KH = 8
NA_KW = 16
NA_KEYW = 2 * NA_KW
NA_NCB = GRID_W // NA_KW
AB_IN = FNET_WIDTH + 3 * NA_WIDTH
AB_OUT = FNET_WIDTH + NA_WIDTH

RET_HEADS = 4
RET_DK = D_MODEL // RET_HEADS
RET_DV = 2 * RET_DK
RET_QK = RET_HEADS * RET_DK
RET_V = RET_HEADS * RET_DV
RET_IN = 2 * RET_QK + 2 * RET_V
RET_CHUNK = 128

N_EXPERTS = 16
N_GROUPS = 4
EXPERTS_PER_GROUP = N_EXPERTS // N_GROUPS
TOP_K = 2
D_EXPERT = D_MODEL // 2

kernel_name = 'hybrid_fnet_natten_retnet_moe_dit'


def rmsnorm(x, g):
    xf = x.astype(jnp.float32)
    y = xf * lax.rsqrt(jnp.mean(xf * xf, axis=-1, keepdims=True) + RMS_EPS)
    return y.astype(x.dtype) * g


def modulate(x, shift, scale):
    return x * (1 + scale) + shift


def _rope_half(x, pos):
    n = x.shape[-1] // 2
    inv_freq = ROPE_BASE ** (-jnp.arange(n, dtype=jnp.float32) / n)
    ang = pos.astype(jnp.float32)[:, None] * inv_freq[None, :]
    cos = jnp.cos(ang)[None, :, None, :]
    sin = jnp.sin(ang)[None, :, None, :]
    xf = x.astype(jnp.float32)
    x1, x2 = xf[..., :n], xf[..., n:]
    return jnp.concatenate([x1 * cos - x2 * sin, x2 * cos + x1 * sin], axis=-1)


def axial_rope(x, row, col):
    half = x.shape[-1] // 2
    return jnp.concatenate([_rope_half(x[..., :half], row), _rope_half(x[..., half:], col)], axis=-1).astype(x.dtype)


def fourier_mix(a):
    B, N, _ = a.shape
    ag = a.reshape(B, N, FNET_GROUPS, FNET_GROUP_DIM).astype(jnp.float32)
    return jnp.fft.fft2(ag, axes=(1, 3), norm='ortho').real.astype(a.dtype).reshape(B, N, FNET_WIDTH)


def dense_attention(q, k, v):
    s = jnp.einsum('bqhd,bkhd->bhqk', q, k).astype(jnp.float32) * (q.shape[-1] ** -0.5)
    p = jax.nn.softmax(s, axis=-1).astype(v.dtype)
    return jnp.einsum('bhqk,bkhd->bqhd', p, v)


def _na_static():
    j = np.arange(NA_NCB)
    key_start = np.clip(j * NA_KW - NA_KW // 2, 0, GRID_W - NA_KEYW)
    key_cols = key_start[:, None] + np.arange(NA_KEYW)[None, :]
    q_cols = j[:, None] * NA_KW + np.arange(NA_KW)[None, :]
    win_start = np.clip(q_cols - NA_KW // 2, 0, GRID_W - NA_KW)[:, :, None]
    kc = key_cols[:, None, :]
    col_mask = (kc >= win_start) & (kc < win_start + NA_KW)
    dc_idx = np.clip(kc - q_cols[:, :, None] + NA_KW - 1, 0, 2 * NA_KW - 2)
    return key_cols, col_mask, dc_idx


def neighborhood_attention(q, k, v, k_ctx, v_ctx, rpb):
    B, L, H, Dh = q.shape
    rows = L // GRID_W
    kh = min(NA_KH, rows)
    scale = Dh ** -0.5
    key_cols, col_mask, dc_idx = _na_static()
    qg = q.reshape(B, rows, NA_NCB, NA_KW, H, Dh)
    kg = k.reshape(B, rows, GRID_W, H, Dh)
    vg = v.reshape(B, rows, GRID_W, H, Dh)
    rpb_cols = rpb[:, :, dc_idx]
    mask = jnp.asarray(col_mask)[None, None, :, :, None, :]

    def row_block(r):
        rs = jnp.clip(r - kh // 2, 0, rows - kh)
        k_blk = lax.dynamic_slice_in_dim(kg, rs, kh, axis=1)[:, :, key_cols]
        v_blk = lax.dynamic_slice_in_dim(vg, rs, kh, axis=1)[:, :, key_cols]
        q_r = lax.dynamic_index_in_dim(qg, r, axis=1, keepdims=False)
        s_loc = jnp.einsum('bjqhd,brjkhd->bhjqrk', q_r, k_blk).astype(jnp.float32) * scale
        dr = rs + jnp.arange(kh) - r + (NA_KH - 1)
        bias = jnp.transpose(rpb_cols[:, dr], (0, 2, 3, 1, 4)).astype(jnp.float32)
        s_loc = jnp.where(mask, s_loc + bias[None], -jnp.inf).reshape(B, H, NA_NCB, NA_KW, kh * NA_KEYW)
        s_ctx = jnp.einsum('bjqhd,bkhd->bhjqk', q_r, k_ctx).astype(jnp.float32) * scale
        p = jax.nn.softmax(jnp.concatenate([s_loc, s_ctx], axis=-1), axis=-1).astype(v.dtype)
        p_loc = p[..., :kh * NA_KEYW].reshape(B, H, NA_NCB, NA_KW, kh, NA_KEYW)
        p_ctx = p[..., kh * NA_KEYW:]
        return (jnp.einsum('bhjqrk,brjkhd->bjqhd', p_loc, v_blk)
                + jnp.einsum('bhjqk,bkhd->bjqhd', p_ctx, v_ctx))

    o = lax.map(row_block, jnp.arange(rows))
    return jnp.moveaxis(o, 0, 1).reshape(B, L, H * Dh)


def fnet_na_mixer(xm, cm, w_in, w_out, rpb, need_ctx):
    B, L, _ = xm.shape
    pl = xm @ w_in
    pc = cm @ w_in

    def heads(p):
        qkv = p[..., FNET_WIDTH:].reshape(p.shape[0], p.shape[1], 3, NA_HEADS, NA_HEAD_DIM)
        return qkv[:, :, 0], qkv[:, :, 1], qkv[:, :, 2]

    ql, kl, vl = heads(pl)
    qc, kc, vc = heads(pc)
    a_lat = fourier_mix(pl[..., :FNET_WIDTH])
    o_lat = neighborhood_attention(ql, kl, vl, kc, vc, rpb)
    y_lat = jnp.concatenate([a_lat, o_lat], axis=-1) @ w_out
    y_ctx = None
    if need_ctx:
        a_ctx = fourier_mix(pc[..., :FNET_WIDTH])
        o_ctx = dense_attention(qc, kc, vc).reshape(B, -1, NA_WIDTH)
        y_ctx = jnp.concatenate([a_ctx, o_ctx], axis=-1) @ w_out
    return y_lat, y_ctx


def retention_scan(q, k, v, log_gamma):
    B, H, N, dk = q.shape
    dv = v.shape[-1]
    nc = N // RET_CHUNK

    def chunks(t):
        return jnp.moveaxis(t.reshape(B, H, nc, RET_CHUNK, t.shape[-1]), 2, 0)

    pos = jnp.arange(RET_CHUNK, dtype=jnp.float32)
    diff = pos[:, None] - pos[None, :]
    lower = diff >= 0
    intra_decay = jnp.where(lower, jnp.exp(jnp.where(lower, diff, 0.0)[None] * log_gamma[:, None, None]), 0.0)
    q_decay = jnp.exp((pos + 1.0)[None, :] * log_gamma[:, None])[..., None]
    k_decay = jnp.exp((RET_CHUNK - 1.0 - pos)[None, :] * log_gamma[:, None])[..., None]
    chunk_decay = jnp.exp(RET_CHUNK * log_gamma)[:, None, None]

    def step(state, qkv):
        qc, kc, vc = qkv
        scores = jnp.einsum('bhnd,bhmd->bhnm', qc, kc) * intra_decay
        out = (jnp.einsum('bhnm,bhmv->bhnv', scores, vc)
               + jnp.einsum('bhnd,bhdv->bhnv', qc * q_decay, state))
        state = state * chunk_decay + jnp.einsum('bhmd,bhmv->bhdv', kc * k_decay, vc)
        return state, out

    state0 = jnp.zeros((B, H, dk, dv), jnp.float32)
    _, out = lax.scan(step, state0, (chunks(q), chunks(k), chunks(v)))
    return jnp.moveaxis(out, 0, 2).reshape(B, H, N, dv)


def retention_mixer(xm, cm, w_in, w_out, decay_param, row, col, need_ctx):
    B, L, _ = xm.shape
    n_ctx = cm.shape[1]

    def split(p):
        n = p.shape[1]
        q = p[..., :RET_QK].reshape(B, n, RET_HEADS, RET_DK)
        k = p[..., RET_QK:2 * RET_QK].reshape(B, n, RET_HEADS, RET_DK) * (RET_DK ** -0.5)
        v = p[..., 2 * RET_QK:2 * RET_QK + RET_V].reshape(B, n, RET_HEADS, RET_DV)
        g = p[..., 2 * RET_QK + RET_V:]
        return q, k, v, g

    ql, kl, vl, gl = split(xm @ w_in)
    qc, kc, vc, gc = split(cm @ w_in)
    ql = axial_rope(ql, row, col)
    kl = axial_rope(kl, row, col)

    def bhnd(t_ctx, t_lat):
        return jnp.concatenate([t_ctx, t_lat], axis=1).transpose(0, 2, 1, 3).astype(jnp.float32)

    q, k, v = bhnd(qc, ql), bhnd(kc, kl), bhnd(vc, vl)
    log_gamma = jnp.log1p(-jnp.exp(decay_param.astype(jnp.float32)))

    def flip(t):
        return jnp.concatenate([t[:, :, :n_ctx][:, :, ::-1], t[:, :, n_ctx:][:, :, ::-1]], axis=2)

    o = retention_scan(q, k, v, log_gamma[0]) + flip(retention_scan(flip(q), flip(k), flip(v), log_gamma[1]))

    def gated_out(o_part, g):
        on = o_part * lax.rsqrt(jnp.mean(o_part * o_part, axis=-1, keepdims=True) + RMS_EPS)
        on = on.transpose(0, 2, 1, 3).reshape(B, -1, RET_V).astype(g.dtype)
        return (jax.nn.silu(g) * on) @ w_out

    y_lat = gated_out(o[:, :, n_ctx:], gl)
    y_ctx = gated_out(o[:, :, :n_ctx], gc) if need_ctx else None
    return y_lat, y_ctx


def moe_ffn(tok, router_w, router_b, w1, w3, w2):
    T = tok.shape[0]
    scores = jax.nn.sigmoid((tok @ router_w).astype(jnp.float32))
    biased = (scores + router_b.astype(jnp.float32)).reshape(T, N_GROUPS, EXPERTS_PER_GROUP)
    group_score = lax.top_k(biased, TOP_K)[0].sum(axis=-1)
    g_sel = jnp.argmax(group_score, axis=-1)
    in_group = jnp.take_along_axis(biased, g_sel[:, None, None], axis=1)[:, 0]
    _, local = lax.top_k(in_group, TOP_K)
    expert_idx = g_sel[:, None] * EXPERTS_PER_GROUP + local
    w = jnp.take_along_axis(scores, expert_idx, axis=-1)
    w = w / jnp.sum(w, axis=-1, keepdims=True)
    gate = jnp.sum(jax.nn.one_hot(expert_idx, N_EXPERTS, dtype=jnp.float32) * w[..., None], axis=1).astype(tok.dtype)
    out = jnp.zeros_like(tok)
    for e in range(N_EXPERTS):
        hid = jax.nn.silu(tok @ w1[e]) * (tok @ w3[e])
        out = out + gate[:, e:e + 1] * (hid @ w2[e])
    return out


def setup_inputs(seed: int = 0) -> dict:
    key = jax.random.key(seed)
    ks = jax.random.split(key, 20)
    n_even = (DEPTH + 1) // 2
    n_odd = DEPTH // 2

    def nrm(k, shape, scale):
        return jax.random.normal(k, shape, jnp.float32) * scale

    base_decay = -(5.0 + jnp.arange(RET_HEADS, dtype=jnp.float32)) * math.log(2.0)
    return {
        'x': nrm(ks[0], (BATCH, SEQ, D_MODEL), 1.0),
        'c': nrm(ks[1], (BATCH, D_MODEL), 1.0),
        'ctx': nrm(ks[2], (BATCH, CTX_LEN, D_MODEL), 1.0),
        'c_ctx': nrm(ks[3], (D_MODEL,), 1.0),
        'ada_w': nrm(ks[4], (DEPTH, D_MODEL, 6 * D_MODEL), 0.5 * D_MODEL ** -0.5),
        'ada_b': nrm(ks[5], (DEPTH, 6 * D_MODEL), 0.02),
        'norm_g': 1.0 + nrm(ks[6], (DEPTH, 2, D_MODEL), 0.02),
        'final_norm_g': 1.0 + nrm(ks[7], (D_MODEL,), 0.02),
        'mixab_w_in': nrm(ks[8], (n_even, D_MODEL, AB_IN), D_MODEL ** -0.5),
        'mixab_w_out': nrm(ks[9], (n_even, AB_OUT, D_MODEL), AB_OUT ** -0.5),
        'na_rpb': nrm(ks[10], (n_even, NA_HEADS, 2 * NA_KH - 1, 2 * NA_KW - 1), 0.1),
        'ret_w_in': nrm(ks[11], (n_odd, D_MODEL, RET_IN), D_MODEL ** -0.5),
        'ret_w_out': nrm(ks[12], (n_odd, RET_V, D_MODEL), RET_V ** -0.5),
        'ret_decay': base_decay[None, None, :] + nrm(ks[13], (n_odd, 2, RET_HEADS), 0.05),
        'router_w': nrm(ks[14], (D_MODEL, N_EXPERTS), D_MODEL ** -0.5),
        'router_b': nrm(ks[15], (N_EXPERTS,), 0.01),
        'moe_w1': nrm(ks[16], (DEPTH, N_EXPERTS, D_MODEL, D_EXPERT), D_MODEL ** -0.5),
        'moe_w3': nrm(ks[17], (DEPTH, N_EXPERTS, D_MODEL, D_EXPERT), D_MODEL ** -0.5),
        'moe_w2': nrm(ks[18], (DEPTH, N_EXPERTS, D_EXPERT, D_MODEL), D_EXPERT ** -0.5),
    }


def reference(x, c, ctx, c_ctx, ada_w, ada_b, norm_g, final_norm_g, mixab_w_in, mixab_w_out, na_rpb,
              ret_w_in, ret_w_out, ret_decay, router_w, router_b, moe_w1, moe_w3, moe_w2):
    B, L, D = x.shape
    t = jnp.arange(L)
    row, col = t // GRID_W, t % GRID_W
    h, hc = x, ctx
    for layer in range(DEPTH):
        need_ctx = layer < DEPTH - 1
        mod = jax.nn.silu(c) @ ada_w[layer] + ada_b[layer]
        mod_c = jax.nn.silu(c_ctx) @ ada_w[layer] + ada_b[layer]
        sh1, sc1, g1, sh2, sc2, g2 = [m[:, None, :] for m in jnp.split(mod, 6, axis=-1)]
        sh1c, sc1c, g1c, sh2c, sc2c, g2c = jnp.split(mod_c, 6, axis=-1)
        xm = modulate(rmsnorm(h, norm_g[layer, 0]), sh1, sc1)
        cm = modulate(rmsnorm(hc, norm_g[layer, 0]), sh1c, sc1c)
        idx = layer // 2
        if layer % 2 == 0:
            y, yc = fnet_na_mixer(xm, cm, mixab_w_in[idx], mixab_w_out[idx], na_rpb[idx], need_ctx)
        else:
            y, yc = retention_mixer(xm, cm, ret_w_in[idx], ret_w_out[idx], ret_decay[idx], row, col, need_ctx)
        h = h + g1 * y
        xm2 = modulate(rmsnorm(h, norm_g[layer, 1]), sh2, sc2)
        if need_ctx:
            hc = hc + g1c * yc
            cm2 = modulate(rmsnorm(hc, norm_g[layer, 1]), sh2c, sc2c)
            n_c = cm2.shape[0] * cm2.shape[1]
            tok = jnp.concatenate([cm2.reshape(-1, D), xm2.reshape(-1, D)], axis=0)
            f = moe_ffn(tok, router_w, router_b, moe_w1[layer], moe_w3[layer], moe_w2[layer])
            hc = hc + g2c * f[:n_c].reshape(hc.shape)
            h = h + g2 * f[n_c:].reshape(h.shape)
        else:
            f = moe_ffn(xm2.reshape(-1, D), router_w, router_b, moe_w1[layer], moe_w3[layer], moe_w2[layer])
            h = h + g2 * f.reshape(h.shape)
    return rmsnorm(h, final_norm_g)
```

```cpp
#include <hip/hip_runtime.h>
#include <cstdio>
#include <cstdint>

typedef unsigned short bf16_t;
typedef short bf16x8 __attribute__((ext_vector_type(8)));
typedef float f32x4 __attribute__((ext_vector_type(4)));
typedef float f32x2 __attribute__((ext_vector_type(2)));
typedef unsigned u32x2 __attribute__((ext_vector_type(2)));
typedef unsigned u32x4 __attribute__((ext_vector_type(4)));
#define LAS __attribute__((address_space(3)))

constexpr int DM = 1024, SEQ = 16384, CTXN = 256, TT = SEQ + CTXN  , GW = 64;
constexpr int NH0 = 12, QK0_LD = 1536, W0IN_ROWS = 2816;
constexpr int NPMAX = 146;
constexpr float RMS_EPS = 1e-6f;
constexpr int NPHASE = 24;

constexpr size_t KiB = 1024, MiB = 1024 * 1024, HMiB = 512 * 1024;
constexpr size_t WS_CTL = 0;
constexpr size_t CTL_BYTES = 64 * KiB;
constexpr size_t CTL_CNT = 16 * KiB;
constexpr size_t CTL_QUEUE = 20 * KiB;
constexpr size_t WS_MOD = 64 * KiB;
constexpr size_t WS_TWC = 256 * KiB, WS_TWS = 320 * KiB;
constexpr size_t WS_ROPEC = 384 * KiB, WS_ROPES = 448 * KiB;
constexpr size_t WS_F1T = 512 * KiB, WS_F2P = 640 * KiB;
constexpr size_t WS_CS256 = 768 * KiB;
constexpr size_t WS_HC = 1 * MiB;
constexpr size_t WS_EID = 2 * MiB;
constexpr size_t WS_GW = 2 * MiB + 256 * KiB;
constexpr size_t WS_SLOT = 2 * MiB + 512 * KiB;
constexpr size_t WS_SSQ = 3 * MiB;
constexpr size_t WS_XTC = 5 * MiB;
constexpr size_t WS_W0IN = 8 * MiB, WS_W0OUT = 14 * MiB, WS_W1IN = 16 * MiB, WS_W1OUT = 28 * MiB;
constexpr size_t AR = 32 * MiB;
constexpr size_t A_XM = AR + 0, A_QK0 = AR + 65 * HMiB, A_VT0 = AR + 81 * MiB + 256 * KiB, A_XT2 = AR + 106 * MiB, A_T2 = AR + 122 * MiB + HMiB, A_AO = AR + 139 * MiB;
constexpr size_t A_XS = AR + 65 * HMiB, A_HD = AR + 106 * MiB, A_MOEW = AR + 245 * MiB;
constexpr size_t B_Q = AR + 0, B_K = AR + 65 * HMiB, B_O = AR + 65 * HMiB, B_KF = AR + 195 * HMiB, B_KB = AR + 130 * MiB, B_SD = AR + 195 * HMiB, B_VT = AR + 325 * HMiB;
constexpr size_t B_XM1 = AR + 455 * HMiB, B_ST = AR + 455 * HMiB, B_XM1B = AR + 0, B_XM2 = AR + 0, B_XS = AR + 195 * HMiB, B_HD = AR + 341 * HMiB;
constexpr size_t WS_END = AR + 294 * MiB;

struct Params {
    const float *x, *c, *ctx, *c_ctx, *ada_w, *ada_b, *norm_g, *final_g, *w0in, *w0out, *rpb, *w1in, *w1out, *decay, *router_w, *router_b, *moe_w1, *moe_w3, *moe_w2;
    float* out; unsigned char* ws; int ph_lo, ph_hi;
};

__device__ __forceinline__ unsigned cvt_pk_bf16(float lo, float hi) { unsigned r; asm volatile("v_cvt_pk_bf16_f32 %0, %1, %2" : "=v"(r) : "v"(lo), "v"(hi)); return r; }
__device__ __forceinline__ bf16_t f2bf(float f) { return (bf16_t)(cvt_pk_bf16(f, 0.f) & 0xffffu); }
__device__ __forceinline__ float bf2f(unsigned short b) { return __uint_as_float(((unsigned)b) << 16); }
__device__ __forceinline__ float bflo(unsigned w) { return __uint_as_float(w << 16); }
__device__ __forceinline__ float bfhi(unsigned w) { return __uint_as_float(w & 0xffff0000u); }
__device__ __forceinline__ float silu_f(float v) { return v / (1.0f + __expf(-v)); }
__device__ __forceinline__ float wave_sum(float v) {
#pragma unroll
    for (int o = 32; o >= 1; o >>= 1) v += __shfl_xor(v, o);
    return v;
}
__device__ __forceinline__ float wave_max(float v) {
#pragma unroll
    for (int o = 32; o >= 1; o >>= 1) v = fmaxf(v, __shfl_xor(v, o));
    return v;
}
#define XB_TMO      128
#define XB_XCNT(j)  (256  + 64 * (j))
#define XB_XSUB(j)  (1280 + 64 * (j))
#define XB_XGEN(j)  (2304 + 64 * (j))
#define XB_TOP      3328
#define XB_TOPGEN   3392
#define XCD_BAR_WORDS 3456
#define XB_SPIN_CAP (1u << 18)

__device__ __forceinline__ unsigned xb_ld(unsigned* p)              { return __hip_atomic_load(p, __ATOMIC_RELAXED, __HIP_MEMORY_SCOPE_AGENT); }
__device__ __forceinline__ unsigned xb_add(unsigned* p, unsigned v) { return __hip_atomic_fetch_add(p, v, __ATOMIC_RELAXED, __HIP_MEMORY_SCOPE_AGENT); }
__device__ __forceinline__ unsigned xb_xcc_id() { return (unsigned)__builtin_amdgcn_s_getreg((3 << 11) | 20) & 0xFu; }
#define XB_SPIN(cond, bar) do { unsigned _sp = 0; while (cond) { __builtin_amdgcn_s_sleep(1); \
    if ((++_sp & 255u) == 0u) { if (xb_ld(&(bar)[XB_TMO])) break; if (_sp > XB_SPIN_CAP) { atomicAdd(&(bar)[XB_TMO], 1u); break; } } } } while (0)

struct XcdBarrier {
    unsigned* bar; unsigned x;
    volatile LAS unsigned* st;
};

__device__ __forceinline__ XcdBarrier xcd_barrier_post(unsigned* bar, volatile LAS unsigned* st) {
    XcdBarrier b; b.bar = bar; b.x = xb_xcc_id(); b.st = st;
    if (threadIdx.x == 0) (void)xb_add(&bar[XB_XCNT(b.x)], 1u);
    return b;
}
__device__ __forceinline__ void xcd_barrier_complete(unsigned* bar, unsigned x, unsigned& nloc, unsigned& nx) {
    const unsigned G = gridDim.x * gridDim.y * gridDim.z;
    unsigned sum, cnt, mine, sp = 0u;
    for (;;) {
        sum = 0u; cnt = 0u; mine = 0u;
#pragma unroll
        for (unsigned j = 0; j < 16; ++j) { const unsigned c = xb_ld(&bar[XB_XCNT(j)]); sum += c; cnt += (c > 0u) ? 1u : 0u; mine = (j == x) ? c : mine; }
        if (sum == G) break;
        __builtin_amdgcn_s_sleep(1);
        if ((++sp & 255u) == 0u) { if (xb_ld(&bar[XB_TMO])) break; if (sp > XB_SPIN_CAP) { atomicAdd(&bar[XB_TMO], 1u); break; } }
    }
    nloc = mine > 0u ? mine : 1u; nx = cnt > 0u ? cnt : 1u;
}

__device__ __forceinline__ void xcd_barrier(const XcdBarrier& b) {
    asm volatile("s_waitcnt vmcnt(0)" ::: "memory");
    __syncthreads();
    if (threadIdx.x == 0) {
        unsigned* bar = b.bar;
        __builtin_amdgcn_s_waitcnt(0);
        unsigned nloc = b.st[0], nx = b.st[1];
        if (nloc == 0u) { xcd_barrier_complete(bar, b.x, nloc, nx); b.st[0] = nloc; b.st[1] = nx; }
        const unsigned old = xb_add(&bar[XB_XSUB(b.x)], 1u);
        const unsigned gen = old / nloc;
        if (old + 1u == (gen + 1u) * nloc) {
            __builtin_amdgcn_fence(__ATOMIC_RELEASE, "agent");
            asm volatile("s_waitcnt vmcnt(0)" ::: "memory");
            const unsigned og = xb_add(&bar[XB_TOP], 1u);
            const unsigned tg = og / nx;
            if (og + 1u == (tg + 1u) * nx) xb_add(&bar[XB_TOPGEN], 1u);
            else XB_SPIN(xb_ld(&bar[XB_TOPGEN]) == tg, bar);
            __builtin_amdgcn_fence(__ATOMIC_ACQUIRE, "agent");
            xb_add(&bar[XB_XGEN(b.x)], 1u);
            asm volatile("s_waitcnt vmcnt(0)" ::: "memory");
        } else {
            XB_SPIN(xb_ld(&bar[XB_XGEN(b.x)]) == gen, bar);
            __builtin_amdgcn_fence(__ATOMIC_ACQUIRE, "agent");
            asm volatile("s_waitcnt vmcnt(0)" ::: "memory");
        }
    }
    __syncthreads();
}
namespace eng {
constexpr int BM = 256, BK = 64, HALF = 128, HTB = HALF * BK * 2, STAGE_BYTES = 8 * HTB;
__device__ __forceinline__ int lds_byte(int r, int c) { const int st = (r >> 4) * 2 + (c >> 5), rr = r & 15, cc = c & 31, ob = rr * 64 + cc * 2; return st * 1024 + (ob ^ (((ob >> 9) & 1) << 5)); }
__device__ __forceinline__ void stage_rc(int b, int& R, int& C) { const int st = b / 1024, sb = b % 1024, swz = sb ^ (((sb >> 9) & 1) << 5); R = (st >> 1) * 16 + swz / 64; C = (st & 1) * 32 + (swz % 64) / 2; }

struct UnitD {
    const char* A0; const char* B0; unsigned lda0, ldb0; int n0;
    const char* A1; const char* B1; unsigned lda1, ldb1; int n1;
    const char* A2; const char* B2; unsigned lda2, ldb2; int n2;
    int kind, i0, i1, i2;
};
struct TD { const char* a; const char* b; unsigned lda, ldb; };
__device__ __forceinline__ TD tile_at(const UnitD& u, int t) {
    TD d;
    if (t < u.n0) { d.a = u.A0 + (size_t)t * 128; d.b = u.B0 + (size_t)t * 128; d.lda = u.lda0; d.ldb = u.ldb0; }
    else if (t < u.n0 + u.n1) { const int s = t - u.n0; d.a = u.A1 + (size_t)s * 128; d.b = u.B1 + (size_t)s * 128; d.lda = u.lda1; d.ldb = u.ldb1; }
    else { const int s = t - u.n0 - u.n1; d.a = u.A2 + (size_t)s * 128; d.b = u.B2 + (size_t)s * 128; d.lda = u.lda2; d.ldb = u.ldb2; }
    return d;
}
typedef f32x4 Acc[2][2][4][2];

template <class P>
__device__ __forceinline__ void gemm_run(LAS unsigned char* lds, const P& ph) {
    const int tid = threadIdx.x, wid = __builtin_amdgcn_readfirstlane(tid >> 6), lane = tid & 63, wr = wid >> 2, wc = wid & 3, fr = lane & 15, fq = lane >> 4;
    int R0, C0; stage_rc(tid * 16, R0, C0);
    const unsigned vR = (unsigned)R0, vC2 = (unsigned)C0 * 2u;
    const unsigned ldsw = (unsigned)wid * 1024u;
    const int aoff = lds_byte(wr * 64 + fr, fq * 8), boff = lds_byte(wc * 32 + fr, fq * 8);
#define EG_SA(b, h) (((b) * 2 + (h)) * HTB)
#define EG_SB(b, h) ((4 + (b) * 2 + (h)) * HTB)
#define EG_STAGE(bufoff, gbase, ld) do { const unsigned _ld = (ld); const char* _g = (gbase) + (size_t)(vR * _ld + vC2); \
        __builtin_amdgcn_global_load_lds((const unsigned*)_g, (LAS unsigned*)(lds + (bufoff) + ldsw), 16, 0, 0); \
        __builtin_amdgcn_global_load_lds((const unsigned*)(_g + (size_t)(64u * _ld)), (LAS unsigned*)(lds + (bufoff) + ldsw + 8192), 16, 0, 0); } while (0)
#define EG_LDA(dst, b, h) do { _Pragma("unroll") for (int m = 0; m < 4; ++m) _Pragma("unroll") for (int k = 0; k < 2; ++k) dst[m][k] = *(const LAS bf16x8*)(lds + EG_SA(b, h) + aoff + m * 2048 + k * 1024); } while (0)
#define EG_LDB(dst, b, h) do { _Pragma("unroll") for (int n = 0; n < 2; ++n) _Pragma("unroll") for (int k = 0; k < 2; ++k) dst[n][k] = *(const LAS bf16x8*)(lds + EG_SB(b, h) + boff + n * 2048 + k * 1024); } while (0)
#define EG_MMA(ai, bj, At, Bt) do { __builtin_amdgcn_s_setprio(1); _Pragma("unroll") for (int m = 0; m < 4; ++m) _Pragma("unroll") for (int n = 0; n < 2; ++n) _Pragma("unroll") for (int k = 0; k < 2; ++k) \
        acc[ai][bj][m][n] = __builtin_amdgcn_mfma_f32_16x16x32_bf16(Bt[n][k], At[m][k], acc[ai][bj][m][n], 0, 0, 0); __builtin_amdgcn_s_setprio(0); } while (0)
#define EG_WAIT_V(n) asm volatile("s_waitcnt vmcnt(" #n ")" ::: "memory")
#define EG_WAIT_L(n) asm volatile("s_waitcnt lgkmcnt(" #n ")" ::: "memory")
#define EG_BAR __builtin_amdgcn_s_barrier()
#define EG_SCHED __builtin_amdgcn_sched_barrier(0)
    UnitD cur; int ui = 0;
    if (!ph.get(0, cur)) return;
    UnitD cu = cur; int cui = 0, ct = 0; bool cvalid = true; TD lastTD = tile_at(cur, 0);
#define EG_NEXT(dst) do { if (cvalid) { dst = tile_at(cu, ct); lastTD = dst; ++ct; if (ct == cu.n0 + cu.n1 + cu.n2) { ++cui; ct = 0; cvalid = ph.get(cui, cu); } } else dst = lastTD; } while (0)
    Acc acc;
#pragma unroll
    for (int a = 0; a < 2; ++a)
#pragma unroll
        for (int b = 0; b < 2; ++b)
#pragma unroll
            for (int m = 0; m < 4; ++m)
#pragma unroll
                for (int n = 0; n < 2; ++n) acc[a][b][m][n] = (f32x4){0.f, 0.f, 0.f, 0.f};
    bf16x8 At[4][2], B0[2][2], B1[2][2];
    TD d1, d2, d3;
    { TD d0; EG_NEXT(d0); EG_NEXT(d1);
      EG_STAGE(EG_SB(0, 0), d0.b, d0.ldb); EG_STAGE(EG_SA(0, 0), d0.a, d0.lda); EG_STAGE(EG_SB(0, 1), d0.b + (size_t)(128u * d0.ldb), d0.ldb); EG_STAGE(EG_SA(0, 1), d0.a + (size_t)(128u * d0.lda), d0.lda); }
    if (wr == 1) EG_BAR;
    EG_WAIT_V(4); EG_BAR;
    EG_STAGE(EG_SB(1, 0), d1.b, d1.ldb); EG_STAGE(EG_SA(1, 0), d1.a, d1.lda); EG_STAGE(EG_SB(1, 1), d1.b + (size_t)(128u * d1.ldb), d1.ldb);
    EG_WAIT_V(6); EG_BAR;
    int tc = 0;
    for (;;) {
        EG_NEXT(d2); EG_NEXT(d3);
        if constexpr (P::HOOKS) { int fr_o = fr; asm volatile("" : "+v"(fr_o)); ph.hook(tc, acc, cur, wr, wc, fr_o, fq); }
        EG_LDB(B0, 0, 0); EG_SCHED; EG_LDA(At, 0, 0); EG_STAGE(EG_SA(1, 1), d1.a + (size_t)(128u * d1.lda), d1.lda);
        EG_WAIT_L(8); EG_BAR; EG_WAIT_L(0); EG_MMA(0, 0, At, B0); EG_BAR; EG_SCHED;
        EG_LDB(B1, 0, 1); EG_STAGE(EG_SB(0, 0), d2.b, d2.ldb);
        EG_BAR; EG_WAIT_L(0); EG_MMA(0, 1, At, B1); EG_BAR;
        EG_LDA(At, 0, 1); EG_STAGE(EG_SA(0, 0), d2.a, d2.lda);
        EG_BAR; EG_WAIT_L(0); EG_MMA(1, 0, At, B0); EG_BAR; EG_SCHED;
        EG_STAGE(EG_SB(0, 1), d2.b + (size_t)(128u * d2.ldb), d2.ldb);
        EG_WAIT_V(6); EG_BAR; EG_MMA(1, 1, At, B1); EG_BAR;
        EG_LDB(B0, 1, 0); EG_SCHED; EG_LDA(At, 1, 0); EG_STAGE(EG_SA(0, 1), d2.a + (size_t)(128u * d2.lda), d2.lda);
        EG_WAIT_L(8); EG_BAR; EG_WAIT_L(0); EG_MMA(0, 0, At, B0); EG_BAR; EG_SCHED;
        EG_LDB(B1, 1, 1); EG_STAGE(EG_SB(1, 0), d3.b, d3.ldb);
        EG_BAR; EG_WAIT_L(0); EG_MMA(0, 1, At, B1); EG_BAR;
        EG_LDA(At, 1, 1); EG_STAGE(EG_SA(1, 0), d3.a, d3.lda);
        EG_BAR; EG_WAIT_L(0); EG_MMA(1, 0, At, B0); EG_BAR; EG_SCHED;
        EG_STAGE(EG_SB(1, 1), d3.b + (size_t)(128u * d3.ldb), d3.ldb);
        EG_WAIT_V(6); EG_BAR; EG_MMA(1, 1, At, B1); EG_BAR;
        d1 = d3; tc += 2;
        if (tc == cur.n0 + cur.n1 + cur.n2) {
            { int fr_o = fr, fq_o = fq; asm volatile("" : "+v"(fr_o), "+v"(fq_o));
              ph.epi(acc, cur, wr, wc, fr_o, fq_o); }
            ++ui; tc = 0;
            if (!ph.get(ui, cur)) break;
#pragma unroll
            for (int a = 0; a < 2; ++a)
#pragma unroll
                for (int b = 0; b < 2; ++b)
#pragma unroll
                    for (int m = 0; m < 4; ++m)
#pragma unroll
                        for (int n = 0; n < 2; ++n) acc[a][b][m][n] = (f32x4){0.f, 0.f, 0.f, 0.f};
        }
    }
    EG_WAIT_V(0);
    if (wr == 0) EG_BAR;
    EG_BAR;
#undef EG_NEXT
}
__device__ __forceinline__ void unit1(UnitD& u, const void* A, unsigned lda, const void* B, unsigned ldb, int nt) {
    u.A0 = (const char*)A; u.B0 = (const char*)B; u.lda0 = lda; u.ldb0 = ldb; u.n0 = nt;
    u.A1 = u.A0; u.B1 = u.B0; u.lda1 = lda; u.ldb1 = ldb; u.n1 = 0; u.A2 = u.A0; u.B2 = u.B0; u.lda2 = lda; u.ldb2 = ldb; u.n2 = 0;
    u.kind = 0; u.i0 = 0; u.i1 = 0; u.i2 = 0;
}
}
using eng::UnitD; using eng::Acc;
__device__ __forceinline__ void efence() { asm volatile("" ::: "memory"); }
#define EPI_ARGS const Acc& acc, const UnitD& u, int wr, int wc, int fr, int fq
#define FOR_FRAG(ai, bj, m, n) _Pragma("unroll") for (int ai = 0; ai < 2; ++ai) _Pragma("unroll") for (int m = 0; m < 4; ++m) _Pragma("unroll") for (int bj = 0; bj < 2; efence(), ++bj) _Pragma("unroll") for (int n = 0; n < 2; ++n)
#define FRAG_ROW(ai, m) (128 * (ai) + 64 * wr + 16 * (m) + fr)
#define FRAG_COL(bj, n) (128 * (bj) + 32 * wc + 16 * (n) + 4 * fq)
__device__ __forceinline__ void st_bf16x4(bf16_t* p, f32x4 v) { u32x2 w; w.x = cvt_pk_bf16(v[0], v[1]); w.y = cvt_pk_bf16(v[2], v[3]); *(u32x2*)p = w; }
struct Frame { Params p; LAS unsigned char* lds; int tid, lane, wid, G, bid; };
#define WSP(T, off) ((T*)(F.p.ws + (off)))

template <class RowSrc>
__device__ __forceinline__ void conv_T(const Frame& F, bf16_t* dst, int nrows, int K, int ld, float scale, const RowSrc& rs) {
    LAS float* tile = (LAS float*)F.lds;
    const int tx = F.tid & 63, ty = F.tid >> 6, nkt = K / 64, ntiles = (nrows / 64) * nkt;
    for (int it = F.bid; it < ntiles; it += F.G) {
        const int rt = it / nkt, kt = it % nkt, r0 = rt * 64, k0 = kt * 64;
        const float* sp = rs(r0 + tx);
#pragma unroll
        for (int p = 0; p < 8; ++p) { const int i = p * 8 + ty; tile[i * 65 + tx] = sp[(size_t)(k0 + i) * ld]; }
        __syncthreads();
#pragma unroll
        for (int p = 0; p < 8; ++p) { const int j = p * 8 + ty; dst[(size_t)(r0 + j) * K + k0 + tx] = f2bf(tile[tx * 65 + j] * scale); }
        __syncthreads();
    }
}
__device__ __forceinline__ int sigma_orig(int s) {
    const int half = s >> 7, s2 = s & 127, uu = s2 >> 5, b = (s2 >> 4) & 1, f = s2 & 15; return half * 128 + 16 * uu + f + 64 * b;
}
__device__ __forceinline__ void conv_moe(const Frame& F, int layer) {
    bf16_t* w13 = WSP(bf16_t, A_MOEW); bf16_t* w2t = WSP(bf16_t, A_MOEW + 32 * MiB);
    for (int e = 0; e < 16; ++e) {
        const float* w1 = F.p.moe_w1 + ((size_t)layer * 16 + e) * 1024 * 512; const float* w3 = F.p.moe_w3 + ((size_t)layer * 16 + e) * 1024 * 512;
        conv_T(F, w13 + (size_t)e * 1024 * 1024, 1024, 1024, 512, 1.0f, [=](int r) { const int j = r >> 8, rr = r & 255; return rr < 128 ? w1 + 128 * j + rr : w3 + 128 * j + rr - 128; });
        const float* w2 = F.p.moe_w2 + ((size_t)layer * 16 + e) * 512 * 1024;
        conv_T(F, w2t + (size_t)e * 1024 * 512, 1024, 512, 1024, 1.0f, [=](int r) { return w2 + r; });
    }
}
__device__ __forceinline__ void p0_prologue(const Frame& F) {
    const float TWO_PI = 6.283185307179586f;
    {
        LAS float* sc0 = (LAS float*)F.lds; LAS float* sc1 = sc0 + 1024; LAS float* red = sc1 + 1024;
        for (int k = F.tid; k < 1024; k += 512) { sc0[k] = silu_f(F.p.c[k]); sc1[k] = silu_f(F.p.c_ctx[k]); }
        __syncthreads();
        float* mod = WSP(float, WS_MOD);
        for (int item = F.bid; item < 192; item += F.G) {
            const int l = item / 96, col0 = (item % 96) * 64, l16 = F.tid & 15, kg = F.tid >> 4;
            f32x4 a0 = {0.f, 0.f, 0.f, 0.f}, a1 = {0.f, 0.f, 0.f, 0.f};
            for (int i = 0; i < 32; ++i) { const int k = kg + 32 * i; const f32x4 w = *(const f32x4*)(F.p.ada_w + ((size_t)l * 1024 + k) * 6144 + col0 + l16 * 4); a0 += sc0[k] * w; a1 += sc1[k] * w; }
#pragma unroll
            for (int e = 0; e < 4; ++e) { red[(kg * 64 + l16 * 4 + e) * 2 + 0] = a0[e]; red[(kg * 64 + l16 * 4 + e) * 2 + 1] = a1[e]; }
            __syncthreads();
            if (F.tid < 128) { const int col = F.tid & 63, which = F.tid >> 6; float s = 0.f; for (int g = 0; g < 32; ++g) s += red[(g * 64 + col) * 2 + which];
                mod[(size_t)which * 2 * 6144 + l * 6144 + col0 + col] = s + F.p.ada_b[l * 6144 + col0 + col]; }
            __syncthreads();
        }
    }
    {
        const int gt = F.bid * 512 + F.tid, gn = F.G * 512;
        float* twc = WSP(float, WS_TWC); float* tws = WSP(float, WS_TWS);
        for (int i = gt; i < 128 * 128; i += gn) { const int b = i >> 7, k1 = i & 127; const float a = (float)((b * k1) & 16383) * (TWO_PI / 16384.0f); twc[i] = cosf(a); tws[i] = sinf(a); }
        float* rc = WSP(float, WS_ROPEC); float* rs = WSP(float, WS_ROPES);
        for (int i = gt; i < 256 * 64; i += gn) { const int pos = i >> 6, fi = i & 63; const float inv = powf(10000.0f, -(float)fi / 64.0f); const float a = (float)pos * inv; rc[i] = cosf(a); rs[i] = sinf(a); }
        bf16_t* f1 = WSP(bf16_t, WS_F1T); bf16_t* f2 = WSP(bf16_t, WS_F2P);
        for (int i = gt; i < 256 * 256; i += gn) { const int n = i >> 8, k = i & 255, k1 = n & 127, a = k & 127; const float ang = (float)((a * k1) & 127) * (TWO_PI / 128.0f); const float cs = cosf(ang), sn = sinf(ang);
            float v1; if (n < 128) v1 = (k < 128) ? cs : sn; else v1 = (k < 128) ? -sn : cs;
            f1[i] = f2bf(v1);
            f2[i] = f2bf(n < 128 ? ((k < 128) ? cs : sn) * (1.0f / 128.0f) : 0.0f); }
        bf16_t* cs256 = WSP(bf16_t, WS_CS256);
        for (int i = gt; i < 256 * 512; i += gn) { const int k = i >> 9, j = i & 511, n = j & 255; const float ang = (float)((n * k) & 255) * (TWO_PI / 256.0f); cs256[i] = f2bf((j < 256 ? cosf(ang) : sinf(ang)) * (1.0f / 16.0f)); }
    }
    {
        LAS float* ct = (LAS float*)F.lds;
        __syncthreads();
        if (F.tid < 64) ct[F.tid] = cosf((float)F.tid * (TWO_PI / 64.0f));
        __syncthreads();
        bf16_t* dst = WSP(bf16_t, WS_W0IN);
        for (int idx = F.bid * 512 + F.tid; idx < 512 * 1024; idx += F.G * 512) {
            const int r = idx >> 10, k = idx & 1023, part = r >> 8, cc = r & 255, g = cc >> 6, cp = cc & 63;
            const float* w = F.p.w0in + (size_t)k * 2560 + g * 64; float s = 0.f;
#pragma unroll 8
            for (int c = 0; c < 64; ++c) { const int ph = (c * cp) & 63; const float t = part ? -ct[(ph + 48) & 63] : ct[ph]; s += w[c] * t; }
            dst[(size_t)(1536 + r) * 1024 + k] = f2bf(s * 0.125f);
        }
        __syncthreads();
    }
    { const float* w = F.p.w0in; bf16_t* d = WSP(bf16_t, WS_W0IN);
      conv_T(F, d, 1536, 1024, 2560, 1.0f, [=](int r) { return w + 256 + r; });
      conv_T(F, d + (size_t)2048 * 1024, 768, 1024, 2560, 1.0f, [=](int r) { return w + 1792 + r; }); }
    { const float* w = F.p.w0out; conv_T(F, WSP(bf16_t, WS_W0OUT), 1024, 1024, 1024, 1.0f, [=](int r) { return w + r; }); }
    { const float* w = F.p.w1in; bf16_t* d = WSP(bf16_t, WS_W1IN);
      conv_T(F, d, 1024, 1024, 6144, 1.0f, [=](int r) { return w + (r & ~255) + sigma_orig(r & 255); });
      conv_T(F, d + (size_t)1024 * 1024, 1024, 1024, 6144, 0.0625f, [=](int r) { return w + 1024 + (r & ~255) + sigma_orig(r & 255); });
      conv_T(F, d + (size_t)2048 * 1024, 4096, 1024, 6144, 1.0f, [=](int r) { return w + 2048 + r; }); }
    { const float* w = F.p.w1out; conv_T(F, WSP(bf16_t, WS_W1OUT), 1024, 2048, 1024, 1.0f, [=](int r) { return w + r; }); }
    conv_moe(F, 0);
}

struct Row { f32x4 v[4]; };
__device__ __forceinline__ void row_load(Row& r, const float* p, int lane) {
#pragma unroll
    for (int i = 0; i < 4; ++i) r.v[i] = *(const f32x4*)(p + 4 * lane + 256 * i);
}
__device__ __forceinline__ void row_store(const Row& r, float* p, int lane) {
#pragma unroll
    for (int i = 0; i < 4; ++i) *(f32x4*)(p + 4 * lane + 256 * i) = r.v[i];
}
__device__ __forceinline__ float row_rstd(const Row& r) {
    float s = 0.f;
#pragma unroll
    for (int i = 0; i < 4; ++i) s += (r.v[i][0] * r.v[i][0] + r.v[i][1] * r.v[i][1]) + (r.v[i][2] * r.v[i][2] + r.v[i][3] * r.v[i][3]);
    s = wave_sum(s);
    return rsqrtf(s * (1.0f / 1024.0f) + RMS_EPS);
}
__device__ __forceinline__ void row_norm_mod(Row& r, const float* g, const float* sh, const float* sc, int lane) {
    const float rs = row_rstd(r);
#pragma unroll
    for (int i = 0; i < 4; ++i) { const int c = 4 * lane + 256 * i; const f32x4 gv = *(const f32x4*)(g + c), shv = *(const f32x4*)(sh + c), scv = *(const f32x4*)(sc + c);
        r.v[i] = (r.v[i] * rs) * gv * (1.0f + scv) + shv; }
}
__device__ __forceinline__ void row_store_bf16(const Row& r, bf16_t* p, int lane) {
#pragma unroll
    for (int i = 0; i < 4; ++i) st_bf16x4(p + 4 * lane + 256 * i, r.v[i]);
}
__device__ __forceinline__ const float* modp(const Frame& F, int layer, bool is_ctx) { return WSP(const float, WS_MOD) + (size_t)(is_ctx ? 2 : 0) * 6144 + layer * 6144; }
__device__ __forceinline__ float* hrow(const Frame& F, int t) { return t < CTXN ? WSP(float, WS_HC) + (size_t)t * DM : F.p.out + (size_t)(t - CTXN) * DM; }

__device__ __forceinline__ void p_norm_in(const Frame& F) {
    bf16_t* xm = WSP(bf16_t, A_XM);
    for (int t = F.bid * 8 + F.wid; t < TT; t += F.G * 8) {
        const bool ic = t < CTXN; const float* src = ic ? F.p.ctx + (size_t)t * DM : F.p.x + (size_t)(t - CTXN) * DM; const float* m = modp(F, 0, ic);
        Row r; row_load(r, src, F.lane); row_norm_mod(r, F.p.norm_g, m, m + 1024, F.lane); row_store_bf16(r, xm + (size_t)t * DM, F.lane);
    }
}
__device__ __forceinline__ void p_norm_l1(const Frame& F, bf16_t* dst) {
    for (int t = CTXN + F.bid * 8 + F.wid; t < TT; t += F.G * 8) {
        const float* m = modp(F, 1, false);
        Row r; row_load(r, hrow(F, t), F.lane); row_norm_mod(r, F.p.norm_g + 2 * DM, m, m + 1024, F.lane); row_store_bf16(r, dst + (size_t)t * DM, F.lane);
    }
}

__device__ __forceinline__ void p_router(const Frame& F, int layer, int t0, bf16_t* dst) {
    LAS float* rwT = (LAS float*)F.lds;
    LAS unsigned* lcnt = (LAS unsigned*)(F.lds + 65536);
    for (int i = F.tid; i < 16 * 1024; i += 512) { const int e = i >> 10, c = i & 1023; rwT[i] = F.p.router_w[c * 16 + e]; }
    if (F.tid < 32) lcnt[F.tid] = 0u;
    __syncthreads();
    int* eid = WSP(int, WS_EID); float* gw = WSP(float, WS_GW); int* slot = WSP(int, WS_SLOT);
    unsigned* gcnt = (unsigned*)(F.p.ws + WS_CTL + CTL_CNT) + layer * 64;
    for (int t = t0 + F.bid * 8 + F.wid; t < TT; t += F.G * 8) {
        const bool ic = t < CTXN; const float* m = modp(F, layer, ic);
        Row r; row_load(r, hrow(F, t), F.lane); row_norm_mod(r, F.p.norm_g + (size_t)(layer * 2 + 1) * DM, m + 3072, m + 4096, F.lane); row_store_bf16(r, dst + (size_t)t * DM, F.lane);
        float lg[16];
#pragma unroll
        for (int e = 0; e < 16; ++e) { float s = 0.f;
#pragma unroll
            for (int i = 0; i < 4; ++i) { const f32x4 w = *(const LAS f32x4*)(rwT + e * 1024 + 4 * F.lane + 256 * i); s += (r.v[i][0] * w[0] + r.v[i][1] * w[1]) + (r.v[i][2] * w[2] + r.v[i][3] * w[3]); }
            lg[e] = wave_sum(s); }
        float scv[16], bi[16];
#pragma unroll
        for (int e = 0; e < 16; ++e) { scv[e] = 1.0f / (1.0f + __expf(-lg[e])); bi[e] = scv[e] + F.p.router_b[e]; }
        int gsel = 0; float best = -1e30f;
#pragma unroll
        for (int g = 0; g < 4; ++g) { const float a = bi[4 * g], b = bi[4 * g + 1], c = bi[4 * g + 2], d = bi[4 * g + 3];
            const float h1 = fmaxf(a, b), l1 = fminf(a, b), h2 = fmaxf(c, d), l2 = fminf(c, d); const float gs = fmaxf(h1, h2) + fmaxf(fminf(h1, h2), fmaxf(l1, l2));
            if (gs > best) { best = gs; gsel = g; } }
        float vb[4], vs[4];
#pragma unroll
        for (int i = 0; i < 4; ++i) { vb[i] = gsel == 0 ? bi[i] : gsel == 1 ? bi[4 + i] : gsel == 2 ? bi[8 + i] : bi[12 + i]; vs[i] = gsel == 0 ? scv[i] : gsel == 1 ? scv[4 + i] : gsel == 2 ? scv[8 + i] : scv[12 + i]; }
        int i0 = 0; float b0 = vb[0];
#pragma unroll
        for (int i = 1; i < 4; ++i) if (vb[i] > b0) { b0 = vb[i]; i0 = i; }
        int i1 = -1; float b1 = -1e30f;
#pragma unroll
        for (int i = 0; i < 4; ++i) if (i != i0 && vb[i] > b1) { b1 = vb[i]; i1 = i; }
        const float s0 = i0 == 0 ? vs[0] : i0 == 1 ? vs[1] : i0 == 2 ? vs[2] : vs[3], s1 = i1 == 0 ? vs[0] : i1 == 1 ? vs[1] : i1 == 2 ? vs[2] : vs[3];
        const float inv = 1.0f / (s0 + s1);
        if (F.lane == 0) {
            const int e0 = gsel * 4 + i0, e1 = gsel * 4 + i1;
            const unsigned r0 = __hip_atomic_fetch_add(lcnt + e0, 1u, __ATOMIC_RELAXED, __HIP_MEMORY_SCOPE_WORKGROUP), r1 = __hip_atomic_fetch_add(lcnt + e1, 1u, __ATOMIC_RELAXED, __HIP_MEMORY_SCOPE_WORKGROUP);
            eid[2 * t] = e0; eid[2 * t + 1] = e1; gw[2 * t] = s0 * inv; gw[2 * t + 1] = s1 * inv; slot[2 * t] = (int)r0; slot[2 * t + 1] = (int)r1;
        }
    }
    __syncthreads();
    if (F.tid < 16) lcnt[16 + F.tid] = __hip_atomic_fetch_add(gcnt + F.tid, lcnt[F.tid], __ATOMIC_RELAXED, __HIP_MEMORY_SCOPE_AGENT);
    __syncthreads();
    for (int t = t0 + F.bid * 8 + F.wid; t < TT; t += F.G * 8)
        if (F.lane < 2) slot[2 * t + F.lane] += (int)lcnt[16 + eid[2 * t + F.lane]];
    __syncthreads();
}
struct PanelTab { int pst[17]; };
__device__ __forceinline__ void panel_tab(const Frame& F, int layer, PanelTab& pt) {
    const unsigned* gcnt = (const unsigned*)(F.p.ws + WS_CTL + CTL_CNT) + layer * 64;
    pt.pst[0] = 0;
#pragma unroll
    for (int e = 0; e < 16; ++e) pt.pst[e + 1] = pt.pst[e] + (int)((__builtin_amdgcn_readfirstlane(gcnt[e]) + 255u) >> 8);
}
__device__ __forceinline__ void p_gather(const Frame& F, int layer, int t0, const bf16_t* xm2, bf16_t* xs) {
    PanelTab pt; panel_tab(F, layer, pt);
    const int* eid = WSP(const int, WS_EID); int* slot = WSP(int, WS_SLOT);
    for (int t = t0 + F.bid * 8 + F.wid; t < TT; t += F.G * 8) {
        const u32x4* src = (const u32x4*)(xm2 + (size_t)t * DM); const u32x4 a = src[F.lane], b = src[64 + F.lane];
#pragma unroll
        for (int k = 0; k < 2; ++k) {
            const int e = eid[2 * t + k]; int ps = 0;
#pragma unroll
            for (int j = 0; j < 16; ++j) ps = (e == j) ? pt.pst[j] : ps;
            const int s = ps * 256 + slot[2 * t + k];
            u32x4* d = (u32x4*)(xs + (size_t)s * DM); d[F.lane] = a; d[64 + F.lane] = b;
            if (F.lane == 0) slot[2 * t + k] = s;
        }
    }
}
__device__ __forceinline__ void row_moe_combine(const Frame& F, Row& r, int t, int layer, const bf16_t* Y) {
    const int* slot = WSP(const int, WS_SLOT); const float* gw = WSP(const float, WS_GW);
    const int s0 = slot[2 * t], s1 = slot[2 * t + 1]; const float w0 = gw[2 * t], w1 = gw[2 * t + 1];
    const float* g2 = modp(F, layer, t < CTXN) + 5120;
#pragma unroll
    for (int i = 0; i < 4; ++i) { const int c = 4 * F.lane + 256 * i;
        const u32x2 a = *(const u32x2*)(Y + (size_t)s0 * DM + c), b = *(const u32x2*)(Y + (size_t)s1 * DM + c); const f32x4 gv = *(const f32x4*)(g2 + c);
        f32x4 f; f[0] = w0 * bflo(a.x) + w1 * bflo(b.x); f[1] = w0 * bfhi(a.x) + w1 * bfhi(b.x); f[2] = w0 * bflo(a.y) + w1 * bflo(b.y); f[3] = w0 * bfhi(a.y) + w1 * bfhi(b.y);
        r.v[i] += gv * f; }
}
__device__ __forceinline__ void p_combine0(const Frame& F) {
    const bf16_t* Y = WSP(const bf16_t, A_XS); bf16_t* xm1 = WSP(bf16_t, B_XM1);
    for (int t = F.bid * 8 + F.wid; t < TT; t += F.G * 8) {
        Row r; float* hp = hrow(F, t); row_load(r, hp, F.lane); row_moe_combine(F, r, t, 0, Y); row_store(r, hp, F.lane);
        const float* m = modp(F, 1, t < CTXN); row_norm_mod(r, F.p.norm_g + 2 * DM, m, m + 1024, F.lane); row_store_bf16(r, xm1 + (size_t)t * DM, F.lane);
    }
}
__device__ __forceinline__ void p_final(const Frame& F) {
    const bf16_t* Y = WSP(const bf16_t, B_XS);
    for (int t = CTXN + F.bid * 8 + F.wid; t < TT; t += F.G * 8) {
        Row r; float* hp = hrow(F, t); row_load(r, hp, F.lane); row_moe_combine(F, r, t, 1, Y);
        const float rs = row_rstd(r);
#pragma unroll
        for (int i = 0; i < 4; ++i) { const f32x4 gv = *(const f32x4*)(F.p.final_g + 4 * F.lane + 256 * i); r.v[i] = (r.v[i] * rs) * gv; }
        row_store(r, hp, F.lane);
    }
}
__device__ __forceinline__ float log_gamma(const Frame& F, int dir, int h) { return log1pf(-expf(F.p.decay[dir * 4 + h])); }
__device__ __forceinline__ void p_scan(const Frame& F) {
    bf16_t* st = WSP(bf16_t, B_ST);
    const int item = F.bid * 512 + F.tid;
    for (int it = item; it < 8 * 16384; it += F.G * 512) {
        const int hd = it >> 14, grp = it & 16383, h = hd >> 1, dir = hd & 1;
        const float lg = log_gamma(F, dir, h), d256 = __expf(256.0f * lg), d512 = __expf(512.0f * lg);
        float s[8];
#pragma unroll
        for (int j = 0; j < 8; ++j) s[j] = 0.f;
#pragma unroll 4
        for (int step = 0; step < 33; ++step) {
            const int c = (dir == 0 || step == 0) ? step : 33 - step;
            u32x4* p = (u32x4*)(st + ((size_t)(c * 8 + hd) * 131072 + (size_t)grp * 8));
            const u32x4 uv = *p; const float dec = (c == 0) ? d256 : d512;
            u32x4 o; o.x = cvt_pk_bf16(s[0], s[1]); o.y = cvt_pk_bf16(s[2], s[3]); o.z = cvt_pk_bf16(s[4], s[5]); o.w = cvt_pk_bf16(s[6], s[7]);
            *p = o;
            s[0] = s[0] * dec + bflo(uv.x); s[1] = s[1] * dec + bfhi(uv.x); s[2] = s[2] * dec + bflo(uv.y); s[3] = s[3] * dec + bfhi(uv.y);
            s[4] = s[4] * dec + bflo(uv.z); s[5] = s[5] * dec + bfhi(uv.z); s[6] = s[6] * dec + bflo(uv.w); s[7] = s[7] * dec + bfhi(uv.w);
        }
    }
}
#define PH_COMMON const unsigned char* ws; int G, bid; static constexpr bool HOOKS = false; \
    __device__ __forceinline__ void hook(int, Acc&, const UnitD&, int, int, int, int) const {}
#define WSC(T, off) ((T*)(ws + (off)))
__device__ __forceinline__ float sel4(f32x4 v, int h) { const float a = h == 0 ? v[0] : v[1], b = h == 2 ? v[2] : v[3]; return h < 2 ? a : b; }
#define SEL4(a, h) sel4(a, h)
#define EFENCE asm volatile("" ::: "memory")

struct PhG1 { PH_COMMON
    __device__ __forceinline__ bool get(int i, UnitD& u) const {
        const int idx = bid + i * G; if (idx >= 715) return false;
        const char* xm = (const char*)(ws + A_XM); const char* w = (const char*)(ws + WS_W0IN);
        if (idx < 390) { const int pm = idx / 6, pn = idx % 6; eng::unit1(u, xm + (size_t)pm * 256 * 2048, 2048, w + (size_t)pn * 256 * 2048, 2048, 16); u.kind = 0; u.i0 = pm; u.i1 = pn; }
        else { const int j = idx - 390, rt = j / 65, ct = j % 65; eng::unit1(u, w + (size_t)(1536 + rt * 256) * 2048, 2048, xm + (size_t)ct * 256 * 2048, 2048, 16); u.kind = rt < 2 ? 1 : 2; u.i0 = rt; u.i1 = ct; }
        return true;
    }
    __device__ __forceinline__ void epi(EPI_ARGS) const {
        if (u.kind == 0) { bf16_t* o = WSC(bf16_t, A_QK0) + (size_t)(u.i0 * 256) * QK0_LD + u.i1 * 256;
            FOR_FRAG(ai, bj, m, n) st_bf16x4(o + (size_t)FRAG_ROW(ai, m) * QK0_LD + FRAG_COL(bj, n), acc[ai][bj][m][n]); }
        else if (u.kind == 2) { bf16_t* o = WSC(bf16_t, A_VT0) + (size_t)((u.i0 - 2) * 256) * TT + u.i1 * 256;
            FOR_FRAG(ai, bj, m, n) st_bf16x4(o + (size_t)FRAG_ROW(ai, m) * TT + FRAG_COL(bj, n), acc[ai][bj][m][n]); }
        else if (u.i1 == 0) { bf16_t* o = WSC(bf16_t, WS_XTC) + u.i0 * 256;
            FOR_FRAG(ai, bj, m, n) st_bf16x4(o + (size_t)FRAG_ROW(ai, m) * 512 + FRAG_COL(bj, n), acc[ai][bj][m][n]); }
        else { bf16_t* o = WSC(bf16_t, A_XT2) + u.i0 * 128;
            FOR_FRAG(ai, bj, m, n) { const int cc = FRAG_ROW(ai, m), nn = (u.i1 - 1) * 256 + FRAG_COL(bj, n), a = nn >> 7, b = nn & 127; const f32x4 v = acc[ai][bj][m][n];
#pragma unroll
                for (int e = 0; e < 4; ++e) o[(size_t)(cc * 128 + b + e) * 256 + a] = f2bf(v[e]);
                EFENCE; } }
    }
};
struct PhF1 { PH_COMMON
    __device__ __forceinline__ bool get(int i, UnitD& u) const {
        const int idx = bid + i * G; if (idx >= 129) return false;
        if (idx < 128) { eng::unit1(u, ws + A_XT2 + (size_t)idx * 256 * 512, 512, ws + WS_F1T, 512, 4); u.kind = 0; u.i0 = idx; }
        else { eng::unit1(u, ws + WS_CS256, 1024, ws + WS_XTC, 1024, 8); u.kind = 1; }
        return true;
    }
    __device__ __forceinline__ void epi(EPI_ARGS) const {
        if (u.kind == 1) { bf16_t* o = WSC(bf16_t, A_AO); FOR_FRAG(ai, bj, m, n) st_bf16x4(o + (size_t)FRAG_ROW(ai, m) * DM + FRAG_COL(bj, n), acc[ai][bj][m][n]); return; }
        const float* twc = WSC(const float, WS_TWC); const float* tws = WSC(const float, WS_TWS); bf16_t* o = WSC(bf16_t, A_T2);
#pragma unroll
        for (int m = 0; m < 4; ++m)
#pragma unroll
            for (int n = 0; n < 2; ++n) { const int b = 64 * wr + 16 * m + fr, k1 = 32 * wc + 16 * n + 4 * fq; const f32x4 cv = *(const f32x4*)(twc + b * 128 + k1), sv = *(const f32x4*)(tws + b * 128 + k1);
#pragma unroll
                for (int ai = 0; ai < 2; ++ai) { const int cc = 2 * u.i0 + ai; const f32x4 tr = acc[ai][0][m][n], ti = acc[ai][1][m][n];
#pragma unroll
                    for (int e = 0; e < 4; ++e) { bf16_t* q = o + (size_t)((k1 + e) * 256 + cc) * 256 + b; q[0] = f2bf(tr[e] * cv[e] + ti[e] * sv[e]); q[128] = f2bf(ti[e] * cv[e] - tr[e] * sv[e]); } } }
    }
};
struct PhF2 { PH_COMMON
    __device__ __forceinline__ bool get(int i, UnitD& u) const {
        const int idx = bid + i * G; if (idx >= 128) return false;
        eng::unit1(u, ws + WS_F2P, 512, ws + A_T2 + (size_t)idx * 256 * 512, 512, 4); u.i0 = idx; return true;
    }
    __device__ __forceinline__ void epi(EPI_ARGS) const {
        bf16_t* o = WSC(bf16_t, A_AO);
#pragma unroll
        for (int m = 0; m < 4; ++m)
#pragma unroll
            for (int bj = 0; bj < 2; ++bj)
#pragma unroll
                for (int n = 0; n < 2; ++n) { const int k2 = FRAG_ROW(0, m); st_bf16x4(o + (size_t)(CTXN + u.i0 + 128 * k2) * DM + FRAG_COL(bj, n), acc[0][bj][m][n]); }
    }
};
struct PhG2 { PH_COMMON const float* x; const float* ctx; float* out;
    __device__ __forceinline__ bool get(int i, UnitD& u) const {
        const int idx = bid + i * G; if (idx >= 260) return false;
        const int pm = idx >> 2, pn = idx & 3; eng::unit1(u, ws + A_AO + (size_t)pm * 256 * 2048, 2048, ws + WS_W0OUT + (size_t)pn * 256 * 2048, 2048, 16); u.i0 = pm; u.i1 = pn; return true;
    }
    __device__ __forceinline__ void epi(EPI_ARGS) const {
        const bool ic = u.i0 == 0; const float* g1 = WSC(const float, WS_MOD) + (ic ? 2 * 6144 : 0) + 2048 + u.i1 * 256;
        const float* src = ic ? ctx : x + (size_t)(u.i0 - 1) * 256 * DM; float* dst = ic ? WSC(float, WS_HC) : out + (size_t)(u.i0 - 1) * 256 * DM;
        FOR_FRAG(ai, bj, m, n) { const size_t off = (size_t)FRAG_ROW(ai, m) * DM + u.i1 * 256 + FRAG_COL(bj, n); const f32x4 gv = *(const f32x4*)(g1 + FRAG_COL(bj, n));
            *(f32x4*)(dst + off) = *(const f32x4*)(src + off) + gv * acc[ai][bj][m][n]; }
    }
};
struct PhM1 { PH_COMMON PanelTab pt; size_t xs, hd;
    __device__ __forceinline__ bool get(int i, UnitD& u) const {
        const int idx = bid + i * G; if (idx >= pt.pst[16] * 4) return false;
        const int p = idx >> 2, j = idx & 3; int e = 0;
#pragma unroll
        for (int k = 1; k < 16; ++k) e += (p >= pt.pst[k]) ? 1 : 0;
        eng::unit1(u, ws + xs + (size_t)p * 256 * 2048, 2048, ws + A_MOEW + ((size_t)e * 1024 + j * 256) * 2048, 2048, 16); u.i0 = p; u.i1 = j; return true;
    }
    __device__ __forceinline__ void epi(EPI_ARGS) const {
        bf16_t* o = (bf16_t*)(ws + hd) + (size_t)(u.i0 * 256) * 512 + u.i1 * 128;
#pragma unroll
        for (int ai = 0; ai < 2; ++ai)
#pragma unroll
            for (int m = 0; m < 4; ++m)
#pragma unroll
                for (int n = 0; n < 2; ++n) { const f32x4 a = acc[ai][0][m][n], b = acc[ai][1][m][n]; f32x4 v;
#pragma unroll
                    for (int e = 0; e < 4; ++e) v[e] = silu_f(a[e]) * b[e];
                    st_bf16x4(o + (size_t)FRAG_ROW(ai, m) * 512 + FRAG_COL(0, n), v); }
    }
};
struct PhM2 { PH_COMMON PanelTab pt; size_t hd, y;
    __device__ __forceinline__ bool get(int i, UnitD& u) const {
        const int idx = bid + i * G; if (idx >= pt.pst[16] * 4) return false;
        const int p = idx >> 2, j = idx & 3; int e = 0;
#pragma unroll
        for (int k = 1; k < 16; ++k) e += (p >= pt.pst[k]) ? 1 : 0;
        eng::unit1(u, ws + hd + (size_t)p * 256 * 1024, 1024, ws + A_MOEW + 32 * MiB + ((size_t)e * 1024 + j * 256) * 1024, 1024, 8); u.i0 = p; u.i1 = j; return true;
    }
    __device__ __forceinline__ void epi(EPI_ARGS) const {
        bf16_t* o = (bf16_t*)(ws + y) + (size_t)(u.i0 * 256) * DM + u.i1 * 256;
        FOR_FRAG(ai, bj, m, n) st_bf16x4(o + (size_t)FRAG_ROW(ai, m) * DM + FRAG_COL(bj, n), acc[ai][bj][m][n]);
    }
};
struct PhG3 { PH_COMMON f32x4 lgf, lgb;
    __device__ __forceinline__ bool get(int i, UnitD& u) const {
        const int idx = bid + i * G; if (idx >= 512 + 780) return false;
        const char* xm = (const char*)(ws + B_XM1); const char* w = (const char*)(ws + WS_W1IN);
        if (idx < 512) { const int pm = 1 + (idx >> 3), pn = idx & 7; eng::unit1(u, xm + (size_t)pm * 256 * 2048, 2048, w + (size_t)pn * 256 * 2048, 2048, 16); u.kind = 0; u.i0 = pm; u.i1 = pn; }
        else { const int j = idx - 512, rt = j / 65, ct = j % 65; eng::unit1(u, w + (size_t)(1024 + rt * 256) * 2048, 2048, xm + (size_t)ct * 256 * 2048, 2048, 16); u.kind = rt < 4 ? 1 : 2; u.i0 = rt; u.i1 = ct; }
        return true;
    }
    __device__ __forceinline__ void epi(EPI_ARGS) const {
        const float* rc = WSC(const float, WS_ROPEC); const float* rs = WSC(const float, WS_ROPES);
        if (u.kind == 0) {
            bf16_t* o = (u.i1 < 4 ? WSC(bf16_t, B_Q) : WSC(bf16_t, B_K)) + (size_t)(u.i0 * 256) * DM + (u.i1 & 3) * 256;
#pragma unroll
            for (int ai = 0; ai < 2; ++ai)
#pragma unroll
                for (int m = 0; m < 4; ++m) { const int r = FRAG_ROW(ai, m), tl = (u.i0 - 1) * 256 + r;
#pragma unroll
                    for (int bj = 0; bj < 2; ++bj) { const int pos = bj == 0 ? (tl >> 6) : (tl & 63); const f32x4 cv = *(const f32x4*)(rc + pos * 64 + 16 * wc + 4 * fq), sv = *(const f32x4*)(rs + pos * 64 + 16 * wc + 4 * fq);
                        const f32x4 x1 = acc[ai][bj][m][0], x2 = acc[ai][bj][m][1];
                        st_bf16x4(o + (size_t)r * DM + FRAG_COL(bj, 0), x1 * cv - x2 * sv); st_bf16x4(o + (size_t)r * DM + FRAG_COL(bj, 1), x2 * cv + x1 * sv); } }
        } else if (u.kind == 2) { bf16_t* o = WSC(bf16_t, B_VT) + (size_t)((u.i0 - 4) * 256) * TT + u.i1 * 256;
            FOR_FRAG(ai, bj, m, n) st_bf16x4(o + (size_t)FRAG_ROW(ai, m) * TT + FRAG_COL(bj, n), acc[ai][bj][m][n]);
        } else {
            const int h = u.i0; const float lf = SEL4(lgf, h), lb = SEL4(lgb, h);
            bf16_t* of = WSC(bf16_t, B_KF) + (size_t)(h * 256) * TT + u.i1 * 256; bf16_t* ob = WSC(bf16_t, B_KB) + (size_t)(h * 256) * TT + u.i1 * 256;
#pragma unroll
            for (int bj = 0; bj < 2; ++bj)
#pragma unroll
                for (int n = 0; n < 2; ++n) { const int c0 = FRAG_COL(bj, n); f32x4 df, db;
                    if (u.i1 == 0) {
#pragma unroll
                        for (int e = 0; e < 4; ++e) { const int pos = c0 + e; df[e] = __expf(lf * (float)(255 - pos)); db[e] = __expf(lb * (float)pos); }
                    } else {
#pragma unroll
                        for (int e = 0; e < 4; ++e) { const int pos = ((u.i1 - 1) * 256 + c0 + e) & 511; df[e] = __expf(lf * (float)(511 - pos)); db[e] = __expf(lb * (float)pos); }
                    }
#pragma unroll
                    for (int ai = 0; ai < 2; ++ai)
#pragma unroll
                        for (int mp = 0; mp < 2; ++mp) { const int p = 32 * wr + 16 * mp + fr; f32x4 x1 = acc[ai][bj][2 * mp][n], x2 = acc[ai][bj][2 * mp + 1][n];
                            if (u.i1 != 0) { const int tl = (u.i1 - 1) * 256 + c0; f32x4 cv, sv;
                                if (ai == 0) { const float c = rc[(tl >> 6) * 64 + p], s = rs[(tl >> 6) * 64 + p]; cv = (f32x4){c, c, c, c}; sv = (f32x4){s, s, s, s}; }
                                else {
#pragma unroll
                                    for (int e = 0; e < 4; ++e) { cv[e] = rc[((tl + e) & 63) * 64 + p]; sv[e] = rs[((tl + e) & 63) * 64 + p]; } }
                                const f32x4 y1 = x1 * cv - x2 * sv, y2 = x2 * cv + x1 * sv; x1 = y1; x2 = y2; }
                            const size_t o1 = (size_t)FRAG_ROW(ai, 2 * mp) * TT + c0, o2 = (size_t)FRAG_ROW(ai, 2 * mp + 1) * TT + c0;
                            st_bf16x4(of + o1, x1 * df); st_bf16x4(of + o2, x2 * df); st_bf16x4(ob + o1, x1 * db); st_bf16x4(ob + o2, x2 * db); } }
        }
    }
};
__device__ __forceinline__ int chunk_tok0(int c) { return c == 0 ? 0 : 256 + 512 * (c - 1); }
struct PhU { PH_COMMON
    __device__ __forceinline__ bool get(int i, UnitD& u) const {
        const int idx = bid + i * G; if (idx >= 528) return false;
        const int dvt = idx & 1, dir = (idx >> 1) & 1, h = (idx >> 2) & 3, c = idx >> 4; const size_t tk = (size_t)chunk_tok0(c) * 2;
        eng::unit1(u, ws + B_VT + (size_t)(h * 512 + dvt * 256) * TT * 2 + tk, TT * 2, ws + (dir ? B_KB : B_KF) + (size_t)(h * 256) * TT * 2 + tk, TT * 2, c == 0 ? 4 : 8);
        u.i0 = (c * 8 + h * 2 + dir); u.i1 = dvt; return true;
    }
    __device__ __forceinline__ void epi(EPI_ARGS) const {
        bf16_t* o = WSC(bf16_t, B_ST) + (size_t)u.i0 * 131072 + (size_t)(u.i1 * 256) * 256;
        FOR_FRAG(ai, bj, m, n) st_bf16x4(o + (size_t)FRAG_ROW(ai, m) * 256 + FRAG_COL(bj, n), acc[ai][bj][m][n]);
    }
};
struct PhSD { PH_COMMON f32x4 lgf, lgb;
    __device__ __forceinline__ bool get(int i, UnitD& u) const {
        const int idx = bid + i * G; if (idx >= 512) return false;
        const int tj = idx & 1, ti = (idx >> 1) & 1, h = (idx >> 2) & 3, c = 1 + (idx >> 4); const int t0 = chunk_tok0(c);
        eng::unit1(u, ws + B_Q + (size_t)(t0 + 256 * ti) * 2048 + h * 512, 2048, ws + B_K + (size_t)(t0 + 256 * tj) * 2048 + h * 512, 2048, 4);
        u.i0 = t0; u.i1 = h; u.i2 = ti * 2 + tj; return true;
    }
    __device__ __forceinline__ void epi(EPI_ARGS) const {
        const int ti = u.i2 >> 1, tj = u.i2 & 1, h = u.i1; const float lf = SEL4(lgf, h), lb = SEL4(lgb, h);
        bf16_t* o = WSC(bf16_t, B_SD) + (size_t)(u.i0 + 256 * ti) * 2048 + h * 512 + 256 * tj;
        FOR_FRAG(ai, bj, m, n) { const int r = FRAG_ROW(ai, m), c0 = FRAG_COL(bj, n), i = 256 * ti + r; f32x4 v = acc[ai][bj][m][n];
#pragma unroll
            for (int e = 0; e < 4; ++e) { const int d = i - (256 * tj + c0 + e); const float w = d > 0 ? __expf(lf * (float)d) : d < 0 ? __expf(lb * (float)(-d)) : 2.0f; v[e] *= w; }
            st_bf16x4(o + (size_t)r * 2048 + c0, v); }
    }
};
struct PhO { const unsigned char* ws; int G, bid; f32x4 lgf, lgb; static constexpr bool HOOKS = true;
    __device__ __forceinline__ bool get(int i, UnitD& u) const {
        const int idx = bid + i * G; if (idx >= 512) return false;
        const int dvt = idx & 1, h = (idx >> 1) & 3, pm = idx >> 3, c = 1 + (pm >> 1), t0 = CTXN + 256 * pm;
        const char* q = (const char*)(ws + B_Q) + (size_t)t0 * 2048 + h * 512;
        const char* st = (const char*)(ws + B_ST) + ((size_t)(c * 8 + h * 2) * 131072 + (size_t)(dvt * 256) * 256) * 2;
        u.A0 = q; u.B0 = st; u.lda0 = 2048; u.ldb0 = 512; u.n0 = 4;
        u.A1 = q; u.B1 = st + (size_t)131072 * 2; u.lda1 = 2048; u.ldb1 = 512; u.n1 = 4;
        u.A2 = (const char*)(ws + B_SD) + (size_t)t0 * 4096 + h * 1024; u.B2 = (const char*)(ws + B_VT) + (size_t)(h * 512 + dvt * 256) * TT * 2 + (size_t)chunk_tok0(c) * 2; u.lda2 = 4096; u.ldb2 = TT * 2; u.n2 = 8;
        u.kind = 0; u.i0 = pm; u.i1 = h; u.i2 = dvt; return true;
    }
    __device__ __forceinline__ void hook(int tc, Acc& acc, const UnitD& u, int wr, int wc, int fr, int fq) const {
        if (tc != 4 && tc != 8) return;
        const float lf = SEL4(lgf, u.i1), lb = SEL4(lgb, u.i1);
#pragma unroll
        for (int ai = 0; ai < 2; ++ai)
#pragma unroll
            for (int m = 0; m < 4; ++m) { const int i = (u.i0 & 1) * 256 + FRAG_ROW(ai, m);
                const float s = tc == 4 ? __expf(lf * (float)(i + 1) - lb * (float)(512 - i)) : __expf(lb * (float)(512 - i));
#pragma unroll
                for (int bj = 0; bj < 2; ++bj)
#pragma unroll
                    for (int n = 0; n < 2; ++n) acc[ai][bj][m][n] *= s; }
    }
    __device__ __forceinline__ void epi(EPI_ARGS) const {
        const int tl = 256 * u.i0, h = u.i1, dvt = u.i2;
        bf16_t* o = WSC(bf16_t, B_O) + (size_t)(CTXN + tl) * 2048 + h * 512 + dvt * 256; float* ssq = WSC(float, WS_SSQ);
#pragma unroll
        for (int ai = 0; ai < 2; ++ai)
#pragma unroll
            for (int m = 0; m < 4; ++m) { const int r = FRAG_ROW(ai, m); float s = 0.f;
#pragma unroll
                for (int bj = 0; bj < 2; ++bj)
#pragma unroll
                    for (int n = 0; n < 2; ++n) { const f32x4 v = acc[ai][bj][m][n]; s += (v[0] * v[0] + v[1] * v[1]) + (v[2] * v[2] + v[3] * v[3]); st_bf16x4(o + (size_t)r * 2048 + FRAG_COL(bj, n), v); }
                s += __shfl_xor(s, 16); s += __shfl_xor(s, 32);
                if (fq == 0) ssq[((size_t)(tl + r) * 4 + h) * 8 + dvt * 4 + wc] = s; }
    }
};
struct PhGG { PH_COMMON
    __device__ __forceinline__ bool get(int i, UnitD& u) const {
        const int idx = bid + i * G; if (idx >= 512) return false;
        const int pm = 1 + (idx >> 3), pn = idx & 7; eng::unit1(u, ws + B_XM1B + (size_t)pm * 256 * 2048, 2048, ws + WS_W1IN + (size_t)(4096 + pn * 256) * 2048, 2048, 16); u.i0 = pm; u.i1 = pn; return true;
    }
    __device__ __forceinline__ void epi(EPI_ARGS) const {
        bf16_t* o = WSC(bf16_t, B_O) + (size_t)(u.i0 * 256) * 2048 + u.i1 * 256; const float* ssq = WSC(const float, WS_SSQ); const int h = u.i1 >> 1;
#pragma unroll
        for (int ai = 0; ai < 2; ++ai)
#pragma unroll
            for (int m = 0; m < 4; ++m) { const int r = FRAG_ROW(ai, m); const float* sp = ssq + ((size_t)((u.i0 - 1) * 256 + r) * 4 + h) * 8;
                const f32x4 s0 = *(const f32x4*)sp, s1 = *(const f32x4*)(sp + 4); const float rstd = rsqrtf((((s0[0] + s0[1]) + (s0[2] + s0[3])) + ((s1[0] + s1[1]) + (s1[2] + s1[3]))) * (1.0f / 512.0f) + RMS_EPS);
#pragma unroll
                for (int bj = 0; bj < 2; ++bj)
#pragma unroll
                    for (int n = 0; n < 2; ++n) { bf16_t* q = o + (size_t)r * 2048 + FRAG_COL(bj, n); const u32x2 ov = *(const u32x2*)q; const f32x4 g = acc[ai][bj][m][n]; f32x4 v;
                        v[0] = silu_f(g[0]) * (bflo(ov.x) * rstd); v[1] = silu_f(g[1]) * (bfhi(ov.x) * rstd); v[2] = silu_f(g[2]) * (bflo(ov.y) * rstd); v[3] = silu_f(g[3]) * (bfhi(ov.y) * rstd);
                        st_bf16x4(q, v); } }
    }
};
struct PhG4 { PH_COMMON float* out;
    __device__ __forceinline__ bool get(int i, UnitD& u) const {
        const int idx = bid + i * G; if (idx >= 256) return false;
        const int pm = idx >> 2, pn = idx & 3; eng::unit1(u, ws + B_O + (size_t)(CTXN + pm * 256) * 4096, 4096, ws + WS_W1OUT + (size_t)pn * 256 * 4096, 4096, 32); u.i0 = pm; u.i1 = pn; return true;
    }
    __device__ __forceinline__ void epi(EPI_ARGS) const {
        const float* g1 = WSC(const float, WS_MOD) + 6144 + 2048 + u.i1 * 256; float* dst = out + (size_t)(u.i0 * 256) * DM + u.i1 * 256;
        FOR_FRAG(ai, bj, m, n) { float* q = dst + (size_t)FRAG_ROW(ai, m) * DM + FRAG_COL(bj, n); const f32x4 gv = *(const f32x4*)(g1 + FRAG_COL(bj, n)); *(f32x4*)q = *(const f32x4*)q + gv * acc[ai][bj][m][n]; }
    }
};

template <bool LOCAL>
__device__ __forceinline__ void na_unit(const Frame& F, int r, int j, int h, int qb, const LAS float* rpb_l) {
    const bf16_t* qk = WSP(const bf16_t, A_QK0); const bf16_t* vt = WSP(const bf16_t, A_VT0); bf16_t* ao = WSP(bf16_t, A_AO);
    const int lane = F.lane, q16 = lane & 15, g = lane >> 4;
    const int tq = LOCAL ? CTXN + r * GW + 16 * j + q16 : 16 * qb + q16;
    bf16x8 qf[2];
#pragma unroll
    for (int ks = 0; ks < 2; ++ks) qf[ks] = *(const bf16x8*)(qk + (size_t)tq * QK0_LD + h * 64 + 32 * ks + 8 * g);
    constexpr int NT = LOCAL ? 32 : 16;
    f32x4 s[NT];
    const int rs = LOCAL ? min(max(r - 4, 0), 248) : 0, kst = LOCAL ? min(max(16 * j - 8, 0), 32) : 0;
    const int krow = 8 * (q16 >> 2) + (q16 & 3);
#pragma unroll
    for (int t = 0; t < NT; ++t) {
        int tok;
        if (LOCAL && t < 16) tok = CTXN + (rs + (t >> 1)) * GW + kst + krow + 4 * (t & 1); else tok = 32 * ((t - (LOCAL ? 16 : 0)) >> 1) + krow + 4 * (t & 1);
        const bf16_t* kp = qk + (size_t)tok * QK0_LD + 768 + h * 64 + 8 * g;
        const bf16x8 k0 = *(const bf16x8*)kp, k1 = *(const bf16x8*)(kp + 32);
        f32x4 a = {0.f, 0.f, 0.f, 0.f};
        a = __builtin_amdgcn_mfma_f32_16x16x32_bf16(k0, qf[0], a, 0, 0, 0); a = __builtin_amdgcn_mfma_f32_16x16x32_bf16(k1, qf[1], a, 0, 0, 0);
        s[t] = a;
    }
    float mx = -1e30f;
    if (LOCAL) { const int qc = 16 * j + q16, wst = min(max(qc - 8, 0), 48);
#pragma unroll
        for (int t = 0; t < 16; ++t) { const int dr = rs + (t >> 1) - r + 7;
#pragma unroll
            for (int e = 0; e < 4; ++e) { const int kc = kst + 8 * g + 4 * (t & 1) + e; const bool ok = kc >= wst && kc < wst + 16; const int dc = min(max(kc - qc + 15, 0), 30);
                const float v = ok ? s[t][e] * 0.125f + rpb_l[(h * 15 + dr) * 31 + dc] : -1e30f; s[t][e] = v; mx = fmaxf(mx, v); } } }
#pragma unroll
    for (int t = LOCAL ? 16 : 0; t < NT; ++t)
#pragma unroll
        for (int e = 0; e < 4; ++e) { const float v = s[t][e] * 0.125f; s[t][e] = v; mx = fmaxf(mx, v); }
    mx = fmaxf(mx, __shfl_xor(mx, 16)); mx = fmaxf(mx, __shfl_xor(mx, 32));
    float sum = 0.f;
#pragma unroll
    for (int t = 0; t < NT; ++t)
#pragma unroll
        for (int e = 0; e < 4; ++e) { const float p = __expf(s[t][e] - mx); s[t][e] = p; sum += p; }
    sum += __shfl_xor(sum, 16); sum += __shfl_xor(sum, 32);
    f32x4 o[4];
#pragma unroll
    for (int dt = 0; dt < 4; ++dt) o[dt] = (f32x4){0.f, 0.f, 0.f, 0.f};
#pragma unroll
    for (int b = 0; b < NT / 2; ++b) {
        u32x4 pw; pw.x = cvt_pk_bf16(s[2 * b][0], s[2 * b][1]); pw.y = cvt_pk_bf16(s[2 * b][2], s[2 * b][3]); pw.z = cvt_pk_bf16(s[2 * b + 1][0], s[2 * b + 1][1]); pw.w = cvt_pk_bf16(s[2 * b + 1][2], s[2 * b + 1][3]);
        const bf16x8 pf = __builtin_bit_cast(bf16x8, pw);
        int tok0;
        if (LOCAL && b < 8) tok0 = CTXN + (rs + b) * GW + kst; else tok0 = 32 * (b - (LOCAL ? 8 : 0));
#pragma unroll
        for (int dt = 0; dt < 4; ++dt) { const bf16x8 vf = *(const bf16x8*)(vt + (size_t)(h * 64 + 16 * dt + q16) * TT + tok0 + 8 * g);
            o[dt] = __builtin_amdgcn_mfma_f32_16x16x32_bf16(vf, pf, o[dt], 0, 0, 0); }
    }
    const float inv = 1.0f / sum;
#pragma unroll
    for (int dt = 0; dt < 4; ++dt) st_bf16x4(ao + (size_t)tq * DM + 256 + h * 64 + 16 * dt + 4 * g, o[dt] * inv);
}
__device__ __forceinline__ void p_attention(const Frame& F) {
    LAS float* rpb_l = (LAS float*)F.lds;
    for (int i = F.tid; i < 12 * 15 * 31; i += 512) rpb_l[i] = F.p.rpb[i];
    __syncthreads();
    unsigned* head = (unsigned*)(F.p.ws + WS_CTL + CTL_QUEUE);
    for (;;) {
        unsigned qi = 0; if (F.lane == 0) qi = __hip_atomic_fetch_add(head, 1u, __ATOMIC_RELAXED, __HIP_MEMORY_SCOPE_AGENT);
        qi = (unsigned)__builtin_amdgcn_readfirstlane((int)qi);
        if (qi >= 12288u + 192u) break;
        if (qi < 12288u) { const int j = qi & 3, h = (qi >> 2) % 12, r = (qi >> 2) / 12; na_unit<true>(F, r, j, h, 0, rpb_l); }
        else { const int q2 = qi - 12288; na_unit<false>(F, 0, 0, q2 % 12, q2 / 12, rpb_l); }
    }
    __syncthreads();
}
constexpr int LDS_BYTES = eng::STAGE_BYTES + 1024;
#ifndef MK_PER_PHASE
#define MK_PER_PHASE 1
#endif

__global__ __launch_bounds__(512, 2) void mk_fwd(Params p) {
    extern __shared__ __attribute__((aligned(16))) unsigned char shm[];
    Frame F; F.p = p; F.lds = (LAS unsigned char*)shm; F.tid = threadIdx.x; F.lane = F.tid & 63; F.wid = __builtin_amdgcn_readfirstlane(F.tid >> 6); F.G = gridDim.x; F.bid = blockIdx.x;
    volatile LAS unsigned* xb = (volatile LAS unsigned*)(F.lds + eng::STAGE_BYTES);
    if (F.tid < 4) xb[F.tid] = 0u;
    __syncthreads();
    const int lo = p.ph_lo, hi = p.ph_hi;
    XcdBarrier bar; bar.bar = (unsigned*)(p.ws + WS_CTL); bar.x = 0; bar.st = xb;
    if (hi - lo > 1) bar = xcd_barrier_post((unsigned*)(p.ws + WS_CTL), xb);
#ifndef PHMASK
#define PHMASK 0xFFFFFFu
#endif
#define IN(k) (((PHMASK >> (k)) & 1u) && lo <= (k) && (k) < hi)
#define SEAM(k) do { if (IN(k) && IN((k) + 1)) xcd_barrier(bar); } while (0)
    const unsigned char* ws = p.ws;

    if (IN(0)) { p0_prologue(F); } SEAM(0);
    if (IN(1)) { p_norm_in(F); } SEAM(1);
    if (IN(2)) { PhG1 ph{ws, F.G, F.bid}; eng::gemm_run(F.lds, ph); } SEAM(2);
    if (IN(3)) { PhF1 ph{ws, F.G, F.bid}; eng::gemm_run(F.lds, ph); p_attention(F); } SEAM(3);
    if (IN(4)) { PhF2 ph{ws, F.G, F.bid}; eng::gemm_run(F.lds, ph); } SEAM(4);
    if (IN(5)) { PhG2 ph{ws, F.G, F.bid, p.x, p.ctx, p.out}; eng::gemm_run(F.lds, ph); } SEAM(5);
    if (IN(6)) { p_router(F, 0, 0, WSP(bf16_t, A_XM)); } SEAM(6);
    if (IN(7)) { p_gather(F, 0, 0, WSP(const bf16_t, A_XM), WSP(bf16_t, A_XS)); } SEAM(7);
    if (IN(8)) { PhM1 ph{ws, F.G, F.bid}; panel_tab(F, 0, ph.pt); ph.xs = A_XS; ph.hd = A_HD; eng::gemm_run(F.lds, ph); } SEAM(8);
    if (IN(9)) { PhM2 ph{ws, F.G, F.bid}; panel_tab(F, 0, ph.pt); ph.hd = A_HD; ph.y = A_XS; eng::gemm_run(F.lds, ph); } SEAM(9);
    if (IN(10)) { p_combine0(F); } SEAM(10);
    if (IN(11)) { PhG3 ph{ws, F.G, F.bid};
        ph.lgf = (f32x4){log_gamma(F, 0, 0), log_gamma(F, 0, 1), log_gamma(F, 0, 2), log_gamma(F, 0, 3)}; ph.lgb = (f32x4){log_gamma(F, 1, 0), log_gamma(F, 1, 1), log_gamma(F, 1, 2), log_gamma(F, 1, 3)};
        eng::gemm_run(F.lds, ph); } SEAM(11);
    if (IN(12)) { PhU ph{ws, F.G, F.bid}; eng::gemm_run(F.lds, ph); } SEAM(12);
    if (IN(13)) { p_scan(F); } SEAM(13);
    if (IN(14)) { PhSD ph{ws, F.G, F.bid};
        ph.lgf = (f32x4){log_gamma(F, 0, 0), log_gamma(F, 0, 1), log_gamma(F, 0, 2), log_gamma(F, 0, 3)}; ph.lgb = (f32x4){log_gamma(F, 1, 0), log_gamma(F, 1, 1), log_gamma(F, 1, 2), log_gamma(F, 1, 3)};
        eng::gemm_run(F.lds, ph); } SEAM(14);
    if (IN(15)) { PhO ph{ws, F.G, F.bid};
        ph.lgf = (f32x4){log_gamma(F, 0, 0), log_gamma(F, 0, 1), log_gamma(F, 0, 2), log_gamma(F, 0, 3)}; ph.lgb = (f32x4){log_gamma(F, 1, 0), log_gamma(F, 1, 1), log_gamma(F, 1, 2), log_gamma(F, 1, 3)};
        eng::gemm_run(F.lds, ph); } SEAM(15);
    if (IN(16)) { p_norm_l1(F, WSP(bf16_t, B_XM1B)); conv_moe(F, 1); } SEAM(16);
    if (IN(17)) { PhGG ph{ws, F.G, F.bid}; eng::gemm_run(F.lds, ph); } SEAM(17);
    if (IN(18)) { PhG4 ph{ws, F.G, F.bid, p.out}; eng::gemm_run(F.lds, ph); } SEAM(18);
    if (IN(19)) { p_router(F, 1, CTXN, WSP(bf16_t, B_XM2)); } SEAM(19);
    if (IN(20)) { p_gather(F, 1, CTXN, WSP(const bf16_t, B_XM2), WSP(bf16_t, B_XS)); } SEAM(20);
    if (IN(21)) { PhM1 ph{ws, F.G, F.bid}; panel_tab(F, 1, ph.pt); ph.xs = B_XS; ph.hd = B_HD; eng::gemm_run(F.lds, ph); } SEAM(21);
    if (IN(22)) { PhM2 ph{ws, F.G, F.bid}; panel_tab(F, 1, ph.pt); ph.hd = B_HD; ph.y = B_XS; eng::gemm_run(F.lds, ph); } SEAM(22);
    if (IN(23)) { p_final(F); }
#undef IN
#undef SEAM
}

extern "C" void kernel_launch(void* const* d_in, const int* in_sizes, int n_in, void* d_out, int out_size, void* d_ws, size_t ws_size, hipStream_t stream) {
    static int grid = 0;
    if (grid == 0) {
        if (n_in != 19 || out_size != SEQ * DM || ws_size < WS_END) { fprintf(stderr, "kernel_launch: unexpected shapes (n_in %d, out %d, ws %zu < %zu)\n", n_in, out_size, ws_size, (size_t)WS_END); grid = -1; return; }
        int dev = 0, cus = 0, per_cu = 0;
        if (hipGetDevice(&dev) != hipSuccess || hipDeviceGetAttribute(&cus, hipDeviceAttributeMultiprocessorCount, dev) != hipSuccess) { grid = -1; return; }
        if (hipFuncSetAttribute((const void*)mk_fwd, hipFuncAttributeMaxDynamicSharedMemorySize, LDS_BYTES) != hipSuccess) { fprintf(stderr, "kernel_launch: hipFuncSetAttribute failed\n"); grid = -1; return; }
        if (hipOccupancyMaxActiveBlocksPerMultiprocessor(&per_cu, (const void*)mk_fwd, 512, LDS_BYTES) != hipSuccess || per_cu < 1) { fprintf(stderr, "kernel_launch: occupancy query says %d\n", per_cu); per_cu = 1; }
        (void)hipGetLastError();
        grid = cus;
        if (grid > 256) grid = 256;
    }
    if (grid < 0) return;
    (void)hipMemsetAsync((char*)d_ws + WS_CTL, 0, CTL_BYTES, stream);
    Params p{};
    const float** pp = (const float**)&p;
    for (int i = 0; i < 19; ++i) pp[i] = (const float*)d_in[i];
    p.out = (float*)d_out; p.ws = (unsigned char*)d_ws;
#if MK_PER_PHASE
    for (int ph = 0; ph < NPHASE; ++ph) { p.ph_lo = ph; p.ph_hi = ph + 1; hipLaunchKernelGGL(mk_fwd, dim3(grid), dim3(512), LDS_BYTES, stream, p); }
#else
    p.ph_lo = 0; p.ph_hi = NPHASE; hipLaunchKernelGGL(mk_fwd, dim3(grid), dim3(512), LDS_BYTES, stream, p);
#endif
}
```

```cpp
#include <hip/hip_runtime.h>
#include <cstdio>
#include <cstdint>

typedef unsigned short bf16_t;
typedef short bf16x8 __attribute__((ext_vector_type(8)));
typedef float f32x4 __attribute__((ext_vector_type(4)));
typedef float f32x2 __attribute__((ext_vector_type(2)));
typedef unsigned u32x2 __attribute__((ext_vector_type(2)));
typedef unsigned u32x4 __attribute__((ext_vector_type(4)));
#define LAS __attribute__((address_space(3)))

constexpr int DM = 1024, SEQ = 16384, CTXN = 256, TT = SEQ + CTXN  , GW = 64;
constexpr int NH0 = 12, QK0_LD = 1536, W0IN_ROWS = 2816;
constexpr int NPMAX = 146;
constexpr float RMS_EPS = 1e-6f;
constexpr int NPHASE = 24;

constexpr size_t KiB = 1024, MiB = 1024 * 1024, HMiB = 512 * 1024;
constexpr size_t WS_CTL = 0;
constexpr size_t CTL_BYTES = 64 * KiB;
constexpr size_t CTL_CNT = 16 * KiB;
constexpr size_t CTL_QUEUE = 20 * KiB;
constexpr size_t WS_MOD = 64 * KiB;
constexpr size_t WS_TWC = 256 * KiB, WS_TWS = 320 * KiB;
constexpr size_t WS_ROPEC = 384 * KiB, WS_ROPES = 448 * KiB;
constexpr size_t WS_F1T = 512 * KiB, WS_F2P = 640 * KiB;
constexpr size_t WS_CS256 = 768 * KiB;
constexpr size_t WS_HC = 1 * MiB;
constexpr size_t WS_EID = 2 * MiB;
constexpr size_t WS_GW = 2 * MiB + 256 * KiB;
constexpr size_t WS_SLOT = 2 * MiB + 512 * KiB;
constexpr size_t WS_SSQ = 3 * MiB;
constexpr size_t WS_XTC = 5 * MiB;
constexpr size_t WS_W0IN = 8 * MiB, WS_W0OUT = 14 * MiB, WS_W1IN = 16 * MiB, WS_W1OUT = 28 * MiB;
constexpr size_t AR = 32 * MiB;
constexpr size_t A_XM = AR + 0, A_QK0 = AR + 65 * HMiB, A_VT0 = AR + 81 * MiB + 256 * KiB, A_XT2 = AR + 106 * MiB, A_T2 = AR + 122 * MiB + HMiB, A_AO = AR + 139 * MiB;
constexpr size_t A_XS = AR + 65 * HMiB, A_HD = AR + 106 * MiB, A_MOEW = AR + 245 * MiB;
constexpr size_t B_Q = AR + 0, B_K = AR + 65 * HMiB, B_O = AR + 65 * HMiB, B_KF = AR + 195 * HMiB, B_KB = AR + 130 * MiB, B_SD = AR + 195 * HMiB, B_VT = AR + 325 * HMiB;
constexpr size_t B_XM1 = AR + 455 * HMiB, B_ST = AR + 455 * HMiB, B_XM1B = AR + 0, B_XM2 = AR + 0, B_XS = AR + 195 * HMiB, B_HD = AR + 341 * HMiB;
constexpr size_t WS_END = AR + 294 * MiB;

struct Params {
    const float *x, *c, *ctx, *c_ctx, *ada_w, *ada_b, *norm_g, *final_g, *w0in, *w0out, *rpb, *w1in, *w1out, *decay, *router_w, *router_b, *moe_w1, *moe_w3, *moe_w2;
    float* out; unsigned char* ws; int ph_lo, ph_hi;
};

__device__ __forceinline__ unsigned cvt_pk_bf16(float lo, float hi) { unsigned r; asm volatile("v_cvt_pk_bf16_f32 %0, %1, %2" : "=v"(r) : "v"(lo), "v"(hi)); return r; }
__device__ __forceinline__ bf16_t f2bf(float f) { return (bf16_t)(cvt_pk_bf16(f, 0.f) & 0xffffu); }
__device__ __forceinline__ float bf2f(unsigned short b) { return __uint_as_float(((unsigned)b) << 16); }
__device__ __forceinline__ float bflo(unsigned w) { return __uint_as_float(w << 16); }
__device__ __forceinline__ float bfhi(unsigned w) { return __uint_as_float(w & 0xffff0000u); }
__device__ __forceinline__ float silu_f(float v) { return v / (1.0f + __expf(-v)); }
__device__ __forceinline__ float wave_sum(float v) {
#pragma unroll
    for (int o = 32; o >= 1; o >>= 1) v += __shfl_xor(v, o);
    return v;
}
__device__ __forceinline__ float wave_max(float v) {
#pragma unroll
    for (int o = 32; o >= 1; o >>= 1) v = fmaxf(v, __shfl_xor(v, o));
    return v;
}
#define XB_TMO      128
#define XB_XCNT(j)  (256  + 64 * (j))
#define XB_XSUB(j)  (1280 + 64 * (j))
#define XB_XGEN(j)  (2304 + 64 * (j))
#define XB_TOP      3328
#define XB_TOPGEN   3392
#define XCD_BAR_WORDS 3456
#define XB_SPIN_CAP (1u << 18)

__device__ __forceinline__ unsigned xb_ld(unsigned* p)              { return __hip_atomic_load(p, __ATOMIC_RELAXED, __HIP_MEMORY_SCOPE_AGENT); }
__device__ __forceinline__ unsigned xb_add(unsigned* p, unsigned v) { return __hip_atomic_fetch_add(p, v, __ATOMIC_RELAXED, __HIP_MEMORY_SCOPE_AGENT); }
__device__ __forceinline__ unsigned xb_xcc_id() { return (unsigned)__builtin_amdgcn_s_getreg((3 << 11) | 20) & 0xFu; }
#define XB_SPIN(cond, bar) do { unsigned _sp = 0; while (cond) { __builtin_amdgcn_s_sleep(1); \
    if ((++_sp & 255u) == 0u) { if (xb_ld(&(bar)[XB_TMO])) break; if (_sp > XB_SPIN_CAP) { atomicAdd(&(bar)[XB_TMO], 1u); break; } } } } while (0)

struct XcdBarrier {
    unsigned* bar; unsigned x;
    volatile LAS unsigned* st;
};

__device__ __forceinline__ XcdBarrier xcd_barrier_post(unsigned* bar, volatile LAS unsigned* st) {
    XcdBarrier b; b.bar = bar; b.x = xb_xcc_id(); b.st = st;
    if (threadIdx.x == 0) (void)xb_add(&bar[XB_XCNT(b.x)], 1u);
    return b;
}
__device__ __forceinline__ void xcd_barrier_complete(unsigned* bar, unsigned x, unsigned& nloc, unsigned& nx) {
    const unsigned G = gridDim.x * gridDim.y * gridDim.z;
    unsigned sum, cnt, mine, sp = 0u;
    for (;;) {
        sum = 0u; cnt = 0u; mine = 0u;
#pragma unroll
        for (unsigned j = 0; j < 16; ++j) { const unsigned c = xb_ld(&bar[XB_XCNT(j)]); sum += c; cnt += (c > 0u) ? 1u : 0u; mine = (j == x) ? c : mine; }
        if (sum == G) break;
        __builtin_amdgcn_s_sleep(1);
        if ((++sp & 255u) == 0u) { if (xb_ld(&bar[XB_TMO])) break; if (sp > XB_SPIN_CAP) { atomicAdd(&bar[XB_TMO], 1u); break; } }
    }
    nloc = mine > 0u ? mine : 1u; nx = cnt > 0u ? cnt : 1u;
}

__device__ __forceinline__ void xcd_barrier(const XcdBarrier& b) {
    asm volatile("s_waitcnt vmcnt(0)" ::: "memory");
    __syncthreads();
    if (threadIdx.x == 0) {
        unsigned* bar = b.bar;
        __builtin_amdgcn_s_waitcnt(0);
        unsigned nloc = b.st[0], nx = b.st[1];
        if (nloc == 0u) { xcd_barrier_complete(bar, b.x, nloc, nx); b.st[0] = nloc; b.st[1] = nx; }
        const unsigned old = xb_add(&bar[XB_XSUB(b.x)], 1u);
        const unsigned gen = old / nloc;
        if (old + 1u == (gen + 1u) * nloc) {
            __builtin_amdgcn_fence(__ATOMIC_RELEASE, "agent");
            asm volatile("s_waitcnt vmcnt(0)" ::: "memory");
            const unsigned og = xb_add(&bar[XB_TOP], 1u);
            const unsigned tg = og / nx;
            if (og + 1u == (tg + 1u) * nx) xb_add(&bar[XB_TOPGEN], 1u);
            else XB_SPIN(xb_ld(&bar[XB_TOPGEN]) == tg, bar);
            __builtin_amdgcn_fence(__ATOMIC_ACQUIRE, "agent");
            xb_add(&bar[XB_XGEN(b.x)], 1u);
            asm volatile("s_waitcnt vmcnt(0)" ::: "memory");
        } else {
            XB_SPIN(xb_ld(&bar[XB_XGEN(b.x)]) == gen, bar);
            __builtin_amdgcn_fence(__ATOMIC_ACQUIRE, "agent");
            asm volatile("s_waitcnt vmcnt(0)" ::: "memory");
        }
    }
    __syncthreads();
}
namespace eng {
constexpr int BM = 256, BK = 64, HALF = 128, HTB = HALF * BK * 2, STAGE_BYTES = 8 * HTB;
__device__ __forceinline__ int lds_byte(int r, int c) { const int st = (r >> 4) * 2 + (c >> 5), rr = r & 15, cc = c & 31, ob = rr * 64 + cc * 2; return st * 1024 + (ob ^ (((ob >> 9) & 1) << 5)); }
__device__ __forceinline__ void stage_rc(int b, int& R, int& C) { const int st = b / 1024, sb = b % 1024, swz = sb ^ (((sb >> 9) & 1) << 5); R = (st >> 1) * 16 + swz / 64; C = (st & 1) * 32 + (swz % 64) / 2; }

struct UnitD {
    const char* A0; const char* B0; unsigned lda0, ldb0; int n0;
    const char* A1; const char* B1; unsigned lda1, ldb1; int n1;
    const char* A2; const char* B2; unsigned lda2, ldb2; int n2;
    int kind, i0, i1, i2;
};
struct TD { const char* a; const char* b; unsigned lda, ldb; };
__device__ __forceinline__ TD tile_at(const UnitD& u, int t) {
    TD d;
    if (t < u.n0) { d.a = u.A0 + (size_t)t * 128; d.b = u.B0 + (size_t)t * 128; d.lda = u.lda0; d.ldb = u.ldb0; }
    else if (t < u.n0 + u.n1) { const int s = t - u.n0; d.a = u.A1 + (size_t)s * 128; d.b = u.B1 + (size_t)s * 128; d.lda = u.lda1; d.ldb = u.ldb1; }
    else { const int s = t - u.n0 - u.n1; d.a = u.A2 + (size_t)s * 128; d.b = u.B2 + (size_t)s * 128; d.lda = u.lda2; d.ldb = u.ldb2; }
    return d;
}
typedef f32x4 Acc[2][2][4][2];

template <class P>
__device__ __forceinline__ void gemm_run(LAS unsigned char* lds, const P& ph) {
    const int tid = threadIdx.x, wid = __builtin_amdgcn_readfirstlane(tid >> 6), lane = tid & 63, wr = wid >> 2, wc = wid & 3, fr = lane & 15, fq = lane >> 4;
    int R0, C0; stage_rc(tid * 16, R0, C0);
    const unsigned vR = (unsigned)R0, vC2 = (unsigned)C0 * 2u;
    const unsigned ldsw = (unsigned)wid * 1024u;
    const int aoff = lds_byte(wr * 64 + fr, fq * 8), boff = lds_byte(wc * 32 + fr, fq * 8);
#define EG_SA(b, h) (((b) * 2 + (h)) * HTB)
#define EG_SB(b, h) ((4 + (b) * 2 + (h)) * HTB)
#define EG_STAGE(bufoff, gbase, ld) do { const unsigned _ld = (ld); const char* _g = (gbase) + (size_t)(vR * _ld + vC2); \
        __builtin_amdgcn_global_load_lds((const unsigned*)_g, (LAS unsigned*)(lds + (bufoff) + ldsw), 16, 0, 0); \
        __builtin_amdgcn_global_load_lds((const unsigned*)(_g + (size_t)(64u * _ld)), (LAS unsigned*)(lds + (bufoff) + ldsw + 8192), 16, 0, 0); } while (0)
#define EG_LDA(dst, b, h) do { _Pragma("unroll") for (int m = 0; m < 4; ++m) _Pragma("unroll") for (int k = 0; k < 2; ++k) dst[m][k] = *(const LAS bf16x8*)(lds + EG_SA(b, h) + aoff + m * 2048 + k * 1024); } while (0)
#define EG_LDB(dst, b, h) do { _Pragma("unroll") for (int n = 0; n < 2; ++n) _Pragma("unroll") for (int k = 0; k < 2; ++k) dst[n][k] = *(const LAS bf16x8*)(lds + EG_SB(b, h) + boff + n * 2048 + k * 1024); } while (0)
#define EG_MMA(ai, bj, At, Bt) do { __builtin_amdgcn_s_setprio(1); _Pragma("unroll") for (int m = 0; m < 4; ++m) _Pragma("unroll") for (int n = 0; n < 2; ++n) _Pragma("unroll") for (int k = 0; k < 2; ++k) \
        acc[ai][bj][m][n] = __builtin_amdgcn_mfma_f32_16x16x32_bf16(Bt[n][k], At[m][k], acc[ai][bj][m][n], 0, 0, 0); __builtin_amdgcn_s_setprio(0); } while (0)
#define EG_WAIT_V(n) asm volatile("s_waitcnt vmcnt(" #n ")" ::: "memory")
#define EG_WAIT_L(n) asm volatile("s_waitcnt lgkmcnt(" #n ")" ::: "memory")
#define EG_BAR __builtin_amdgcn_s_barrier()
#define EG_SCHED __builtin_amdgcn_sched_barrier(0)
    UnitD cur; int ui = 0;
    if (!ph.get(0, cur)) return;
    UnitD cu = cur; int cui = 0, ct = 0; bool cvalid = true; TD lastTD = tile_at(cur, 0);
#define EG_NEXT(dst) do { if (cvalid) { dst = tile_at(cu, ct); lastTD = dst; ++ct; if (ct == cu.n0 + cu.n1 + cu.n2) { ++cui; ct = 0; cvalid = ph.get(cui, cu); } } else dst = lastTD; } while (0)
    Acc acc;
#pragma unroll
    for (int a = 0; a < 2; ++a)
#pragma unroll
        for (int b = 0; b < 2; ++b)
#pragma unroll
            for (int m = 0; m < 4; ++m)
#pragma unroll
                for (int n = 0; n < 2; ++n) acc[a][b][m][n] = (f32x4){0.f, 0.f, 0.f, 0.f};
    bf16x8 At[4][2], B0[2][2], B1[2][2];
    TD d1, d2, d3;
    { TD d0; EG_NEXT(d0); EG_NEXT(d1);
      EG_STAGE(EG_SB(0, 0), d0.b, d0.ldb); EG_STAGE(EG_SA(0, 0), d0.a, d0.lda); EG_STAGE(EG_SB(0, 1), d0.b + (size_t)(128u * d0.ldb), d0.ldb); EG_STAGE(EG_SA(0, 1), d0.a + (size_t)(128u * d0.lda), d0.lda); }
    if (wr == 1) EG_BAR;
    EG_WAIT_V(4); EG_BAR;
    EG_STAGE(EG_SB(1, 0), d1.b, d1.ldb); EG_STAGE(EG_SA(1, 0), d1.a, d1.lda); EG_STAGE(EG_SB(1, 1), d1.b + (size_t)(128u * d1.ldb), d1.ldb);
    EG_WAIT_V(6); EG_BAR;
    int tc = 0;
    for (;;) {
        EG_NEXT(d2); EG_NEXT(d3);
        if constexpr (P::HOOKS) { int fr_o = fr; asm volatile("" : "+v"(fr_o)); ph.hook(tc, acc, cur, wr, wc, fr_o, fq); }
        EG_LDB(B0, 0, 0); EG_SCHED; EG_LDA(At, 0, 0); EG_STAGE(EG_SA(1, 1), d1.a + (size_t)(128u * d1.lda), d1.lda);
        EG_WAIT_L(8); EG_BAR; EG_WAIT_L(0); EG_MMA(0, 0, At, B0); EG_BAR; EG_SCHED;
        EG_LDB(B1, 0, 1); EG_STAGE(EG_SB(0, 0), d2.b, d2.ldb);
        EG_BAR; EG_WAIT_L(0); EG_MMA(0, 1, At, B1); EG_BAR;
        EG_LDA(At, 0, 1); EG_STAGE(EG_SA(0, 0), d2.a, d2.lda);
        EG_BAR; EG_WAIT_L(0); EG_MMA(1, 0, At, B0); EG_BAR; EG_SCHED;
        EG_STAGE(EG_SB(0, 1), d2.b + (size_t)(128u * d2.ldb), d2.ldb);
        EG_WAIT_V(6); EG_BAR; EG_MMA(1, 1, At, B1); EG_BAR;
        EG_LDB(B0, 1, 0); EG_SCHED; EG_LDA(At, 1, 0); EG_STAGE(EG_SA(0, 1), d2.a + (size_t)(128u * d2.lda), d2.lda);
        EG_WAIT_L(8); EG_BAR; EG_WAIT_L(0); EG_MMA(0, 0, At, B0); EG_BAR; EG_SCHED;
        EG_LDB(B1, 1, 1); EG_STAGE(EG_SB(1, 0), d3.b, d3.ldb);
        EG_BAR; EG_WAIT_L(0); EG_MMA(0, 1, At, B1); EG_BAR;
        EG_LDA(At, 1, 1); EG_STAGE(EG_SA(1, 0), d3.a, d3.lda);
        EG_BAR; EG_WAIT_L(0); EG_MMA(1, 0, At, B0); EG_BAR; EG_SCHED;
        EG_STAGE(EG_SB(1, 1), d3.b + (size_t)(128u * d3.ldb), d3.ldb);
        EG_WAIT_V(6); EG_BAR; EG_MMA(1, 1, At, B1); EG_BAR;
        d1 = d3; tc += 2;
        if (tc == cur.n0 + cur.n1 + cur.n2) {
            { int fr_o = fr, fq_o = fq; asm volatile("" : "+v"(fr_o), "+v"(fq_o));
              ph.epi(acc, cur, wr, wc, fr_o, fq_o); }
            ++ui; tc = 0;
            if (!ph.get(ui, cur)) break;
#pragma unroll
            for (int a = 0; a < 2; ++a)
#pragma unroll
                for (int b = 0; b < 2; ++b)
#pragma unroll
                    for (int m = 0; m < 4; ++m)
#pragma unroll
                        for (int n = 0; n < 2; ++n) acc[a][b][m][n] = (f32x4){0.f, 0.f, 0.f, 0.f};
        }
    }
    EG_WAIT_V(0);
    if (wr == 0) EG_BAR;
    EG_BAR;
#undef EG_NEXT
}
__device__ __forceinline__ void unit1(UnitD& u, const void* A, unsigned lda, const void* B, unsigned ldb, int nt) {
    u.A0 = (const char*)A; u.B0 = (const char*)B; u.lda0 = lda; u.ldb0 = ldb; u.n0 = nt;
    u.A1 = u.A0; u.B1 = u.B0; u.lda1 = lda; u.ldb1 = ldb; u.n1 = 0; u.A2 = u.A0; u.B2 = u.B0; u.lda2 = lda; u.ldb2 = ldb; u.n2 = 0;
    u.kind = 0; u.i0 = 0; u.i1 = 0; u.i2 = 0;
}
}
using eng::UnitD; using eng::Acc;
__device__ __forceinline__ void efence() { asm volatile("" ::: "memory"); }
#define EPI_ARGS const Acc& acc, const UnitD& u, int wr, int wc, int fr, int fq
#define FOR_FRAG(ai, bj, m, n) _Pragma("unroll") for (int ai = 0; ai < 2; ++ai) _Pragma("unroll") for (int m = 0; m < 4; ++m) _Pragma("unroll") for (int bj = 0; bj < 2; efence(), ++bj) _Pragma("unroll") for (int n = 0; n < 2; ++n)
#define FRAG_ROW(ai, m) (128 * (ai) + 64 * wr + 16 * (m) + fr)
#define FRAG_COL(bj, n) (128 * (bj) + 32 * wc + 16 * (n) + 4 * fq)
__device__ __forceinline__ void st_bf16x4(bf16_t* p, f32x4 v) { u32x2 w; w.x = cvt_pk_bf16(v[0], v[1]); w.y = cvt_pk_bf16(v[2], v[3]); *(u32x2*)p = w; }
struct Frame { Params p; LAS unsigned char* lds; int tid, lane, wid, G, bid; };
#define WSP(T, off) ((T*)(F.p.ws + (off)))

template <class RowSrc>
__device__ __forceinline__ void conv_T(const Frame& F, bf16_t* dst, int nrows, int K, int ld, float scale, const RowSrc& rs) {
    LAS float* tile = (LAS float*)F.lds;
    const int tx = F.tid & 63, ty = F.tid >> 6, nkt = K / 64, ntiles = (nrows / 64) * nkt;
    for (int it = F.bid; it < ntiles; it += F.G) {
        const int rt = it / nkt, kt = it % nkt, r0 = rt * 64, k0 = kt * 64;
        const float* sp = rs(r0 + tx);
#pragma unroll
        for (int p = 0; p < 8; ++p) { const int i = p * 8 + ty; tile[i * 65 + tx] = sp[(size_t)(k0 + i) * ld]; }
        __syncthreads();
#pragma unroll
        for (int p = 0; p < 8; ++p) { const int j = p * 8 + ty; dst[(size_t)(r0 + j) * K + k0 + tx] = f2bf(tile[tx * 65 + j] * scale); }
        __syncthreads();
    }
}
__device__ __forceinline__ int sigma_orig(int s) {
    const int half = s >> 7, s2 = s & 127, uu = s2 >> 5, b = (s2 >> 4) & 1, f = s2 & 15; return half * 128 + 16 * uu + f + 64 * b;
}
__device__ __forceinline__ void conv_moe(const Frame& F, int layer) {
    bf16_t* w13 = WSP(bf16_t, A_MOEW); bf16_t* w2t = WSP(bf16_t, A_MOEW + 32 * MiB);
    for (int e = 0; e < 16; ++e) {
        const float* w1 = F.p.moe_w1 + ((size_t)layer * 16 + e) * 1024 * 512; const float* w3 = F.p.moe_w3 + ((size_t)layer * 16 + e) * 1024 * 512;
        conv_T(F, w13 + (size_t)e * 1024 * 1024, 1024, 1024, 512, 1.0f, [=](int r) { const int j = r >> 8, rr = r & 255; return rr < 128 ? w1 + 128 * j + rr : w3 + 128 * j + rr - 128; });
        const float* w2 = F.p.moe_w2 + ((size_t)layer * 16 + e) * 512 * 1024;
        conv_T(F, w2t + (size_t)e * 1024 * 512, 1024, 512, 1024, 1.0f, [=](int r) { return w2 + r; });
    }
}
__device__ __forceinline__ void p0_prologue(const Frame& F) {
    const float TWO_PI = 6.283185307179586f;
    {
        LAS float* sc0 = (LAS float*)F.lds; LAS float* sc1 = sc0 + 1024; LAS float* red = sc1 + 1024;
        for (int k = F.tid; k < 1024; k += 512) { sc0[k] = silu_f(F.p.c[k]); sc1[k] = silu_f(F.p.c_ctx[k]); }
        __syncthreads();
        float* mod = WSP(float, WS_MOD);
        for (int item = F.bid; item < 192; item += F.G) {
            const int l = item / 96, col0 = (item % 96) * 64, l16 = F.tid & 15, kg = F.tid >> 4;
            f32x4 a0 = {0.f, 0.f, 0.f, 0.f}, a1 = {0.f, 0.f, 0.f, 0.f};
            for (int i = 0; i < 32; ++i) { const int k = kg + 32 * i; const f32x4 w = *(const f32x4*)(F.p.ada_w + ((size_t)l * 1024 + k) * 6144 + col0 + l16 * 4); a0 += sc0[k] * w; a1 += sc1[k] * w; }
#pragma unroll
            for (int e = 0; e < 4; ++e) { red[(kg * 64 + l16 * 4 + e) * 2 + 0] = a0[e]; red[(kg * 64 + l16 * 4 + e) * 2 + 1] = a1[e]; }
            __syncthreads();
            if (F.tid < 128) { const int col = F.tid & 63, which = F.tid >> 6; float s = 0.f; for (int g = 0; g < 32; ++g) s += red[(g * 64 + col) * 2 + which];
                mod[(size_t)which * 2 * 6144 + l * 6144 + col0 + col] = s + F.p.ada_b[l * 6144 + col0 + col]; }
            __syncthreads();
        }
    }
    {
        const int gt = F.bid * 512 + F.tid, gn = F.G * 512;
        float* twc = WSP(float, WS_TWC); float* tws = WSP(float, WS_TWS);
        for (int i = gt; i < 128 * 128; i += gn) { const int b = i >> 7, k1 = i & 127; const float a = (float)((b * k1) & 16383) * (TWO_PI / 16384.0f); twc[i] = cosf(a); tws[i] = sinf(a); }
        float* rc = WSP(float, WS_ROPEC); float* rs = WSP(float, WS_ROPES);
        for (int i = gt; i < 256 * 64; i += gn) { const int pos = i >> 6, fi = i & 63; const float inv = powf(10000.0f, -(float)fi / 64.0f); const float a = (float)pos * inv; rc[i] = cosf(a); rs[i] = sinf(a); }
        bf16_t* f1 = WSP(bf16_t, WS_F1T); bf16_t* f2 = WSP(bf16_t, WS_F2P);
        for (int i = gt; i < 256 * 256; i += gn) { const int n = i >> 8, k = i & 255, k1 = n & 127, a = k & 127; const float ang = (float)((a * k1) & 127) * (TWO_PI / 128.0f); const float cs = cosf(ang), sn = sinf(ang);
            float v1; if (n < 128) v1 = (k < 128) ? cs : sn; else v1 = (k < 128) ? -sn : cs;
            f1[i] = f2bf(v1);
            f2[i] = f2bf(n < 128 ? ((k < 128) ? cs : sn) * (1.0f / 128.0f) : 0.0f); }
        bf16_t* cs256 = WSP(bf16_t, WS_CS256);
        for (int i = gt; i < 256 * 512; i += gn) { const int k = i >> 9, j = i & 511, n = j & 255; const float ang = (float)((n * k) & 255) * (TWO_PI / 256.0f); cs256[i] = f2bf((j < 256 ? cosf(ang) : sinf(ang)) * (1.0f / 16.0f)); }
    }
    {
        LAS float* ct = (LAS float*)F.lds;
        __syncthreads();
        if (F.tid < 64) ct[F.tid] = cosf((float)F.tid * (TWO_PI / 64.0f));
        __syncthreads();
        bf16_t* dst = WSP(bf16_t, WS_W0IN);
        for (int idx = F.bid * 512 + F.tid; idx < 512 * 1024; idx += F.G * 512) {
            const int r = idx >> 10, k = idx & 1023, part = r >> 8, cc = r & 255, g = cc >> 6, cp = cc & 63;
            const float* w = F.p.w0in + (size_t)k * 2560 + g * 64; float s = 0.f;
#pragma unroll 8
            for (int c = 0; c < 64; ++c) { const int ph = (c * cp) & 63; const float t = part ? -ct[(ph + 48) & 63] : ct[ph]; s += w[c] * t; }
            dst[(size_t)(1536 + r) * 1024 + k] = f2bf(s * 0.125f);
        }
        __syncthreads();
    }
    { const float* w = F.p.w0in; bf16_t* d = WSP(bf16_t, WS_W0IN);
      conv_T(F, d, 1536, 1024, 2560, 1.0f, [=](int r) { return w + 256 + r; });
      conv_T(F, d + (size_t)2048 * 1024, 768, 1024, 2560, 1.0f, [=](int r) { return w + 1792 + r; }); }
    { const float* w = F.p.w0out; conv_T(F, WSP(bf16_t, WS_W0OUT), 1024, 1024, 1024, 1.0f, [=](int r) { return w + r; }); }
    { const float* w = F.p.w1in; bf16_t* d = WSP(bf16_t, WS_W1IN);
      conv_T(F, d, 1024, 1024, 6144, 1.0f, [=](int r) { return w + (r & ~255) + sigma_orig(r & 255); });
      conv_T(F, d + (size_t)1024 * 1024, 1024, 1024, 6144, 0.0625f, [=](int r) { return w + 1024 + (r & ~255) + sigma_orig(r & 255); });
      conv_T(F, d + (size_t)2048 * 1024, 4096, 1024, 6144, 1.0f, [=](int r) { return w + 2048 + r; }); }
    { const float* w = F.p.w1out; conv_T(F, WSP(bf16_t, WS_W1OUT), 1024, 2048, 1024, 1.0f, [=](int r) { return w + r; }); }
    conv_moe(F, 0);
}

struct Row { f32x4 v[4]; };
__device__ __forceinline__ void row_load(Row& r, const float* p, int lane) {
#pragma unroll
    for (int i = 0; i < 4; ++i) r.v[i] = *(const f32x4*)(p + 4 * lane + 256 * i);
}
__device__ __forceinline__ void row_store(const Row& r, float* p, int lane) {
#pragma unroll
    for (int i = 0; i < 4; ++i) *(f32x4*)(p + 4 * lane + 256 * i) = r.v[i];
}
__device__ __forceinline__ float row_rstd(const Row& r) {
    float s = 0.f;
#pragma unroll
    for (int i = 0; i < 4; ++i) s += (r.v[i][0] * r.v[i][0] + r.v[i][1] * r.v[i][1]) + (r.v[i][2] * r.v[i][2] + r.v[i][3] * r.v[i][3]);
    s = wave_sum(s);
    return rsqrtf(s * (1.0f / 1024.0f) + RMS_EPS);
}
__device__ __forceinline__ void row_norm_mod(Row& r, const float* g, const float* sh, const float* sc, int lane) {
    const float rs = row_rstd(r);
#pragma unroll
    for (int i = 0; i < 4; ++i) { const int c = 4 * lane + 256 * i; const f32x4 gv = *(const f32x4*)(g + c), shv = *(const f32x4*)(sh + c), scv = *(const f32x4*)(sc + c);
        r.v[i] = (r.v[i] * rs) * gv * (1.0f + scv) + shv; }
}
__device__ __forceinline__ void row_store_bf16(const Row& r, bf16_t* p, int lane) {
#pragma unroll
    for (int i = 0; i < 4; ++i) st_bf16x4(p + 4 * lane + 256 * i, r.v[i]);
}
__device__ __forceinline__ const float* modp(const Frame& F, int layer, bool is_ctx) { return WSP(const float, WS_MOD) + (size_t)(is_ctx ? 2 : 0) * 6144 + layer * 6144; }
__device__ __forceinline__ float* hrow(const Frame& F, int t) { return t < CTXN ? WSP(float, WS_HC) + (size_t)t * DM : F.p.out + (size_t)(t - CTXN) * DM; }

__device__ __forceinline__ void p_norm_in(const Frame& F) {
    bf16_t* xm = WSP(bf16_t, A_XM);
    for (int t = F.bid * 8 + F.wid; t < TT; t += F.G * 8) {
        const bool ic = t < CTXN; const float* src = ic ? F.p.ctx + (size_t)t * DM : F.p.x + (size_t)(t - CTXN) * DM; const float* m = modp(F, 0, ic);
        Row r; row_load(r, src, F.lane); row_norm_mod(r, F.p.norm_g, m, m + 1024, F.lane); row_store_bf16(r, xm + (size_t)t * DM, F.lane);
    }
}
__device__ __forceinline__ void p_norm_l1(const Frame& F, bf16_t* dst) {
    for (int t = CTXN + F.bid * 8 + F.wid; t < TT; t += F.G * 8) {
        const float* m = modp(F, 1, false);
        Row r; row_load(r, hrow(F, t), F.lane); row_norm_mod(r, F.p.norm_g + 2 * DM, m, m + 1024, F.lane); row_store_bf16(r, dst + (size_t)t * DM, F.lane);
    }
}

__device__ __forceinline__ void p_router(const Frame& F, int layer, int t0, bf16_t* dst) {
    LAS float* rwT = (LAS float*)F.lds;
    LAS unsigned* lcnt = (LAS unsigned*)(F.lds + 65536);
    for (int i = F.tid; i < 16 * 1024; i += 512) { const int e = i >> 10, c = i & 1023; rwT[i] = F.p.router_w[c * 16 + e]; }
    if (F.tid < 32) lcnt[F.tid] = 0u;
    __syncthreads();
    int* eid = WSP(int, WS_EID); float* gw = WSP(float, WS_GW); int* slot = WSP(int, WS_SLOT);
    unsigned* gcnt = (unsigned*)(F.p.ws + WS_CTL + CTL_CNT) + layer * 64;
    for (int t = t0 + F.bid * 8 + F.wid; t < TT; t += F.G * 8) {
        const bool ic = t < CTXN; const float* m = modp(F, layer, ic);
        Row r; row_load(r, hrow(F, t), F.lane); row_norm_mod(r, F.p.norm_g + (size_t)(layer * 2 + 1) * DM, m + 3072, m + 4096, F.lane); row_store_bf16(r, dst + (size_t)t * DM, F.lane);
        float lg[16];
#pragma unroll
        for (int e = 0; e < 16; ++e) { float s = 0.f;
#pragma unroll
            for (int i = 0; i < 4; ++i) { const f32x4 w = *(const LAS f32x4*)(rwT + e * 1024 + 4 * F.lane + 256 * i); s += (r.v[i][0] * w[0] + r.v[i][1] * w[1]) + (r.v[i][2] * w[2] + r.v[i][3] * w[3]); }
            lg[e] = wave_sum(s); }
        float scv[16], bi[16];
#pragma unroll
        for (int e = 0; e < 16; ++e) { scv[e] = 1.0f / (1.0f + __expf(-lg[e])); bi[e] = scv[e] + F.p.router_b[e]; }
        int gsel = 0; float best = -1e30f;
#pragma unroll
        for (int g = 0; g < 4; ++g) { const float a = bi[4 * g], b = bi[4 * g + 1], c = bi[4 * g + 2], d = bi[4 * g + 3];
            const float h1 = fmaxf(a, b), l1 = fminf(a, b), h2 = fmaxf(c, d), l2 = fminf(c, d); const float gs = fmaxf(h1, h2) + fmaxf(fminf(h1, h2), fmaxf(l1, l2));
            if (gs > best) { best = gs; gsel = g; } }
        float vb[4], vs[4];
#pragma unroll
        for (int i = 0; i < 4; ++i) { vb[i] = gsel == 0 ? bi[i] : gsel == 1 ? bi[4 + i] : gsel == 2 ? bi[8 + i] : bi[12 + i]; vs[i] = gsel == 0 ? scv[i] : gsel == 1 ? scv[4 + i] : gsel == 2 ? scv[8 + i] : scv[12 + i]; }
        int i0 = 0; float b0 = vb[0];
#pragma unroll
        for (int i = 1; i < 4; ++i) if (vb[i] > b0) { b0 = vb[i]; i0 = i; }
        int i1 = -1; float b1 = -1e30f;
#pragma unroll
        for (int i = 0; i < 4; ++i) if (i != i0 && vb[i] > b1) { b1 = vb[i]; i1 = i; }
        const float s0 = i0 == 0 ? vs[0] : i0 == 1 ? vs[1] : i0 == 2 ? vs[2] : vs[3], s1 = i1 == 0 ? vs[0] : i1 == 1 ? vs[1] : i1 == 2 ? vs[2] : vs[3];
        const float inv = 1.0f / (s0 + s1);
        if (F.lane == 0) {
            const int e0 = gsel * 4 + i0, e1 = gsel * 4 + i1;
            const unsigned r0 = __hip_atomic_fetch_add(lcnt + e0, 1u, __ATOMIC_RELAXED, __HIP_MEMORY_SCOPE_WORKGROUP), r1 = __hip_atomic_fetch_add(lcnt + e1, 1u, __ATOMIC_RELAXED, __HIP_MEMORY_SCOPE_WORKGROUP);
            eid[2 * t] = e0; eid[2 * t + 1] = e1; gw[2 * t] = s0 * inv; gw[2 * t + 1] = s1 * inv; slot[2 * t] = (int)r0; slot[2 * t + 1] = (int)r1;
        }
    }
    __syncthreads();
    if (F.tid < 16) lcnt[16 + F.tid] = __hip_atomic_fetch_add(gcnt + F.tid, lcnt[F.tid], __ATOMIC_RELAXED, __HIP_MEMORY_SCOPE_AGENT);
    __syncthreads();
    for (int t = t0 + F.bid * 8 + F.wid; t < TT; t += F.G * 8)
        if (F.lane < 2) slot[2 * t + F.lane] += (int)lcnt[16 + eid[2 * t + F.lane]];
    __syncthreads();
}
struct PanelTab { int pst[17]; };
__device__ __forceinline__ void panel_tab(const Frame& F, int layer, PanelTab& pt) {
    const unsigned* gcnt = (const unsigned*)(F.p.ws + WS_CTL + CTL_CNT) + layer * 64;
    pt.pst[0] = 0;
#pragma unroll
    for (int e = 0; e < 16; ++e) pt.pst[e + 1] = pt.pst[e] + (int)((__builtin_amdgcn_readfirstlane(gcnt[e]) + 255u) >> 8);
}
__device__ __forceinline__ void p_gather(const Frame& F, int layer, int t0, const bf16_t* xm2, bf16_t* xs) {
    PanelTab pt; panel_tab(F, layer, pt);
    const int* eid = WSP(const int, WS_EID); int* slot = WSP(int, WS_SLOT);
    for (int t = t0 + F.bid * 8 + F.wid; t < TT; t += F.G * 8) {
        const u32x4* src = (const u32x4*)(xm2 + (size_t)t * DM); const u32x4 a = src[F.lane], b = src[64 + F.lane];
#pragma unroll
        for (int k = 0; k < 2; ++k) {
            const int e = eid[2 * t + k]; int ps = 0;
#pragma unroll
            for (int j = 0; j < 16; ++j) ps = (e == j) ? pt.pst[j] : ps;
            const int s = ps * 256 + slot[2 * t + k];
            u32x4* d = (u32x4*)(xs + (size_t)s * DM); d[F.lane] = a; d[64 + F.lane] = b;
            if (F.lane == 0) slot[2 * t + k] = s;
        }
    }
}
__device__ __forceinline__ void row_moe_combine(const Frame& F, Row& r, int t, int layer, const bf16_t* Y) {
    const int* slot = WSP(const int, WS_SLOT); const float* gw = WSP(const float, WS_GW);
    const int s0 = slot[2 * t], s1 = slot[2 * t + 1]; const float w0 = gw[2 * t], w1 = gw[2 * t + 1];
    const float* g2 = modp(F, layer, t < CTXN) + 5120;
#pragma unroll
    for (int i = 0; i < 4; ++i) { const int c = 4 * F.lane + 256 * i;
        const u32x2 a = *(const u32x2*)(Y + (size_t)s0 * DM + c), b = *(const u32x2*)(Y + (size_t)s1 * DM + c); const f32x4 gv = *(const f32x4*)(g2 + c);
        f32x4 f; f[0] = w0 * bflo(a.x) + w1 * bflo(b.x); f[1] = w0 * bfhi(a.x) + w1 * bfhi(b.x); f[2] = w0 * bflo(a.y) + w1 * bflo(b.y); f[3] = w0 * bfhi(a.y) + w1 * bfhi(b.y);
        r.v[i] += gv * f; }
}
__device__ __forceinline__ void p_combine0(const Frame& F) {
    const bf16_t* Y = WSP(const bf16_t, A_XS); bf16_t* xm1 = WSP(bf16_t, B_XM1);
    for (int t = F.bid * 8 + F.wid; t < TT; t += F.G * 8) {
        Row r; float* hp = hrow(F, t); row_load(r, hp, F.lane); row_moe_combine(F, r, t, 0, Y); row_store(r, hp, F.lane);
        const float* m = modp(F, 1, t < CTXN); row_norm_mod(r, F.p.norm_g + 2 * DM, m, m + 1024, F.lane); row_store_bf16(r, xm1 + (size_t)t * DM, F.lane);
    }
}
__device__ __forceinline__ void p_final(const Frame& F) {
    const bf16_t* Y = WSP(const bf16_t, B_XS);
    for (int t = CTXN + F.bid * 8 + F.wid; t < TT; t += F.G * 8) {
        Row r; float* hp = hrow(F, t); row_load(r, hp, F.lane); row_moe_combine(F, r, t, 1, Y);
        const float rs = row_rstd(r);
#pragma unroll
        for (int i = 0; i < 4; ++i) { const f32x4 gv = *(const f32x4*)(F.p.final_g + 4 * F.lane + 256 * i); r.v[i] = (r.v[i] * rs) * gv; }
        row_store(r, hp, F.lane);
    }
}
__device__ __forceinline__ float log_gamma(const Frame& F, int dir, int h) { return log1pf(-expf(F.p.decay[dir * 4 + h])); }
__device__ __forceinline__ void p_scan(const Frame& F) {
    bf16_t* st = WSP(bf16_t, B_ST);
    const int item = F.bid * 512 + F.tid;
    for (int it = item; it < 8 * 16384; it += F.G * 512) {
        const int hd = it >> 14, grp = it & 16383, h = hd >> 1, dir = hd & 1;
        const float lg = log_gamma(F, dir, h), d256 = __expf(256.0f * lg), d512 = __expf(512.0f * lg);
        float s[8];
#pragma unroll
        for (int j = 0; j < 8; ++j) s[j] = 0.f;
#pragma unroll 4
        for (int step = 0; step < 33; ++step) {
            const int c = (dir == 0 || step == 0) ? step : 33 - step;
            u32x4* p = (u32x4*)(st + ((size_t)(c * 8 + hd) * 131072 + (size_t)grp * 8));
            const u32x4 uv = *p; const float dec = (c == 0) ? d256 : d512;
            u32x4 o; o.x = cvt_pk_bf16(s[0], s[1]); o.y = cvt_pk_bf16(s[2], s[3]); o.z = cvt_pk_bf16(s[4], s[5]); o.w = cvt_pk_bf16(s[6], s[7]);
            *p = o;
            s[0] = s[0] * dec + bflo(uv.x); s[1] = s[1] * dec + bfhi(uv.x); s[2] = s[2] * dec + bflo(uv.y); s[3] = s[3] * dec + bfhi(uv.y);
            s[4] = s[4] * dec + bflo(uv.z); s[5] = s[5] * dec + bfhi(uv.z); s[6] = s[6] * dec + bflo(uv.w); s[7] = s[7] * dec + bfhi(uv.w);
        }
    }
}
#define PH_COMMON const unsigned char* ws; int G, bid; static constexpr bool HOOKS = false; \
    __device__ __forceinline__ void hook(int, Acc&, const UnitD&, int, int, int, int) const {}
#define WSC(T, off) ((T*)(ws + (off)))
__device__ __forceinline__ float sel4(f32x4 v, int h) { const float a = h == 0 ? v[0] : v[1], b = h == 2 ? v[2] : v[3]; return h < 2 ? a : b; }
#define SEL4(a, h) sel4(a, h)
#define EFENCE asm volatile("" ::: "memory")

struct PhG1 { PH_COMMON
    __device__ __forceinline__ bool get(int i, UnitD& u) const {
        const int idx = bid + i * G; if (idx >= 715) return false;
        const char* xm = (const char*)(ws + A_XM); const char* w = (const char*)(ws + WS_W0IN);
        if (idx < 390) { const int pm = idx / 6, pn = idx % 6; eng::unit1(u, xm + (size_t)pm * 256 * 2048, 2048, w + (size_t)pn * 256 * 2048, 2048, 16); u.kind = 0; u.i0 = pm; u.i1 = pn; }
        else { const int j = idx - 390, rt = j / 65, ct = j % 65; eng::unit1(u, w + (size_t)(1536 + rt * 256) * 2048, 2048, xm + (size_t)ct * 256 * 2048, 2048, 16); u.kind = rt < 2 ? 1 : 2; u.i0 = rt; u.i1 = ct; }
        return true;
    }
    __device__ __forceinline__ void epi(EPI_ARGS) const {
        if (u.kind == 0) { bf16_t* o = WSC(bf16_t, A_QK0) + (size_t)(u.i0 * 256) * QK0_LD + u.i1 * 256;
            FOR_FRAG(ai, bj, m, n) st_bf16x4(o + (size_t)FRAG_ROW(ai, m) * QK0_LD + FRAG_COL(bj, n), acc[ai][bj][m][n]); }
        else if (u.kind == 2) { bf16_t* o = WSC(bf16_t, A_VT0) + (size_t)((u.i0 - 2) * 256) * TT + u.i1 * 256;
            FOR_FRAG(ai, bj, m, n) st_bf16x4(o + (size_t)FRAG_ROW(ai, m) * TT + FRAG_COL(bj, n), acc[ai][bj][m][n]); }
        else if (u.i1 == 0) { bf16_t* o = WSC(bf16_t, WS_XTC) + u.i0 * 256;
            FOR_FRAG(ai, bj, m, n) st_bf16x4(o + (size_t)FRAG_ROW(ai, m) * 512 + FRAG_COL(bj, n), acc[ai][bj][m][n]); }
        else { bf16_t* o = WSC(bf16_t, A_XT2) + u.i0 * 128;
            FOR_FRAG(ai, bj, m, n) { const int cc = FRAG_ROW(ai, m), nn = (u.i1 - 1) * 256 + FRAG_COL(bj, n), a = nn >> 7, b = nn & 127; const f32x4 v = acc[ai][bj][m][n];
#pragma unroll
                for (int e = 0; e < 4; ++e) o[(size_t)(cc * 128 + b + e) * 256 + a] = f2bf(v[e]);
                EFENCE; } }
    }
};
struct PhF1 { PH_COMMON
    __device__ __forceinline__ bool get(int i, UnitD& u) const {
        const int idx = bid + i * G; if (idx >= 129) return false;
        if (idx < 128) { eng::unit1(u, ws + A_XT2 + (size_t)idx * 256 * 512, 512, ws + WS_F1T, 512, 4); u.kind = 0; u.i0 = idx; }
        else { eng::unit1(u, ws + WS_CS256, 1024, ws + WS_XTC, 1024, 8); u.kind = 1; }
        return true;
    }
    __device__ __forceinline__ void epi(EPI_ARGS) const {
        if (u.kind == 1) { bf16_t* o = WSC(bf16_t, A_AO); FOR_FRAG(ai, bj, m, n) st_bf16x4(o + (size_t)FRAG_ROW(ai, m) * DM + FRAG_COL(bj, n), acc[ai][bj][m][n]); return; }
        const float* twc = WSC(const float, WS_TWC); const float* tws = WSC(const float, WS_TWS); bf16_t* o = WSC(bf16_t, A_T2);
#pragma unroll
        for (int m = 0; m < 4; ++m)
#pragma unroll
            for (int n = 0; n < 2; ++n) { const int b = 64 * wr + 16 * m + fr, k1 = 32 * wc + 16 * n + 4 * fq; const f32x4 cv = *(const f32x4*)(twc + b * 128 + k1), sv = *(const f32x4*)(tws + b * 128 + k1);
#pragma unroll
                for (int ai = 0; ai < 2; ++ai) { const int cc = 2 * u.i0 + ai; const f32x4 tr = acc[ai][0][m][n], ti = acc[ai][1][m][n];
#pragma unroll
                    for (int e = 0; e < 4; ++e) { bf16_t* q = o + (size_t)((k1 + e) * 256 + cc) * 256 + b; q[0] = f2bf(tr[e] * cv[e] + ti[e] * sv[e]); q[128] = f2bf(ti[e] * cv[e] - tr[e] * sv[e]); } } }
    }
};
struct PhF2 { PH_COMMON
    __device__ __forceinline__ bool get(int i, UnitD& u) const {
        const int idx = bid + i * G; if (idx >= 128) return false;
        eng::unit1(u, ws + WS_F2P, 512, ws + A_T2 + (size_t)idx * 256 * 512, 512, 4); u.i0 = idx; return true;
    }
    __device__ __forceinline__ void epi(EPI_ARGS) const {
        bf16_t* o = WSC(bf16_t, A_AO);
#pragma unroll
        for (int m = 0; m < 4; ++m)
#pragma unroll
            for (int bj = 0; bj < 2; ++bj)
#pragma unroll
                for (int n = 0; n < 2; ++n) { const int k2 = FRAG_ROW(0, m); st_bf16x4(o + (size_t)(CTXN + u.i0 + 128 * k2) * DM + FRAG_COL(bj, n), acc[0][bj][m][n]); }
    }
};
struct PhG2 { PH_COMMON const float* x; const float* ctx; float* out;
    __device__ __forceinline__ bool get(int i, UnitD& u) const {
        const int idx = bid + i * G; if (idx >= 260) return false;
        const int pm = idx >> 2, pn = idx & 3; eng::unit1(u, ws + A_AO + (size_t)pm * 256 * 2048, 2048, ws + WS_W0OUT + (size_t)pn * 256 * 2048, 2048, 16); u.i0 = pm; u.i1 = pn; return true;
    }
    __device__ __forceinline__ void epi(EPI_ARGS) const {
        const bool ic = u.i0 == 0; const float* g1 = WSC(const float, WS_MOD) + (ic ? 2 * 6144 : 0) + 2048 + u.i1 * 256;
        const float* src = ic ? ctx : x + (size_t)(u.i0 - 1) * 256 * DM; float* dst = ic ? WSC(float, WS_HC) : out + (size_t)(u.i0 - 1) * 256 * DM;
        FOR_FRAG(ai, bj, m, n) { const size_t off = (size_t)FRAG_ROW(ai, m) * DM + u.i1 * 256 + FRAG_COL(bj, n); const f32x4 gv = *(const f32x4*)(g1 + FRAG_COL(bj, n));
            *(f32x4*)(dst + off) = *(const f32x4*)(src + off) + gv * acc[ai][bj][m][n]; }
    }
};
struct PhM1 { PH_COMMON PanelTab pt; size_t xs, hd;
    __device__ __forceinline__ bool get(int i, UnitD& u) const {
        const int idx = bid + i * G; if (idx >= pt.pst[16] * 4) return false;
        const int p = idx >> 2, j = idx & 3; int e = 0;
#pragma unroll
        for (int k = 1; k < 16; ++k) e += (p >= pt.pst[k]) ? 1 : 0;
        eng::unit1(u, ws + xs + (size_t)p * 256 * 2048, 2048, ws + A_MOEW + ((size_t)e * 1024 + j * 256) * 2048, 2048, 16); u.i0 = p; u.i1 = j; return true;
    }
    __device__ __forceinline__ void epi(EPI_ARGS) const {
        bf16_t* o = (bf16_t*)(ws + hd) + (size_t)(u.i0 * 256) * 512 + u.i1 * 128;
#pragma unroll
        for (int ai = 0; ai < 2; ++ai)
#pragma unroll
            for (int m = 0; m < 4; ++m)
#pragma unroll
                for (int n = 0; n < 2; ++n) { const f32x4 a = acc[ai][0][m][n], b = acc[ai][1][m][n]; f32x4 v;
#pragma unroll
                    for (int e = 0; e < 4; ++e) v[e] = silu_f(a[e]) * b[e];
                    st_bf16x4(o + (size_t)FRAG_ROW(ai, m) * 512 + FRAG_COL(0, n), v); }
    }
};
struct PhM2 { PH_COMMON PanelTab pt; size_t hd, y;
    __device__ __forceinline__ bool get(int i, UnitD& u) const {
        const int idx = bid + i * G; if (idx >= pt.pst[16] * 4) return false;
        const int p = idx >> 2, j = idx & 3; int e = 0;
#pragma unroll
        for (int k = 1; k < 16; ++k) e += (p >= pt.pst[k]) ? 1 : 0;
        eng::unit1(u, ws + hd + (size_t)p * 256 * 1024, 1024, ws + A_MOEW + 32 * MiB + ((size_t)e * 1024 + j * 256) * 1024, 1024, 8); u.i0 = p; u.i1 = j; return true;
    }
    __device__ __forceinline__ void epi(EPI_ARGS) const {
        bf16_t* o = (bf16_t*)(ws + y) + (size_t)(u.i0 * 256) * DM + u.i1 * 256;
        FOR_FRAG(ai, bj, m, n) st_bf16x4(o + (size_t)FRAG_ROW(ai, m) * DM + FRAG_COL(bj, n), acc[ai][bj][m][n]);
    }
};
struct PhG3 { PH_COMMON f32x4 lgf, lgb;
    __device__ __forceinline__ bool get(int i, UnitD& u) const {
        const int idx = bid + i * G; if (idx >= 512 + 780) return false;
        const char* xm = (const char*)(ws + B_XM1); const char* w = (const char*)(ws + WS_W1IN);
        if (idx < 512) { const int pm = 1 + (idx >> 3), pn = idx & 7; eng::unit1(u, xm + (size_t)pm * 256 * 2048, 2048, w + (size_t)pn * 256 * 2048, 2048, 16); u.kind = 0; u.i0 = pm; u.i1 = pn; }
        else { const int j = idx - 512, rt = j / 65, ct = j % 65; eng::unit1(u, w + (size_t)(1024 + rt * 256) * 2048, 2048, xm + (size_t)ct * 256 * 2048, 2048, 16); u.kind = rt < 4 ? 1 : 2; u.i0 = rt; u.i1 = ct; }
        return true;
    }
    __device__ __forceinline__ void epi(EPI_ARGS) const {
        const float* rc = WSC(const float, WS_ROPEC); const float* rs = WSC(const float, WS_ROPES);
        if (u.kind == 0) {
            bf16_t* o = (u.i1 < 4 ? WSC(bf16_t, B_Q) : WSC(bf16_t, B_K)) + (size_t)(u.i0 * 256) * DM + (u.i1 & 3) * 256;
#pragma unroll
            for (int ai = 0; ai < 2; ++ai)
#pragma unroll
                for (int m = 0; m < 4; ++m) { const int r = FRAG_ROW(ai, m), tl = (u.i0 - 1) * 256 + r;
#pragma unroll
                    for (int bj = 0; bj < 2; ++bj) { const int pos = bj == 0 ? (tl >> 6) : (tl & 63); const f32x4 cv = *(const f32x4*)(rc + pos * 64 + 16 * wc + 4 * fq), sv = *(const f32x4*)(rs + pos * 64 + 16 * wc + 4 * fq);
                        const f32x4 x1 = acc[ai][bj][m][0], x2 = acc[ai][bj][m][1];
                        st_bf16x4(o + (size_t)r * DM + FRAG_COL(bj, 0), x1 * cv - x2 * sv); st_bf16x4(o + (size_t)r * DM + FRAG_COL(bj, 1), x2 * cv + x1 * sv); } }
        } else if (u.kind == 2) { bf16_t* o = WSC(bf16_t, B_VT) + (size_t)((u.i0 - 4) * 256) * TT + u.i1 * 256;
            FOR_FRAG(ai, bj, m, n) st_bf16x4(o + (size_t)FRAG_ROW(ai, m) * TT + FRAG_COL(bj, n), acc[ai][bj][m][n]);
        } else {
            const int h = u.i0; const float lf = SEL4(lgf, h), lb = SEL4(lgb, h);
            bf16_t* of = WSC(bf16_t, B_KF) + (size_t)(h * 256) * TT + u.i1 * 256; bf16_t* ob = WSC(bf16_t, B_KB) + (size_t)(h * 256) * TT + u.i1 * 256;
#pragma unroll
            for (int bj = 0; bj < 2; ++bj)
#pragma unroll
                for (int n = 0; n < 2; ++n) { const int c0 = FRAG_COL(bj, n); f32x4 df, db;
                    if (u.i1 == 0) {
#pragma unroll
                        for (int e = 0; e < 4; ++e) { const int pos = c0 + e; df[e] = __expf(lf * (float)(255 - pos)); db[e] = __expf(lb * (float)pos); }
                    } else {
#pragma unroll
                        for (int e = 0; e < 4; ++e) { const int pos = ((u.i1 - 1) * 256 + c0 + e) & 511; df[e] = __expf(lf * (float)(511 - pos)); db[e] = __expf(lb * (float)pos); }
                    }
#pragma unroll
                    for (int ai = 0; ai < 2; ++ai)
#pragma unroll
                        for (int mp = 0; mp < 2; ++mp) { const int p = 32 * wr + 16 * mp + fr; f32x4 x1 = acc[ai][bj][2 * mp][n], x2 = acc[ai][bj][2 * mp + 1][n];
                            if (u.i1 != 0) { const int tl = (u.i1 - 1) * 256 + c0; f32x4 cv, sv;
                                if (ai == 0) { const float c = rc[(tl >> 6) * 64 + p], s = rs[(tl >> 6) * 64 + p]; cv = (f32x4){c, c, c, c}; sv = (f32x4){s, s, s, s}; }
                                else {
#pragma unroll
                                    for (int e = 0; e < 4; ++e) { cv[e] = rc[((tl + e) & 63) * 64 + p]; sv[e] = rs[((tl + e) & 63) * 64 + p]; } }
                                const f32x4 y1 = x1 * cv - x2 * sv, y2 = x2 * cv + x1 * sv; x1 = y1; x2 = y2; }
                            const size_t o1 = (size_t)FRAG_ROW(ai, 2 * mp) * TT + c0, o2 = (size_t)FRAG_ROW(ai, 2 * mp + 1) * TT + c0;
                            st_bf16x4(of + o1, x1 * df); st_bf16x4(of + o2, x2 * df); st_bf16x4(ob + o1, x1 * db); st_bf16x4(ob + o2, x2 * db); } }
        }
    }
};
__device__ __forceinline__ int chunk_tok0(int c) { return c == 0 ? 0 : 256 + 512 * (c - 1); }
struct PhU { PH_COMMON
    __device__ __forceinline__ bool get(int i, UnitD& u) const {
        const int idx = bid + i * G; if (idx >= 528) return false;
        const int dvt = idx & 1, dir = (idx >> 1) & 1, h = (idx >> 2) & 3, c = idx >> 4; const size_t tk = (size_t)chunk_tok0(c) * 2;
        eng::unit1(u, ws + B_VT + (size_t)(h * 512 + dvt * 256) * TT * 2 + tk, TT * 2, ws + (dir ? B_KB : B_KF) + (size_t)(h * 256) * TT * 2 + tk, TT * 2, c == 0 ? 4 : 8);
        u.i0 = (c * 8 + h * 2 + dir); u.i1 = dvt; return true;
    }
    __device__ __forceinline__ void epi(EPI_ARGS) const {
        bf16_t* o = WSC(bf16_t, B_ST) + (size_t)u.i0 * 131072 + (size_t)(u.i1 * 256) * 256;
        FOR_FRAG(ai, bj, m, n) st_bf16x4(o + (size_t)FRAG_ROW(ai, m) * 256 + FRAG_COL(bj, n), acc[ai][bj][m][n]);
    }
};
struct PhSD { PH_COMMON f32x4 lgf, lgb;
    __device__ __forceinline__ bool get(int i, UnitD& u) const {
        const int idx = bid + i * G; if (idx >= 512) return false;
        const int tj = idx & 1, ti = (idx >> 1) & 1, h = (idx >> 2) & 3, c = 1 + (idx >> 4); const int t0 = chunk_tok0(c);
        eng::unit1(u, ws + B_Q + (size_t)(t0 + 256 * ti) * 2048 + h * 512, 2048, ws + B_K + (size_t)(t0 + 256 * tj) * 2048 + h * 512, 2048, 4);
        u.i0 = t0; u.i1 = h; u.i2 = ti * 2 + tj; return true;
    }
    __device__ __forceinline__ void epi(EPI_ARGS) const {
        const int ti = u.i2 >> 1, tj = u.i2 & 1, h = u.i1; const float lf = SEL4(lgf, h), lb = SEL4(lgb, h);
        bf16_t* o = WSC(bf16_t, B_SD) + (size_t)(u.i0 + 256 * ti) * 2048 + h * 512 + 256 * tj;
        FOR_FRAG(ai, bj, m, n) { const int r = FRAG_ROW(ai, m), c0 = FRAG_COL(bj, n), i = 256 * ti + r; f32x4 v = acc[ai][bj][m][n];
#pragma unroll
            for (int e = 0; e < 4; ++e) { const int d = i - (256 * tj + c0 + e); const float w = d > 0 ? __expf(lf * (float)d) : d < 0 ? __expf(lb * (float)(-d)) : 2.0f; v[e] *= w; }
            st_bf16x4(o + (size_t)r * 2048 + c0, v); }
    }
};
struct PhO { const unsigned char* ws; int G, bid; f32x4 lgf, lgb; static constexpr bool HOOKS = true;
    __device__ __forceinline__ bool get(int i, UnitD& u) const {
        const int idx = bid + i * G; if (idx >= 512) return false;
        const int dvt = idx & 1, h = (idx >> 1) & 3, pm = idx >> 3, c = 1 + (pm >> 1), t0 = CTXN + 256 * pm;
        const char* q = (const char*)(ws + B_Q) + (size_t)t0 * 2048 + h * 512;
        const char* st = (const char*)(ws + B_ST) + ((size_t)(c * 8 + h * 2) * 131072 + (size_t)(dvt * 256) * 256) * 2;
        u.A0 = q; u.B0 = st; u.lda0 = 2048; u.ldb0 = 512; u.n0 = 4;
        u.A1 = q; u.B1 = st + (size_t)131072 * 2; u.lda1 = 2048; u.ldb1 = 512; u.n1 = 4;
        u.A2 = (const char*)(ws + B_SD) + (size_t)t0 * 4096 + h * 1024; u.B2 = (const char*)(ws + B_VT) + (size_t)(h * 512 + dvt * 256) * TT * 2 + (size_t)chunk_tok0(c) * 2; u.lda2 = 4096; u.ldb2 = TT * 2; u.n2 = 8;
        u.kind = 0; u.i0 = pm; u.i1 = h; u.i2 = dvt; return true;
    }
    __device__ __forceinline__ void hook(int tc, Acc& acc, const UnitD& u, int wr, int wc, int fr, int fq) const {
        if (tc != 4 && tc != 8) return;
        const float lf = SEL4(lgf, u.i1), lb = SEL4(lgb, u.i1);
#pragma unroll
        for (int ai = 0; ai < 2; ++ai)
#pragma unroll
            for (int m = 0; m < 4; ++m) { const int i = (u.i0 & 1) * 256 + FRAG_ROW(ai, m);
                const float s = tc == 4 ? __expf(lf * (float)(i + 1) - lb * (float)(512 - i)) : __expf(lb * (float)(512 - i));
#pragma unroll
                for (int bj = 0; bj < 2; ++bj)
#pragma unroll
                    for (int n = 0; n < 2; ++n) acc[ai][bj][m][n] *= s; }
    }
    __device__ __forceinline__ void epi(EPI_ARGS) const {
        const int tl = 256 * u.i0, h = u.i1, dvt = u.i2;
        bf16_t* o = WSC(bf16_t, B_O) + (size_t)(CTXN + tl) * 2048 + h * 512 + dvt * 256; float* ssq = WSC(float, WS_SSQ);
#pragma unroll
        for (int ai = 0; ai < 2; ++ai)
#pragma unroll
            for (int m = 0; m < 4; ++m) { const int r = FRAG_ROW(ai, m); float s = 0.f;
#pragma unroll
                for (int bj = 0; bj < 2; ++bj)
#pragma unroll
                    for (int n = 0; n < 2; ++n) { const f32x4 v = acc[ai][bj][m][n]; s += (v[0] * v[0] + v[1] * v[1]) + (v[2] * v[2] + v[3] * v[3]); st_bf16x4(o + (size_t)r * 2048 + FRAG_COL(bj, n), v); }
                s += __shfl_xor(s, 16); s += __shfl_xor(s, 32);
                if (fq == 0) ssq[((size_t)(tl + r) * 4 + h) * 8 + dvt * 4 + wc] = s; }
    }
};
struct PhGG { PH_COMMON
    __device__ __forceinline__ bool get(int i, UnitD& u) const {
        const int idx = bid + i * G; if (idx >= 512) return false;
        const int pm = 1 + (idx >> 3), pn = idx & 7; eng::unit1(u, ws + B_XM1B + (size_t)pm * 256 * 2048, 2048, ws + WS_W1IN + (size_t)(4096 + pn * 256) * 2048, 2048, 16); u.i0 = pm; u.i1 = pn; return true;
    }
    __device__ __forceinline__ void epi(EPI_ARGS) const {
        bf16_t* o = WSC(bf16_t, B_O) + (size_t)(u.i0 * 256) * 2048 + u.i1 * 256; const float* ssq = WSC(const float, WS_SSQ); const int h = u.i1 >> 1;
#pragma unroll
        for (int ai = 0; ai < 2; ++ai)
#pragma unroll
            for (int m = 0; m < 4; ++m) { const int r = FRAG_ROW(ai, m); const float* sp = ssq + ((size_t)((u.i0 - 1) * 256 + r) * 4 + h) * 8;
                const f32x4 s0 = *(const f32x4*)sp, s1 = *(const f32x4*)(sp + 4); const float rstd = rsqrtf((((s0[0] + s0[1]) + (s0[2] + s0[3])) + ((s1[0] + s1[1]) + (s1[2] + s1[3]))) * (1.0f / 512.0f) + RMS_EPS);
#pragma unroll
                for (int bj = 0; bj < 2; ++bj)
#pragma unroll
                    for (int n = 0; n < 2; ++n) { bf16_t* q = o + (size_t)r * 2048 + FRAG_COL(bj, n); const u32x2 ov = *(const u32x2*)q; const f32x4 g = acc[ai][bj][m][n]; f32x4 v;
                        v[0] = silu_f(g[0]) * (bflo(ov.x) * rstd); v[1] = silu_f(g[1]) * (bfhi(ov.x) * rstd); v[2] = silu_f(g[2]) * (bflo(ov.y) * rstd); v[3] = silu_f(g[3]) * (bfhi(ov.y) * rstd);
                        st_bf16x4(q, v); } }
    }
};
struct PhG4 { PH_COMMON float* out;
    __device__ __forceinline__ bool get(int i, UnitD& u) const {
        const int idx = bid + i * G; if (idx >= 256) return false;
        const int pm = idx >> 2, pn = idx & 3; eng::unit1(u, ws + B_O + (size_t)(CTXN + pm * 256) * 4096, 4096, ws + WS_W1OUT + (size_t)pn * 256 * 4096, 4096, 32); u.i0 = pm; u.i1 = pn; return true;
    }
    __device__ __forceinline__ void epi(EPI_ARGS) const {
        const float* g1 = WSC(const float, WS_MOD) + 6144 + 2048 + u.i1 * 256; float* dst = out + (size_t)(u.i0 * 256) * DM + u.i1 * 256;
        FOR_FRAG(ai, bj, m, n) { float* q = dst + (size_t)FRAG_ROW(ai, m) * DM + FRAG_COL(bj, n); const f32x4 gv = *(const f32x4*)(g1 + FRAG_COL(bj, n)); *(f32x4*)q = *(const f32x4*)q + gv * acc[ai][bj][m][n]; }
    }
};

template <bool LOCAL>
__device__ __forceinline__ void na_unit(const Frame& F, int r, int j, int h, int qb, const LAS float* rpb_l) {
    const bf16_t* qk = WSP(const bf16_t, A_QK0); const bf16_t* vt = WSP(const bf16_t, A_VT0); bf16_t* ao = WSP(bf16_t, A_AO);
    const int lane = F.lane, q16 = lane & 15, g = lane >> 4;
    const int tq = LOCAL ? CTXN + r * GW + 16 * j + q16 : 16 * qb + q16;
    bf16x8 qf[2];
#pragma unroll
    for (int ks = 0; ks < 2; ++ks) qf[ks] = *(const bf16x8*)(qk + (size_t)tq * QK0_LD + h * 64 + 32 * ks + 8 * g);
    constexpr int NT = LOCAL ? 32 : 16;
    f32x4 s[NT];
    const int rs = LOCAL ? min(max(r - 4, 0), 248) : 0, kst = LOCAL ? min(max(16 * j - 8, 0), 32) : 0;
    const int krow = 8 * (q16 >> 2) + (q16 & 3);
#pragma unroll
    for (int t = 0; t < NT; ++t) {
        int tok;
        if (LOCAL && t < 16) tok = CTXN + (rs + (t >> 1)) * GW + kst + krow + 4 * (t & 1); else tok = 32 * ((t - (LOCAL ? 16 : 0)) >> 1) + krow + 4 * (t & 1);
        const bf16_t* kp = qk + (size_t)tok * QK0_LD + 768 + h * 64 + 8 * g;
        const bf16x8 k0 = *(const bf16x8*)kp, k1 = *(const bf16x8*)(kp + 32);
        f32x4 a = {0.f, 0.f, 0.f, 0.f};
        a = __builtin_amdgcn_mfma_f32_16x16x32_bf16(k0, qf[0], a, 0, 0, 0); a = __builtin_amdgcn_mfma_f32_16x16x32_bf16(k1, qf[1], a, 0, 0, 0);
        s[t] = a;
    }
    float mx = -1e30f;
    if (LOCAL) { const int qc = 16 * j + q16, wst = min(max(qc - 8, 0), 48);
#pragma unroll
        for (int t = 0; t < 16; ++t) { const int dr = rs + (t >> 1) - r + 7;
#pragma unroll
            for (int e = 0; e < 4; ++e) { const int kc = kst + 8 * g + 4 * (t & 1) + e; const bool ok = kc >= wst && kc < wst + 16; const int dc = min(max(kc - qc + 15, 0), 30);
                const float v = ok ? s[t][e] * 0.125f + rpb_l[(h * 15 + dr) * 31 + dc] : -1e30f; s[t][e] = v; mx = fmaxf(mx, v); } } }
#pragma unroll
    for (int t = LOCAL ? 16 : 0; t < NT; ++t)
#pragma unroll
        for (int e = 0; e < 4; ++e) { const float v = s[t][e] * 0.125f; s[t][e] = v; mx = fmaxf(mx, v); }
    mx = fmaxf(mx, __shfl_xor(mx, 16)); mx = fmaxf(mx, __shfl_xor(mx, 32));
    float sum = 0.f;
#pragma unroll
    for (int t = 0; t < NT; ++t)
#pragma unroll
        for (int e = 0; e < 4; ++e) { const float p = __expf(s[t][e] - mx); s[t][e] = p; sum += p; }
    sum += __shfl_xor(sum, 16); sum += __shfl_xor(sum, 32);
    f32x4 o[4];
#pragma unroll
    for (int dt = 0; dt < 4; ++dt) o[dt] = (f32x4){0.f, 0.f, 0.f, 0.f};
#pragma unroll
    for (int b = 0; b < NT / 2; ++b) {
        u32x4 pw; pw.x = cvt_pk_bf16(s[2 * b][0], s[2 * b][1]); pw.y = cvt_pk_bf16(s[2 * b][2], s[2 * b][3]); pw.z = cvt_pk_bf16(s[2 * b + 1][0], s[2 * b + 1][1]); pw.w = cvt_pk_bf16(s[2 * b + 1][2], s[2 * b + 1][3]);
        const bf16x8 pf = __builtin_bit_cast(bf16x8, pw);
        int tok0;
        if (LOCAL && b < 8) tok0 = CTXN + (rs + b) * GW + kst; else tok0 = 32 * (b - (LOCAL ? 8 : 0));
#pragma unroll
        for (int dt = 0; dt < 4; ++dt) { const bf16x8 vf = *(const bf16x8*)(vt + (size_t)(h * 64 + 16 * dt + q16) * TT + tok0 + 8 * g);
            o[dt] = __builtin_amdgcn_mfma_f32_16x16x32_bf16(vf, pf, o[dt], 0, 0, 0); }
    }
    const float inv = 1.0f / sum;
#pragma unroll
    for (int dt = 0; dt < 4; ++dt) st_bf16x4(ao + (size_t)tq * DM + 256 + h * 64 + 16 * dt + 4 * g, o[dt] * inv);
}
__device__ __forceinline__ void p_attention(const Frame& F) {
    LAS float* rpb_l = (LAS float*)F.lds;
    for (int i = F.tid; i < 12 * 15 * 31; i += 512) rpb_l[i] = F.p.rpb[i];
    __syncthreads();
    unsigned* head = (unsigned*)(F.p.ws + WS_CTL + CTL_QUEUE);
    for (;;) {
        unsigned qi = 0; if (F.lane == 0) qi = __hip_atomic_fetch_add(head, 1u, __ATOMIC_RELAXED, __HIP_MEMORY_SCOPE_AGENT);
        qi = (unsigned)__builtin_amdgcn_readfirstlane((int)qi);
        if (qi >= 12288u + 192u) break;
        if (qi < 12288u) { const int j = qi & 3, h = (qi >> 2) % 12, r = (qi >> 2) / 12; na_unit<true>(F, r, j, h, 0, rpb_l); }
        else { const int q2 = qi - 12288; na_unit<false>(F, 0, 0, q2 % 12, q2 / 12, rpb_l); }
    }
    __syncthreads();
}
constexpr int LDS_BYTES = eng::STAGE_BYTES + 1024;
#ifndef MK_PER_PHASE
#define MK_PER_PHASE 0
#endif

__global__ __launch_bounds__(512, 2) void mk_fwd(Params p) {
    extern __shared__ __attribute__((aligned(16))) unsigned char shm[];
    Frame F; F.p = p; F.lds = (LAS unsigned char*)shm; F.tid = threadIdx.x; F.lane = F.tid & 63; F.wid = __builtin_amdgcn_readfirstlane(F.tid >> 6); F.G = gridDim.x; F.bid = blockIdx.x;
    volatile LAS unsigned* xb = (volatile LAS unsigned*)(F.lds + eng::STAGE_BYTES);
    if (F.tid < 4) xb[F.tid] = 0u;
    __syncthreads();
    const int lo = p.ph_lo, hi = p.ph_hi;
    XcdBarrier bar; bar.bar = (unsigned*)(p.ws + WS_CTL); bar.x = 0; bar.st = xb;
    if (hi - lo > 1) bar = xcd_barrier_post((unsigned*)(p.ws + WS_CTL), xb);
#ifndef PHMASK
#define PHMASK 0xFFFFFFu
#endif
#define IN(k) (((PHMASK >> (k)) & 1u) && lo <= (k) && (k) < hi)
#define SEAM(k) do { if (IN(k) && IN((k) + 1)) xcd_barrier(bar); } while (0)
    const unsigned char* ws = p.ws;

    if (IN(0)) { p0_prologue(F); } SEAM(0);
    if (IN(1)) { p_norm_in(F); } SEAM(1);
    if (IN(2)) { PhG1 ph{ws, F.G, F.bid}; eng::gemm_run(F.lds, ph); } SEAM(2);
    if (IN(3)) { PhF1 ph{ws, F.G, F.bid}; eng::gemm_run(F.lds, ph); p_attention(F); } SEAM(3);
    if (IN(4)) { PhF2 ph{ws, F.G, F.bid}; eng::gemm_run(F.lds, ph); } SEAM(4);
    if (IN(5)) { PhG2 ph{ws, F.G, F.bid, p.x, p.ctx, p.out}; eng::gemm_run(F.lds, ph); } SEAM(5);
    if (IN(6)) { p_router(F, 0, 0, WSP(bf16_t, A_XM)); } SEAM(6);
    if (IN(7)) { p_gather(F, 0, 0, WSP(const bf16_t, A_XM), WSP(bf16_t, A_XS)); } SEAM(7);
    if (IN(8)) { PhM1 ph{ws, F.G, F.bid}; panel_tab(F, 0, ph.pt); ph.xs = A_XS; ph.hd = A_HD; eng::gemm_run(F.lds, ph); } SEAM(8);
    if (IN(9)) { PhM2 ph{ws, F.G, F.bid}; panel_tab(F, 0, ph.pt); ph.hd = A_HD; ph.y = A_XS; eng::gemm_run(F.lds, ph); } SEAM(9);
    if (IN(10)) { p_combine0(F); } SEAM(10);
    if (IN(11)) { PhG3 ph{ws, F.G, F.bid};
        ph.lgf = (f32x4){log_gamma(F, 0, 0), log_gamma(F, 0, 1), log_gamma(F, 0, 2), log_gamma(F, 0, 3)}; ph.lgb = (f32x4){log_gamma(F, 1, 0), log_gamma(F, 1, 1), log_gamma(F, 1, 2), log_gamma(F, 1, 3)};
        eng::gemm_run(F.lds, ph); } SEAM(11);
    if (IN(12)) { PhU ph{ws, F.G, F.bid}; eng::gemm_run(F.lds, ph); } SEAM(12);
    if (IN(13)) { p_scan(F); } SEAM(13);
    if (IN(14)) { PhSD ph{ws, F.G, F.bid};
        ph.lgf = (f32x4){log_gamma(F, 0, 0), log_gamma(F, 0, 1), log_gamma(F, 0, 2), log_gamma(F, 0, 3)}; ph.lgb = (f32x4){log_gamma(F, 1, 0), log_gamma(F, 1, 1), log_gamma(F, 1, 2), log_gamma(F, 1, 3)};
        eng::gemm_run(F.lds, ph); } SEAM(14);
    if (IN(15)) { PhO ph{ws, F.G, F.bid};
        ph.lgf = (f32x4){log_gamma(F, 0, 0), log_gamma(F, 0, 1), log_gamma(F, 0, 2), log_gamma(F, 0, 3)}; ph.lgb = (f32x4){log_gamma(F, 1, 0), log_gamma(F, 1, 1), log_gamma(F, 1, 2), log_gamma(F, 1, 3)};
        eng::gemm_run(F.lds, ph); } SEAM(15);
    if (IN(16)) { p_norm_l1(F, WSP(bf16_t, B_XM1B)); conv_moe(F, 1); } SEAM(16);
    if (IN(17)) { PhGG ph{ws, F.G, F.bid}; eng::gemm_run(F.lds, ph); } SEAM(17);
    if (IN(18)) { PhG4 ph{ws, F.G, F.bid, p.out}; eng::gemm_run(F.lds, ph); } SEAM(18);
    if (IN(19)) { p_router(F, 1, CTXN, WSP(bf16_t, B_XM2)); } SEAM(19);
    if (IN(20)) { p_gather(F, 1, CTXN, WSP(const bf16_t, B_XM2), WSP(bf16_t, B_XS)); } SEAM(20);
    if (IN(21)) { PhM1 ph{ws, F.G, F.bid}; panel_tab(F, 1, ph.pt); ph.xs = B_XS; ph.hd = B_HD; eng::gemm_run(F.lds, ph); } SEAM(21);
    if (IN(22)) { PhM2 ph{ws, F.G, F.bid}; panel_tab(F, 1, ph.pt); ph.hd = B_HD; ph.y = B_XS; eng::gemm_run(F.lds, ph); } SEAM(22);
    if (IN(23)) { p_final(F); }
#undef IN
#undef SEAM
}

extern "C" void kernel_launch(void* const* d_in, const int* in_sizes, int n_in, void* d_out, int out_size, void* d_ws, size_t ws_size, hipStream_t stream) {
    static int grid = 0;
    if (grid == 0) {
        if (n_in != 19 || out_size != SEQ * DM || ws_size < WS_END) { fprintf(stderr, "kernel_launch: unexpected shapes (n_in %d, out %d, ws %zu < %zu)\n", n_in, out_size, ws_size, (size_t)WS_END); grid = -1; return; }
        int dev = 0, cus = 0, per_cu = 0;
        if (hipGetDevice(&dev) != hipSuccess || hipDeviceGetAttribute(&cus, hipDeviceAttributeMultiprocessorCount, dev) != hipSuccess) { grid = -1; return; }
        if (hipFuncSetAttribute((const void*)mk_fwd, hipFuncAttributeMaxDynamicSharedMemorySize, LDS_BYTES) != hipSuccess) { fprintf(stderr, "kernel_launch: hipFuncSetAttribute failed\n"); grid = -1; return; }
        if (hipOccupancyMaxActiveBlocksPerMultiprocessor(&per_cu, (const void*)mk_fwd, 512, LDS_BYTES) != hipSuccess || per_cu < 1) { fprintf(stderr, "kernel_launch: occupancy query says %d\n", per_cu); per_cu = 1; }
        (void)hipGetLastError();
        grid = cus;
        if (grid > 256) grid = 256;
    }
    if (grid < 0) return;
    (void)hipMemsetAsync((char*)d_ws + WS_CTL, 0, CTL_BYTES, stream);
    Params p{};
    const float** pp = (const float**)&p;
    for (int i = 0; i < 19; ++i) pp[i] = (const float*)d_in[i];
    p.out = (float*)d_out; p.ws = (unsigned char*)d_ws;
#if MK_PER_PHASE
    for (int ph = 0; ph < NPHASE; ++ph) { p.ph_lo = ph; p.ph_hi = ph + 1; hipLaunchKernelGGL(mk_fwd, dim3(grid), dim3(512), LDS_BYTES, stream, p); }
#else
    p.ph_lo = 0; p.ph_hi = NPHASE; hipLaunchKernelGGL(mk_fwd, dim3(grid), dim3(512), LDS_BYTES, stream, p);
#endif
}
```

```cpp
#include <hip/hip_runtime.h>
#include <cstdio>
#include <cstdint>

typedef unsigned short bf16_t;
typedef short bf16x8 __attribute__((ext_vector_type(8)));
typedef float f32x4 __attribute__((ext_vector_type(4)));
typedef float f32x2 __attribute__((ext_vector_type(2)));
typedef unsigned u32x2 __attribute__((ext_vector_type(2)));
typedef unsigned u32x4 __attribute__((ext_vector_type(4)));
#define LAS __attribute__((address_space(3)))

constexpr int DM = 1024, SEQ = 16384, CTXN = 256, TT = SEQ + CTXN  , GW = 64;
constexpr int NH0 = 12, QK0_LD = 1536, W0IN_ROWS = 2816;
constexpr int NPMAX = 146;
constexpr float RMS_EPS = 1e-6f;
constexpr int NPHASE = 24;

constexpr size_t KiB = 1024, MiB = 1024 * 1024, HMiB = 512 * 1024;
constexpr size_t WS_CTL = 0;
constexpr size_t CTL_BYTES = 64 * KiB;
constexpr size_t CTL_CNT = 16 * KiB;
constexpr size_t CTL_QUEUE = 20 * KiB;
constexpr size_t WS_MOD = 64 * KiB;
constexpr size_t WS_TWC = 256 * KiB, WS_TWS = 320 * KiB;
constexpr size_t WS_ROPEC = 384 * KiB, WS_ROPES = 448 * KiB;
constexpr size_t WS_F1T = 512 * KiB, WS_F2P = 640 * KiB;
constexpr size_t WS_CS256 = 768 * KiB;
constexpr size_t WS_HC = 1 * MiB;
constexpr size_t WS_EID = 2 * MiB;
constexpr size_t WS_GW = 2 * MiB + 256 * KiB;
constexpr size_t WS_SLOT = 2 * MiB + 512 * KiB;
constexpr size_t WS_SSQ = 3 * MiB;
constexpr size_t WS_XTC = 5 * MiB;
constexpr size_t WS_W0IN = 8 * MiB, WS_W0OUT = 14 * MiB, WS_W1IN = 16 * MiB, WS_W1OUT = 28 * MiB;
constexpr size_t AR = 32 * MiB;
constexpr size_t A_XM = AR + 0, A_QK0 = AR + 65 * HMiB, A_VT0 = AR + 81 * MiB + 256 * KiB, A_XT2 = AR + 106 * MiB, A_T2 = AR + 122 * MiB + HMiB, A_AO = AR + 139 * MiB;
constexpr size_t A_XS = AR + 65 * HMiB, A_HD = AR + 106 * MiB, A_MOEW = AR + 245 * MiB;
constexpr size_t B_Q = AR + 0, B_K = AR + 65 * HMiB, B_O = AR + 65 * HMiB, B_KF = AR + 195 * HMiB, B_KB = AR + 130 * MiB, B_SD = AR + 195 * HMiB, B_VT = AR + 325 * HMiB;
constexpr size_t B_XM1 = AR + 455 * HMiB, B_ST = AR + 455 * HMiB, B_XM1B = AR + 0, B_XM2 = AR + 0, B_XS = AR + 195 * HMiB, B_HD = AR + 341 * HMiB;
constexpr size_t WS_END = AR + 294 * MiB;

struct Params {
    const float *x, *c, *ctx, *c_ctx, *ada_w, *ada_b, *norm_g, *final_g, *w0in, *w0out, *rpb, *w1in, *w1out, *decay, *router_w, *router_b, *moe_w1, *moe_w3, *moe_w2;
    float* out; unsigned char* ws; int ph_lo, ph_hi;
};

__device__ __forceinline__ unsigned cvt_pk_bf16(float lo, float hi) { unsigned r; asm volatile("v_cvt_pk_bf16_f32 %0, %1, %2" : "=v"(r) : "v"(lo), "v"(hi)); return r; }
__device__ __forceinline__ bf16_t f2bf(float f) { return (bf16_t)(cvt_pk_bf16(f, 0.f) & 0xffffu); }
__device__ __forceinline__ float bf2f(unsigned short b) { return __uint_as_float(((unsigned)b) << 16); }
__device__ __forceinline__ float bflo(unsigned w) { return __uint_as_float(w << 16); }
__device__ __forceinline__ float bfhi(unsigned w) { return __uint_as_float(w & 0xffff0000u); }
__device__ __forceinline__ float silu_f(float v) { return v / (1.0f + __expf(-v)); }
__device__ __forceinline__ float wave_sum(float v) {
#pragma unroll
    for (int o = 32; o >= 1; o >>= 1) v += __shfl_xor(v, o);
    return v;
}
__device__ __forceinline__ float wave_max(float v) {
#pragma unroll
    for (int o = 32; o >= 1; o >>= 1) v = fmaxf(v, __shfl_xor(v, o));
    return v;
}
#define XB_TMO      128
#define XB_XCNT(j)  (256  + 64 * (j))
#define XB_XSUB(j)  (1280 + 64 * (j))
#define XB_XGEN(j)  (2304 + 64 * (j))
#define XB_TOP      3328
#define XB_TOPGEN   3392
#define XCD_BAR_WORDS 3456
#define XB_SPIN_CAP (1u << 18)

__device__ __forceinline__ unsigned xb_ld(unsigned* p)              { return __hip_atomic_load(p, __ATOMIC_RELAXED, __HIP_MEMORY_SCOPE_AGENT); }
__device__ __forceinline__ unsigned xb_add(unsigned* p, unsigned v) { return __hip_atomic_fetch_add(p, v, __ATOMIC_RELAXED, __HIP_MEMORY_SCOPE_AGENT); }
__device__ __forceinline__ unsigned xb_xcc_id() { return (unsigned)__builtin_amdgcn_s_getreg((3 << 11) | 20) & 0xFu; }
#define XB_SPIN(cond, bar) do { unsigned _sp = 0; while (cond) { __builtin_amdgcn_s_sleep(1); \
    if ((++_sp & 255u) == 0u) { if (xb_ld(&(bar)[XB_TMO])) break; if (_sp > XB_SPIN_CAP) { atomicAdd(&(bar)[XB_TMO], 1u); break; } } } } while (0)

struct XcdBarrier {
    unsigned* bar; unsigned x;
    volatile LAS unsigned* st;
};

__device__ __forceinline__ XcdBarrier xcd_barrier_post(unsigned* bar, volatile LAS unsigned* st) {
    XcdBarrier b; b.bar = bar; b.x = xb_xcc_id(); b.st = st;
    if (threadIdx.x == 0) (void)xb_add(&bar[XB_XCNT(b.x)], 1u);
    return b;
}
__device__ __forceinline__ void xcd_barrier_complete(unsigned* bar, unsigned x, unsigned& nloc, unsigned& nx) {
    const unsigned G = gridDim.x * gridDim.y * gridDim.z;
    unsigned sum, cnt, mine, sp = 0u;
    for (;;) {
        sum = 0u; cnt = 0u; mine = 0u;
#pragma unroll
        for (unsigned j = 0; j < 16; ++j) { const unsigned c = xb_ld(&bar[XB_XCNT(j)]); sum += c; cnt += (c > 0u) ? 1u : 0u; mine = (j == x) ? c : mine; }
        if (sum == G) break;
        __builtin_amdgcn_s_sleep(1);
        if ((++sp & 255u) == 0u) { if (xb_ld(&bar[XB_TMO])) break; if (sp > XB_SPIN_CAP) { atomicAdd(&bar[XB_TMO], 1u); break; } }
    }
    nloc = mine > 0u ? mine : 1u; nx = cnt > 0u ? cnt : 1u;
}

__device__ __forceinline__ void xcd_barrier(const XcdBarrier& b) {
    asm volatile("s_waitcnt vmcnt(0)" ::: "memory");
    __syncthreads();
    if (threadIdx.x == 0) {
        unsigned* bar = b.bar;
        __builtin_amdgcn_s_waitcnt(0);
        unsigned nloc = b.st[0], nx = b.st[1];
        if (nloc == 0u) { xcd_barrier_complete(bar, b.x, nloc, nx); b.st[0] = nloc; b.st[1] = nx; }
        const unsigned old = xb_add(&bar[XB_XSUB(b.x)], 1u);
        const unsigned gen = old / nloc;
        if (old + 1u == (gen + 1u) * nloc) {
            __builtin_amdgcn_fence(__ATOMIC_RELEASE, "agent");
            asm volatile("s_waitcnt vmcnt(0)" ::: "memory");
            const unsigned og = xb_add(&bar[XB_TOP], 1u);
            const unsigned tg = og / nx;
            if (og + 1u == (tg + 1u) * nx) xb_add(&bar[XB_TOPGEN], 1u);
            else XB_SPIN(xb_ld(&bar[XB_TOPGEN]) == tg, bar);
            __builtin_amdgcn_fence(__ATOMIC_ACQUIRE, "agent");
            xb_add(&bar[XB_XGEN(b.x)], 1u);
            asm volatile("s_waitcnt vmcnt(0)" ::: "memory");
        } else {
            XB_SPIN(xb_ld(&bar[XB_XGEN(b.x)]) == gen, bar);
            __builtin_amdgcn_fence(__ATOMIC_ACQUIRE, "agent");
            asm volatile("s_waitcnt vmcnt(0)" ::: "memory");
        }
    }
    __syncthreads();
}
namespace eng {
constexpr int BM = 256, BK = 64, HALF = 128, HTB = HALF * BK * 2, STAGE_BYTES = 8 * HTB;
__device__ __forceinline__ int lds_byte(int r, int c) { const int st = (r >> 4) * 2 + (c >> 5), rr = r & 15, cc = c & 31, ob = rr * 64 + cc * 2; return st * 1024 + (ob ^ (((ob >> 9) & 1) << 5)); }
__device__ __forceinline__ void stage_rc(int b, int& R, int& C) { const int st = b / 1024, sb = b % 1024, swz = sb ^ (((sb >> 9) & 1) << 5); R = (st >> 1) * 16 + swz / 64; C = (st & 1) * 32 + (swz % 64) / 2; }

struct UnitD {
    const char* A0; const char* B0; unsigned lda0, ldb0; int n0;
    const char* A1; const char* B1; unsigned lda1, ldb1; int n1;
    const char* A2; const char* B2; unsigned lda2, ldb2; int n2;
    int kind, i0, i1, i2;
};
struct TD { const char* a; const char* b; unsigned lda, ldb; };
__device__ __forceinline__ TD tile_at(const UnitD& u, int t) {
    TD d;
    if (t < u.n0) { d.a = u.A0 + (size_t)t * 128; d.b = u.B0 + (size_t)t * 128; d.lda = u.lda0; d.ldb = u.ldb0; }
    else if (t < u.n0 + u.n1) { const int s = t - u.n0; d.a = u.A1 + (size_t)s * 128; d.b = u.B1 + (size_t)s * 128; d.lda = u.lda1; d.ldb = u.ldb1; }
    else { const int s = t - u.n0 - u.n1; d.a = u.A2 + (size_t)s * 128; d.b = u.B2 + (size_t)s * 128; d.lda = u.lda2; d.ldb = u.ldb2; }
    return d;
}
typedef f32x4 Acc[2][2][4][2];

template <class P>
__device__ __forceinline__ void gemm_run(LAS unsigned char* lds, const P& ph) {
    const int tid = threadIdx.x, wid = __builtin_amdgcn_readfirstlane(tid >> 6), lane = tid & 63, wr = wid >> 2, wc = wid & 3, fr = lane & 15, fq = lane >> 4;
    int R0, C0; stage_rc(tid * 16, R0, C0);
    const unsigned vR = (unsigned)R0, vC2 = (unsigned)C0 * 2u;
    const unsigned ldsw = (unsigned)wid * 1024u;
    const int aoff = lds_byte(wr * 64 + fr, fq * 8), boff = lds_byte(wc * 32 + fr, fq * 8);
#define EG_SA(b, h) (((b) * 2 + (h)) * HTB)
#define EG_SB(b, h) ((4 + (b) * 2 + (h)) * HTB)
#define EG_STAGE(bufoff, gbase, ld) do { const unsigned _ld = (ld); const char* _g = (gbase) + (size_t)(vR * _ld + vC2); \
        __builtin_amdgcn_global_load_lds((const unsigned*)_g, (LAS unsigned*)(lds + (bufoff) + ldsw), 16, 0, 0); \
        __builtin_amdgcn_global_load_lds((const unsigned*)(_g + (size_t)(64u * _ld)), (LAS unsigned*)(lds + (bufoff) + ldsw + 8192), 16, 0, 0); } while (0)
#define EG_LDA(dst, b, h) do { _Pragma("unroll") for (int m = 0; m < 4; ++m) _Pragma("unroll") for (int k = 0; k < 2; ++k) dst[m][k] = *(const LAS bf16x8*)(lds + EG_SA(b, h) + aoff + m * 2048 + k * 1024); } while (0)
#define EG_LDB(dst, b, h) do { _Pragma("unroll") for (int n = 0; n < 2; ++n) _Pragma("unroll") for (int k = 0; k < 2; ++k) dst[n][k] = *(const LAS bf16x8*)(lds + EG_SB(b, h) + boff + n * 2048 + k * 1024); } while (0)
#define EG_MMA(ai, bj, At, Bt) do { __builtin_amdgcn_s_setprio(1); _Pragma("unroll") for (int m = 0; m < 4; ++m) _Pragma("unroll") for (int n = 0; n < 2; ++n) _Pragma("unroll") for (int k = 0; k < 2; ++k) \
        acc[ai][bj][m][n] = __builtin_amdgcn_mfma_f32_16x16x32_bf16(Bt[n][k], At[m][k], acc[ai][bj][m][n], 0, 0, 0); __builtin_amdgcn_s_setprio(0); } while (0)
#define EG_WAIT_V(n) asm volatile("s_waitcnt vmcnt(" #n ")" ::: "memory")
#define EG_WAIT_L(n) asm volatile("s_waitcnt lgkmcnt(" #n ")" ::: "memory")
#define EG_BAR __builtin_amdgcn_s_barrier()
#define EG_SCHED __builtin_amdgcn_sched_barrier(0)
    UnitD cur; int ui = 0;
    if (!ph.get(0, cur)) return;
    UnitD cu = cur; int cui = 0, ct = 0; bool cvalid = true; TD lastTD = tile_at(cur, 0);
#define EG_NEXT(dst) do { if (cvalid) { dst = tile_at(cu, ct); lastTD = dst; ++ct; if (ct == cu.n0 + cu.n1 + cu.n2) { ++cui; ct = 0; cvalid = ph.get(cui, cu); } } else dst = lastTD; } while (0)
    Acc acc;
#pragma unroll
    for (int a = 0; a < 2; ++a)
#pragma unroll
        for (int b = 0; b < 2; ++b)
#pragma unroll
            for (int m = 0; m < 4; ++m)
#pragma unroll
                for (int n = 0; n < 2; ++n) acc[a][b][m][n] = (f32x4){0.f, 0.f, 0.f, 0.f};
    bf16x8 At[4][2], B0[2][2], B1[2][2];
    TD d1, d2, d3;
    { TD d0; EG_NEXT(d0); EG_NEXT(d1);
      EG_STAGE(EG_SB(0, 0), d0.b, d0.ldb); EG_STAGE(EG_SA(0, 0), d0.a, d0.lda); EG_STAGE(EG_SB(0, 1), d0.b + (size_t)(128u * d0.ldb), d0.ldb); EG_STAGE(EG_SA(0, 1), d0.a + (size_t)(128u * d0.lda), d0.lda); }
    if (wr == 1) EG_BAR;
    EG_WAIT_V(4); EG_BAR;
    EG_STAGE(EG_SB(1, 0), d1.b, d1.ldb); EG_STAGE(EG_SA(1, 0), d1.a, d1.lda); EG_STAGE(EG_SB(1, 1), d1.b + (size_t)(128u * d1.ldb), d1.ldb);
    EG_WAIT_V(6); EG_BAR;
    int tc = 0;
    for (;;) {
        EG_NEXT(d2); EG_NEXT(d3);
        if constexpr (P::HOOKS) { int fr_o = fr; asm volatile("" : "+v"(fr_o)); ph.hook(tc, acc, cur, wr, wc, fr_o, fq); }
        EG_LDB(B0, 0, 0); EG_SCHED; EG_LDA(At, 0, 0); EG_STAGE(EG_SA(1, 1), d1.a + (size_t)(128u * d1.lda), d1.lda);
        EG_WAIT_L(8); EG_BAR; EG_WAIT_L(0); EG_MMA(0, 0, At, B0); EG_BAR; EG_SCHED;
        EG_LDB(B1, 0, 1); EG_STAGE(EG_SB(0, 0), d2.b, d2.ldb);
        EG_BAR; EG_WAIT_L(0); EG_MMA(0, 1, At, B1); EG_BAR;
        EG_LDA(At, 0, 1); EG_STAGE(EG_SA(0, 0), d2.a, d2.lda);
        EG_BAR; EG_WAIT_L(0); EG_MMA(1, 0, At, B0); EG_BAR; EG_SCHED;
        EG_STAGE(EG_SB(0, 1), d2.b + (size_t)(128u * d2.ldb), d2.ldb);
        EG_WAIT_V(6); EG_BAR; EG_MMA(1, 1, At, B1); EG_BAR;
        EG_LDB(B0, 1, 0); EG_SCHED; EG_LDA(At, 1, 0); EG_STAGE(EG_SA(0, 1), d2.a + (size_t)(128u * d2.lda), d2.lda);
        EG_WAIT_L(8); EG_BAR; EG_WAIT_L(0); EG_MMA(0, 0, At, B0); EG_BAR; EG_SCHED;
        EG_LDB(B1, 1, 1); EG_STAGE(EG_SB(1, 0), d3.b, d3.ldb);
        EG_BAR; EG_WAIT_L(0); EG_MMA(0, 1, At, B1); EG_BAR;
        EG_LDA(At, 1, 1); EG_STAGE(EG_SA(1, 0), d3.a, d3.lda);
        EG_BAR; EG_WAIT_L(0); EG_MMA(1, 0, At, B0); EG_BAR; EG_SCHED;
        EG_STAGE(EG_SB(1, 1), d3.b + (size_t)(128u * d3.ldb), d3.ldb);
        EG_WAIT_V(6); EG_BAR; EG_MMA(1, 1, At, B1); EG_BAR;
        d1 = d3; tc += 2;
        if (tc == cur.n0 + cur.n1 + cur.n2) {
            { int fr_o = fr, fq_o = fq; asm volatile("" : "+v"(fr_o), "+v"(fq_o));
              ph.epi(acc, cur, wr, wc, fr_o, fq_o); }
            ++ui; tc = 0;
            if (!ph.get(ui, cur)) break;
#pragma unroll
            for (int a = 0; a < 2; ++a)
#pragma unroll
                for (int b = 0; b < 2; ++b)
#pragma unroll
                    for (int m = 0; m < 4; ++m)
#pragma unroll
                        for (int n = 0; n < 2; ++n) acc[a][b][m][n] = (f32x4){0.f, 0.f, 0.f, 0.f};
        }
    }
    EG_WAIT_V(0);
    if (wr == 0) EG_BAR;
    EG_BAR;
#undef EG_NEXT
}
__device__ __forceinline__ void unit1(UnitD& u, const void* A, unsigned lda, const void* B, unsigned ldb, int nt) {
    u.A0 = (const char*)A; u.B0 = (const char*)B; u.lda0 = lda; u.ldb0 = ldb; u.n0 = nt;
    u.A1 = u.A0; u.B1 = u.B0; u.lda1 = lda; u.ldb1 = ldb; u.n1 = 0; u.A2 = u.A0; u.B2 = u.B0; u.lda2 = lda; u.ldb2 = ldb; u.n2 = 0;
    u.kind = 0; u.i0 = 0; u.i1 = 0; u.i2 = 0;
}
}
using eng::UnitD; using eng::Acc;
__device__ __forceinline__ void efence() { asm volatile("" ::: "memory"); }
#define EPI_ARGS const Acc& acc, const UnitD& u, int wr, int wc, int fr, int fq
#define FOR_FRAG(ai, bj, m, n) _Pragma("unroll") for (int ai = 0; ai < 2; ++ai) _Pragma("unroll") for (int m = 0; m < 4; ++m) _Pragma("unroll") for (int bj = 0; bj < 2; efence(), ++bj) _Pragma("unroll") for (int n = 0; n < 2; ++n)
#define FRAG_ROW(ai, m) (128 * (ai) + 64 * wr + 16 * (m) + fr)
#define FRAG_COL(bj, n) (128 * (bj) + 32 * wc + 16 * (n) + 4 * fq)
__device__ __forceinline__ void st_bf16x4(bf16_t* p, f32x4 v) { u32x2 w; w.x = cvt_pk_bf16(v[0], v[1]); w.y = cvt_pk_bf16(v[2], v[3]); *(u32x2*)p = w; }
struct Frame { Params p; LAS unsigned char* lds; int tid, lane, wid, G, bid; };
#define WSP(T, off) ((T*)(F.p.ws + (off)))

template <class RowSrc>
__device__ __forceinline__ void conv_tile(const Frame& F, bf16_t* dst, int K, int ld, float scale, int r0, int k0, const RowSrc& rs) {
    LAS float* tile = (LAS float*)F.lds;
    const int n4 = (F.tid & 15) * 4, kq = F.tid >> 4;
    const float* sp = rs(r0 + n4) + (size_t)(k0 + kq) * ld;
#pragma unroll
    for (int p = 0; p < 8; ++p) { const f32x4 v = *(const f32x4*)(sp + (size_t)(p * 32) * ld); LAS float* q = tile + (p * 32 + kq) * 65 + n4; q[0] = v[0]; q[1] = v[1]; q[2] = v[2]; q[3] = v[3]; }
    __syncthreads();
    const int i2 = (F.tid & 127) * 2, jb = F.tid >> 7;
#pragma unroll
    for (int p = 0; p < 16; ++p) { const int j = p * 4 + jb; *(unsigned*)(dst + (size_t)(r0 + j) * K + k0 + i2) = cvt_pk_bf16(tile[i2 * 65 + j] * scale, tile[(i2 + 1) * 65 + j] * scale); }
    __syncthreads();
}
__device__ __forceinline__ int sigma_orig(int s) {
    const int half = s >> 7, s2 = s & 127, uu = s2 >> 5, b = (s2 >> 4) & 1, f = s2 & 15; return half * 128 + 16 * uu + f + 64 * b;
}
__device__ __forceinline__ void conv_moe_tile(const Frame& F, int layer, int t) {
    bf16_t* w13 = WSP(bf16_t, A_MOEW); bf16_t* w2t = WSP(bf16_t, A_MOEW + 32 * MiB);
    if (t < 1024) { const int e = t >> 6, rt = (t >> 2) & 15, kt = t & 3;
        const float* w1 = F.p.moe_w1 + ((size_t)layer * 16 + e) * 1024 * 512; const float* w3 = F.p.moe_w3 + ((size_t)layer * 16 + e) * 1024 * 512;
        conv_tile(F, w13 + (size_t)e * 1024 * 1024, 1024, 512, 1.0f, rt * 64, kt * 256, [=](int r) { const int j = r >> 8, rr = r & 255; return rr < 128 ? w1 + 128 * j + rr : w3 + 128 * j + rr - 128; });
    } else { const int u = t - 1024, e = u >> 5, rt = (u >> 1) & 15, kt = u & 1;
        const float* w2 = F.p.moe_w2 + ((size_t)layer * 16 + e) * 512 * 1024;
        conv_tile(F, w2t + (size_t)e * 1024 * 512, 512, 1024, 1.0f, rt * 64, kt * 256, [=](int r) { return w2 + r; }); }
}
__device__ __forceinline__ void conv_moe(const Frame& F, int layer) { for (int t = F.bid; t < 1536; t += F.G) conv_moe_tile(F, layer, t); }
__device__ __forceinline__ void conv_small_tile(const Frame& F, int t) {
    if (t < 96) { const float* w = F.p.w0in; conv_tile(F, WSP(bf16_t, WS_W0IN), 1024, 2560, 1.0f, (t >> 2) * 64, (t & 3) * 256, [=](int r) { return w + 256 + r; }); }
    else if (t < 144) { const int u = t - 96; const float* w = F.p.w0in; conv_tile(F, WSP(bf16_t, WS_W0IN) + (size_t)2048 * 1024, 1024, 2560, 1.0f, (u >> 2) * 64, (u & 3) * 256, [=](int r) { return w + 1792 + r; }); }
    else if (t < 208) { const int u = t - 144; const float* w = F.p.w0out; conv_tile(F, WSP(bf16_t, WS_W0OUT), 1024, 1024, 1.0f, (u >> 2) * 64, (u & 3) * 256, [=](int r) { return w + r; }); }
    else if (t < 272) { const int u = t - 208; const float* w = F.p.w1in; conv_tile(F, WSP(bf16_t, WS_W1IN), 1024, 6144, 1.0f, (u >> 2) * 64, (u & 3) * 256, [=](int r) { return w + (r & ~255) + sigma_orig(r & 255); }); }
    else if (t < 336) { const int u = t - 272; const float* w = F.p.w1in; conv_tile(F, WSP(bf16_t, WS_W1IN) + (size_t)1024 * 1024, 1024, 6144, 0.0625f, (u >> 2) * 64, (u & 3) * 256, [=](int r) { return w + 1024 + (r & ~255) + sigma_orig(r & 255); }); }
    else if (t < 592) { const int u = t - 336; const float* w = F.p.w1in; conv_tile(F, WSP(bf16_t, WS_W1IN) + (size_t)2048 * 1024, 1024, 6144, 1.0f, (u >> 2) * 64, (u & 3) * 256, [=](int r) { return w + 2048 + r; }); }
    else { const int u = t - 592; const float* w = F.p.w1out; conv_tile(F, WSP(bf16_t, WS_W1OUT), 2048, 1024, 1.0f, (u >> 3) * 64, (u & 7) * 256, [=](int r) { return w + r; }); }
}
__device__ __forceinline__ void p0_prologue(const Frame& F) {
    const float TWO_PI = 6.283185307179586f;
    {
        LAS float* sc0 = (LAS float*)F.lds; LAS float* sc1 = sc0 + 1024; LAS float* red = sc1 + 1024;
        for (int k = F.tid; k < 1024; k += 512) { sc0[k] = silu_f(F.p.c[k]); sc1[k] = silu_f(F.p.c_ctx[k]); }
        __syncthreads();
        float* mod = WSP(float, WS_MOD);
        for (int item = F.bid; item < 192; item += F.G) {
            const int l = item / 96, col0 = (item % 96) * 64, l16 = F.tid & 15, kg = F.tid >> 4;
            f32x4 a0 = {0.f, 0.f, 0.f, 0.f}, a1 = {0.f, 0.f, 0.f, 0.f};
#pragma unroll 8
            for (int i = 0; i < 32; ++i) { const int k = kg + 32 * i; const f32x4 w = *(const f32x4*)(F.p.ada_w + ((size_t)l * 1024 + k) * 6144 + col0 + l16 * 4); a0 += sc0[k] * w; a1 += sc1[k] * w; }
#pragma unroll
            for (int e = 0; e < 4; ++e) { red[(kg * 64 + l16 * 4 + e) * 2 + 0] = a0[e]; red[(kg * 64 + l16 * 4 + e) * 2 + 1] = a1[e]; }
            __syncthreads();
            if (F.tid < 128) { const int col = F.tid & 63, which = F.tid >> 6; float s = 0.f; for (int g = 0; g < 32; ++g) s += red[(g * 64 + col) * 2 + which];
                mod[(size_t)which * 2 * 6144 + l * 6144 + col0 + col] = s + F.p.ada_b[l * 6144 + col0 + col]; }
            __syncthreads();
        }
    }
    {
        const int gt = F.bid * 512 + F.tid, gn = F.G * 512;
        float* twc = WSP(float, WS_TWC); float* tws = WSP(float, WS_TWS);
        for (int i = gt; i < 128 * 128; i += gn) { const int b = i >> 7, k1 = i & 127; const float a = (float)((b * k1) & 16383) * (TWO_PI / 16384.0f); twc[i] = cosf(a); tws[i] = sinf(a); }
        float* rc = WSP(float, WS_ROPEC); float* rs = WSP(float, WS_ROPES);
        for (int i = gt; i < 256 * 64; i += gn) { const int pos = i >> 6, fi = i & 63; const float inv = powf(10000.0f, -(float)fi / 64.0f); const float a = (float)pos * inv; rc[i] = cosf(a); rs[i] = sinf(a); }
        bf16_t* f1 = WSP(bf16_t, WS_F1T); bf16_t* f2 = WSP(bf16_t, WS_F2P);
        for (int i = gt; i < 256 * 256; i += gn) { const int n = i >> 8, k = i & 255, k1 = n & 127, a = k & 127; const float ang = (float)((a * k1) & 127) * (TWO_PI / 128.0f); const float cs = cosf(ang), sn = sinf(ang);
            float v1; if (n < 128) v1 = (k < 128) ? cs : sn; else v1 = (k < 128) ? -sn : cs;
            f1[i] = f2bf(v1);
            f2[i] = f2bf(n < 128 ? ((k < 128) ? cs : sn) * (1.0f / 128.0f) : 0.0f); }
        bf16_t* cs256 = WSP(bf16_t, WS_CS256);
        for (int i = gt; i < 256 * 512; i += gn) { const int k = i >> 9, j = i & 511, n = j & 255; const float ang = (float)((n * k) & 255) * (TWO_PI / 256.0f); cs256[i] = f2bf((j < 256 ? cosf(ang) : sinf(ang)) * (1.0f / 16.0f)); }
    }
    {
        LAS float* ct = (LAS float*)F.lds;
        __syncthreads();
        if (F.tid < 64) ct[F.tid] = cosf((float)F.tid * (TWO_PI / 64.0f));
        __syncthreads();
        bf16_t* dst = WSP(bf16_t, WS_W0IN);
        for (int idx = F.bid * 512 + F.tid; idx < 512 * 1024; idx += F.G * 512) {
            const int r = idx >> 10, k = idx & 1023, part = r >> 8, cc = r & 255, g = cc >> 6, cp = cc & 63;
            const float* w = F.p.w0in + (size_t)k * 2560 + g * 64; float s = 0.f;
#pragma unroll 8
            for (int c = 0; c < 64; ++c) { const int ph = (c * cp) & 63; const float t = part ? -ct[(ph + 48) & 63] : ct[ph]; s += w[c] * t; }
            dst[(size_t)(1536 + r) * 1024 + k] = f2bf(s * 0.125f);
        }
        __syncthreads();
    }
    for (int t = F.bid; t < 720 + 1536; t += F.G) { if (t < 720) conv_small_tile(F, t); else conv_moe_tile(F, 0, t - 720); }
}

struct Row { f32x4 v[4]; };
__device__ __forceinline__ void row_load(Row& r, const float* p, int lane) {
#pragma unroll
    for (int i = 0; i < 4; ++i) r.v[i] = *(const f32x4*)(p + 4 * lane + 256 * i);
}
__device__ __forceinline__ void row_store(const Row& r, float* p, int lane) {
#pragma unroll
    for (int i = 0; i < 4; ++i) *(f32x4*)(p + 4 * lane + 256 * i) = r.v[i];
}
__device__ __forceinline__ float row_rstd(const Row& r) {
    float s = 0.f;
#pragma unroll
    for (int i = 0; i < 4; ++i) s += (r.v[i][0] * r.v[i][0] + r.v[i][1] * r.v[i][1]) + (r.v[i][2] * r.v[i][2] + r.v[i][3] * r.v[i][3]);
    s = wave_sum(s);
    return rsqrtf(s * (1.0f / 1024.0f) + RMS_EPS);
}
__device__ __forceinline__ void row_norm_mod(Row& r, const float* g, const float* sh, const float* sc, int lane) {
    const float rs = row_rstd(r);
#pragma unroll
    for (int i = 0; i < 4; ++i) { const int c = 4 * lane + 256 * i; const f32x4 gv = *(const f32x4*)(g + c), shv = *(const f32x4*)(sh + c), scv = *(const f32x4*)(sc + c);
        r.v[i] = (r.v[i] * rs) * gv * (1.0f + scv) + shv; }
}
__device__ __forceinline__ void row_store_bf16(const Row& r, bf16_t* p, int lane) {
#pragma unroll
    for (int i = 0; i < 4; ++i) st_bf16x4(p + 4 * lane + 256 * i, r.v[i]);
}
__device__ __forceinline__ const float* modp(const Frame& F, int layer, bool is_ctx) { return WSP(const float, WS_MOD) + (size_t)(is_ctx ? 2 : 0) * 6144 + layer * 6144; }
__device__ __forceinline__ float* hrow(const Frame& F, int t) { return t < CTXN ? WSP(float, WS_HC) + (size_t)t * DM : F.p.out + (size_t)(t - CTXN) * DM; }

__device__ __forceinline__ void p_norm_in(const Frame& F) {
    bf16_t* xm = WSP(bf16_t, A_XM);
    for (int t = F.bid * 8 + F.wid; t < TT; t += F.G * 8) {
        const bool ic = t < CTXN; const float* src = ic ? F.p.ctx + (size_t)t * DM : F.p.x + (size_t)(t - CTXN) * DM; const float* m = modp(F, 0, ic);
        Row r; row_load(r, src, F.lane); row_norm_mod(r, F.p.norm_g, m, m + 1024, F.lane); row_store_bf16(r, xm + (size_t)t * DM, F.lane);
    }
}
__device__ __forceinline__ void p_norm_l1(const Frame& F, bf16_t* dst) {
    for (int t = CTXN + F.bid * 8 + F.wid; t < TT; t += F.G * 8) {
        const float* m = modp(F, 1, false);
        Row r; row_load(r, hrow(F, t), F.lane); row_norm_mod(r, F.p.norm_g + 2 * DM, m, m + 1024, F.lane); row_store_bf16(r, dst + (size_t)t * DM, F.lane);
    }
}

__device__ __forceinline__ void p_router(const Frame& F, int layer, int t0, bf16_t* dst) {
    LAS float* rwT = (LAS float*)F.lds;
    LAS unsigned* lcnt = (LAS unsigned*)(F.lds + 65536);
    for (int i = F.tid; i < 16 * 1024; i += 512) { const int e = i >> 10, c = i & 1023; rwT[i] = F.p.router_w[c * 16 + e]; }
    if (F.tid < 32) lcnt[F.tid] = 0u;
    __syncthreads();
    int* eid = WSP(int, WS_EID); float* gw = WSP(float, WS_GW); int* slot = WSP(int, WS_SLOT);
    unsigned* gcnt = (unsigned*)(F.p.ws + WS_CTL + CTL_CNT) + layer * 64;
    for (int t = t0 + F.bid * 8 + F.wid; t < TT; t += F.G * 8) {
        const bool ic = t < CTXN; const float* m = modp(F, layer, ic);
        Row r; row_load(r, hrow(F, t), F.lane); row_norm_mod(r, F.p.norm_g + (size_t)(layer * 2 + 1) * DM, m + 3072, m + 4096, F.lane); row_store_bf16(r, dst + (size_t)t * DM, F.lane);
        float lg[16];
#pragma unroll
        for (int e = 0; e < 16; ++e) { float s = 0.f;
#pragma unroll
            for (int i = 0; i < 4; ++i) { const f32x4 w = *(const LAS f32x4*)(rwT + e * 1024 + 4 * F.lane + 256 * i); s += (r.v[i][0] * w[0] + r.v[i][1] * w[1]) + (r.v[i][2] * w[2] + r.v[i][3] * w[3]); }
            lg[e] = wave_sum(s); }
        float scv[16], bi[16];
#pragma unroll
        for (int e = 0; e < 16; ++e) { scv[e] = 1.0f / (1.0f + __expf(-lg[e])); bi[e] = scv[e] + F.p.router_b[e]; }
        int gsel = 0; float best = -1e30f;
#pragma unroll
        for (int g = 0; g < 4; ++g) { const float a = bi[4 * g], b = bi[4 * g + 1], c = bi[4 * g + 2], d = bi[4 * g + 3];
            const float h1 = fmaxf(a, b), l1 = fminf(a, b), h2 = fmaxf(c, d), l2 = fminf(c, d); const float gs = fmaxf(h1, h2) + fmaxf(fminf(h1, h2), fmaxf(l1, l2));
            if (gs > best) { best = gs; gsel = g; } }
        float vb[4], vs[4];
#pragma unroll
        for (int i = 0; i < 4; ++i) { vb[i] = gsel == 0 ? bi[i] : gsel == 1 ? bi[4 + i] : gsel == 2 ? bi[8 + i] : bi[12 + i]; vs[i] = gsel == 0 ? scv[i] : gsel == 1 ? scv[4 + i] : gsel == 2 ? scv[8 + i] : scv[12 + i]; }
        int i0 = 0; float b0 = vb[0];
#pragma unroll
        for (int i = 1; i < 4; ++i) if (vb[i] > b0) { b0 = vb[i]; i0 = i; }
        int i1 = -1; float b1 = -1e30f;
#pragma unroll
        for (int i = 0; i < 4; ++i) if (i != i0 && vb[i] > b1) { b1 = vb[i]; i1 = i; }
        const float s0 = i0 == 0 ? vs[0] : i0 == 1 ? vs[1] : i0 == 2 ? vs[2] : vs[3], s1 = i1 == 0 ? vs[0] : i1 == 1 ? vs[1] : i1 == 2 ? vs[2] : vs[3];
        const float inv = 1.0f / (s0 + s1);
        if (F.lane == 0) {
            const int e0 = gsel * 4 + i0, e1 = gsel * 4 + i1;
            const unsigned r0 = __hip_atomic_fetch_add(lcnt + e0, 1u, __ATOMIC_RELAXED, __HIP_MEMORY_SCOPE_WORKGROUP), r1 = __hip_atomic_fetch_add(lcnt + e1, 1u, __ATOMIC_RELAXED, __HIP_MEMORY_SCOPE_WORKGROUP);
            eid[2 * t] = e0; eid[2 * t + 1] = e1; gw[2 * t] = s0 * inv; gw[2 * t + 1] = s1 * inv; slot[2 * t] = (int)r0; slot[2 * t + 1] = (int)r1;
        }
    }
    __syncthreads();
    if (F.tid < 16) lcnt[16 + F.tid] = __hip_atomic_fetch_add(gcnt + F.tid, lcnt[F.tid], __ATOMIC_RELAXED, __HIP_MEMORY_SCOPE_AGENT);
    __syncthreads();
    for (int t = t0 + F.bid * 8 + F.wid; t < TT; t += F.G * 8)
        if (F.lane < 2) slot[2 * t + F.lane] += (int)lcnt[16 + eid[2 * t + F.lane]];
    __syncthreads();
}
struct PanelTab { int pst[17]; };
__device__ __forceinline__ void panel_tab(const Frame& F, int layer, PanelTab& pt) {
    const unsigned* gcnt = (const unsigned*)(F.p.ws + WS_CTL + CTL_CNT) + layer * 64;
    pt.pst[0] = 0;
#pragma unroll
    for (int e = 0; e < 16; ++e) pt.pst[e + 1] = pt.pst[e] + (int)((__builtin_amdgcn_readfirstlane(gcnt[e]) + 255u) >> 8);
}
__device__ __forceinline__ void p_gather(const Frame& F, int layer, int t0, const bf16_t* xm2, bf16_t* xs) {
    PanelTab pt; panel_tab(F, layer, pt);
    const int* eid = WSP(const int, WS_EID); int* slot = WSP(int, WS_SLOT);
    for (int t = t0 + F.bid * 8 + F.wid; t < TT; t += F.G * 8) {
        const u32x4* src = (const u32x4*)(xm2 + (size_t)t * DM); const u32x4 a = src[F.lane], b = src[64 + F.lane];
#pragma unroll
        for (int k = 0; k < 2; ++k) {
            const int e = eid[2 * t + k]; int ps = 0;
#pragma unroll
            for (int j = 0; j < 16; ++j) ps = (e == j) ? pt.pst[j] : ps;
            const int s = ps * 256 + slot[2 * t + k];
            u32x4* d = (u32x4*)(xs + (size_t)s * DM); d[F.lane] = a; d[64 + F.lane] = b;
            if (F.lane == 0) slot[2 * t + k] = s;
        }
    }
}
__device__ __forceinline__ void row_moe_combine(const Frame& F, Row& r, int t, int layer, const bf16_t* Y) {
    const int* slot = WSP(const int, WS_SLOT); const float* gw = WSP(const float, WS_GW);
    const int s0 = slot[2 * t], s1 = slot[2 * t + 1]; const float w0 = gw[2 * t], w1 = gw[2 * t + 1];
    const float* g2 = modp(F, layer, t < CTXN) + 5120;
#pragma unroll
    for (int i = 0; i < 4; ++i) { const int c = 4 * F.lane + 256 * i;
        const u32x2 a = *(const u32x2*)(Y + (size_t)s0 * DM + c), b = *(const u32x2*)(Y + (size_t)s1 * DM + c); const f32x4 gv = *(const f32x4*)(g2 + c);
        f32x4 f; f[0] = w0 * bflo(a.x) + w1 * bflo(b.x); f[1] = w0 * bfhi(a.x) + w1 * bfhi(b.x); f[2] = w0 * bflo(a.y) + w1 * bflo(b.y); f[3] = w0 * bfhi(a.y) + w1 * bfhi(b.y);
        r.v[i] += gv * f; }
}
__device__ __forceinline__ void p_combine0(const Frame& F) {
    const bf16_t* Y = WSP(const bf16_t, A_XS); bf16_t* xm1 = WSP(bf16_t, B_XM1);
    for (int t = F.bid * 8 + F.wid; t < TT; t += F.G * 8) {
        Row r; float* hp = hrow(F, t); row_load(r, hp, F.lane); row_moe_combine(F, r, t, 0, Y); row_store(r, hp, F.lane);
        const float* m = modp(F, 1, t < CTXN); row_norm_mod(r, F.p.norm_g + 2 * DM, m, m + 1024, F.lane); row_store_bf16(r, xm1 + (size_t)t * DM, F.lane);
    }
}
__device__ __forceinline__ void p_final(const Frame& F) {
    const bf16_t* Y = WSP(const bf16_t, B_XS);
    for (int t = CTXN + F.bid * 8 + F.wid; t < TT; t += F.G * 8) {
        Row r; float* hp = hrow(F, t); row_load(r, hp, F.lane); row_moe_combine(F, r, t, 1, Y);
        const float rs = row_rstd(r);
#pragma unroll
        for (int i = 0; i < 4; ++i) { const f32x4 gv = *(const f32x4*)(F.p.final_g + 4 * F.lane + 256 * i); r.v[i] = (r.v[i] * rs) * gv; }
        row_store(r, hp, F.lane);
    }
}
__device__ __forceinline__ float log_gamma(const Frame& F, int dir, int h) { return log1pf(-expf(F.p.decay[dir * 4 + h])); }
__device__ __forceinline__ void p_scan(const Frame& F) {
    bf16_t* st = WSP(bf16_t, B_ST);
    const int item = F.bid * 512 + F.tid;
    for (int it = item; it < 8 * 16384; it += F.G * 512) {
        const int hd = it >> 14, grp = it & 16383, h = hd >> 1, dir = hd & 1;
        const float lg = log_gamma(F, dir, h), d256 = __expf(256.0f * lg), d512 = __expf(512.0f * lg);
        float s[8];
#pragma unroll
        for (int j = 0; j < 8; ++j) s[j] = 0.f;
#pragma unroll 4
        for (int step = 0; step < 33; ++step) {
            const int c = (dir == 0 || step == 0) ? step : 33 - step;
            u32x4* p = (u32x4*)(st + ((size_t)(c * 8 + hd) * 131072 + (size_t)grp * 8));
            const u32x4 uv = *p; const float dec = (c == 0) ? d256 : d512;
            u32x4 o; o.x = cvt_pk_bf16(s[0], s[1]); o.y = cvt_pk_bf16(s[2], s[3]); o.z = cvt_pk_bf16(s[4], s[5]); o.w = cvt_pk_bf16(s[6], s[7]);
            *p = o;
            s[0] = s[0] * dec + bflo(uv.x); s[1] = s[1] * dec + bfhi(uv.x); s[2] = s[2] * dec + bflo(uv.y); s[3] = s[3] * dec + bfhi(uv.y);
            s[4] = s[4] * dec + bflo(uv.z); s[5] = s[5] * dec + bfhi(uv.z); s[6] = s[6] * dec + bflo(uv.w); s[7] = s[7] * dec + bfhi(uv.w);
        }
    }
}
#define PH_COMMON const unsigned char* ws; int G, bid; static constexpr bool HOOKS = false; \
    __device__ __forceinline__ void hook(int, Acc&, const UnitD&, int, int, int, int) const {}
#define WSC(T, off) ((T*)(ws + (off)))
__device__ __forceinline__ int xcd_remap(int idx, int N) { const int q = N >> 3, r = N & 7, x = idx & 7, off = idx >> 3; return (x < r ? x * (q + 1) : r * (q + 1) + (x - r) * q) + off; }
__device__ __forceinline__ float sel4(f32x4 v, int h) { const float a = h == 0 ? v[0] : v[1], b = h == 2 ? v[2] : v[3]; return h < 2 ? a : b; }
#define SEL4(a, h) sel4(a, h)
#define EFENCE asm volatile("" ::: "memory")

struct PhG1 { PH_COMMON
    __device__ __forceinline__ bool get(int i, UnitD& u) const {
        const int idx = bid + i * G; if (idx >= 715) return false;
        const char* xm = (const char*)(ws + A_XM); const char* w = (const char*)(ws + WS_W0IN);
        if (idx < 390) { const int v = xcd_remap(idx, 390), pm = v / 6, pn = v % 6; eng::unit1(u, xm + (size_t)pm * 256 * 2048, 2048, w + (size_t)pn * 256 * 2048, 2048, 16); u.kind = 0; u.i0 = pm; u.i1 = pn; }
        else { const int j = xcd_remap(idx - 390, 325), ct = j / 5, rt = j % 5; eng::unit1(u, w + (size_t)(1536 + rt * 256) * 2048, 2048, xm + (size_t)ct * 256 * 2048, 2048, 16); u.kind = rt < 2 ? 1 : 2; u.i0 = rt; u.i1 = ct; }
        return true;
    }
    __device__ __forceinline__ void epi(EPI_ARGS) const {
        if (u.kind == 0) { bf16_t* o = WSC(bf16_t, A_QK0) + (size_t)(u.i0 * 256) * QK0_LD + u.i1 * 256;
            FOR_FRAG(ai, bj, m, n) st_bf16x4(o + (size_t)FRAG_ROW(ai, m) * QK0_LD + FRAG_COL(bj, n), acc[ai][bj][m][n]); }
        else if (u.kind == 2) { bf16_t* o = WSC(bf16_t, A_VT0) + (size_t)((u.i0 - 2) * 256) * TT + u.i1 * 256;
            FOR_FRAG(ai, bj, m, n) st_bf16x4(o + (size_t)FRAG_ROW(ai, m) * TT + FRAG_COL(bj, n), acc[ai][bj][m][n]); }
        else if (u.i1 == 0) { bf16_t* o = WSC(bf16_t, WS_XTC) + u.i0 * 256;
            FOR_FRAG(ai, bj, m, n) st_bf16x4(o + (size_t)FRAG_ROW(ai, m) * 512 + FRAG_COL(bj, n), acc[ai][bj][m][n]); }
        else { bf16_t* o = WSC(bf16_t, A_XT2) + u.i0 * 128;
            FOR_FRAG(ai, bj, m, n) { const int cc = FRAG_ROW(ai, m), nn = (u.i1 - 1) * 256 + FRAG_COL(bj, n), a = nn >> 7, b = nn & 127; const f32x4 v = acc[ai][bj][m][n];
#pragma unroll
                for (int e = 0; e < 4; ++e) o[(size_t)(cc * 128 + b + e) * 256 + a] = f2bf(v[e]);
                EFENCE; } }
    }
};
struct PhF1 { PH_COMMON
    __device__ __forceinline__ bool get(int i, UnitD& u) const {
        const int idx = bid + i * G; if (idx >= 129) return false;
        if (idx < 128) { eng::unit1(u, ws + A_XT2 + (size_t)idx * 256 * 512, 512, ws + WS_F1T, 512, 4); u.kind = 0; u.i0 = idx; }
        else { eng::unit1(u, ws + WS_CS256, 1024, ws + WS_XTC, 1024, 8); u.kind = 1; }
        return true;
    }
    __device__ __forceinline__ void epi(EPI_ARGS) const {
        if (u.kind == 1) { bf16_t* o = WSC(bf16_t, A_AO); FOR_FRAG(ai, bj, m, n) st_bf16x4(o + (size_t)FRAG_ROW(ai, m) * DM + FRAG_COL(bj, n), acc[ai][bj][m][n]); return; }
        const float* twc = WSC(const float, WS_TWC); const float* tws = WSC(const float, WS_TWS); bf16_t* o = WSC(bf16_t, A_T2);
#pragma unroll
        for (int m = 0; m < 4; ++m)
#pragma unroll
            for (int n = 0; n < 2; ++n) { const int b = 64 * wr + 16 * m + fr, k1 = 32 * wc + 16 * n + 4 * fq; const f32x4 cv = *(const f32x4*)(twc + b * 128 + k1), sv = *(const f32x4*)(tws + b * 128 + k1);
#pragma unroll
                for (int ai = 0; ai < 2; ++ai) { const int cc = 2 * u.i0 + ai; const f32x4 tr = acc[ai][0][m][n], ti = acc[ai][1][m][n];
#pragma unroll
                    for (int e = 0; e < 4; ++e) { bf16_t* q = o + (size_t)((k1 + e) * 256 + cc) * 256 + b; q[0] = f2bf(tr[e] * cv[e] + ti[e] * sv[e]); q[128] = f2bf(ti[e] * cv[e] - tr[e] * sv[e]); } } }
    }
};
struct PhF2 { PH_COMMON
    __device__ __forceinline__ bool get(int i, UnitD& u) const {
        const int idx = bid + i * G; if (idx >= 128) return false;
        eng::unit1(u, ws + WS_F2P, 512, ws + A_T2 + (size_t)idx * 256 * 512, 512, 4); u.i0 = idx; return true;
    }
    __device__ __forceinline__ void epi(EPI_ARGS) const {
        bf16_t* o = WSC(bf16_t, A_AO);
#pragma unroll
        for (int m = 0; m < 4; ++m)
#pragma unroll
            for (int bj = 0; bj < 2; ++bj)
#pragma unroll
                for (int n = 0; n < 2; ++n) { const int k2 = FRAG_ROW(0, m); st_bf16x4(o + (size_t)(CTXN + u.i0 + 128 * k2) * DM + FRAG_COL(bj, n), acc[0][bj][m][n]); }
    }
};
struct PhG2 { PH_COMMON const float* x; const float* ctx; float* out;
    __device__ __forceinline__ bool get(int i, UnitD& u) const {
        const int idx0 = bid + i * G; if (idx0 >= 260) return false;
        const int idx = xcd_remap(idx0, 260), pm = idx >> 2, pn = idx & 3; eng::unit1(u, ws + A_AO + (size_t)pm * 256 * 2048, 2048, ws + WS_W0OUT + (size_t)pn * 256 * 2048, 2048, 16); u.i0 = pm; u.i1 = pn; return true;
    }
    __device__ __forceinline__ void epi(EPI_ARGS) const {
        const bool ic = u.i0 == 0; const float* g1 = WSC(const float, WS_MOD) + (ic ? 2 * 6144 : 0) + 2048 + u.i1 * 256;
        const float* src = ic ? ctx : x + (size_t)(u.i0 - 1) * 256 * DM; float* dst = ic ? WSC(float, WS_HC) : out + (size_t)(u.i0 - 1) * 256 * DM;
        FOR_FRAG(ai, bj, m, n) { const size_t off = (size_t)FRAG_ROW(ai, m) * DM + u.i1 * 256 + FRAG_COL(bj, n); const f32x4 gv = *(const f32x4*)(g1 + FRAG_COL(bj, n));
            *(f32x4*)(dst + off) = *(const f32x4*)(src + off) + gv * acc[ai][bj][m][n]; }
    }
};
struct PhM1 { PH_COMMON PanelTab pt; size_t xs, hd;
    __device__ __forceinline__ bool get(int i, UnitD& u) const {
        const int idx0 = bid + i * G, NU = pt.pst[16] * 4; if (idx0 >= NU) return false;
        const int idx = xcd_remap(idx0, NU), p = idx >> 2, j = idx & 3; int e = 0;
#pragma unroll
        for (int k = 1; k < 16; ++k) e += (p >= pt.pst[k]) ? 1 : 0;
        eng::unit1(u, ws + xs + (size_t)p * 256 * 2048, 2048, ws + A_MOEW + ((size_t)e * 1024 + j * 256) * 2048, 2048, 16); u.i0 = p; u.i1 = j; return true;
    }
    __device__ __forceinline__ void epi(EPI_ARGS) const {
        bf16_t* o = (bf16_t*)(ws + hd) + (size_t)(u.i0 * 256) * 512 + u.i1 * 128;
#pragma unroll
        for (int ai = 0; ai < 2; ++ai)
#pragma unroll
            for (int m = 0; m < 4; ++m)
#pragma unroll
                for (int n = 0; n < 2; ++n) { const f32x4 a = acc[ai][0][m][n], b = acc[ai][1][m][n]; f32x4 v;
#pragma unroll
                    for (int e = 0; e < 4; ++e) v[e] = silu_f(a[e]) * b[e];
                    st_bf16x4(o + (size_t)FRAG_ROW(ai, m) * 512 + FRAG_COL(0, n), v); }
    }
};
struct PhM2 { PH_COMMON PanelTab pt; size_t hd, y;
    __device__ __forceinline__ bool get(int i, UnitD& u) const {
        const int idx0 = bid + i * G, NU = pt.pst[16] * 4; if (idx0 >= NU) return false;
        const int idx = xcd_remap(idx0, NU), p = idx >> 2, j = idx & 3; int e = 0;
#pragma unroll
        for (int k = 1; k < 16; ++k) e += (p >= pt.pst[k]) ? 1 : 0;
        eng::unit1(u, ws + hd + (size_t)p * 256 * 1024, 1024, ws + A_MOEW + 32 * MiB + ((size_t)e * 1024 + j * 256) * 1024, 1024, 8); u.i0 = p; u.i1 = j; return true;
    }
    __device__ __forceinline__ void epi(EPI_ARGS) const {
        bf16_t* o = (bf16_t*)(ws + y) + (size_t)(u.i0 * 256) * DM + u.i1 * 256;
        FOR_FRAG(ai, bj, m, n) st_bf16x4(o + (size_t)FRAG_ROW(ai, m) * DM + FRAG_COL(bj, n), acc[ai][bj][m][n]);
    }
};
struct PhG3 { PH_COMMON f32x4 lgf, lgb;
    __device__ __forceinline__ bool get(int i, UnitD& u) const {
        const int idx = bid + i * G; if (idx >= 512 + 780) return false;
        const char* xm = (const char*)(ws + B_XM1); const char* w = (const char*)(ws + WS_W1IN);
        if (idx < 512) { const int v = xcd_remap(idx, 512), pm = 1 + (v >> 3), pn = v & 7; eng::unit1(u, xm + (size_t)pm * 256 * 2048, 2048, w + (size_t)pn * 256 * 2048, 2048, 16); u.kind = 0; u.i0 = pm; u.i1 = pn; }
        else { const int j = xcd_remap(idx - 512, 780), ct = j / 12, rt = j % 12; eng::unit1(u, w + (size_t)(1024 + rt * 256) * 2048, 2048, xm + (size_t)ct * 256 * 2048, 2048, 16); u.kind = rt < 4 ? 1 : 2; u.i0 = rt; u.i1 = ct; }
        return true;
    }
    __device__ __forceinline__ void epi(EPI_ARGS) const {
        const float* rc = WSC(const float, WS_ROPEC); const float* rs = WSC(const float, WS_ROPES);
        if (u.kind == 0) {
            bf16_t* o = (u.i1 < 4 ? WSC(bf16_t, B_Q) : WSC(bf16_t, B_K)) + (size_t)(u.i0 * 256) * DM + (u.i1 & 3) * 256;
#pragma unroll
            for (int ai = 0; ai < 2; ++ai)
#pragma unroll
                for (int m = 0; m < 4; ++m) { const int r = FRAG_ROW(ai, m), tl = (u.i0 - 1) * 256 + r;
#pragma unroll
                    for (int bj = 0; bj < 2; ++bj) { const int pos = bj == 0 ? (tl >> 6) : (tl & 63); const f32x4 cv = *(const f32x4*)(rc + pos * 64 + 16 * wc + 4 * fq), sv = *(const f32x4*)(rs + pos * 64 + 16 * wc + 4 * fq);
                        const f32x4 x1 = acc[ai][bj][m][0], x2 = acc[ai][bj][m][1];
                        st_bf16x4(o + (size_t)r * DM + FRAG_COL(bj, 0), x1 * cv - x2 * sv); st_bf16x4(o + (size_t)r * DM + FRAG_COL(bj, 1), x2 * cv + x1 * sv); } }
        } else if (u.kind == 2) { bf16_t* o = WSC(bf16_t, B_VT) + (size_t)((u.i0 - 4) * 256) * TT + u.i1 * 256;
            FOR_FRAG(ai, bj, m, n) st_bf16x4(o + (size_t)FRAG_ROW(ai, m) * TT + FRAG_COL(bj, n), acc[ai][bj][m][n]);
        } else {
            const int h = u.i0; const float lf = SEL4(lgf, h), lb = SEL4(lgb, h);
            bf16_t* of = WSC(bf16_t, B_KF) + (size_t)(h * 256) * TT + u.i1 * 256; bf16_t* ob = WSC(bf16_t, B_KB) + (size_t)(h * 256) * TT + u.i1 * 256;
#pragma unroll
            for (int bj = 0; bj < 2; ++bj)
#pragma unroll
                for (int n = 0; n < 2; ++n) { const int c0 = FRAG_COL(bj, n); f32x4 df, db;
                    if (u.i1 == 0) {
#pragma unroll
                        for (int e = 0; e < 4; ++e) { const int pos = c0 + e; df[e] = __expf(lf * (float)(255 - pos)); db[e] = __expf(lb * (float)pos); }
                    } else {
#pragma unroll
                        for (int e = 0; e < 4; ++e) { const int pos = ((u.i1 - 1) * 256 + c0 + e) & 511; df[e] = __expf(lf * (float)(511 - pos)); db[e] = __expf(lb * (float)pos); }
                    }
#pragma unroll
                    for (int ai = 0; ai < 2; ++ai)
#pragma unroll
                        for (int mp = 0; mp < 2; ++mp) { const int p = 32 * wr + 16 * mp + fr; f32x4 x1 = acc[ai][bj][2 * mp][n], x2 = acc[ai][bj][2 * mp + 1][n];
                            if (u.i1 != 0) { const int tl = (u.i1 - 1) * 256 + c0; f32x4 cv, sv;
                                if (ai == 0) { const float c = rc[(tl >> 6) * 64 + p], s = rs[(tl >> 6) * 64 + p]; cv = (f32x4){c, c, c, c}; sv = (f32x4){s, s, s, s}; }
                                else {
#pragma unroll
                                    for (int e = 0; e < 4; ++e) { cv[e] = rc[((tl + e) & 63) * 64 + p]; sv[e] = rs[((tl + e) & 63) * 64 + p]; } }
                                const f32x4 y1 = x1 * cv - x2 * sv, y2 = x2 * cv + x1 * sv; x1 = y1; x2 = y2; }
                            const size_t o1 = (size_t)FRAG_ROW(ai, 2 * mp) * TT + c0, o2 = (size_t)FRAG_ROW(ai, 2 * mp + 1) * TT + c0;
                            st_bf16x4(of + o1, x1 * df); st_bf16x4(of + o2, x2 * df); st_bf16x4(ob + o1, x1 * db); st_bf16x4(ob + o2, x2 * db); } }
        }
    }
};
__device__ __forceinline__ int chunk_tok0(int c) { return c == 0 ? 0 : 256 + 512 * (c - 1); }
struct PhU { PH_COMMON
    __device__ __forceinline__ bool get(int i, UnitD& u) const {
        const int idx0 = bid + i * G; if (idx0 >= 528) return false;
        const int idx = xcd_remap(idx0, 528), dvt = idx & 1, dir = (idx >> 1) & 1, h = (idx >> 2) & 3, c = idx >> 4; const size_t tk = (size_t)chunk_tok0(c) * 2;
        eng::unit1(u, ws + B_VT + (size_t)(h * 512 + dvt * 256) * TT * 2 + tk, TT * 2, ws + (dir ? B_KB : B_KF) + (size_t)(h * 256) * TT * 2 + tk, TT * 2, c == 0 ? 4 : 8);
        u.i0 = (c * 8 + h * 2 + dir); u.i1 = dvt; return true;
    }
    __device__ __forceinline__ void epi(EPI_ARGS) const {
        bf16_t* o = WSC(bf16_t, B_ST) + (size_t)u.i0 * 131072 + (size_t)(u.i1 * 256) * 256;
        FOR_FRAG(ai, bj, m, n) st_bf16x4(o + (size_t)FRAG_ROW(ai, m) * 256 + FRAG_COL(bj, n), acc[ai][bj][m][n]);
    }
};
struct PhSD { PH_COMMON f32x4 lgf, lgb;
    __device__ __forceinline__ bool get(int i, UnitD& u) const {
        const int idx0 = bid + i * G; if (idx0 >= 512) return false;
        const int idx = xcd_remap(idx0, 512), tj = idx & 1, ti = (idx >> 1) & 1, h = (idx >> 2) & 3, c = 1 + (idx >> 4); const int t0 = chunk_tok0(c);
        eng::unit1(u, ws + B_Q + (size_t)(t0 + 256 * ti) * 2048 + h * 512, 2048, ws + B_K + (size_t)(t0 + 256 * tj) * 2048 + h * 512, 2048, 4);
        u.i0 = t0; u.i1 = h; u.i2 = ti * 2 + tj; return true;
    }
    __device__ __forceinline__ void epi(EPI_ARGS) const {
        const int ti = u.i2 >> 1, tj = u.i2 & 1, h = u.i1; const float lf = SEL4(lgf, h), lb = SEL4(lgb, h);
        bf16_t* o = WSC(bf16_t, B_SD) + (size_t)(u.i0 + 256 * ti) * 2048 + h * 512 + 256 * tj;
        FOR_FRAG(ai, bj, m, n) { const int r = FRAG_ROW(ai, m), c0 = FRAG_COL(bj, n), i = 256 * ti + r; f32x4 v = acc[ai][bj][m][n];
#pragma unroll
            for (int e = 0; e < 4; ++e) { const int d = i - (256 * tj + c0 + e); const float w = d > 0 ? __expf(lf * (float)d) : d < 0 ? __expf(lb * (float)(-d)) : 2.0f; v[e] *= w; }
            st_bf16x4(o + (size_t)r * 2048 + c0, v); }
    }
};
struct PhO { const unsigned char* ws; int G, bid; f32x4 lgf, lgb; static constexpr bool HOOKS = true;
    __device__ __forceinline__ bool get(int i, UnitD& u) const {
        const int idx0 = bid + i * G; if (idx0 >= 512) return false;
        const int idx = xcd_remap(idx0, 512), dvt = idx & 1, h = (idx >> 1) & 3, pm = idx >> 3, c = 1 + (pm >> 1), t0 = CTXN + 256 * pm;
        const char* q = (const char*)(ws + B_Q) + (size_t)t0 * 2048 + h * 512;
        const char* st = (const char*)(ws + B_ST) + ((size_t)(c * 8 + h * 2) * 131072 + (size_t)(dvt * 256) * 256) * 2;
        u.A0 = q; u.B0 = st; u.lda0 = 2048; u.ldb0 = 512; u.n0 = 4;
        u.A1 = q; u.B1 = st + (size_t)131072 * 2; u.lda1 = 2048; u.ldb1 = 512; u.n1 = 4;
        u.A2 = (const char*)(ws + B_SD) + (size_t)t0 * 4096 + h * 1024; u.B2 = (const char*)(ws + B_VT) + (size_t)(h * 512 + dvt * 256) * TT * 2 + (size_t)chunk_tok0(c) * 2; u.lda2 = 4096; u.ldb2 = TT * 2; u.n2 = 8;
        u.kind = 0; u.i0 = pm; u.i1 = h; u.i2 = dvt; return true;
    }
    __device__ __forceinline__ void hook(int tc, Acc& acc, const UnitD& u, int wr, int wc, int fr, int fq) const {
        if (tc != 4 && tc != 8) return;
        const float lf = SEL4(lgf, u.i1), lb = SEL4(lgb, u.i1);
#pragma unroll
        for (int ai = 0; ai < 2; ++ai)
#pragma unroll
            for (int m = 0; m < 4; ++m) { const int i = (u.i0 & 1) * 256 + FRAG_ROW(ai, m);
                const float s = tc == 4 ? __expf(lf * (float)(i + 1) - lb * (float)(512 - i)) : __expf(lb * (float)(512 - i));
#pragma unroll
                for (int bj = 0; bj < 2; ++bj)
#pragma unroll
                    for (int n = 0; n < 2; ++n) acc[ai][bj][m][n] *= s; }
    }
    __device__ __forceinline__ void epi(EPI_ARGS) const {
        const int tl = 256 * u.i0, h = u.i1, dvt = u.i2;
        bf16_t* o = WSC(bf16_t, B_O) + (size_t)(CTXN + tl) * 2048 + h * 512 + dvt * 256; float* ssq = WSC(float, WS_SSQ);
#pragma unroll
        for (int ai = 0; ai < 2; ++ai)
#pragma unroll
            for (int m = 0; m < 4; ++m) { const int r = FRAG_ROW(ai, m); float s = 0.f;
#pragma unroll
                for (int bj = 0; bj < 2; ++bj)
#pragma unroll
                    for (int n = 0; n < 2; ++n) { const f32x4 v = acc[ai][bj][m][n]; s += (v[0] * v[0] + v[1] * v[1]) + (v[2] * v[2] + v[3] * v[3]); st_bf16x4(o + (size_t)r * 2048 + FRAG_COL(bj, n), v); }
                s += __shfl_xor(s, 16); s += __shfl_xor(s, 32);
                if (fq == 0) ssq[((size_t)(tl + r) * 4 + h) * 8 + dvt * 4 + wc] = s; }
    }
};
struct PhGG { PH_COMMON
    __device__ __forceinline__ bool get(int i, UnitD& u) const {
        const int idx0 = bid + i * G; if (idx0 >= 512) return false;
        const int idx = xcd_remap(idx0, 512), pm = 1 + (idx >> 3), pn = idx & 7; eng::unit1(u, ws + B_XM1B + (size_t)pm * 256 * 2048, 2048, ws + WS_W1IN + (size_t)(4096 + pn * 256) * 2048, 2048, 16); u.i0 = pm; u.i1 = pn; return true;
    }
    __device__ __forceinline__ void epi(EPI_ARGS) const {
        bf16_t* o = WSC(bf16_t, B_O) + (size_t)(u.i0 * 256) * 2048 + u.i1 * 256; const float* ssq = WSC(const float, WS_SSQ); const int h = u.i1 >> 1;
#pragma unroll
        for (int ai = 0; ai < 2; ++ai)
#pragma unroll
            for (int m = 0; m < 4; ++m) { const int r = FRAG_ROW(ai, m); const float* sp = ssq + ((size_t)((u.i0 - 1) * 256 + r) * 4 + h) * 8;
                const f32x4 s0 = *(const f32x4*)sp, s1 = *(const f32x4*)(sp + 4); const float rstd = rsqrtf((((s0[0] + s0[1]) + (s0[2] + s0[3])) + ((s1[0] + s1[1]) + (s1[2] + s1[3]))) * (1.0f / 512.0f) + RMS_EPS);
#pragma unroll
                for (int bj = 0; bj < 2; ++bj)
#pragma unroll
                    for (int n = 0; n < 2; ++n) { bf16_t* q = o + (size_t)r * 2048 + FRAG_COL(bj, n); const u32x2 ov = *(const u32x2*)q; const f32x4 g = acc[ai][bj][m][n]; f32x4 v;
                        v[0] = silu_f(g[0]) * (bflo(ov.x) * rstd); v[1] = silu_f(g[1]) * (bfhi(ov.x) * rstd); v[2] = silu_f(g[2]) * (bflo(ov.y) * rstd); v[3] = silu_f(g[3]) * (bfhi(ov.y) * rstd);
                        st_bf16x4(q, v); } }
    }
};
struct PhG4 { PH_COMMON float* out;
    __device__ __forceinline__ bool get(int i, UnitD& u) const {
        const int idx0 = bid + i * G; if (idx0 >= 256) return false;
        const int idx = xcd_remap(idx0, 256), pm = idx >> 2, pn = idx & 3; eng::unit1(u, ws + B_O + (size_t)(CTXN + pm * 256) * 4096, 4096, ws + WS_W1OUT + (size_t)pn * 256 * 4096, 4096, 32); u.i0 = pm; u.i1 = pn; return true;
    }
    __device__ __forceinline__ void epi(EPI_ARGS) const {
        const float* g1 = WSC(const float, WS_MOD) + 6144 + 2048 + u.i1 * 256; float* dst = out + (size_t)(u.i0 * 256) * DM + u.i1 * 256;
        FOR_FRAG(ai, bj, m, n) { float* q = dst + (size_t)FRAG_ROW(ai, m) * DM + FRAG_COL(bj, n); const f32x4 gv = *(const f32x4*)(g1 + FRAG_COL(bj, n)); *(f32x4*)q = *(const f32x4*)q + gv * acc[ai][bj][m][n]; }
    }
};

template <bool LOCAL>
__device__ __forceinline__ void na_unit(const Frame& F, int r, int j, int h, int qb, const LAS float* rpb_l) {
    const bf16_t* qk = WSP(const bf16_t, A_QK0); const bf16_t* vt = WSP(const bf16_t, A_VT0); bf16_t* ao = WSP(bf16_t, A_AO);
    const int lane = F.lane, q16 = lane & 15, g = lane >> 4;
    const int tq = LOCAL ? CTXN + r * GW + 16 * j + q16 : 16 * qb + q16;
    bf16x8 qf[2];
#pragma unroll
    for (int ks = 0; ks < 2; ++ks) qf[ks] = *(const bf16x8*)(qk + (size_t)tq * QK0_LD + h * 64 + 32 * ks + 8 * g);
    constexpr int NT = LOCAL ? 32 : 16;
    f32x4 s[NT];
    const int rs = LOCAL ? min(max(r - 4, 0), 248) : 0, kst = LOCAL ? min(max(16 * j - 8, 0), 32) : 0;
    const int krow = 8 * (q16 >> 2) + (q16 & 3);
#pragma unroll
    for (int t = 0; t < NT; ++t) {
        int tok;
        if (LOCAL && t < 16) tok = CTXN + (rs + (t >> 1)) * GW + kst + krow + 4 * (t & 1); else tok = 32 * ((t - (LOCAL ? 16 : 0)) >> 1) + krow + 4 * (t & 1);
        const bf16_t* kp = qk + (size_t)tok * QK0_LD + 768 + h * 64 + 8 * g;
        const bf16x8 k0 = *(const bf16x8*)kp, k1 = *(const bf16x8*)(kp + 32);
        f32x4 a = {0.f, 0.f, 0.f, 0.f};
        a = __builtin_amdgcn_mfma_f32_16x16x32_bf16(k0, qf[0], a, 0, 0, 0); a = __builtin_amdgcn_mfma_f32_16x16x32_bf16(k1, qf[1], a, 0, 0, 0);
        s[t] = a;
    }
    float mx = -1e30f;
    if (LOCAL) { const int qc = 16 * j + q16, wst = min(max(qc - 8, 0), 48);
#pragma unroll
        for (int t = 0; t < 16; ++t) { const int dr = rs + (t >> 1) - r + 7;
#pragma unroll
            for (int e = 0; e < 4; ++e) { const int kc = kst + 8 * g + 4 * (t & 1) + e; const bool ok = kc >= wst && kc < wst + 16; const int dc = min(max(kc - qc + 15, 0), 30);
                const float v = ok ? s[t][e] * 0.125f + rpb_l[(h * 15 + dr) * 31 + dc] : -1e30f; s[t][e] = v; mx = fmaxf(mx, v); } } }
#pragma unroll
    for (int t = LOCAL ? 16 : 0; t < NT; ++t)
#pragma unroll
        for (int e = 0; e < 4; ++e) { const float v = s[t][e] * 0.125f; s[t][e] = v; mx = fmaxf(mx, v); }
    mx = fmaxf(mx, __shfl_xor(mx, 16)); mx = fmaxf(mx, __shfl_xor(mx, 32));
    float sum = 0.f;
#pragma unroll
    for (int t = 0; t < NT; ++t)
#pragma unroll
        for (int e = 0; e < 4; ++e) { const float p = __expf(s[t][e] - mx); s[t][e] = p; sum += p; }
    sum += __shfl_xor(sum, 16); sum += __shfl_xor(sum, 32);
    f32x4 o[4];
#pragma unroll
    for (int dt = 0; dt < 4; ++dt) o[dt] = (f32x4){0.f, 0.f, 0.f, 0.f};
#pragma unroll
    for (int b = 0; b < NT / 2; ++b) {
        u32x4 pw; pw.x = cvt_pk_bf16(s[2 * b][0], s[2 * b][1]); pw.y = cvt_pk_bf16(s[2 * b][2], s[2 * b][3]); pw.z = cvt_pk_bf16(s[2 * b + 1][0], s[2 * b + 1][1]); pw.w = cvt_pk_bf16(s[2 * b + 1][2], s[2 * b + 1][3]);
        const bf16x8 pf = __builtin_bit_cast(bf16x8, pw);
        int tok0;
        if (LOCAL && b < 8) tok0 = CTXN + (rs + b) * GW + kst; else tok0 = 32 * (b - (LOCAL ? 8 : 0));
#pragma unroll
        for (int dt = 0; dt < 4; ++dt) { const bf16x8 vf = *(const bf16x8*)(vt + (size_t)(h * 64 + 16 * dt + q16) * TT + tok0 + 8 * g);
            o[dt] = __builtin_amdgcn_mfma_f32_16x16x32_bf16(vf, pf, o[dt], 0, 0, 0); }
    }
    const float inv = 1.0f / sum;
#pragma unroll
    for (int dt = 0; dt < 4; ++dt) st_bf16x4(ao + (size_t)tq * DM + 256 + h * 64 + 16 * dt + 4 * g, o[dt] * inv);
}
__device__ __forceinline__ void p_attention(const Frame& F) {
    LAS float* rpb_l = (LAS float*)F.lds;
    for (int i = F.tid; i < 12 * 15 * 31; i += 512) rpb_l[i] = F.p.rpb[i];
    __syncthreads();
    unsigned* head = (unsigned*)(F.p.ws + WS_CTL + CTL_QUEUE);
    for (;;) {
        unsigned qi = 0; if (F.lane == 0) qi = __hip_atomic_fetch_add(head, 1u, __ATOMIC_RELAXED, __HIP_MEMORY_SCOPE_AGENT);
        qi = (unsigned)__builtin_amdgcn_readfirstlane((int)qi);
        if (qi >= 12288u + 192u) break;
        if (qi < 12288u) { const int j = qi & 3, h = (qi >> 2) % 12, r = (qi >> 2) / 12; na_unit<true>(F, r, j, h, 0, rpb_l); }
        else { const int q2 = qi - 12288; na_unit<false>(F, 0, 0, q2 % 12, q2 / 12, rpb_l); }
    }
    __syncthreads();
}
constexpr int LDS_BYTES = eng::STAGE_BYTES + 1024;
#ifndef MK_PER_PHASE
#define MK_PER_PHASE 0
#endif

__global__ __launch_bounds__(512, 2) void mk_fwd(Params p) {
    extern __shared__ __attribute__((aligned(16))) unsigned char shm[];
    Frame F; F.p = p; F.lds = (LAS unsigned char*)shm; F.tid = threadIdx.x; F.lane = F.tid & 63; F.wid = __builtin_amdgcn_readfirstlane(F.tid >> 6); F.G = gridDim.x; F.bid = blockIdx.x;
    volatile LAS unsigned* xb = (volatile LAS unsigned*)(F.lds + eng::STAGE_BYTES);
    if (F.tid < 4) xb[F.tid] = 0u;
    __syncthreads();
    const int lo = p.ph_lo, hi = p.ph_hi;
    XcdBarrier bar; bar.bar = (unsigned*)(p.ws + WS_CTL); bar.x = 0; bar.st = xb;
    if (hi - lo > 1) bar = xcd_barrier_post((unsigned*)(p.ws + WS_CTL), xb);
#ifndef PHMASK
#define PHMASK 0xFFFFFFu
#endif
#define IN(k) (((PHMASK >> (k)) & 1u) && lo <= (k) && (k) < hi)
#ifndef PROBE_MASK
#define PROBE_MASK 0u
#endif
#ifndef PROBE_MULT
#define PROBE_MULT 1
#endif
    unsigned long long pr_acc = 0, pr_prev = PROBE_MASK ? wall_clock64() : 0ull;
#define SEAM(k) do { if (IN(k) && IN((k) + 1)) xcd_barrier(bar); if (PROBE_MASK) { const unsigned long long _n = wall_clock64(); if ((PROBE_MASK >> (k)) & 1u) pr_acc += _n - pr_prev; pr_prev = _n; } } while (0)
    const unsigned char* ws = p.ws;

    if (IN(0)) { p0_prologue(F); } SEAM(0);
    if (IN(1)) { p_norm_in(F); } SEAM(1);
    if (IN(2)) { PhG1 ph{ws, F.G, F.bid}; eng::gemm_run(F.lds, ph); } SEAM(2);
    if (IN(3)) { PhF1 ph{ws, F.G, F.bid}; eng::gemm_run(F.lds, ph); p_attention(F); } SEAM(3);
    if (IN(4)) { PhF2 ph{ws, F.G, F.bid}; eng::gemm_run(F.lds, ph); } SEAM(4);
    if (IN(5)) { PhG2 ph{ws, F.G, F.bid, p.x, p.ctx, p.out}; eng::gemm_run(F.lds, ph); } SEAM(5);
    if (IN(6)) { p_router(F, 0, 0, WSP(bf16_t, A_XM)); } SEAM(6);
    if (IN(7)) { p_gather(F, 0, 0, WSP(const bf16_t, A_XM), WSP(bf16_t, A_XS)); } SEAM(7);
    if (IN(8)) { PhM1 ph{ws, F.G, F.bid}; panel_tab(F, 0, ph.pt); ph.xs = A_XS; ph.hd = A_HD; eng::gemm_run(F.lds, ph); } SEAM(8);
    if (IN(9)) { PhM2 ph{ws, F.G, F.bid}; panel_tab(F, 0, ph.pt); ph.hd = A_HD; ph.y = A_XS; eng::gemm_run(F.lds, ph); } SEAM(9);
    if (IN(10)) { p_combine0(F); } SEAM(10);
    if (IN(11)) { PhG3 ph{ws, F.G, F.bid};
        ph.lgf = (f32x4){log_gamma(F, 0, 0), log_gamma(F, 0, 1), log_gamma(F, 0, 2), log_gamma(F, 0, 3)}; ph.lgb = (f32x4){log_gamma(F, 1, 0), log_gamma(F, 1, 1), log_gamma(F, 1, 2), log_gamma(F, 1, 3)};
        eng::gemm_run(F.lds, ph); } SEAM(11);
    if (IN(12)) { PhU ph{ws, F.G, F.bid}; eng::gemm_run(F.lds, ph); } SEAM(12);
    if (IN(13)) { p_scan(F); } SEAM(13);
    if (IN(14)) { PhSD ph{ws, F.G, F.bid};
        ph.lgf = (f32x4){log_gamma(F, 0, 0), log_gamma(F, 0, 1), log_gamma(F, 0, 2), log_gamma(F, 0, 3)}; ph.lgb = (f32x4){log_gamma(F, 1, 0), log_gamma(F, 1, 1), log_gamma(F, 1, 2), log_gamma(F, 1, 3)};
        eng::gemm_run(F.lds, ph); } SEAM(14);
    if (IN(15)) { PhO ph{ws, F.G, F.bid};
        ph.lgf = (f32x4){log_gamma(F, 0, 0), log_gamma(F, 0, 1), log_gamma(F, 0, 2), log_gamma(F, 0, 3)}; ph.lgb = (f32x4){log_gamma(F, 1, 0), log_gamma(F, 1, 1), log_gamma(F, 1, 2), log_gamma(F, 1, 3)};
        eng::gemm_run(F.lds, ph); } SEAM(15);
    if (IN(16)) { p_norm_l1(F, WSP(bf16_t, B_XM1B)); conv_moe(F, 1); } SEAM(16);
    if (IN(17)) { PhGG ph{ws, F.G, F.bid}; eng::gemm_run(F.lds, ph); } SEAM(17);
    if (IN(18)) { PhG4 ph{ws, F.G, F.bid, p.out}; eng::gemm_run(F.lds, ph); } SEAM(18);
    if (IN(19)) { p_router(F, 1, CTXN, WSP(bf16_t, B_XM2)); } SEAM(19);
    if (IN(20)) { p_gather(F, 1, CTXN, WSP(const bf16_t, B_XM2), WSP(bf16_t, B_XS)); } SEAM(20);
    if (IN(21)) { PhM1 ph{ws, F.G, F.bid}; panel_tab(F, 1, ph.pt); ph.xs = B_XS; ph.hd = B_HD; eng::gemm_run(F.lds, ph); } SEAM(21);
    if (IN(22)) { PhM2 ph{ws, F.G, F.bid}; panel_tab(F, 1, ph.pt); ph.hd = B_HD; ph.y = B_XS; eng::gemm_run(F.lds, ph); } SEAM(22);
    if (IN(23)) { p_final(F); }
    if (PROBE_MASK) { SEAM(23); if (F.bid == 0) { const unsigned long long t0 = wall_clock64(); while (wall_clock64() - t0 < pr_acc * PROBE_MULT) __builtin_amdgcn_s_sleep(8); } }
#undef IN
#undef SEAM
}

extern "C" void kernel_launch(void* const* d_in, const int* in_sizes, int n_in, void* d_out, int out_size, void* d_ws, size_t ws_size, hipStream_t stream) {
    static int grid = 0;
    if (grid == 0) {
        if (n_in != 19 || out_size != SEQ * DM || ws_size < WS_END) { fprintf(stderr, "kernel_launch: unexpected shapes (n_in %d, out %d, ws %zu < %zu)\n", n_in, out_size, ws_size, (size_t)WS_END); grid = -1; return; }
        int dev = 0, cus = 0, per_cu = 0;
        if (hipGetDevice(&dev) != hipSuccess || hipDeviceGetAttribute(&cus, hipDeviceAttributeMultiprocessorCount, dev) != hipSuccess) { grid = -1; return; }
        if (hipFuncSetAttribute((const void*)mk_fwd, hipFuncAttributeMaxDynamicSharedMemorySize, LDS_BYTES) != hipSuccess) { fprintf(stderr, "kernel_launch: hipFuncSetAttribute failed\n"); grid = -1; return; }
        if (hipOccupancyMaxActiveBlocksPerMultiprocessor(&per_cu, (const void*)mk_fwd, 512, LDS_BYTES) != hipSuccess || per_cu < 1) { fprintf(stderr, "kernel_launch: occupancy query says %d\n", per_cu); per_cu = 1; }
        (void)hipGetLastError();
        grid = cus;
        if (grid > 256) grid = 256;
    }
    if (grid < 0) return;
    (void)hipMemsetAsync((char*)d_ws + WS_CTL, 0, CTL_BYTES, stream);
    Params p{};
    const float** pp = (const float**)&p;
    for (int i = 0; i < 19; ++i) pp[i] = (const float*)d_in[i];
    p.out = (float*)d_out; p.ws = (unsigned char*)d_ws;
#if MK_PER_PHASE
    for (int ph = 0; ph < NPHASE; ++ph) { p.ph_lo = ph; p.ph_hi = ph + 1; hipLaunchKernelGGL(mk_fwd, dim3(grid), dim3(512), LDS_BYTES, stream, p); }
#else
    p.ph_lo = 0; p.ph_hi = NPHASE; hipLaunchKernelGGL(mk_fwd, dim3(grid), dim3(512), LDS_BYTES, stream, p);
#endif
}
```

```cpp
#include <hip/hip_runtime.h>
#include <cstdio>
#include <cstdint>

typedef unsigned short bf16_t;
typedef short bf16x8 __attribute__((ext_vector_type(8)));
typedef float f32x4 __attribute__((ext_vector_type(4)));
typedef float f32x2 __attribute__((ext_vector_type(2)));
typedef unsigned u32x2 __attribute__((ext_vector_type(2)));
typedef unsigned u32x4 __attribute__((ext_vector_type(4)));
#define LAS __attribute__((address_space(3)))

constexpr int DM = 1024, SEQ = 16384, CTXN = 256, TT = SEQ + CTXN  , GW = 64;
constexpr int NH0 = 12, QK0_LD = 1536, W0IN_ROWS = 2816;
constexpr int NPMAX = 146;
constexpr float RMS_EPS = 1e-6f;
constexpr int NPHASE = 24;

constexpr size_t KiB = 1024, MiB = 1024 * 1024, HMiB = 512 * 1024;
constexpr size_t WS_CTL = 0;
constexpr size_t CTL_BYTES = 64 * KiB;
constexpr size_t CTL_CNT = 16 * KiB;
constexpr size_t CTL_QUEUE = 20 * KiB;
constexpr size_t WS_MOD = 64 * KiB;
constexpr size_t WS_TWC = 256 * KiB, WS_TWS = 320 * KiB;
constexpr size_t WS_ROPEC = 384 * KiB, WS_ROPES = 448 * KiB;
constexpr size_t WS_F1T = 512 * KiB, WS_F2P = 640 * KiB;
constexpr size_t WS_CS256 = 768 * KiB;
constexpr size_t WS_HC = 1 * MiB;
constexpr size_t WS_EID = 2 * MiB;
constexpr size_t WS_GW = 2 * MiB + 256 * KiB;
constexpr size_t WS_SLOT = 2 * MiB + 512 * KiB;
constexpr size_t WS_SSQ = 3 * MiB;
constexpr size_t WS_XTC = 5 * MiB;
constexpr size_t WS_W0IN = 8 * MiB, WS_W0OUT = 14 * MiB, WS_W1IN = 16 * MiB, WS_W1OUT = 28 * MiB;
constexpr size_t AR = 32 * MiB;
constexpr size_t A_XM = AR + 0, A_QK0 = AR + 65 * HMiB, A_VT0 = AR + 81 * MiB + 256 * KiB, A_XT2 = AR + 106 * MiB, A_T2 = AR + 122 * MiB + HMiB, A_AO = AR + 139 * MiB;
constexpr size_t A_XS = AR + 65 * HMiB, A_HD = AR + 106 * MiB, A_MOEW = AR + 245 * MiB;
constexpr size_t B_Q = AR + 0, B_K = AR + 65 * HMiB, B_O = AR + 65 * HMiB, B_KF = AR + 195 * HMiB, B_KB = AR + 130 * MiB, B_SD = AR + 195 * HMiB, B_VT = AR + 325 * HMiB;
constexpr size_t B_XM1 = AR + 455 * HMiB, B_ST = AR + 455 * HMiB, B_XM1B = AR + 0, B_XM2 = AR + 0, B_XS = AR + 195 * HMiB, B_HD = AR + 341 * HMiB;
constexpr size_t WS_END = AR + 294 * MiB;

struct Params {
    const float *x, *c, *ctx, *c_ctx, *ada_w, *ada_b, *norm_g, *final_g, *w0in, *w0out, *rpb, *w1in, *w1out, *decay, *router_w, *router_b, *moe_w1, *moe_w3, *moe_w2;
    float* out; unsigned char* ws; int ph_lo, ph_hi;
};

__device__ __forceinline__ unsigned cvt_pk_bf16(float lo, float hi) { unsigned r; asm volatile("v_cvt_pk_bf16_f32 %0, %1, %2" : "=v"(r) : "v"(lo), "v"(hi)); return r; }
__device__ __forceinline__ bf16_t f2bf(float f) { return (bf16_t)(cvt_pk_bf16(f, 0.f) & 0xffffu); }
__device__ __forceinline__ float bf2f(unsigned short b) { return __uint_as_float(((unsigned)b) << 16); }
__device__ __forceinline__ float bflo(unsigned w) { return __uint_as_float(w << 16); }
__device__ __forceinline__ float bfhi(unsigned w) { return __uint_as_float(w & 0xffff0000u); }
__device__ __forceinline__ float silu_f(float v) { return v / (1.0f + __expf(-v)); }
__device__ __forceinline__ float wave_sum(float v) {
#pragma unroll
    for (int o = 32; o >= 1; o >>= 1) v += __shfl_xor(v, o);
    return v;
}
__device__ __forceinline__ float wave_max(float v) {
#pragma unroll
    for (int o = 32; o >= 1; o >>= 1) v = fmaxf(v, __shfl_xor(v, o));
    return v;
}
#define XB_TMO      128
#define XB_XCNT(j)  (256  + 64 * (j))
#define XB_XSUB(j)  (1280 + 64 * (j))
#define XB_XGEN(j)  (2304 + 64 * (j))
#define XB_TOP      3328
#define XB_TOPGEN   3392
#define XCD_BAR_WORDS 3456
#define XB_SPIN_CAP (1u << 18)

__device__ __forceinline__ unsigned xb_ld(unsigned* p)              { return __hip_atomic_load(p, __ATOMIC_RELAXED, __HIP_MEMORY_SCOPE_AGENT); }
__device__ __forceinline__ unsigned xb_add(unsigned* p, unsigned v) { return __hip_atomic_fetch_add(p, v, __ATOMIC_RELAXED, __HIP_MEMORY_SCOPE_AGENT); }
__device__ __forceinline__ unsigned xb_xcc_id() { return (unsigned)__builtin_amdgcn_s_getreg((3 << 11) | 20) & 0xFu; }
#define XB_SPIN(cond, bar) do { unsigned _sp = 0; while (cond) { __builtin_amdgcn_s_sleep(1); \
    if ((++_sp & 255u) == 0u) { if (xb_ld(&(bar)[XB_TMO])) break; if (_sp > XB_SPIN_CAP) { atomicAdd(&(bar)[XB_TMO], 1u); break; } } } } while (0)

struct XcdBarrier {
    unsigned* bar; unsigned x;
    volatile LAS unsigned* st;
};

__device__ __forceinline__ XcdBarrier xcd_barrier_post(unsigned* bar, volatile LAS unsigned* st) {
    XcdBarrier b; b.bar = bar; b.x = xb_xcc_id(); b.st = st;
    if (threadIdx.x == 0) (void)xb_add(&bar[XB_XCNT(b.x)], 1u);
    return b;
}
__device__ __forceinline__ void xcd_barrier_complete(unsigned* bar, unsigned x, unsigned& nloc, unsigned& nx) {
    const unsigned G = gridDim.x * gridDim.y * gridDim.z;
    unsigned sum, cnt, mine, sp = 0u;
    for (;;) {
        sum = 0u; cnt = 0u; mine = 0u;
#pragma unroll
        for (unsigned j = 0; j < 16; ++j) { const unsigned c = xb_ld(&bar[XB_XCNT(j)]); sum += c; cnt += (c > 0u) ? 1u : 0u; mine = (j == x) ? c : mine; }
        if (sum == G) break;
        __builtin_amdgcn_s_sleep(1);
        if ((++sp & 255u) == 0u) { if (xb_ld(&bar[XB_TMO])) break; if (sp > XB_SPIN_CAP) { atomicAdd(&bar[XB_TMO], 1u); break; } }
    }
    nloc = mine > 0u ? mine : 1u; nx = cnt > 0u ? cnt : 1u;
}

__device__ __forceinline__ void xcd_barrier(const XcdBarrier& b) {
    asm volatile("s_waitcnt vmcnt(0)" ::: "memory");
    __syncthreads();
    if (threadIdx.x == 0) {
        unsigned* bar = b.bar;
        __builtin_amdgcn_s_waitcnt(0);
        unsigned nloc = b.st[0], nx = b.st[1];
        if (nloc == 0u) { xcd_barrier_complete(bar, b.x, nloc, nx); b.st[0] = nloc; b.st[1] = nx; }
        const unsigned old = xb_add(&bar[XB_XSUB(b.x)], 1u);
        const unsigned gen = old / nloc;
        if (old + 1u == (gen + 1u) * nloc) {
            __builtin_amdgcn_fence(__ATOMIC_RELEASE, "agent");
            asm volatile("s_waitcnt vmcnt(0)" ::: "memory");
            const unsigned og = xb_add(&bar[XB_TOP], 1u);
            const unsigned tg = og / nx;
            if (og + 1u == (tg + 1u) * nx) xb_add(&bar[XB_TOPGEN], 1u);
            else XB_SPIN(xb_ld(&bar[XB_TOPGEN]) == tg, bar);
            __builtin_amdgcn_fence(__ATOMIC_ACQUIRE, "agent");
            xb_add(&bar[XB_XGEN(b.x)], 1u);
            asm volatile("s_waitcnt vmcnt(0)" ::: "memory");
        } else {
            XB_SPIN(xb_ld(&bar[XB_XGEN(b.x)]) == gen, bar);
            __builtin_amdgcn_fence(__ATOMIC_ACQUIRE, "agent");
            asm volatile("s_waitcnt vmcnt(0)" ::: "memory");
        }
    }
    __syncthreads();
}
namespace eng {
constexpr int BM = 256, BK = 64, HALF = 128, HTB = HALF * BK * 2, STAGE_BYTES = 8 * HTB;
__device__ __forceinline__ int lds_byte(int r, int c) { const int st = (r >> 4) * 2 + (c >> 5), rr = r & 15, cc = c & 31, ob = rr * 64 + cc * 2; return st * 1024 + (ob ^ (((ob >> 9) & 1) << 5)); }
__device__ __forceinline__ void stage_rc(int b, int& R, int& C) { const int st = b / 1024, sb = b % 1024, swz = sb ^ (((sb >> 9) & 1) << 5); R = (st >> 1) * 16 + swz / 64; C = (st & 1) * 32 + (swz % 64) / 2; }

struct UnitD {
    const char* A0; const char* B0; unsigned lda0, ldb0; int n0;
    const char* A1; const char* B1; unsigned lda1, ldb1; int n1;
    const char* A2; const char* B2; unsigned lda2, ldb2; int n2;
    int kind, i0, i1, i2;
};
struct TD { const char* a; const char* b; unsigned lda, ldb; };
__device__ __forceinline__ TD tile_at(const UnitD& u, int t) {
    TD d;
    if (t < u.n0) { d.a = u.A0 + (size_t)t * 128; d.b = u.B0 + (size_t)t * 128; d.lda = u.lda0; d.ldb = u.ldb0; }
    else if (t < u.n0 + u.n1) { const int s = t - u.n0; d.a = u.A1 + (size_t)s * 128; d.b = u.B1 + (size_t)s * 128; d.lda = u.lda1; d.ldb = u.ldb1; }
    else { const int s = t - u.n0 - u.n1; d.a = u.A2 + (size_t)s * 128; d.b = u.B2 + (size_t)s * 128; d.lda = u.lda2; d.ldb = u.ldb2; }
    return d;
}
typedef f32x4 Acc[2][2][4][2];

template <class P>
__device__ __forceinline__ void gemm_run(LAS unsigned char* lds, const P& ph) {
    const int tid = threadIdx.x, wid = __builtin_amdgcn_readfirstlane(tid >> 6), lane = tid & 63, wr = wid >> 2, wc = wid & 3, fr = lane & 15, fq = lane >> 4;
    int R0, C0; stage_rc(tid * 16, R0, C0);
    const unsigned vR = (unsigned)R0, vC2 = (unsigned)C0 * 2u;
    const unsigned ldsw = (unsigned)wid * 1024u;
    const int aoff = lds_byte(wr * 64 + fr, fq * 8), boff = lds_byte(wc * 32 + fr, fq * 8);
#define EG_SA(b, h) (((b) * 2 + (h)) * HTB)
#define EG_SB(b, h) ((4 + (b) * 2 + (h)) * HTB)
#define EG_STAGE(bufoff, gbase, ld) do { const unsigned _ld = (ld); const char* _g = (gbase) + (size_t)(vR * _ld + vC2); \
        __builtin_amdgcn_global_load_lds((const unsigned*)_g, (LAS unsigned*)(lds + (bufoff) + ldsw), 16, 0, 0); \
        __builtin_amdgcn_global_load_lds((const unsigned*)(_g + (size_t)(64u * _ld)), (LAS unsigned*)(lds + (bufoff) + ldsw + 8192), 16, 0, 0); } while (0)
#define EG_LDA(dst, b, h) do { _Pragma("unroll") for (int m = 0; m < 4; ++m) _Pragma("unroll") for (int k = 0; k < 2; ++k) dst[m][k] = *(const LAS bf16x8*)(lds + EG_SA(b, h) + aoff + m * 2048 + k * 1024); } while (0)
#define EG_LDB(dst, b, h) do { _Pragma("unroll") for (int n = 0; n < 2; ++n) _Pragma("unroll") for (int k = 0; k < 2; ++k) dst[n][k] = *(const LAS bf16x8*)(lds + EG_SB(b, h) + boff + n * 2048 + k * 1024); } while (0)
#define EG_MMA(ai, bj, At, Bt) do { __builtin_amdgcn_s_setprio(1); _Pragma("unroll") for (int m = 0; m < 4; ++m) _Pragma("unroll") for (int n = 0; n < 2; ++n) _Pragma("unroll") for (int k = 0; k < 2; ++k) \
        acc[ai][bj][m][n] = __builtin_amdgcn_mfma_f32_16x16x32_bf16(Bt[n][k], At[m][k], acc[ai][bj][m][n], 0, 0, 0); __builtin_amdgcn_s_setprio(0); } while (0)
#define EG_WAIT_V(n) asm volatile("s_waitcnt vmcnt(" #n ")" ::: "memory")
#define EG_WAIT_L(n) asm volatile("s_waitcnt lgkmcnt(" #n ")" ::: "memory")
#define EG_BAR __builtin_amdgcn_s_barrier()
#define EG_SCHED __builtin_amdgcn_sched_barrier(0)
    UnitD cur; int ui = 0;
    if (!ph.get(0, cur)) return;
    UnitD cu = cur; int cui = 0, ct = 0; bool cvalid = true; TD lastTD = tile_at(cur, 0);
#define EG_NEXT(dst) do { if (cvalid) { dst = tile_at(cu, ct); lastTD = dst; ++ct; if (ct == cu.n0 + cu.n1 + cu.n2) { ++cui; ct = 0; cvalid = ph.get(cui, cu); } } else dst = lastTD; } while (0)
    Acc acc;
#pragma unroll
    for (int a = 0; a < 2; ++a)
#pragma unroll
        for (int b = 0; b < 2; ++b)
#pragma unroll
            for (int m = 0; m < 4; ++m)
#pragma unroll
                for (int n = 0; n < 2; ++n) acc[a][b][m][n] = (f32x4){0.f, 0.f, 0.f, 0.f};
    bf16x8 At[4][2], B0[2][2], B1[2][2];
    TD d1, d2, d3;
    { TD d0; EG_NEXT(d0); EG_NEXT(d1);
      EG_STAGE(EG_SB(0, 0), d0.b, d0.ldb); EG_STAGE(EG_SA(0, 0), d0.a, d0.lda); EG_STAGE(EG_SB(0, 1), d0.b + (size_t)(128u * d0.ldb), d0.ldb); EG_STAGE(EG_SA(0, 1), d0.a + (size_t)(128u * d0.lda), d0.lda); }
    if (wr == 1) EG_BAR;
    EG_WAIT_V(4); EG_BAR;
    EG_STAGE(EG_SB(1, 0), d1.b, d1.ldb); EG_STAGE(EG_SA(1, 0), d1.a, d1.lda); EG_STAGE(EG_SB(1, 1), d1.b + (size_t)(128u * d1.ldb), d1.ldb);
    EG_WAIT_V(6); EG_BAR;
    int tc = 0;
    for (;;) {
        EG_NEXT(d2); EG_NEXT(d3);
        if constexpr (P::HOOKS) { int fr_o = fr; asm volatile("" : "+v"(fr_o)); ph.hook(tc, acc, cur, wr, wc, fr_o, fq); }
        EG_LDB(B0, 0, 0); EG_SCHED; EG_LDA(At, 0, 0); EG_STAGE(EG_SA(1, 1), d1.a + (size_t)(128u * d1.lda), d1.lda);
        EG_WAIT_L(8); EG_BAR; EG_WAIT_L(0); EG_MMA(0, 0, At, B0); EG_BAR; EG_SCHED;
        EG_LDB(B1, 0, 1); EG_STAGE(EG_SB(0, 0), d2.b, d2.ldb);
        EG_BAR; EG_WAIT_L(0); EG_MMA(0, 1, At, B1); EG_BAR;
        EG_LDA(At, 0, 1); EG_STAGE(EG_SA(0, 0), d2.a, d2.lda);
        EG_BAR; EG_WAIT_L(0); EG_MMA(1, 0, At, B0); EG_BAR; EG_SCHED;
        EG_STAGE(EG_SB(0, 1), d2.b + (size_t)(128u * d2.ldb), d2.ldb);
        EG_WAIT_V(6); EG_BAR; EG_MMA(1, 1, At, B1); EG_BAR;
        EG_LDB(B0, 1, 0); EG_SCHED; EG_LDA(At, 1, 0); EG_STAGE(EG_SA(0, 1), d2.a + (size_t)(128u * d2.lda), d2.lda);
        EG_WAIT_L(8); EG_BAR; EG_WAIT_L(0); EG_MMA(0, 0, At, B0); EG_BAR; EG_SCHED;
        EG_LDB(B1, 1, 1); EG_STAGE(EG_SB(1, 0), d3.b, d3.ldb);
        EG_BAR; EG_WAIT_L(0); EG_MMA(0, 1, At, B1); EG_BAR;
        EG_LDA(At, 1, 1); EG_STAGE(EG_SA(1, 0), d3.a, d3.lda);
        EG_BAR; EG_WAIT_L(0); EG_MMA(1, 0, At, B0); EG_BAR; EG_SCHED;
        EG_STAGE(EG_SB(1, 1), d3.b + (size_t)(128u * d3.ldb), d3.ldb);
        EG_WAIT_V(6); EG_BAR; EG_MMA(1, 1, At, B1); EG_BAR;
        d1 = d3; tc += 2;
        if (tc == cur.n0 + cur.n1 + cur.n2) {
            { int fr_o = fr, fq_o = fq; asm volatile("" : "+v"(fr_o), "+v"(fq_o));
              ph.epi(acc, cur, wr, wc, fr_o, fq_o); }
            ++ui; tc = 0;
            if (!ph.get(ui, cur)) break;
#pragma unroll
            for (int a = 0; a < 2; ++a)
#pragma unroll
                for (int b = 0; b < 2; ++b)
#pragma unroll
                    for (int m = 0; m < 4; ++m)
#pragma unroll
                        for (int n = 0; n < 2; ++n) acc[a][b][m][n] = (f32x4){0.f, 0.f, 0.f, 0.f};
        }
    }
    EG_WAIT_V(0);
    if (wr == 0) EG_BAR;
    EG_BAR;
#undef EG_NEXT
}
__device__ __forceinline__ void unit1(UnitD& u, const void* A, unsigned lda, const void* B, unsigned ldb, int nt) {
    u.A0 = (const char*)A; u.B0 = (const char*)B; u.lda0 = lda; u.ldb0 = ldb; u.n0 = nt;
    u.A1 = u.A0; u.B1 = u.B0; u.lda1 = lda; u.ldb1 = ldb; u.n1 = 0; u.A2 = u.A0; u.B2 = u.B0; u.lda2 = lda; u.ldb2 = ldb; u.n2 = 0;
    u.kind = 0; u.i0 = 0; u.i1 = 0; u.i2 = 0;
}
}
using eng::UnitD; using eng::Acc;
__device__ __forceinline__ void efence() { asm volatile("" ::: "memory"); }
#define EPI_ARGS const Acc& acc, const UnitD& u, int wr, int wc, int fr, int fq
#define FOR_FRAG(ai, bj, m, n) _Pragma("unroll") for (int ai = 0; ai < 2; ++ai) _Pragma("unroll") for (int m = 0; m < 4; ++m) _Pragma("unroll") for (int bj = 0; bj < 2; efence(), ++bj) _Pragma("unroll") for (int n = 0; n < 2; ++n)
#define FRAG_ROW(ai, m) (128 * (ai) + 64 * wr + 16 * (m) + fr)
#define FRAG_COL(bj, n) (128 * (bj) + 32 * wc + 16 * (n) + 4 * fq)
__device__ __forceinline__ void st_bf16x4(bf16_t* p, f32x4 v) { u32x2 w; w.x = cvt_pk_bf16(v[0], v[1]); w.y = cvt_pk_bf16(v[2], v[3]); *(u32x2*)p = w; }
struct Frame { Params p; LAS unsigned char* lds; int tid, lane, wid, G, bid; };
#define WSP(T, off) ((T*)(F.p.ws + (off)))

template <class RowSrc>
__device__ __forceinline__ void conv_tile(const Frame& F, bf16_t* dst, int K, int ld, float scale, int r0, int k0, const RowSrc& rs) {
    LAS float* tile = (LAS float*)F.lds;
    const int n4 = (F.tid & 15) * 4, kq = F.tid >> 4;
    const float* sp = rs(r0 + n4) + (size_t)(k0 + kq) * ld;
#pragma unroll
    for (int p = 0; p < 8; ++p) { const f32x4 v = *(const f32x4*)(sp + (size_t)(p * 32) * ld); LAS float* q = tile + (p * 32 + kq) * 65 + n4; q[0] = v[0]; q[1] = v[1]; q[2] = v[2]; q[3] = v[3]; }
    __syncthreads();
    const int i2 = (F.tid & 127) * 2, jb = F.tid >> 7;
#pragma unroll
    for (int p = 0; p < 16; ++p) { const int j = p * 4 + jb; *(unsigned*)(dst + (size_t)(r0 + j) * K + k0 + i2) = cvt_pk_bf16(tile[i2 * 65 + j] * scale, tile[(i2 + 1) * 65 + j] * scale); }
    __syncthreads();
}
__device__ __forceinline__ int sigma_orig(int s) {
    const int half = s >> 7, s2 = s & 127, uu = s2 >> 5, b = (s2 >> 4) & 1, f = s2 & 15; return half * 128 + 16 * uu + f + 64 * b;
}
__device__ __forceinline__ void conv_moe_tile(const Frame& F, int layer, int t) {
    bf16_t* w13 = WSP(bf16_t, A_MOEW); bf16_t* w2t = WSP(bf16_t, A_MOEW + 32 * MiB);
    if (t < 1024) { const int e = t >> 6, rt = (t >> 2) & 15, kt = t & 3;
        const float* w1 = F.p.moe_w1 + ((size_t)layer * 16 + e) * 1024 * 512; const float* w3 = F.p.moe_w3 + ((size_t)layer * 16 + e) * 1024 * 512;
        conv_tile(F, w13 + (size_t)e * 1024 * 1024, 1024, 512, 1.0f, rt * 64, kt * 256, [=](int r) { const int j = r >> 8, rr = r & 255; return rr < 128 ? w1 + 128 * j + rr : w3 + 128 * j + rr - 128; });
    } else { const int u = t - 1024, e = u >> 5, rt = (u >> 1) & 15, kt = u & 1;
        const float* w2 = F.p.moe_w2 + ((size_t)layer * 16 + e) * 512 * 1024;
        conv_tile(F, w2t + (size_t)e * 1024 * 512, 512, 1024, 1.0f, rt * 64, kt * 256, [=](int r) { return w2 + r; }); }
}
__device__ __forceinline__ void conv_moe(const Frame& F, int layer) { for (int t = F.bid; t < 1536; t += F.G) conv_moe_tile(F, layer, t); }
__device__ __forceinline__ void conv_small_tile(const Frame& F, int t) {
    if (t < 96) { const float* w = F.p.w0in; conv_tile(F, WSP(bf16_t, WS_W0IN), 1024, 2560, 1.0f, (t >> 2) * 64, (t & 3) * 256, [=](int r) { return w + 256 + r; }); }
    else if (t < 144) { const int u = t - 96; const float* w = F.p.w0in; conv_tile(F, WSP(bf16_t, WS_W0IN) + (size_t)2048 * 1024, 1024, 2560, 1.0f, (u >> 2) * 64, (u & 3) * 256, [=](int r) { return w + 1792 + r; }); }
    else if (t < 208) { const int u = t - 144; const float* w = F.p.w0out; conv_tile(F, WSP(bf16_t, WS_W0OUT), 1024, 1024, 1.0f, (u >> 2) * 64, (u & 3) * 256, [=](int r) { return w + r; }); }
    else if (t < 272) { const int u = t - 208; const float* w = F.p.w1in; conv_tile(F, WSP(bf16_t, WS_W1IN), 1024, 6144, 1.0f, (u >> 2) * 64, (u & 3) * 256, [=](int r) { return w + (r & ~255) + sigma_orig(r & 255); }); }
    else if (t < 336) { const int u = t - 272; const float* w = F.p.w1in; conv_tile(F, WSP(bf16_t, WS_W1IN) + (size_t)1024 * 1024, 1024, 6144, 0.0625f, (u >> 2) * 64, (u & 3) * 256, [=](int r) { return w + 1024 + (r & ~255) + sigma_orig(r & 255); }); }
    else if (t < 592) { const int u = t - 336; const float* w = F.p.w1in; conv_tile(F, WSP(bf16_t, WS_W1IN) + (size_t)2048 * 1024, 1024, 6144, 1.0f, (u >> 2) * 64, (u & 3) * 256, [=](int r) { return w + 2048 + r; }); }
    else { const int u = t - 592; const float* w = F.p.w1out; conv_tile(F, WSP(bf16_t, WS_W1OUT), 2048, 1024, 1.0f, (u >> 3) * 64, (u & 7) * 256, [=](int r) { return w + r; }); }
}
__device__ __forceinline__ void p0_prologue(const Frame& F) {
    const float TWO_PI = 6.283185307179586f;
    {
        LAS float* sc0 = (LAS float*)F.lds; LAS float* sc1 = sc0 + 1024; LAS float* red = sc1 + 1024;
        for (int k = F.tid; k < 1024; k += 512) { sc0[k] = silu_f(F.p.c[k]); sc1[k] = silu_f(F.p.c_ctx[k]); }
        __syncthreads();
        float* mod = WSP(float, WS_MOD);
        for (int item = F.bid; item < 192; item += F.G) {
            const int l = item / 96, col0 = (item % 96) * 64, l16 = F.tid & 15, kg = F.tid >> 4;
            f32x4 a0 = {0.f, 0.f, 0.f, 0.f}, a1 = {0.f, 0.f, 0.f, 0.f};
#pragma unroll 8
            for (int i = 0; i < 32; ++i) { const int k = kg + 32 * i; const f32x4 w = *(const f32x4*)(F.p.ada_w + ((size_t)l * 1024 + k) * 6144 + col0 + l16 * 4); a0 += sc0[k] * w; a1 += sc1[k] * w; }
#pragma unroll
            for (int e = 0; e < 4; ++e) { red[(kg * 64 + l16 * 4 + e) * 2 + 0] = a0[e]; red[(kg * 64 + l16 * 4 + e) * 2 + 1] = a1[e]; }
            __syncthreads();
            if (F.tid < 128) { const int col = F.tid & 63, which = F.tid >> 6; float s = 0.f; for (int g = 0; g < 32; ++g) s += red[(g * 64 + col) * 2 + which];
                mod[(size_t)which * 2 * 6144 + l * 6144 + col0 + col] = s + F.p.ada_b[l * 6144 + col0 + col]; }
            __syncthreads();
        }
    }
    {
        const int gt = F.bid * 512 + F.tid, gn = F.G * 512;
        float* twc = WSP(float, WS_TWC); float* tws = WSP(float, WS_TWS);
        for (int i = gt; i < 128 * 128; i += gn) { const int b = i >> 7, k1 = i & 127; const float a = (float)((b * k1) & 16383) * (TWO_PI / 16384.0f); twc[i] = cosf(a); tws[i] = sinf(a); }
        float* rc = WSP(float, WS_ROPEC); float* rs = WSP(float, WS_ROPES);
        for (int i = gt; i < 256 * 64; i += gn) { const int pos = i >> 6, fi = i & 63; const float inv = powf(10000.0f, -(float)fi / 64.0f); const float a = (float)pos * inv; rc[i] = cosf(a); rs[i] = sinf(a); }
        bf16_t* f1 = WSP(bf16_t, WS_F1T); bf16_t* f2 = WSP(bf16_t, WS_F2P);
        for (int i = gt; i < 256 * 256; i += gn) { const int n = i >> 8, k = i & 255, k1 = n & 127, a = k & 127; const float ang = (float)((a * k1) & 127) * (TWO_PI / 128.0f); const float cs = cosf(ang), sn = sinf(ang);
            float v1; if (n < 128) v1 = (k < 128) ? cs : sn; else v1 = (k < 128) ? -sn : cs;
            f1[i] = f2bf(v1);
            f2[i] = f2bf(n < 128 ? ((k < 128) ? cs : sn) * (1.0f / 128.0f) : 0.0f); }
        bf16_t* cs256 = WSP(bf16_t, WS_CS256);
        for (int i = gt; i < 256 * 512; i += gn) { const int k = i >> 9, j = i & 511, n = j & 255; const float ang = (float)((n * k) & 255) * (TWO_PI / 256.0f); cs256[i] = f2bf((j < 256 ? cosf(ang) : sinf(ang)) * (1.0f / 16.0f)); }
    }
    {
        LAS float* ct = (LAS float*)F.lds;
        __syncthreads();
        if (F.tid < 64) ct[F.tid] = cosf((float)F.tid * (TWO_PI / 64.0f));
        __syncthreads();
        bf16_t* dst = WSP(bf16_t, WS_W0IN);
        for (int idx = F.bid * 512 + F.tid; idx < 512 * 1024; idx += F.G * 512) {
            const int r = idx >> 10, k = idx & 1023, part = r >> 8, cc = r & 255, g = cc >> 6, cp = cc & 63;
            const float* w = F.p.w0in + (size_t)k * 2560 + g * 64; float s = 0.f;
#pragma unroll 8
            for (int c = 0; c < 64; ++c) { const int ph = (c * cp) & 63; const float t = part ? -ct[(ph + 48) & 63] : ct[ph]; s += w[c] * t; }
            dst[(size_t)(1536 + r) * 1024 + k] = f2bf(s * 0.125f);
        }
        __syncthreads();
    }
    for (int t = F.bid; t < 720 + 1536; t += F.G) { if (t < 720) conv_small_tile(F, t); else conv_moe_tile(F, 0, t - 720); }
}

struct Row { f32x4 v[4]; };
__device__ __forceinline__ void row_load(Row& r, const float* p, int lane) {
#pragma unroll
    for (int i = 0; i < 4; ++i) r.v[i] = *(const f32x4*)(p + 4 * lane + 256 * i);
}
__device__ __forceinline__ void row_store(const Row& r, float* p, int lane) {
#pragma unroll
    for (int i = 0; i < 4; ++i) *(f32x4*)(p + 4 * lane + 256 * i) = r.v[i];
}
__device__ __forceinline__ float row_rstd(const Row& r) {
    float s = 0.f;
#pragma unroll
    for (int i = 0; i < 4; ++i) s += (r.v[i][0] * r.v[i][0] + r.v[i][1] * r.v[i][1]) + (r.v[i][2] * r.v[i][2] + r.v[i][3] * r.v[i][3]);
    s = wave_sum(s);
    return rsqrtf(s * (1.0f / 1024.0f) + RMS_EPS);
}
__device__ __forceinline__ void row_norm_mod(Row& r, const float* g, const float* sh, const float* sc, int lane) {
    const float rs = row_rstd(r);
#pragma unroll
    for (int i = 0; i < 4; ++i) { const int c = 4 * lane + 256 * i; const f32x4 gv = *(const f32x4*)(g + c), shv = *(const f32x4*)(sh + c), scv = *(const f32x4*)(sc + c);
        r.v[i] = (r.v[i] * rs) * gv * (1.0f + scv) + shv; }
}
__device__ __forceinline__ void row_store_bf16(const Row& r, bf16_t* p, int lane) {
#pragma unroll
    for (int i = 0; i < 4; ++i) st_bf16x4(p + 4 * lane + 256 * i, r.v[i]);
}
__device__ __forceinline__ const float* modp(const Frame& F, int layer, bool is_ctx) { return WSP(const float, WS_MOD) + (size_t)(is_ctx ? 2 : 0) * 6144 + layer * 6144; }
__device__ __forceinline__ float* hrow(const Frame& F, int t) { return t < CTXN ? WSP(float, WS_HC) + (size_t)t * DM : F.p.out + (size_t)(t - CTXN) * DM; }

__device__ __forceinline__ void p_norm_in(const Frame& F) {
    bf16_t* xm = WSP(bf16_t, A_XM);
    for (int t = F.bid * 8 + F.wid; t < TT; t += F.G * 8) {
        const bool ic = t < CTXN; const float* src = ic ? F.p.ctx + (size_t)t * DM : F.p.x + (size_t)(t - CTXN) * DM; const float* m = modp(F, 0, ic);
        Row r; row_load(r, src, F.lane); row_norm_mod(r, F.p.norm_g, m, m + 1024, F.lane); row_store_bf16(r, xm + (size_t)t * DM, F.lane);
    }
}
__device__ __forceinline__ void p_norm_l1(const Frame& F, bf16_t* dst) {
    for (int t = CTXN + F.bid * 8 + F.wid; t < TT; t += F.G * 8) {
        const float* m = modp(F, 1, false);
        Row r; row_load(r, hrow(F, t), F.lane); row_norm_mod(r, F.p.norm_g + 2 * DM, m, m + 1024, F.lane); row_store_bf16(r, dst + (size_t)t * DM, F.lane);
    }
}

__device__ __forceinline__ void p_router(const Frame& F, int layer, int t0, bf16_t* dst) {
    LAS float* rwT = (LAS float*)F.lds;
    LAS unsigned* lcnt = (LAS unsigned*)(F.lds + 65536);
    for (int i = F.tid; i < 16 * 1024; i += 512) { const int e = i >> 10, c = i & 1023; rwT[i] = F.p.router_w[c * 16 + e]; }
    if (F.tid < 32) lcnt[F.tid] = 0u;
    __syncthreads();
    int* eid = WSP(int, WS_EID); float* gw = WSP(float, WS_GW); int* slot = WSP(int, WS_SLOT);
    unsigned* gcnt = (unsigned*)(F.p.ws + WS_CTL + CTL_CNT) + layer * 64;
    for (int t = t0 + F.bid * 8 + F.wid; t < TT; t += F.G * 8) {
        const bool ic = t < CTXN; const float* m = modp(F, layer, ic);
        Row r; row_load(r, hrow(F, t), F.lane); row_norm_mod(r, F.p.norm_g + (size_t)(layer * 2 + 1) * DM, m + 3072, m + 4096, F.lane); row_store_bf16(r, dst + (size_t)t * DM, F.lane);
        float lg[16];
#pragma unroll
        for (int e = 0; e < 16; ++e) { float s = 0.f;
#pragma unroll
            for (int i = 0; i < 4; ++i) { const f32x4 w = *(const LAS f32x4*)(rwT + e * 1024 + 4 * F.lane + 256 * i); s += (r.v[i][0] * w[0] + r.v[i][1] * w[1]) + (r.v[i][2] * w[2] + r.v[i][3] * w[3]); }
            lg[e] = wave_sum(s); }
        float scv[16], bi[16];
#pragma unroll
        for (int e = 0; e < 16; ++e) { scv[e] = 1.0f / (1.0f + __expf(-lg[e])); bi[e] = scv[e] + F.p.router_b[e]; }
        int gsel = 0; float best = -1e30f;
#pragma unroll
        for (int g = 0; g < 4; ++g) { const float a = bi[4 * g], b = bi[4 * g + 1], c = bi[4 * g + 2], d = bi[4 * g + 3];
            const float h1 = fmaxf(a, b), l1 = fminf(a, b), h2 = fmaxf(c, d), l2 = fminf(c, d); const float gs = fmaxf(h1, h2) + fmaxf(fminf(h1, h2), fmaxf(l1, l2));
            if (gs > best) { best = gs; gsel = g; } }
        float vb[4], vs[4];
#pragma unroll
        for (int i = 0; i < 4; ++i) { vb[i] = gsel == 0 ? bi[i] : gsel == 1 ? bi[4 + i] : gsel == 2 ? bi[8 + i] : bi[12 + i]; vs[i] = gsel == 0 ? scv[i] : gsel == 1 ? scv[4 + i] : gsel == 2 ? scv[8 + i] : scv[12 + i]; }
        int i0 = 0; float b0 = vb[0];
#pragma unroll
        for (int i = 1; i < 4; ++i) if (vb[i] > b0) { b0 = vb[i]; i0 = i; }
        int i1 = -1; float b1 = -1e30f;
#pragma unroll
        for (int i = 0; i < 4; ++i) if (i != i0 && vb[i] > b1) { b1 = vb[i]; i1 = i; }
        const float s0 = i0 == 0 ? vs[0] : i0 == 1 ? vs[1] : i0 == 2 ? vs[2] : vs[3], s1 = i1 == 0 ? vs[0] : i1 == 1 ? vs[1] : i1 == 2 ? vs[2] : vs[3];
        const float inv = 1.0f / (s0 + s1);
        if (F.lane == 0) {
            const int e0 = gsel * 4 + i0, e1 = gsel * 4 + i1;
            const unsigned r0 = __hip_atomic_fetch_add(lcnt + e0, 1u, __ATOMIC_RELAXED, __HIP_MEMORY_SCOPE_WORKGROUP), r1 = __hip_atomic_fetch_add(lcnt + e1, 1u, __ATOMIC_RELAXED, __HIP_MEMORY_SCOPE_WORKGROUP);
            eid[2 * t] = e0; eid[2 * t + 1] = e1; gw[2 * t] = s0 * inv; gw[2 * t + 1] = s1 * inv; slot[2 * t] = (int)r0; slot[2 * t + 1] = (int)r1;
        }
    }
    __syncthreads();
    if (F.tid < 16) lcnt[16 + F.tid] = __hip_atomic_fetch_add(gcnt + F.tid, lcnt[F.tid], __ATOMIC_RELAXED, __HIP_MEMORY_SCOPE_AGENT);
    __syncthreads();
    for (int t = t0 + F.bid * 8 + F.wid; t < TT; t += F.G * 8)
        if (F.lane < 2) slot[2 * t + F.lane] += (int)lcnt[16 + eid[2 * t + F.lane]];
    __syncthreads();
}
struct PanelTab { int pst[17]; };
__device__ __forceinline__ void panel_tab(const Frame& F, int layer, PanelTab& pt) {
    const unsigned* gcnt = (const unsigned*)(F.p.ws + WS_CTL + CTL_CNT) + layer * 64;
    pt.pst[0] = 0;
#pragma unroll
    for (int e = 0; e < 16; ++e) pt.pst[e + 1] = pt.pst[e] + (int)((__builtin_amdgcn_readfirstlane(gcnt[e]) + 255u) >> 8);
}
__device__ __forceinline__ void p_gather(const Frame& F, int layer, int t0, const bf16_t* xm2, bf16_t* xs) {
    PanelTab pt; panel_tab(F, layer, pt);
    const int* eid = WSP(const int, WS_EID); int* slot = WSP(int, WS_SLOT);
    for (int t = t0 + F.bid * 8 + F.wid; t < TT; t += F.G * 8) {
        const u32x4* src = (const u32x4*)(xm2 + (size_t)t * DM); const u32x4 a = src[F.lane], b = src[64 + F.lane];
#pragma unroll
        for (int k = 0; k < 2; ++k) {
            const int e = eid[2 * t + k]; int ps = 0;
#pragma unroll
            for (int j = 0; j < 16; ++j) ps = (e == j) ? pt.pst[j] : ps;
            const int s = ps * 256 + slot[2 * t + k];
            u32x4* d = (u32x4*)(xs + (size_t)s * DM); d[F.lane] = a; d[64 + F.lane] = b;
            if (F.lane == 0) slot[2 * t + k] = s;
        }
    }
}
__device__ __forceinline__ void row_moe_combine(const Frame& F, Row& r, int t, int layer, const bf16_t* Y) {
    const int* slot = WSP(const int, WS_SLOT); const float* gw = WSP(const float, WS_GW);
    const int s0 = slot[2 * t], s1 = slot[2 * t + 1]; const float w0 = gw[2 * t], w1 = gw[2 * t + 1];
    const float* g2 = modp(F, layer, t < CTXN) + 5120;
#pragma unroll
    for (int i = 0; i < 4; ++i) { const int c = 4 * F.lane + 256 * i;
        const u32x2 a = *(const u32x2*)(Y + (size_t)s0 * DM + c), b = *(const u32x2*)(Y + (size_t)s1 * DM + c); const f32x4 gv = *(const f32x4*)(g2 + c);
        f32x4 f; f[0] = w0 * bflo(a.x) + w1 * bflo(b.x); f[1] = w0 * bfhi(a.x) + w1 * bfhi(b.x); f[2] = w0 * bflo(a.y) + w1 * bflo(b.y); f[3] = w0 * bfhi(a.y) + w1 * bfhi(b.y);
        r.v[i] += gv * f; }
}
__device__ __forceinline__ void p_combine0(const Frame& F) {
    const bf16_t* Y = WSP(const bf16_t, A_XS); bf16_t* xm1 = WSP(bf16_t, B_XM1);
    for (int t = F.bid * 8 + F.wid; t < TT; t += F.G * 8) {
        Row r; float* hp = hrow(F, t); row_load(r, hp, F.lane); row_moe_combine(F, r, t, 0, Y); row_store(r, hp, F.lane);
        const float* m = modp(F, 1, t < CTXN); row_norm_mod(r, F.p.norm_g + 2 * DM, m, m + 1024, F.lane); row_store_bf16(r, xm1 + (size_t)t * DM, F.lane);
    }
}
__device__ __forceinline__ void p_final(const Frame& F) {
    const bf16_t* Y = WSP(const bf16_t, B_XS);
    for (int t = CTXN + F.bid * 8 + F.wid; t < TT; t += F.G * 8) {
        Row r; float* hp = hrow(F, t); row_load(r, hp, F.lane); row_moe_combine(F, r, t, 1, Y);
        const float rs = row_rstd(r);
#pragma unroll
        for (int i = 0; i < 4; ++i) { const f32x4 gv = *(const f32x4*)(F.p.final_g + 4 * F.lane + 256 * i); r.v[i] = (r.v[i] * rs) * gv; }
        row_store(r, hp, F.lane);
    }
}
__device__ __forceinline__ float log_gamma(const Frame& F, int dir, int h) { return log1pf(-expf(F.p.decay[dir * 4 + h])); }
__device__ __forceinline__ void p_scan(const Frame& F) {
    bf16_t* st = WSP(bf16_t, B_ST);
    const int item = F.bid * 512 + F.tid;
    for (int it = item; it < 8 * 16384; it += F.G * 512) {
        const int hd = it >> 14, grp = it & 16383, h = hd >> 1, dir = hd & 1;
        const float lg = log_gamma(F, dir, h), d256 = __expf(256.0f * lg), d512 = __expf(512.0f * lg);
        float s[8];
#pragma unroll
        for (int j = 0; j < 8; ++j) s[j] = 0.f;
#pragma unroll 4
        for (int step = 0; step < 33; ++step) {
            const int c = (dir == 0 || step == 0) ? step : 33 - step;
            u32x4* p = (u32x4*)(st + ((size_t)(c * 8 + hd) * 131072 + (size_t)grp * 8));
            const u32x4 uv = *p; const float dec = (c == 0) ? d256 : d512;
            u32x4 o; o.x = cvt_pk_bf16(s[0], s[1]); o.y = cvt_pk_bf16(s[2], s[3]); o.z = cvt_pk_bf16(s[4], s[5]); o.w = cvt_pk_bf16(s[6], s[7]);
            *p = o;
            s[0] = s[0] * dec + bflo(uv.x); s[1] = s[1] * dec + bfhi(uv.x); s[2] = s[2] * dec + bflo(uv.y); s[3] = s[3] * dec + bfhi(uv.y);
            s[4] = s[4] * dec + bflo(uv.z); s[5] = s[5] * dec + bfhi(uv.z); s[6] = s[6] * dec + bflo(uv.w); s[7] = s[7] * dec + bfhi(uv.w);
        }
    }
}
#define PH_COMMON const unsigned char* ws; int G, bid; static constexpr bool HOOKS = false; \
    __device__ __forceinline__ void hook(int, Acc&, const UnitD&, int, int, int, int) const {}
#define WSC(T, off) ((T*)(ws + (off)))
__device__ __forceinline__ int xcd_remap(int idx, int N) { const int q = N >> 3, r = N & 7, x = idx & 7, off = idx >> 3; return (x < r ? x * (q + 1) : r * (q + 1) + (x - r) * q) + off; }
__device__ __forceinline__ float sel4(f32x4 v, int h) { const float a = h == 0 ? v[0] : v[1], b = h == 2 ? v[2] : v[3]; return h < 2 ? a : b; }
#define SEL4(a, h) sel4(a, h)
#define EFENCE asm volatile("" ::: "memory")

struct PhG1 { PH_COMMON
    __device__ __forceinline__ bool get(int i, UnitD& u) const {
        const int idx = bid + i * G; if (idx >= 715) return false;
        const char* xm = (const char*)(ws + A_XM); const char* w = (const char*)(ws + WS_W0IN);
        if (idx < 390) { const int v = xcd_remap(idx, 390), pm = v / 6, pn = v % 6; eng::unit1(u, xm + (size_t)pm * 256 * 2048, 2048, w + (size_t)pn * 256 * 2048, 2048, 16); u.kind = 0; u.i0 = pm; u.i1 = pn; }
        else { const int j = xcd_remap(idx - 390, 325), ct = j / 5, rt = j % 5; eng::unit1(u, w + (size_t)(1536 + rt * 256) * 2048, 2048, xm + (size_t)ct * 256 * 2048, 2048, 16); u.kind = rt < 2 ? 1 : 2; u.i0 = rt; u.i1 = ct; }
        return true;
    }
    __device__ __forceinline__ void epi(EPI_ARGS) const {
        if (u.kind == 0) { bf16_t* o = WSC(bf16_t, A_QK0) + (size_t)(u.i0 * 256) * QK0_LD + u.i1 * 256;
            FOR_FRAG(ai, bj, m, n) st_bf16x4(o + (size_t)FRAG_ROW(ai, m) * QK0_LD + FRAG_COL(bj, n), acc[ai][bj][m][n]); }
        else if (u.kind == 2) { bf16_t* o = WSC(bf16_t, A_VT0) + (size_t)((u.i0 - 2) * 256) * TT + u.i1 * 256;
            FOR_FRAG(ai, bj, m, n) st_bf16x4(o + (size_t)FRAG_ROW(ai, m) * TT + FRAG_COL(bj, n), acc[ai][bj][m][n]); }
        else if (u.i1 == 0) { bf16_t* o = WSC(bf16_t, WS_XTC) + u.i0 * 256;
            FOR_FRAG(ai, bj, m, n) st_bf16x4(o + (size_t)FRAG_ROW(ai, m) * 512 + FRAG_COL(bj, n), acc[ai][bj][m][n]); }
        else { bf16_t* o = WSC(bf16_t, A_XT2) + u.i0 * 128;
            FOR_FRAG(ai, bj, m, n) { const int cc = FRAG_ROW(ai, m), nn = (u.i1 - 1) * 256 + FRAG_COL(bj, n), a = nn >> 7, b = nn & 127; const f32x4 v = acc[ai][bj][m][n];
#pragma unroll
                for (int e = 0; e < 4; ++e) o[(size_t)(cc * 128 + b + e) * 256 + a] = f2bf(v[e]);
                EFENCE; } }
    }
};
struct PhF1 { PH_COMMON
    __device__ __forceinline__ bool get(int i, UnitD& u) const {
        const int idx = bid + i * G; if (idx >= 129) return false;
        if (idx < 128) { eng::unit1(u, ws + A_XT2 + (size_t)idx * 256 * 512, 512, ws + WS_F1T, 512, 4); u.kind = 0; u.i0 = idx; }
        else { eng::unit1(u, ws + WS_CS256, 1024, ws + WS_XTC, 1024, 8); u.kind = 1; }
        return true;
    }
    __device__ __forceinline__ void epi(EPI_ARGS) const {
        if (u.kind == 1) { bf16_t* o = WSC(bf16_t, A_AO); FOR_FRAG(ai, bj, m, n) st_bf16x4(o + (size_t)FRAG_ROW(ai, m) * DM + FRAG_COL(bj, n), acc[ai][bj][m][n]); return; }
        const float* twc = WSC(const float, WS_TWC); const float* tws = WSC(const float, WS_TWS); bf16_t* o = WSC(bf16_t, A_T2);
#pragma unroll
        for (int m = 0; m < 4; ++m)
#pragma unroll
            for (int n = 0; n < 2; ++n) { const int b = 64 * wr + 16 * m + fr, k1 = 32 * wc + 16 * n + 4 * fq; const f32x4 cv = *(const f32x4*)(twc + b * 128 + k1), sv = *(const f32x4*)(tws + b * 128 + k1);
#pragma unroll
                for (int ai = 0; ai < 2; ++ai) { const int cc = 2 * u.i0 + ai; const f32x4 tr = acc[ai][0][m][n], ti = acc[ai][1][m][n];
#pragma unroll
                    for (int e = 0; e < 4; ++e) { bf16_t* q = o + (size_t)((k1 + e) * 256 + cc) * 256 + b; q[0] = f2bf(tr[e] * cv[e] + ti[e] * sv[e]); q[128] = f2bf(ti[e] * cv[e] - tr[e] * sv[e]); } } }
    }
};
struct PhF2 { PH_COMMON const float* ctx;
    __device__ __forceinline__ bool get(int i, UnitD& u) const {
        const int idx = bid + i * G; if (idx >= 132) return false;
        if (idx < 128) { eng::unit1(u, ws + WS_F2P, 512, ws + A_T2 + (size_t)idx * 256 * 512, 512, 4); u.i0 = idx; }
        else { const int pn = idx - 128; eng::unit1(u, ws + A_AO, 2048, ws + WS_W0OUT + (size_t)pn * 256 * 2048, 2048, 16); u.kind = 1; u.i1 = pn; }
        return true;
    }
    __device__ __forceinline__ void epi(EPI_ARGS) const {
        if (u.kind == 1) { const float* g1 = WSC(const float, WS_MOD) + 2 * 6144 + 2048 + u.i1 * 256; float* dst = WSC(float, WS_HC);
            FOR_FRAG(ai, bj, m, n) { const size_t off = (size_t)FRAG_ROW(ai, m) * DM + u.i1 * 256 + FRAG_COL(bj, n); const f32x4 gv = *(const f32x4*)(g1 + FRAG_COL(bj, n));
                *(f32x4*)(dst + off) = *(const f32x4*)(ctx + off) + gv * acc[ai][bj][m][n]; }
            return; }
        bf16_t* o = WSC(bf16_t, A_AO);
#pragma unroll
        for (int m = 0; m < 4; ++m)
#pragma unroll
            for (int bj = 0; bj < 2; ++bj)
#pragma unroll
                for (int n = 0; n < 2; ++n) { const int k2 = FRAG_ROW(0, m); st_bf16x4(o + (size_t)(CTXN + u.i0 + 128 * k2) * DM + FRAG_COL(bj, n), acc[0][bj][m][n]); }
    }
};
struct PhG2 { PH_COMMON const float* x; float* out;
    __device__ __forceinline__ bool get(int i, UnitD& u) const {
        const int idx0 = bid + i * G; if (idx0 >= 256) return false;
        const int idx = xcd_remap(idx0, 256), pm = 1 + (idx >> 2), pn = idx & 3; eng::unit1(u, ws + A_AO + (size_t)pm * 256 * 2048, 2048, ws + WS_W0OUT + (size_t)pn * 256 * 2048, 2048, 16); u.i0 = pm; u.i1 = pn; return true;
    }
    __device__ __forceinline__ void epi(EPI_ARGS) const {
        const float* g1 = WSC(const float, WS_MOD) + 2048 + u.i1 * 256;
        const float* src = x + (size_t)(u.i0 - 1) * 256 * DM; float* dst = out + (size_t)(u.i0 - 1) * 256 * DM;
        FOR_FRAG(ai, bj, m, n) { const size_t off = (size_t)FRAG_ROW(ai, m) * DM + u.i1 * 256 + FRAG_COL(bj, n); const f32x4 gv = *(const f32x4*)(g1 + FRAG_COL(bj, n));
            *(f32x4*)(dst + off) = *(const f32x4*)(src + off) + gv * acc[ai][bj][m][n]; }
    }
};
struct PhM1 { PH_COMMON PanelTab pt; size_t xs, hd;
    __device__ __forceinline__ bool get(int i, UnitD& u) const {
        const int idx0 = bid + i * G, NU = pt.pst[16] * 4; if (idx0 >= NU) return false;
        const int idx = xcd_remap(idx0, NU), p = idx >> 2, j = idx & 3; int e = 0;
#pragma unroll
        for (int k = 1; k < 16; ++k) e += (p >= pt.pst[k]) ? 1 : 0;
        eng::unit1(u, ws + xs + (size_t)p * 256 * 2048, 2048, ws + A_MOEW + ((size_t)e * 1024 + j * 256) * 2048, 2048, 16); u.i0 = p; u.i1 = j; return true;
    }
    __device__ __forceinline__ void epi(EPI_ARGS) const {
        bf16_t* o = (bf16_t*)(ws + hd) + (size_t)(u.i0 * 256) * 512 + u.i1 * 128;
#pragma unroll
        for (int ai = 0; ai < 2; ++ai)
#pragma unroll
            for (int m = 0; m < 4; ++m)
#pragma unroll
                for (int n = 0; n < 2; ++n) { const f32x4 a = acc[ai][0][m][n], b = acc[ai][1][m][n]; f32x4 v;
#pragma unroll
                    for (int e = 0; e < 4; ++e) v[e] = silu_f(a[e]) * b[e];
                    st_bf16x4(o + (size_t)FRAG_ROW(ai, m) * 512 + FRAG_COL(0, n), v); }
    }
};
struct PhM2 { PH_COMMON PanelTab pt; size_t hd, y;
    __device__ __forceinline__ bool get(int i, UnitD& u) const {
        const int idx0 = bid + i * G, NU = pt.pst[16] * 4; if (idx0 >= NU) return false;
        const int idx = xcd_remap(idx0, NU), p = idx >> 2, j = idx & 3; int e = 0;
#pragma unroll
        for (int k = 1; k < 16; ++k) e += (p >= pt.pst[k]) ? 1 : 0;
        eng::unit1(u, ws + hd + (size_t)p * 256 * 1024, 1024, ws + A_MOEW + 32 * MiB + ((size_t)e * 1024 + j * 256) * 1024, 1024, 8); u.i0 = p; u.i1 = j; return true;
    }
    __device__ __forceinline__ void epi(EPI_ARGS) const {
        bf16_t* o = (bf16_t*)(ws + y) + (size_t)(u.i0 * 256) * DM + u.i1 * 256;
        FOR_FRAG(ai, bj, m, n) st_bf16x4(o + (size_t)FRAG_ROW(ai, m) * DM + FRAG_COL(bj, n), acc[ai][bj][m][n]);
    }
};
struct PhG3 { PH_COMMON f32x4 lgf, lgb;
    __device__ __forceinline__ bool get(int i, UnitD& u) const {
        const int idx = bid + i * G; if (idx >= 512 + 780) return false;
        const char* xm = (const char*)(ws + B_XM1); const char* w = (const char*)(ws + WS_W1IN);
        if (idx < 512) { const int v = xcd_remap(idx, 512), pm = 1 + (v >> 3), pn = v & 7; eng::unit1(u, xm + (size_t)pm * 256 * 2048, 2048, w + (size_t)pn * 256 * 2048, 2048, 16); u.kind = 0; u.i0 = pm; u.i1 = pn; }
        else { const int j = xcd_remap(idx - 512, 780), ct = j / 12, rt = j % 12; eng::unit1(u, w + (size_t)(1024 + rt * 256) * 2048, 2048, xm + (size_t)ct * 256 * 2048, 2048, 16); u.kind = rt < 4 ? 1 : 2; u.i0 = rt; u.i1 = ct; }
        return true;
    }
    __device__ __forceinline__ void epi(EPI_ARGS) const {
        const float* rc = WSC(const float, WS_ROPEC); const float* rs = WSC(const float, WS_ROPES);
        if (u.kind == 0) {
            bf16_t* o = (u.i1 < 4 ? WSC(bf16_t, B_Q) : WSC(bf16_t, B_K)) + (size_t)(u.i0 * 256) * DM + (u.i1 & 3) * 256;
#pragma unroll
            for (int ai = 0; ai < 2; ++ai)
#pragma unroll
                for (int m = 0; m < 4; ++m) { const int r = FRAG_ROW(ai, m), tl = (u.i0 - 1) * 256 + r;
#pragma unroll
                    for (int bj = 0; bj < 2; ++bj) { const int pos = bj == 0 ? (tl >> 6) : (tl & 63); const f32x4 cv = *(const f32x4*)(rc + pos * 64 + 16 * wc + 4 * fq), sv = *(const f32x4*)(rs + pos * 64 + 16 * wc + 4 * fq);
                        const f32x4 x1 = acc[ai][bj][m][0], x2 = acc[ai][bj][m][1];
                        st_bf16x4(o + (size_t)r * DM + FRAG_COL(bj, 0), x1 * cv - x2 * sv); st_bf16x4(o + (size_t)r * DM + FRAG_COL(bj, 1), x2 * cv + x1 * sv); } }
        } else if (u.kind == 2) { bf16_t* o = WSC(bf16_t, B_VT) + (size_t)((u.i0 - 4) * 256) * TT + u.i1 * 256;
            FOR_FRAG(ai, bj, m, n) st_bf16x4(o + (size_t)FRAG_ROW(ai, m) * TT + FRAG_COL(bj, n), acc[ai][bj][m][n]);
        } else {
            const int h = u.i0; const float lf = SEL4(lgf, h), lb = SEL4(lgb, h);
            bf16_t* of = WSC(bf16_t, B_KF) + (size_t)(h * 256) * TT + u.i1 * 256; bf16_t* ob = WSC(bf16_t, B_KB) + (size_t)(h * 256) * TT + u.i1 * 256;
#pragma unroll
            for (int bj = 0; bj < 2; ++bj)
#pragma unroll
                for (int n = 0; n < 2; ++n) { const int c0 = FRAG_COL(bj, n); f32x4 df, db;
                    if (u.i1 == 0) {
#pragma unroll
                        for (int e = 0; e < 4; ++e) { const int pos = c0 + e; df[e] = __expf(lf * (float)(255 - pos)); db[e] = __expf(lb * (float)pos); }
                    } else {
#pragma unroll
                        for (int e = 0; e < 4; ++e) { const int pos = ((u.i1 - 1) * 256 + c0 + e) & 511; df[e] = __expf(lf * (float)(511 - pos)); db[e] = __expf(lb * (float)pos); }
                    }
#pragma unroll
                    for (int ai = 0; ai < 2; ++ai)
#pragma unroll
                        for (int mp = 0; mp < 2; ++mp) { const int p = 32 * wr + 16 * mp + fr; f32x4 x1 = acc[ai][bj][2 * mp][n], x2 = acc[ai][bj][2 * mp + 1][n];
                            if (u.i1 != 0) { const int tl = (u.i1 - 1) * 256 + c0; f32x4 cv, sv;
                                if (ai == 0) { const float c = rc[(tl >> 6) * 64 + p], s = rs[(tl >> 6) * 64 + p]; cv = (f32x4){c, c, c, c}; sv = (f32x4){s, s, s, s}; }
                                else {
#pragma unroll
                                    for (int e = 0; e < 4; ++e) { cv[e] = rc[((tl + e) & 63) * 64 + p]; sv[e] = rs[((tl + e) & 63) * 64 + p]; } }
                                const f32x4 y1 = x1 * cv - x2 * sv, y2 = x2 * cv + x1 * sv; x1 = y1; x2 = y2; }
                            const size_t o1 = (size_t)FRAG_ROW(ai, 2 * mp) * TT + c0, o2 = (size_t)FRAG_ROW(ai, 2 * mp + 1) * TT + c0;
                            st_bf16x4(of + o1, x1 * df); st_bf16x4(of + o2, x2 * df); st_bf16x4(ob + o1, x1 * db); st_bf16x4(ob + o2, x2 * db); } }
        }
    }
};
__device__ __forceinline__ int chunk_tok0(int c) { return c == 0 ? 0 : 256 + 512 * (c - 1); }
struct PhU { PH_COMMON
    __device__ __forceinline__ bool get(int i, UnitD& u) const {
        const int idx0 = bid + i * G; if (idx0 >= 528) return false;
        const int idx = xcd_remap(idx0, 528), dvt = idx & 1, dir = (idx >> 1) & 1, h = (idx >> 2) & 3, c = idx >> 4; const size_t tk = (size_t)chunk_tok0(c) * 2;
        eng::unit1(u, ws + B_VT + (size_t)(h * 512 + dvt * 256) * TT * 2 + tk, TT * 2, ws + (dir ? B_KB : B_KF) + (size_t)(h * 256) * TT * 2 + tk, TT * 2, c == 0 ? 4 : 8);
        u.i0 = (c * 8 + h * 2 + dir); u.i1 = dvt; return true;
    }
    __device__ __forceinline__ void epi(EPI_ARGS) const {
        bf16_t* o = WSC(bf16_t, B_ST) + (size_t)u.i0 * 131072 + (size_t)(u.i1 * 256) * 256;
        FOR_FRAG(ai, bj, m, n) st_bf16x4(o + (size_t)FRAG_ROW(ai, m) * 256 + FRAG_COL(bj, n), acc[ai][bj][m][n]);
    }
};
struct PhSD { PH_COMMON f32x4 lgf, lgb;
    __device__ __forceinline__ bool get(int i, UnitD& u) const {
        const int idx0 = bid + i * G; if (idx0 >= 512) return false;
        const int idx = xcd_remap(idx0, 512), tj = idx & 1, ti = (idx >> 1) & 1, h = (idx >> 2) & 3, c = 1 + (idx >> 4); const int t0 = chunk_tok0(c);
        eng::unit1(u, ws + B_Q + (size_t)(t0 + 256 * ti) * 2048 + h * 512, 2048, ws + B_K + (size_t)(t0 + 256 * tj) * 2048 + h * 512, 2048, 4);
        u.i0 = t0; u.i1 = h; u.i2 = ti * 2 + tj; return true;
    }
    __device__ __forceinline__ void epi(EPI_ARGS) const {
        const int ti = u.i2 >> 1, tj = u.i2 & 1, h = u.i1; const float lf = SEL4(lgf, h), lb = SEL4(lgb, h);
        bf16_t* o = WSC(bf16_t, B_SD) + (size_t)(u.i0 + 256 * ti) * 2048 + h * 512 + 256 * tj;
        FOR_FRAG(ai, bj, m, n) { const int r = FRAG_ROW(ai, m), c0 = FRAG_COL(bj, n), i = 256 * ti + r; f32x4 v = acc[ai][bj][m][n];
#pragma unroll
            for (int e = 0; e < 4; ++e) { const int d = i - (256 * tj + c0 + e); const float w = d > 0 ? __expf(lf * (float)d) : d < 0 ? __expf(lb * (float)(-d)) : 2.0f; v[e] *= w; }
            st_bf16x4(o + (size_t)r * 2048 + c0, v); }
    }
};
struct PhO { const unsigned char* ws; int G, bid; f32x4 lgf, lgb; static constexpr bool HOOKS = true;
    __device__ __forceinline__ bool get(int i, UnitD& u) const {
        const int idx0 = bid + i * G; if (idx0 >= 512) return false;
        const int idx = xcd_remap(idx0, 512), dvt = idx & 1, h = (idx >> 1) & 3, pm = idx >> 3, c = 1 + (pm >> 1), t0 = CTXN + 256 * pm;
        const char* q = (const char*)(ws + B_Q) + (size_t)t0 * 2048 + h * 512;
        const char* st = (const char*)(ws + B_ST) + ((size_t)(c * 8 + h * 2) * 131072 + (size_t)(dvt * 256) * 256) * 2;
        u.A0 = q; u.B0 = st; u.lda0 = 2048; u.ldb0 = 512; u.n0 = 4;
        u.A1 = q; u.B1 = st + (size_t)131072 * 2; u.lda1 = 2048; u.ldb1 = 512; u.n1 = 4;
        u.A2 = (const char*)(ws + B_SD) + (size_t)t0 * 4096 + h * 1024; u.B2 = (const char*)(ws + B_VT) + (size_t)(h * 512 + dvt * 256) * TT * 2 + (size_t)chunk_tok0(c) * 2; u.lda2 = 4096; u.ldb2 = TT * 2; u.n2 = 8;
        u.kind = 0; u.i0 = pm; u.i1 = h; u.i2 = dvt; return true;
    }
    __device__ __forceinline__ void hook(int tc, Acc& acc, const UnitD& u, int wr, int wc, int fr, int fq) const {
        if (tc != 4 && tc != 8) return;
        const float lf = SEL4(lgf, u.i1), lb = SEL4(lgb, u.i1);
#pragma unroll
        for (int ai = 0; ai < 2; ++ai)
#pragma unroll
            for (int m = 0; m < 4; ++m) { const int i = (u.i0 & 1) * 256 + FRAG_ROW(ai, m);
                const float s = tc == 4 ? __expf(lf * (float)(i + 1) - lb * (float)(512 - i)) : __expf(lb * (float)(512 - i));
#pragma unroll
                for (int bj = 0; bj < 2; ++bj)
#pragma unroll
                    for (int n = 0; n < 2; ++n) acc[ai][bj][m][n] *= s; }
    }
    __device__ __forceinline__ void epi(EPI_ARGS) const {
        const int tl = 256 * u.i0, h = u.i1, dvt = u.i2;
        bf16_t* o = WSC(bf16_t, B_O) + (size_t)(CTXN + tl) * 2048 + h * 512 + dvt * 256; float* ssq = WSC(float, WS_SSQ);
#pragma unroll
        for (int ai = 0; ai < 2; ++ai)
#pragma unroll
            for (int m = 0; m < 4; ++m) { const int r = FRAG_ROW(ai, m); float s = 0.f;
#pragma unroll
                for (int bj = 0; bj < 2; ++bj)
#pragma unroll
                    for (int n = 0; n < 2; ++n) { const f32x4 v = acc[ai][bj][m][n]; s += (v[0] * v[0] + v[1] * v[1]) + (v[2] * v[2] + v[3] * v[3]); st_bf16x4(o + (size_t)r * 2048 + FRAG_COL(bj, n), v); }
                s += __shfl_xor(s, 16); s += __shfl_xor(s, 32);
                if (fq == 0) ssq[((size_t)(tl + r) * 4 + h) * 8 + dvt * 4 + wc] = s; }
    }
};
struct PhGG { PH_COMMON
    __device__ __forceinline__ bool get(int i, UnitD& u) const {
        const int idx0 = bid + i * G; if (idx0 >= 512) return false;
        const int idx = xcd_remap(idx0, 512), pm = 1 + (idx >> 3), pn = idx & 7; eng::unit1(u, ws + B_XM1B + (size_t)pm * 256 * 2048, 2048, ws + WS_W1IN + (size_t)(4096 + pn * 256) * 2048, 2048, 16); u.i0 = pm; u.i1 = pn; return true;
    }
    __device__ __forceinline__ void epi(EPI_ARGS) const {
        bf16_t* o = WSC(bf16_t, B_O) + (size_t)(u.i0 * 256) * 2048 + u.i1 * 256; const float* ssq = WSC(const float, WS_SSQ); const int h = u.i1 >> 1;
#pragma unroll
        for (int ai = 0; ai < 2; ++ai)
#pragma unroll
            for (int m = 0; m < 4; ++m) { const int r = FRAG_ROW(ai, m); const float* sp = ssq + ((size_t)((u.i0 - 1) * 256 + r) * 4 + h) * 8;
                const f32x4 s0 = *(const f32x4*)sp, s1 = *(const f32x4*)(sp + 4); const float rstd = rsqrtf((((s0[0] + s0[1]) + (s0[2] + s0[3])) + ((s1[0] + s1[1]) + (s1[2] + s1[3]))) * (1.0f / 512.0f) + RMS_EPS);
#pragma unroll
                for (int bj = 0; bj < 2; ++bj)
#pragma unroll
                    for (int n = 0; n < 2; ++n) { bf16_t* q = o + (size_t)r * 2048 + FRAG_COL(bj, n); const u32x2 ov = *(const u32x2*)q; const f32x4 g = acc[ai][bj][m][n]; f32x4 v;
                        v[0] = silu_f(g[0]) * (bflo(ov.x) * rstd); v[1] = silu_f(g[1]) * (bfhi(ov.x) * rstd); v[2] = silu_f(g[2]) * (bflo(ov.y) * rstd); v[3] = silu_f(g[3]) * (bfhi(ov.y) * rstd);
                        st_bf16x4(q, v); } }
    }
};
struct PhG4 { PH_COMMON float* out;
    __device__ __forceinline__ bool get(int i, UnitD& u) const {
        const int idx0 = bid + i * G; if (idx0 >= 256) return false;
        const int idx = xcd_remap(idx0, 256), pm = idx >> 2, pn = idx & 3; eng::unit1(u, ws + B_O + (size_t)(CTXN + pm * 256) * 4096, 4096, ws + WS_W1OUT + (size_t)pn * 256 * 4096, 4096, 32); u.i0 = pm; u.i1 = pn; return true;
    }
    __device__ __forceinline__ void epi(EPI_ARGS) const {
        const float* g1 = WSC(const float, WS_MOD) + 6144 + 2048 + u.i1 * 256; float* dst = out + (size_t)(u.i0 * 256) * DM + u.i1 * 256;
        FOR_FRAG(ai, bj, m, n) { float* q = dst + (size_t)FRAG_ROW(ai, m) * DM + FRAG_COL(bj, n); const f32x4 gv = *(const f32x4*)(g1 + FRAG_COL(bj, n)); *(f32x4*)q = *(const f32x4*)q + gv * acc[ai][bj][m][n]; }
    }
};

constexpr int NA_KC = 0, NA_VC = 32768, NA_RPB = 65536;
__device__ __forceinline__ int na_ksw(int tok) { return ((tok >> 1) & 1) | (((tok >> 3) & 3) << 1); }
__device__ __forceinline__ void na_load_ctx(const Frame& F, int h) {
    const bf16_t* qk = WSP(const bf16_t, A_QK0); const bf16_t* vt = WSP(const bf16_t, A_VT0);
#pragma unroll
    for (int i = 0; i < 4; ++i) { const int cid = F.tid + 512 * i, tok = cid >> 3, c = cid & 7;
        *(LAS u32x4*)(F.lds + NA_KC + tok * 128 + ((c ^ na_ksw(tok)) << 4)) = *(const u32x4*)(qk + (size_t)tok * QK0_LD + 768 + h * 64 + c * 8); }
#pragma unroll
    for (int i = 0; i < 4; ++i) { const int cid = F.tid + 512 * i, d = cid >> 5, ch = cid & 31;
        *(LAS u32x4*)(F.lds + NA_VC + d * 512 + ((ch ^ (d & 15)) << 4)) = *(const u32x4*)(vt + (size_t)(h * 64 + d) * TT + ch * 8); }
}
template <bool LOCAL>
__device__ __forceinline__ void na_unit(const Frame& F, int r, int j, int h, int qb) {
    const bf16_t* qk = WSP(const bf16_t, A_QK0); const bf16_t* vt = WSP(const bf16_t, A_VT0); bf16_t* ao = WSP(bf16_t, A_AO);
    const LAS float* rpb_l = (const LAS float*)(F.lds + NA_RPB);
    const int lane = F.lane, q16 = lane & 15, g = lane >> 4;
    const int tq = LOCAL ? CTXN + r * GW + 16 * j + q16 : 16 * qb + q16;
    bf16x8 qf[2];
#pragma unroll
    for (int ks = 0; ks < 2; ++ks) qf[ks] = *(const bf16x8*)(qk + (size_t)tq * QK0_LD + h * 64 + 32 * ks + 8 * g);
    constexpr int NT = LOCAL ? 32 : 16, NL = LOCAL ? 16 : 0;
    f32x4 s[NT];
    const int rs = LOCAL ? min(max(r - 4, 0), 248) : 0, kst = LOCAL ? min(max(16 * j - 8, 0), 32) : 0;
    const int krow = 8 * (q16 >> 2) + (q16 & 3);
#pragma unroll
    for (int t = 0; t < NT; ++t) {
        bf16x8 k0, k1;
        if (t < NL) { const int tok = CTXN + (rs + (t >> 1)) * GW + kst + krow + 4 * (t & 1); const bf16_t* kp = qk + (size_t)tok * QK0_LD + 768 + h * 64 + 8 * g; k0 = *(const bf16x8*)kp; k1 = *(const bf16x8*)(kp + 32); }
        else { const int tok = 32 * ((t - NL) >> 1) + krow + 4 * (t & 1), sw = na_ksw(tok); const LAS unsigned char* kp = F.lds + NA_KC + tok * 128;
            k0 = *(const LAS bf16x8*)(kp + ((g ^ sw) << 4)); k1 = *(const LAS bf16x8*)(kp + (((4 + g) ^ sw) << 4)); }
        f32x4 a = {0.f, 0.f, 0.f, 0.f};
        a = __builtin_amdgcn_mfma_f32_16x16x32_bf16(k0, qf[0], a, 0, 0, 0); a = __builtin_amdgcn_mfma_f32_16x16x32_bf16(k1, qf[1], a, 0, 0, 0);
        s[t] = a;
    }
    float mx = -1e30f;
    if (LOCAL) { const int qc = 16 * j + q16, wst = min(max(qc - 8, 0), 48);
#pragma unroll
        for (int t = 0; t < NL; ++t) { const int dr = rs + (t >> 1) - r + 7;
#pragma unroll
            for (int e = 0; e < 4; ++e) { const int kc = kst + 8 * g + 4 * (t & 1) + e; const bool ok = kc >= wst && kc < wst + 16; const int dc = min(max(kc - qc + 15, 0), 30);
                const float v = ok ? s[t][e] * 0.125f + rpb_l[(h * 15 + dr) * 31 + dc] : -1e30f; s[t][e] = v; mx = fmaxf(mx, v); } } }
#pragma unroll
    for (int t = NL; t < NT; ++t)
#pragma unroll
        for (int e = 0; e < 4; ++e) { const float v = s[t][e] * 0.125f; s[t][e] = v; mx = fmaxf(mx, v); }
    mx = fmaxf(mx, __shfl_xor(mx, 16)); mx = fmaxf(mx, __shfl_xor(mx, 32));
    float sum = 0.f;
#pragma unroll
    for (int t = 0; t < NT; ++t)
#pragma unroll
        for (int e = 0; e < 4; ++e) { const float p = __expf(s[t][e] - mx); s[t][e] = p; sum += p; }
    sum += __shfl_xor(sum, 16); sum += __shfl_xor(sum, 32);
    f32x4 o[4];
#pragma unroll
    for (int dt = 0; dt < 4; ++dt) o[dt] = (f32x4){0.f, 0.f, 0.f, 0.f};
#pragma unroll
    for (int b = 0; b < NT / 2; ++b) {
        u32x4 pw; pw.x = cvt_pk_bf16(s[2 * b][0], s[2 * b][1]); pw.y = cvt_pk_bf16(s[2 * b][2], s[2 * b][3]); pw.z = cvt_pk_bf16(s[2 * b + 1][0], s[2 * b + 1][1]); pw.w = cvt_pk_bf16(s[2 * b + 1][2], s[2 * b + 1][3]);
        const bf16x8 pf = __builtin_bit_cast(bf16x8, pw);
#pragma unroll
        for (int dt = 0; dt < 4; ++dt) { bf16x8 vf;
            if (b < NL / 2) vf = *(const bf16x8*)(vt + (size_t)(h * 64 + 16 * dt + q16) * TT + CTXN + (rs + b) * GW + kst + 8 * g);
            else vf = *(const LAS bf16x8*)(F.lds + NA_VC + (16 * dt + q16) * 512 + (((4 * (b - NL / 2) + g) ^ q16) << 4));
            o[dt] = __builtin_amdgcn_mfma_f32_16x16x32_bf16(vf, pf, o[dt], 0, 0, 0); }
    }
    const float inv = 1.0f / sum;
#pragma unroll
    for (int dt = 0; dt < 4; ++dt) st_bf16x4(ao + (size_t)tq * DM + 256 + h * 64 + 16 * dt + 4 * g, o[dt] * inv);
}
__device__ __forceinline__ void p_attention(const Frame& F) {
    LAS float* rpb_l = (LAS float*)(F.lds + NA_RPB);
    for (int i = F.tid; i < 12 * 15 * 31; i += 512) rpb_l[i] = F.p.rpb[i];
    int cur_h = -1;
    for (int pi = 0; pi < 6; ++pi) {
        const int U0 = 12 * F.bid + 2 * pi; if (U0 >= 3072) break;
        const int h = U0 >> 8;
        if (h != cur_h) { __syncthreads(); na_load_ctx(F, h); __syncthreads(); cur_h = h; }
        const int U = U0 + (F.wid >> 2);
        na_unit<true>(F, U & 255, F.wid & 3, h, 0);
        if ((U0 & 255) == 0) { na_unit<false>(F, 0, 0, h, F.wid); na_unit<false>(F, 0, 0, h, F.wid + 8); }
    }
    __syncthreads();
}
constexpr int LDS_BYTES = eng::STAGE_BYTES + 1024;
#ifndef MK_PER_PHASE
#define MK_PER_PHASE 0
#endif

__global__ __launch_bounds__(512, 2) void mk_fwd(Params p) {
    extern __shared__ __attribute__((aligned(16))) unsigned char shm[];
    Frame F; F.p = p; F.lds = (LAS unsigned char*)shm; F.tid = threadIdx.x; F.lane = F.tid & 63; F.wid = __builtin_amdgcn_readfirstlane(F.tid >> 6); F.G = gridDim.x; F.bid = blockIdx.x;
    volatile LAS unsigned* xb = (volatile LAS unsigned*)(F.lds + eng::STAGE_BYTES);
    if (F.tid < 4) xb[F.tid] = 0u;
    __syncthreads();
    const int lo = p.ph_lo, hi = p.ph_hi;
    XcdBarrier bar; bar.bar = (unsigned*)(p.ws + WS_CTL); bar.x = 0; bar.st = xb;
    if (hi - lo > 1) bar = xcd_barrier_post((unsigned*)(p.ws + WS_CTL), xb);
#ifndef PHMASK
#define PHMASK 0xFFFFFFu
#endif
#define IN(k) (((PHMASK >> (k)) & 1u) && lo <= (k) && (k) < hi)
#ifndef PROBE_MASK
#define PROBE_MASK 0u
#endif
#ifndef PROBE_MULT
#define PROBE_MULT 1
#endif
    unsigned long long pr_acc = 0, pr_prev = PROBE_MASK ? wall_clock64() : 0ull;
#define SEAM(k) do { if (IN(k) && IN((k) + 1)) xcd_barrier(bar); if (PROBE_MASK) { const unsigned long long _n = wall_clock64(); if ((PROBE_MASK >> (k)) & 1u) pr_acc += _n - pr_prev; pr_prev = _n; } } while (0)
    const unsigned char* ws = p.ws;

    if (IN(0)) { p0_prologue(F); } SEAM(0);
    if (IN(1)) { p_norm_in(F); } SEAM(1);
    if (IN(2)) { PhG1 ph{ws, F.G, F.bid}; eng::gemm_run(F.lds, ph); } SEAM(2);
    if (IN(3)) { PhF1 ph{ws, F.G, F.bid}; eng::gemm_run(F.lds, ph); p_attention(F); } SEAM(3);
    if (IN(4)) { PhF2 ph{ws, F.G, F.bid, p.ctx}; eng::gemm_run(F.lds, ph); } SEAM(4);
    if (IN(5)) { PhG2 ph{ws, F.G, F.bid, p.x, p.out}; eng::gemm_run(F.lds, ph); } SEAM(5);
    if (IN(6)) { p_router(F, 0, 0, WSP(bf16_t, A_XM)); } SEAM(6);
    if (IN(7)) { p_gather(F, 0, 0, WSP(const bf16_t, A_XM), WSP(bf16_t, A_XS)); } SEAM(7);
    if (IN(8)) { PhM1 ph{ws, F.G, F.bid}; panel_tab(F, 0, ph.pt); ph.xs = A_XS; ph.hd = A_HD; eng::gemm_run(F.lds, ph); } SEAM(8);
    if (IN(9)) { PhM2 ph{ws, F.G, F.bid}; panel_tab(F, 0, ph.pt); ph.hd = A_HD; ph.y = A_XS; eng::gemm_run(F.lds, ph); } SEAM(9);
    if (IN(10)) { p_combine0(F); } SEAM(10);
    if (IN(11)) { PhG3 ph{ws, F.G, F.bid};
        ph.lgf = (f32x4){log_gamma(F, 0, 0), log_gamma(F, 0, 1), log_gamma(F, 0, 2), log_gamma(F, 0, 3)}; ph.lgb = (f32x4){log_gamma(F, 1, 0), log_gamma(F, 1, 1), log_gamma(F, 1, 2), log_gamma(F, 1, 3)};
        eng::gemm_run(F.lds, ph); } SEAM(11);
    if (IN(12)) { PhU ph{ws, F.G, F.bid}; eng::gemm_run(F.lds, ph); } SEAM(12);
    if (IN(13)) { p_scan(F); } SEAM(13);
    if (IN(14)) { PhSD ph{ws, F.G, F.bid};
        ph.lgf = (f32x4){log_gamma(F, 0, 0), log_gamma(F, 0, 1), log_gamma(F, 0, 2), log_gamma(F, 0, 3)}; ph.lgb = (f32x4){log_gamma(F, 1, 0), log_gamma(F, 1, 1), log_gamma(F, 1, 2), log_gamma(F, 1, 3)};
        eng::gemm_run(F.lds, ph); } SEAM(14);
    if (IN(15)) { PhO ph{ws, F.G, F.bid};
        ph.lgf = (f32x4){log_gamma(F, 0, 0), log_gamma(F, 0, 1), log_gamma(F, 0, 2), log_gamma(F, 0, 3)}; ph.lgb = (f32x4){log_gamma(F, 1, 0), log_gamma(F, 1, 1), log_gamma(F, 1, 2), log_gamma(F, 1, 3)};
        eng::gemm_run(F.lds, ph); } SEAM(15);
    if (IN(16)) { p_norm_l1(F, WSP(bf16_t, B_XM1B)); conv_moe(F, 1); } SEAM(16);
    if (IN(17)) { PhGG ph{ws, F.G, F.bid}; eng::gemm_run(F.lds, ph); } SEAM(17);
    if (IN(18)) { PhG4 ph{ws, F.G, F.bid, p.out}; eng::gemm_run(F.lds, ph); } SEAM(18);
    if (IN(19)) { p_router(F, 1, CTXN, WSP(bf16_t, B_XM2)); } SEAM(19);
    if (IN(20)) { p_gather(F, 1, CTXN, WSP(const bf16_t, B_XM2), WSP(bf16_t, B_XS)); } SEAM(20);
    if (IN(21)) { PhM1 ph{ws, F.G, F.bid}; panel_tab(F, 1, ph.pt); ph.xs = B_XS; ph.hd = B_HD; eng::gemm_run(F.lds, ph); } SEAM(21);
    if (IN(22)) { PhM2 ph{ws, F.G, F.bid}; panel_tab(F, 1, ph.pt); ph.hd = B_HD; ph.y = B_XS; eng::gemm_run(F.lds, ph); } SEAM(22);
    if (IN(23)) { p_final(F); }
    if (PROBE_MASK) { SEAM(23); if (F.bid == 0) { const unsigned long long t0 = wall_clock64(); while (wall_clock64() - t0 < pr_acc * PROBE_MULT) __builtin_amdgcn_s_sleep(8); } }
#undef IN
#undef SEAM
}

extern "C" void kernel_launch(void* const* d_in, const int* in_sizes, int n_in, void* d_out, int out_size, void* d_ws, size_t ws_size, hipStream_t stream) {
    static int grid = 0;
    if (grid == 0) {
        if (n_in != 19 || out_size != SEQ * DM || ws_size < WS_END) { fprintf(stderr, "kernel_launch: unexpected shapes (n_in %d, out %d, ws %zu < %zu)\n", n_in, out_size, ws_size, (size_t)WS_END); grid = -1; return; }
        int dev = 0, cus = 0, per_cu = 0;
        if (hipGetDevice(&dev) != hipSuccess || hipDeviceGetAttribute(&cus, hipDeviceAttributeMultiprocessorCount, dev) != hipSuccess) { grid = -1; return; }
        if (hipFuncSetAttribute((const void*)mk_fwd, hipFuncAttributeMaxDynamicSharedMemorySize, LDS_BYTES) != hipSuccess) { fprintf(stderr, "kernel_launch: hipFuncSetAttribute failed\n"); grid = -1; return; }
        if (hipOccupancyMaxActiveBlocksPerMultiprocessor(&per_cu, (const void*)mk_fwd, 512, LDS_BYTES) != hipSuccess || per_cu < 1) { fprintf(stderr, "kernel_launch: occupancy query says %d\n", per_cu); per_cu = 1; }
        (void)hipGetLastError();
        grid = cus;
        if (grid > 256) grid = 256;
    }
    if (grid < 0) return;
    (void)hipMemsetAsync((char*)d_ws + WS_CTL, 0, CTL_BYTES, stream);
    Params p{};
    const float** pp = (const float**)&p;
    for (int i = 0; i < 19; ++i) pp[i] = (const float*)d_in[i];
    p.out = (float*)d_out; p.ws = (unsigned char*)d_ws;
#if MK_PER_PHASE
    for (int ph = 0; ph < NPHASE; ++ph) { p.ph_lo = ph; p.ph_hi = ph + 1; hipLaunchKernelGGL(mk_fwd, dim3(grid), dim3(512), LDS_BYTES, stream, p); }
#else
    p.ph_lo = 0; p.ph_hi = NPHASE; hipLaunchKernelGGL(mk_fwd, dim3(grid), dim3(512), LDS_BYTES, stream, p);
#endif
}
```

```cpp
#include <hip/hip_runtime.h>
#include <cstdio>
#include <cstdint>

typedef unsigned short bf16_t;
typedef short bf16x8 __attribute__((ext_vector_type(8)));
typedef float f32x4 __attribute__((ext_vector_type(4)));
typedef float f32x2 __attribute__((ext_vector_type(2)));
typedef unsigned u32x2 __attribute__((ext_vector_type(2)));
typedef unsigned u32x4 __attribute__((ext_vector_type(4)));
#define LAS __attribute__((address_space(3)))

constexpr int DM = 1024, SEQ = 16384, CTXN = 256, TT = SEQ + CTXN  , GW = 64;
constexpr int NH0 = 12, QK0_LD = 1536, W0IN_ROWS = 2816;
constexpr int NPMAX = 146;
constexpr float RMS_EPS = 1e-6f;
constexpr int NPHASE = 24;

constexpr size_t KiB = 1024, MiB = 1024 * 1024, HMiB = 512 * 1024;
constexpr size_t WS_CTL = 0;
constexpr size_t CTL_BYTES = 64 * KiB;
constexpr size_t CTL_CNT = 16 * KiB;
constexpr size_t CTL_QUEUE = 20 * KiB;
constexpr size_t WS_MOD = 64 * KiB;
constexpr size_t WS_TWC = 256 * KiB, WS_TWS = 320 * KiB;
constexpr size_t WS_ROPEC = 384 * KiB, WS_ROPES = 448 * KiB;
constexpr size_t WS_F1T = 512 * KiB, WS_F2P = 640 * KiB;
constexpr size_t WS_CS256 = 768 * KiB;
constexpr size_t WS_HC = 1 * MiB;
constexpr size_t WS_EID = 2 * MiB;
constexpr size_t WS_GW = 2 * MiB + 256 * KiB;
constexpr size_t WS_SLOT = 2 * MiB + 512 * KiB;
constexpr size_t WS_SSQ = 3 * MiB;
constexpr size_t WS_XTC = 5 * MiB;
constexpr size_t WS_PERM = 6 * MiB;
constexpr size_t WS_W0IN = 8 * MiB, WS_W0OUT = 14 * MiB, WS_W1IN = 16 * MiB, WS_W1OUT = 28 * MiB;
constexpr size_t AR = 32 * MiB;
constexpr size_t A_XM = AR + 0, A_QK0 = AR + 65 * HMiB, A_VT0 = AR + 81 * MiB + 256 * KiB, A_XT2 = AR + 106 * MiB, A_T2 = AR + 122 * MiB + HMiB, A_AO = AR + 139 * MiB;
constexpr size_t A_XS = AR + 65 * HMiB, A_HD = AR + 106 * MiB, A_MOEW = AR + 245 * MiB;
constexpr size_t B_Q = AR + 0, B_K = AR + 65 * HMiB, B_O = AR + 65 * HMiB, B_KF = AR + 195 * HMiB, B_KB = AR + 130 * MiB, B_SD = AR + 195 * HMiB, B_VT = AR + 325 * HMiB;
constexpr size_t B_XM1 = AR + 455 * HMiB, B_ST = AR + 455 * HMiB, B_XM1B = AR + 0, B_XM2 = AR + 0, B_XS = AR + 195 * HMiB, B_HD = AR + 341 * HMiB;
constexpr size_t B_XM1A = AR + 587 * HMiB;
constexpr size_t WS_END = AR + 319 * MiB;

struct Params {
    const float *x, *c, *ctx, *c_ctx, *ada_w, *ada_b, *norm_g, *final_g, *w0in, *w0out, *rpb, *w1in, *w1out, *decay, *router_w, *router_b, *moe_w1, *moe_w3, *moe_w2;
    float* out; unsigned char* ws; int ph_lo, ph_hi;
};

__device__ __forceinline__ unsigned cvt_pk_bf16(float lo, float hi) { unsigned r; asm volatile("v_cvt_pk_bf16_f32 %0, %1, %2" : "=v"(r) : "v"(lo), "v"(hi)); return r; }
__device__ __forceinline__ bf16_t f2bf(float f) { return (bf16_t)(cvt_pk_bf16(f, 0.f) & 0xffffu); }
__device__ __forceinline__ float bf2f(unsigned short b) { return __uint_as_float(((unsigned)b) << 16); }
__device__ __forceinline__ float bflo(unsigned w) { return __uint_as_float(w << 16); }
__device__ __forceinline__ float bfhi(unsigned w) { return __uint_as_float(w & 0xffff0000u); }
__device__ __forceinline__ float silu_f(float v) { return v / (1.0f + __expf(-v)); }
__device__ __forceinline__ float wave_sum(float v) {
#pragma unroll
    for (int o = 32; o >= 1; o >>= 1) v += __shfl_xor(v, o);
    return v;
}
__device__ __forceinline__ float wave_max(float v) {
#pragma unroll
    for (int o = 32; o >= 1; o >>= 1) v = fmaxf(v, __shfl_xor(v, o));
    return v;
}
#define XB_TMO      128
#define XB_XCNT(j)  (256  + 64 * (j))
#define XB_XSUB(j)  (1280 + 64 * (j))
#define XB_XGEN(j)  (2304 + 64 * (j))
#define XB_TOP      3328
#define XB_TOPGEN   3392
#define XCD_BAR_WORDS 3456
#define XB_SPIN_CAP (1u << 18)

__device__ __forceinline__ unsigned xb_ld(unsigned* p)              { return __hip_atomic_load(p, __ATOMIC_RELAXED, __HIP_MEMORY_SCOPE_AGENT); }
__device__ __forceinline__ unsigned xb_add(unsigned* p, unsigned v) { return __hip_atomic_fetch_add(p, v, __ATOMIC_RELAXED, __HIP_MEMORY_SCOPE_AGENT); }
__device__ __forceinline__ unsigned xb_xcc_id() { return (unsigned)__builtin_amdgcn_s_getreg((3 << 11) | 20) & 0xFu; }
#define XB_SPIN(cond, bar) do { unsigned _sp = 0; while (cond) { __builtin_amdgcn_s_sleep(1); \
    if ((++_sp & 255u) == 0u) { if (xb_ld(&(bar)[XB_TMO])) break; if (_sp > XB_SPIN_CAP) { atomicAdd(&(bar)[XB_TMO], 1u); break; } } } } while (0)

struct XcdBarrier {
    unsigned* bar; unsigned x;
    volatile LAS unsigned* st;
};

__device__ __forceinline__ XcdBarrier xcd_barrier_post(unsigned* bar, volatile LAS unsigned* st) {
    XcdBarrier b; b.bar = bar; b.x = xb_xcc_id(); b.st = st;
    if (threadIdx.x == 0) (void)xb_add(&bar[XB_XCNT(b.x)], 1u);
    return b;
}
__device__ __forceinline__ void xcd_barrier_complete(unsigned* bar, unsigned x, unsigned& nloc, unsigned& nx) {
    const unsigned G = gridDim.x * gridDim.y * gridDim.z;
    unsigned sum, cnt, mine, sp = 0u;
    for (;;) {
        sum = 0u; cnt = 0u; mine = 0u;
#pragma unroll
        for (unsigned j = 0; j < 16; ++j) { const unsigned c = xb_ld(&bar[XB_XCNT(j)]); sum += c; cnt += (c > 0u) ? 1u : 0u; mine = (j == x) ? c : mine; }
        if (sum == G) break;
        __builtin_amdgcn_s_sleep(1);
        if ((++sp & 255u) == 0u) { if (xb_ld(&bar[XB_TMO])) break; if (sp > XB_SPIN_CAP) { atomicAdd(&bar[XB_TMO], 1u); break; } }
    }
    nloc = mine > 0u ? mine : 1u; nx = cnt > 0u ? cnt : 1u;
}

__device__ __forceinline__ void xcd_barrier(const XcdBarrier& b) {
    asm volatile("s_waitcnt vmcnt(0)" ::: "memory");
    __syncthreads();
    if (threadIdx.x == 0) {
        unsigned* bar = b.bar;
        __builtin_amdgcn_s_waitcnt(0);
        unsigned nloc = b.st[0], nx = b.st[1];
        if (nloc == 0u) { xcd_barrier_complete(bar, b.x, nloc, nx); b.st[0] = nloc; b.st[1] = nx; }
        const unsigned old = xb_add(&bar[XB_XSUB(b.x)], 1u);
        const unsigned gen = old / nloc;
        if (old + 1u == (gen + 1u) * nloc) {
            __builtin_amdgcn_fence(__ATOMIC_RELEASE, "agent");
            asm volatile("s_waitcnt vmcnt(0)" ::: "memory");
            const unsigned og = xb_add(&bar[XB_TOP], 1u);
            const unsigned tg = og / nx;
            if (og + 1u == (tg + 1u) * nx) xb_add(&bar[XB_TOPGEN], 1u);
            else XB_SPIN(xb_ld(&bar[XB_TOPGEN]) == tg, bar);
            __builtin_amdgcn_fence(__ATOMIC_ACQUIRE, "agent");
            xb_add(&bar[XB_XGEN(b.x)], 1u);
            asm volatile("s_waitcnt vmcnt(0)" ::: "memory");
        } else {
            XB_SPIN(xb_ld(&bar[XB_XGEN(b.x)]) == gen, bar);
            __builtin_amdgcn_fence(__ATOMIC_ACQUIRE, "agent");
            asm volatile("s_waitcnt vmcnt(0)" ::: "memory");
        }
    }
    __syncthreads();
}
namespace eng {
constexpr int BM = 256, BK = 64, HALF = 128, HTB = HALF * BK * 2, STAGE_BYTES = 8 * HTB;
__device__ __forceinline__ int lds_byte(int r, int c) { const int st = (r >> 4) * 2 + (c >> 5), rr = r & 15, cc = c & 31, ob = rr * 64 + cc * 2; return st * 1024 + (ob ^ (((ob >> 9) & 1) << 5)); }
__device__ __forceinline__ void stage_rc(int b, int& R, int& C) { const int st = b / 1024, sb = b % 1024, swz = sb ^ (((sb >> 9) & 1) << 5); R = (st >> 1) * 16 + swz / 64; C = (st & 1) * 32 + (swz % 64) / 2; }

struct UnitD {
    const char* A0; const char* B0; unsigned lda0, ldb0; int n0;
    const char* A1; const char* B1; unsigned lda1, ldb1; int n1;
    const char* A2; const char* B2; unsigned lda2, ldb2; int n2;
    int kind, i0, i1, i2;
};
struct TD { const char* a; const char* b; unsigned lda, ldb; int gpar; };
__device__ __forceinline__ TD tile_at(const UnitD& u, int t) {
    TD d;
    if (t < u.n0) { d.a = u.A0 + (size_t)t * 128; d.b = u.B0 + (size_t)t * 128; d.lda = u.lda0; d.ldb = u.ldb0; }
    else if (t < u.n0 + u.n1) { const int s = t - u.n0; d.a = u.A1 + (size_t)s * 128; d.b = u.B1 + (size_t)s * 128; d.lda = u.lda1; d.ldb = u.ldb1; }
    else { const int s = t - u.n0 - u.n1; d.a = u.A2 + (size_t)s * 128; d.b = u.B2 + (size_t)s * 128; d.lda = u.lda2; d.ldb = u.ldb2; }
    return d;
}
typedef f32x4 Acc[2][2][4][2];

template <class P>
__device__ __forceinline__ void gemm_run(LAS unsigned char* lds, const P& ph) {
    const int tid = threadIdx.x, wid = __builtin_amdgcn_readfirstlane(tid >> 6), lane = tid & 63, wr = wid >> 2, wc = wid & 3, fr = lane & 15, fq = lane >> 4;
    int R0, C0; stage_rc(tid * 16, R0, C0);
    const unsigned vR = (unsigned)R0, vC2 = (unsigned)C0 * 2u;
    const unsigned ldsw = (unsigned)wid * 1024u;
    const int aoff = lds_byte(wr * 64 + fr, fq * 8), boff = lds_byte(wc * 32 + fr, fq * 8);
#define EG_SA(b, h) (((b) * 2 + (h)) * HTB)
#define EG_SB(b, h) ((4 + (b) * 2 + (h)) * HTB)
#define EG_STAGE(bufoff, gbase, ld) do { const unsigned _ld = (ld); const char* _g = (gbase) + (size_t)(vR * _ld + vC2); \
        __builtin_amdgcn_global_load_lds((const unsigned*)_g, (LAS unsigned*)(lds + (bufoff) + ldsw), 16, 0, 0); \
        __builtin_amdgcn_global_load_lds((const unsigned*)(_g + (size_t)(64u * _ld)), (LAS unsigned*)(lds + (bufoff) + ldsw + 8192), 16, 0, 0); } while (0)
#define EG_STAGEA(bufoff, d, h) do { if constexpr (P::GATHER) { const char* _g = (d).a + vC2; const unsigned _o0 = (d).gpar ? gB[(h) * 2] : gA[(h) * 2], _o1 = (d).gpar ? gB[(h) * 2 + 1] : gA[(h) * 2 + 1]; \
        __builtin_amdgcn_global_load_lds((const unsigned*)(_g + _o0), (LAS unsigned*)(lds + (bufoff) + ldsw), 16, 0, 0); \
        __builtin_amdgcn_global_load_lds((const unsigned*)(_g + _o1), (LAS unsigned*)(lds + (bufoff) + ldsw + 8192), 16, 0, 0); } \
        else EG_STAGE(bufoff, (d).a + (size_t)((h) * 128u * (d).lda), (d).lda); } while (0)
#define EG_LDA(dst, b, h) do { _Pragma("unroll") for (int m = 0; m < 4; ++m) _Pragma("unroll") for (int k = 0; k < 2; ++k) dst[m][k] = *(const LAS bf16x8*)(lds + EG_SA(b, h) + aoff + m * 2048 + k * 1024); } while (0)
#define EG_LDB(dst, b, h) do { _Pragma("unroll") for (int n = 0; n < 2; ++n) _Pragma("unroll") for (int k = 0; k < 2; ++k) dst[n][k] = *(const LAS bf16x8*)(lds + EG_SB(b, h) + boff + n * 2048 + k * 1024); } while (0)
#define EG_MMA(ai, bj, At, Bt) do { __builtin_amdgcn_s_setprio(1); _Pragma("unroll") for (int m = 0; m < 4; ++m) _Pragma("unroll") for (int n = 0; n < 2; ++n) _Pragma("unroll") for (int k = 0; k < 2; ++k) \
        acc[ai][bj][m][n] = __builtin_amdgcn_mfma_f32_16x16x32_bf16(Bt[n][k], At[m][k], acc[ai][bj][m][n], 0, 0, 0); __builtin_amdgcn_s_setprio(0); } while (0)
#define EG_WAIT_V(n) asm volatile("s_waitcnt vmcnt(" #n ")" ::: "memory")
#define EG_WAIT_L(n) asm volatile("s_waitcnt lgkmcnt(" #n ")" ::: "memory")
#define EG_BAR __builtin_amdgcn_s_barrier()
#define EG_SCHED __builtin_amdgcn_sched_barrier(0)
    UnitD cur; int ui = 0;
    if (!ph.get(0, cur)) return;
    UnitD cu = cur; int cui = 0, ct = 0; bool cvalid = true; TD lastTD = tile_at(cur, 0); lastTD.gpar = 0;
    unsigned gA[4] = {0u, 0u, 0u, 0u}, gB[4] = {0u, 0u, 0u, 0u};
    const LAS unsigned* rowtab = (const LAS unsigned*)(lds + STAGE_BYTES + 1024);
#define EG_GLOAD(ord) do { if constexpr (P::GATHER) { if ((ord) & 1) { _Pragma("unroll") for (int _k = 0; _k < 4; ++_k) gB[_k] = rowtab[(ord) * 256 + (_k >> 1) * 128 + (_k & 1) * 64 + vR]; } \
        else { _Pragma("unroll") for (int _k = 0; _k < 4; ++_k) gA[_k] = rowtab[(ord) * 256 + (_k >> 1) * 128 + (_k & 1) * 64 + vR]; } } } while (0)
    EG_GLOAD(0);
#define EG_NEXT(dst) do { if (cvalid) { dst = tile_at(cu, ct); dst.gpar = cui & 1; lastTD = dst; ++ct; if (ct == cu.n0 + cu.n1 + cu.n2) { ++cui; ct = 0; cvalid = ph.get(cui, cu); if (cvalid) EG_GLOAD(cui); } } else dst = lastTD; } while (0)
    Acc acc;
#pragma unroll
    for (int a = 0; a < 2; ++a)
#pragma unroll
        for (int b = 0; b < 2; ++b)
#pragma unroll
            for (int m = 0; m < 4; ++m)
#pragma unroll
                for (int n = 0; n < 2; ++n) acc[a][b][m][n] = (f32x4){0.f, 0.f, 0.f, 0.f};
    bf16x8 At[4][2], B0[2][2], B1[2][2];
    TD d1, d2, d3;
    { TD d0; EG_NEXT(d0); EG_NEXT(d1);
      EG_STAGE(EG_SB(0, 0), d0.b, d0.ldb); EG_STAGEA(EG_SA(0, 0), d0, 0); EG_STAGE(EG_SB(0, 1), d0.b + (size_t)(128u * d0.ldb), d0.ldb); EG_STAGEA(EG_SA(0, 1), d0, 1); }
    if (wr == 1) EG_BAR;
    EG_WAIT_V(4); EG_BAR;
    EG_STAGE(EG_SB(1, 0), d1.b, d1.ldb); EG_STAGEA(EG_SA(1, 0), d1, 0); EG_STAGE(EG_SB(1, 1), d1.b + (size_t)(128u * d1.ldb), d1.ldb);
    EG_WAIT_V(6); EG_BAR;
    int tc = 0;
    for (;;) {
        EG_NEXT(d2); EG_NEXT(d3);
        if constexpr (P::HOOKS) { int fr_o = fr; asm volatile("" : "+v"(fr_o)); ph.hook(tc, acc, cur, wr, wc, fr_o, fq); }
        EG_LDB(B0, 0, 0); EG_SCHED; EG_LDA(At, 0, 0); EG_STAGEA(EG_SA(1, 1), d1, 1);
        EG_WAIT_L(8); EG_BAR; EG_WAIT_L(0); EG_MMA(0, 0, At, B0); EG_BAR; EG_SCHED;
        EG_LDB(B1, 0, 1); EG_STAGE(EG_SB(0, 0), d2.b, d2.ldb);
        EG_BAR; EG_WAIT_L(0); EG_MMA(0, 1, At, B1); EG_BAR;
        EG_LDA(At, 0, 1); EG_STAGEA(EG_SA(0, 0), d2, 0);
        EG_BAR; EG_WAIT_L(0); EG_MMA(1, 0, At, B0); EG_BAR; EG_SCHED;
        EG_STAGE(EG_SB(0, 1), d2.b + (size_t)(128u * d2.ldb), d2.ldb);
        EG_WAIT_V(6); EG_BAR; EG_MMA(1, 1, At, B1); EG_BAR;
        EG_LDB(B0, 1, 0); EG_SCHED; EG_LDA(At, 1, 0); EG_STAGEA(EG_SA(0, 1), d2, 1);
        EG_WAIT_L(8); EG_BAR; EG_WAIT_L(0); EG_MMA(0, 0, At, B0); EG_BAR; EG_SCHED;
        EG_LDB(B1, 1, 1); EG_STAGE(EG_SB(1, 0), d3.b, d3.ldb);
        EG_BAR; EG_WAIT_L(0); EG_MMA(0, 1, At, B1); EG_BAR;
        EG_LDA(At, 1, 1); EG_STAGEA(EG_SA(1, 0), d3, 0);
        EG_BAR; EG_WAIT_L(0); EG_MMA(1, 0, At, B0); EG_BAR; EG_SCHED;
        EG_STAGE(EG_SB(1, 1), d3.b + (size_t)(128u * d3.ldb), d3.ldb);
        EG_WAIT_V(6); EG_BAR; EG_MMA(1, 1, At, B1); EG_BAR;
        d1 = d3; tc += 2;
        if (tc == cur.n0 + cur.n1 + cur.n2) {
            { int fr_o = fr, fq_o = fq; asm volatile("" : "+v"(fr_o), "+v"(fq_o));
              ph.epi(acc, cur, wr, wc, fr_o, fq_o); }
            ++ui; tc = 0;
            if (!ph.get(ui, cur)) break;
#pragma unroll
            for (int a = 0; a < 2; ++a)
#pragma unroll
                for (int b = 0; b < 2; ++b)
#pragma unroll
                    for (int m = 0; m < 4; ++m)
#pragma unroll
                        for (int n = 0; n < 2; ++n) acc[a][b][m][n] = (f32x4){0.f, 0.f, 0.f, 0.f};
        }
    }
    EG_WAIT_V(0);
    if (wr == 0) EG_BAR;
    EG_BAR;
#undef EG_NEXT
#undef EG_GLOAD
}
__device__ __forceinline__ void unit1(UnitD& u, const void* A, unsigned lda, const void* B, unsigned ldb, int nt) {
    u.A0 = (const char*)A; u.B0 = (const char*)B; u.lda0 = lda; u.ldb0 = ldb; u.n0 = nt;
    u.A1 = u.A0; u.B1 = u.B0; u.lda1 = lda; u.ldb1 = ldb; u.n1 = 0; u.A2 = u.A0; u.B2 = u.B0; u.lda2 = lda; u.ldb2 = ldb; u.n2 = 0;
    u.kind = 0; u.i0 = 0; u.i1 = 0; u.i2 = 0;
}
}
using eng::UnitD; using eng::Acc;
__device__ __forceinline__ int xcd_remap(int idx, int N) { const int q = N >> 3, r = N & 7, x = idx & 7, off = idx >> 3; return (x < r ? x * (q + 1) : r * (q + 1) + (x - r) * q) + off; }
__device__ __forceinline__ void efence() { asm volatile("" ::: "memory"); }
#define EPI_ARGS const Acc& acc, const UnitD& u, int wr, int wc, int fr, int fq
#define FOR_FRAG(ai, bj, m, n) _Pragma("unroll") for (int ai = 0; ai < 2; ++ai) _Pragma("unroll") for (int m = 0; m < 4; ++m) _Pragma("unroll") for (int bj = 0; bj < 2; efence(), ++bj) _Pragma("unroll") for (int n = 0; n < 2; ++n)
#define FRAG_ROW(ai, m) (128 * (ai) + 64 * wr + 16 * (m) + fr)
#define FRAG_COL(bj, n) (128 * (bj) + 32 * wc + 16 * (n) + 4 * fq)
__device__ __forceinline__ void st_bf16x4(bf16_t* p, f32x4 v) { u32x2 w; w.x = cvt_pk_bf16(v[0], v[1]); w.y = cvt_pk_bf16(v[2], v[3]); *(u32x2*)p = w; }
struct Frame { Params p; LAS unsigned char* lds; int tid, lane, wid, G, bid; };
#define WSP(T, off) ((T*)(F.p.ws + (off)))

template <class RowSrc>
__device__ __forceinline__ void conv_tile(const Frame& F, bf16_t* dst, int K, int ld, float scale, int r0, int k0, const RowSrc& rs) {
    LAS float* tile = (LAS float*)F.lds;
    const int n4 = (F.tid & 15) * 4, kq = F.tid >> 4;
    const float* sp = rs(r0 + n4) + (size_t)(k0 + kq) * ld;
#pragma unroll
    for (int p = 0; p < 8; ++p) { const f32x4 v = *(const f32x4*)(sp + (size_t)(p * 32) * ld); LAS float* q = tile + (p * 32 + kq) * 65 + n4; q[0] = v[0]; q[1] = v[1]; q[2] = v[2]; q[3] = v[3]; }
    __syncthreads();
    const int i2 = (F.tid & 127) * 2, jb = F.tid >> 7;
#pragma unroll
    for (int p = 0; p < 16; ++p) { const int j = p * 4 + jb; *(unsigned*)(dst + (size_t)(r0 + j) * K + k0 + i2) = cvt_pk_bf16(tile[i2 * 65 + j] * scale, tile[(i2 + 1) * 65 + j] * scale); }
    __syncthreads();
}
__device__ __forceinline__ int sigma_orig(int s) {
    const int half = s >> 7, s2 = s & 127, uu = s2 >> 5, b = (s2 >> 4) & 1, f = s2 & 15; return half * 128 + 16 * uu + f + 64 * b;
}
__device__ __forceinline__ void conv_moe_tile(const Frame& F, int layer, int t) {
    bf16_t* w13 = WSP(bf16_t, A_MOEW); bf16_t* w2t = WSP(bf16_t, A_MOEW + 32 * MiB);
    if (t < 1024) { const int e = t >> 6, rt = (t >> 2) & 15, kt = t & 3;
        const float* w1 = F.p.moe_w1 + ((size_t)layer * 16 + e) * 1024 * 512; const float* w3 = F.p.moe_w3 + ((size_t)layer * 16 + e) * 1024 * 512;
        conv_tile(F, w13 + (size_t)e * 1024 * 1024, 1024, 512, 1.0f, rt * 64, kt * 256, [=](int r) { const int j = r >> 8, rr = r & 255; return rr < 128 ? w1 + 128 * j + rr : w3 + 128 * j + rr - 128; });
    } else { const int u = t - 1024, e = u >> 5, rt = (u >> 1) & 15, kt = u & 1;
        const float* w2 = F.p.moe_w2 + ((size_t)layer * 16 + e) * 512 * 1024;
        conv_tile(F, w2t + (size_t)e * 1024 * 512, 512, 1024, 1.0f, rt * 64, kt * 256, [=](int r) { return w2 + r; }); }
}
__device__ __forceinline__ void conv_moe(const Frame& F, int layer) { for (int t = F.bid; t < 1536; t += F.G) conv_moe_tile(F, layer, t); }
__device__ __forceinline__ void conv_small_tile(const Frame& F, int t) {
    if (t < 96) { const float* w = F.p.w0in; conv_tile(F, WSP(bf16_t, WS_W0IN), 1024, 2560, 1.0f, (t >> 2) * 64, (t & 3) * 256, [=](int r) { return w + 256 + r; }); }
    else if (t < 144) { const int u = t - 96; const float* w = F.p.w0in; conv_tile(F, WSP(bf16_t, WS_W0IN) + (size_t)2048 * 1024, 1024, 2560, 1.0f, (u >> 2) * 64, (u & 3) * 256, [=](int r) { return w + 1792 + r; }); }
    else if (t < 208) { const int u = t - 144; const float* w = F.p.w0out; conv_tile(F, WSP(bf16_t, WS_W0OUT), 1024, 1024, 1.0f, (u >> 2) * 64, (u & 3) * 256, [=](int r) { return w + r; }); }
    else if (t < 272) { const int u = t - 208; const float* w = F.p.w1in; conv_tile(F, WSP(bf16_t, WS_W1IN), 1024, 6144, 1.0f, (u >> 2) * 64, (u & 3) * 256, [=](int r) { return w + (r & ~255) + sigma_orig(r & 255); }); }
    else if (t < 336) { const int u = t - 272; const float* w = F.p.w1in; conv_tile(F, WSP(bf16_t, WS_W1IN) + (size_t)1024 * 1024, 1024, 6144, 0.0625f, (u >> 2) * 64, (u & 3) * 256, [=](int r) { return w + 1024 + (r & ~255) + sigma_orig(r & 255); }); }
    else if (t < 592) { const int u = t - 336; const float* w = F.p.w1in; conv_tile(F, WSP(bf16_t, WS_W1IN) + (size_t)2048 * 1024, 1024, 6144, 1.0f, (u >> 2) * 64, (u & 3) * 256, [=](int r) { return w + 2048 + r; }); }
    else { const int u = t - 592; const float* w = F.p.w1out; conv_tile(F, WSP(bf16_t, WS_W1OUT), 2048, 1024, 1.0f, (u >> 3) * 64, (u & 7) * 256, [=](int r) { return w + r; }); }
}
__device__ __forceinline__ void p0_prologue(const Frame& F) {
    const float TWO_PI = 6.283185307179586f;
    {
        LAS float* sc0 = (LAS float*)F.lds; LAS float* sc1 = sc0 + 1024; LAS float* red = sc1 + 1024;
        for (int k = F.tid; k < 1024; k += 512) { sc0[k] = silu_f(F.p.c[k]); sc1[k] = silu_f(F.p.c_ctx[k]); }
        __syncthreads();
        float* mod = WSP(float, WS_MOD);
        for (int item = F.bid; item < 192; item += F.G) {
            const int l = item / 96, col0 = (item % 96) * 64, l16 = F.tid & 15, kg = F.tid >> 4;
            f32x4 a0 = {0.f, 0.f, 0.f, 0.f}, a1 = {0.f, 0.f, 0.f, 0.f};
#pragma unroll 8
            for (int i = 0; i < 32; ++i) { const int k = kg + 32 * i; const f32x4 w = *(const f32x4*)(F.p.ada_w + ((size_t)l * 1024 + k) * 6144 + col0 + l16 * 4); a0 += sc0[k] * w; a1 += sc1[k] * w; }
#pragma unroll
            for (int e = 0; e < 4; ++e) { red[(kg * 64 + l16 * 4 + e) * 2 + 0] = a0[e]; red[(kg * 64 + l16 * 4 + e) * 2 + 1] = a1[e]; }
            __syncthreads();
            if (F.tid < 128) { const int col = F.tid & 63, which = F.tid >> 6; float s = 0.f; for (int g = 0; g < 32; ++g) s += red[(g * 64 + col) * 2 + which];
                mod[(size_t)which * 2 * 6144 + l * 6144 + col0 + col] = s + F.p.ada_b[l * 6144 + col0 + col]; }
            __syncthreads();
        }
    }
    {
        const int gt = F.bid * 512 + F.tid, gn = F.G * 512;
        float* twc = WSP(float, WS_TWC); float* tws = WSP(float, WS_TWS);
        for (int i = gt; i < 128 * 128; i += gn) { const int b = i >> 7, k1 = i & 127; const float a = (float)((b * k1) & 16383) * (TWO_PI / 16384.0f); twc[i] = cosf(a); tws[i] = sinf(a); }
        float* rc = WSP(float, WS_ROPEC); float* rs = WSP(float, WS_ROPES);
        for (int i = gt; i < 256 * 64; i += gn) { const int pos = i >> 6, fi = i & 63; const float inv = powf(10000.0f, -(float)fi / 64.0f); const float a = (float)pos * inv; rc[i] = cosf(a); rs[i] = sinf(a); }
        bf16_t* f1 = WSP(bf16_t, WS_F1T); bf16_t* f2 = WSP(bf16_t, WS_F2P);
        for (int i = gt; i < 256 * 256; i += gn) { const int n = i >> 8, k = i & 255, k1 = n & 127, a = k & 127; const float ang = (float)((a * k1) & 127) * (TWO_PI / 128.0f); const float cs = cosf(ang), sn = sinf(ang);
            float v1; if (n < 128) v1 = (k < 128) ? cs : sn; else v1 = (k < 128) ? -sn : cs;
            f1[i] = f2bf(v1);
            f2[i] = f2bf(n < 128 ? ((k < 128) ? cs : sn) * (1.0f / 128.0f) : 0.0f); }
        bf16_t* cs256 = WSP(bf16_t, WS_CS256);
        for (int i = gt; i < 256 * 512; i += gn) { const int k = i >> 9, j = i & 511, n = j & 255; const float ang = (float)((n * k) & 255) * (TWO_PI / 256.0f); cs256[i] = f2bf((j < 256 ? cosf(ang) : sinf(ang)) * (1.0f / 16.0f)); }
    }
    {
        LAS float* ct = (LAS float*)F.lds;
        __syncthreads();
        if (F.tid < 64) ct[F.tid] = cosf((float)F.tid * (TWO_PI / 64.0f));
        __syncthreads();
        bf16_t* dst = WSP(bf16_t, WS_W0IN);
        for (int idx = F.bid * 512 + F.tid; idx < 512 * 1024; idx += F.G * 512) {
            const int r = idx >> 10, k = idx & 1023, part = r >> 8, cc = r & 255, g = cc >> 6, cp = cc & 63;
            const float* w = F.p.w0in + (size_t)k * 2560 + g * 64; float s = 0.f;
#pragma unroll 8
            for (int c = 0; c < 64; ++c) { const int ph = (c * cp) & 63; const float t = part ? -ct[(ph + 48) & 63] : ct[ph]; s += w[c] * t; }
            dst[(size_t)(1536 + r) * 1024 + k] = f2bf(s * 0.125f);
        }
        __syncthreads();
    }
    for (int t = F.bid; t < 720 + 1536; t += F.G) { if (t < 720) conv_small_tile(F, t); else conv_moe_tile(F, 0, t - 720); }
}

struct Row { f32x4 v[4]; };
__device__ __forceinline__ void row_load(Row& r, const float* p, int lane) {
#pragma unroll
    for (int i = 0; i < 4; ++i) r.v[i] = *(const f32x4*)(p + 4 * lane + 256 * i);
}
__device__ __forceinline__ void row_store(const Row& r, float* p, int lane) {
#pragma unroll
    for (int i = 0; i < 4; ++i) *(f32x4*)(p + 4 * lane + 256 * i) = r.v[i];
}
__device__ __forceinline__ float row_rstd(const Row& r) {
    float s = 0.f;
#pragma unroll
    for (int i = 0; i < 4; ++i) s += (r.v[i][0] * r.v[i][0] + r.v[i][1] * r.v[i][1]) + (r.v[i][2] * r.v[i][2] + r.v[i][3] * r.v[i][3]);
    s = wave_sum(s);
    return rsqrtf(s * (1.0f / 1024.0f) + RMS_EPS);
}
__device__ __forceinline__ void row_norm_mod(Row& r, const float* g, const float* sh, const float* sc, int lane) {
    const float rs = row_rstd(r);
#pragma unroll
    for (int i = 0; i < 4; ++i) { const int c = 4 * lane + 256 * i; const f32x4 gv = *(const f32x4*)(g + c), shv = *(const f32x4*)(sh + c), scv = *(const f32x4*)(sc + c);
        r.v[i] = (r.v[i] * rs) * gv * (1.0f + scv) + shv; }
}
__device__ __forceinline__ void row_store_bf16(const Row& r, bf16_t* p, int lane) {
#pragma unroll
    for (int i = 0; i < 4; ++i) st_bf16x4(p + 4 * lane + 256 * i, r.v[i]);
}
__device__ __forceinline__ const float* modp(const Frame& F, int layer, bool is_ctx) { return WSP(const float, WS_MOD) + (size_t)(is_ctx ? 2 : 0) * 6144 + layer * 6144; }
__device__ __forceinline__ unsigned char* xm1_panel(const unsigned char* ws, int pm) { return (unsigned char*)ws + (pm < 51 ? B_XM1A + (size_t)pm * HMiB : WS_W0IN + (size_t)(pm - 51) * HMiB); }
__device__ __forceinline__ float* hrow(const Frame& F, int t) { return t < CTXN ? WSP(float, WS_HC) + (size_t)t * DM : F.p.out + (size_t)(t - CTXN) * DM; }

__device__ __forceinline__ void p_norm_in(const Frame& F) {
    bf16_t* xm = WSP(bf16_t, A_XM);
    for (int t = F.bid * 8 + F.wid; t < TT; t += F.G * 8) {
        const bool ic = t < CTXN; const float* src = ic ? F.p.ctx + (size_t)t * DM : F.p.x + (size_t)(t - CTXN) * DM; const float* m = modp(F, 0, ic);
        Row r; row_load(r, src, F.lane); row_norm_mod(r, F.p.norm_g, m, m + 1024, F.lane); row_store_bf16(r, xm + (size_t)t * DM, F.lane);
    }
}
__device__ __forceinline__ void p_router(const Frame& F, int layer, int t0, bf16_t* dst) {
    LAS float* rwT = (LAS float*)F.lds;
    LAS unsigned* lcnt = (LAS unsigned*)(F.lds + 65536);
    for (int i = F.tid; i < 16 * 1024; i += 512) { const int e = i >> 10, c = i & 1023; rwT[i] = F.p.router_w[c * 16 + e]; }
    if (F.tid < 32) lcnt[F.tid] = 0u;
    __syncthreads();
    int* eid = WSP(int, WS_EID); float* gw = WSP(float, WS_GW); int* slot = WSP(int, WS_SLOT);
    unsigned* gcnt = (unsigned*)(F.p.ws + WS_CTL + CTL_CNT) + layer * 64;
    for (int t = t0 + F.bid * 8 + F.wid; t < TT; t += F.G * 8) {
        const bool ic = t < CTXN; const float* m = modp(F, layer, ic);
        Row r; row_load(r, hrow(F, t), F.lane); row_norm_mod(r, F.p.norm_g + (size_t)(layer * 2 + 1) * DM, m + 3072, m + 4096, F.lane); row_store_bf16(r, dst + (size_t)t * DM, F.lane);
        float lg[16];
#pragma unroll
        for (int e = 0; e < 16; ++e) { float s = 0.f;
#pragma unroll
            for (int i = 0; i < 4; ++i) { const f32x4 w = *(const LAS f32x4*)(rwT + e * 1024 + 4 * F.lane + 256 * i); s += (r.v[i][0] * w[0] + r.v[i][1] * w[1]) + (r.v[i][2] * w[2] + r.v[i][3] * w[3]); }
            lg[e] = wave_sum(s); }
        float scv[16], bi[16];
#pragma unroll
        for (int e = 0; e < 16; ++e) { scv[e] = 1.0f / (1.0f + __expf(-lg[e])); bi[e] = scv[e] + F.p.router_b[e]; }
        int gsel = 0; float best = -1e30f;
#pragma unroll
        for (int g = 0; g < 4; ++g) { const float a = bi[4 * g], b = bi[4 * g + 1], c = bi[4 * g + 2], d = bi[4 * g + 3];
            const float h1 = fmaxf(a, b), l1 = fminf(a, b), h2 = fmaxf(c, d), l2 = fminf(c, d); const float gs = fmaxf(h1, h2) + fmaxf(fminf(h1, h2), fmaxf(l1, l2));
            if (gs > best) { best = gs; gsel = g; } }
        float vb[4], vs[4];
#pragma unroll
        for (int i = 0; i < 4; ++i) { vb[i] = gsel == 0 ? bi[i] : gsel == 1 ? bi[4 + i] : gsel == 2 ? bi[8 + i] : bi[12 + i]; vs[i] = gsel == 0 ? scv[i] : gsel == 1 ? scv[4 + i] : gsel == 2 ? scv[8 + i] : scv[12 + i]; }
        int i0 = 0; float b0 = vb[0];
#pragma unroll
        for (int i = 1; i < 4; ++i) if (vb[i] > b0) { b0 = vb[i]; i0 = i; }
        int i1 = -1; float b1 = -1e30f;
#pragma unroll
        for (int i = 0; i < 4; ++i) if (i != i0 && vb[i] > b1) { b1 = vb[i]; i1 = i; }
        const float s0 = i0 == 0 ? vs[0] : i0 == 1 ? vs[1] : i0 == 2 ? vs[2] : vs[3], s1 = i1 == 0 ? vs[0] : i1 == 1 ? vs[1] : i1 == 2 ? vs[2] : vs[3];
        const float inv = 1.0f / (s0 + s1);
        if (F.lane == 0) {
            const int e0 = gsel * 4 + i0, e1 = gsel * 4 + i1;
            const unsigned r0 = __hip_atomic_fetch_add(lcnt + e0, 1u, __ATOMIC_RELAXED, __HIP_MEMORY_SCOPE_WORKGROUP), r1 = __hip_atomic_fetch_add(lcnt + e1, 1u, __ATOMIC_RELAXED, __HIP_MEMORY_SCOPE_WORKGROUP);
            eid[2 * t] = e0; eid[2 * t + 1] = e1; gw[2 * t] = s0 * inv; gw[2 * t + 1] = s1 * inv; slot[2 * t] = (int)r0; slot[2 * t + 1] = (int)r1;
        }
    }
    __syncthreads();
    if (F.tid < 16) lcnt[16 + F.tid] = __hip_atomic_fetch_add(gcnt + F.tid, lcnt[F.tid], __ATOMIC_RELAXED, __HIP_MEMORY_SCOPE_AGENT);
    __syncthreads();
    int* perm = WSP(int, WS_PERM);
    for (int t = t0 + F.bid * 8 + F.wid; t < TT; t += F.G * 8)
        if (F.lane < 2) { const int e = eid[2 * t + F.lane], rk = slot[2 * t + F.lane] + (int)lcnt[16 + e]; slot[2 * t + F.lane] = rk; perm[e * TT + rk] = t; }
    __syncthreads();
}
struct PanelTab { int pst[17]; };
__device__ __forceinline__ void panel_tab(const Frame& F, int layer, PanelTab& pt) {
    const unsigned* gcnt = (const unsigned*)(F.p.ws + WS_CTL + CTL_CNT) + layer * 64;
    pt.pst[0] = 0;
#pragma unroll
    for (int e = 0; e < 16; ++e) pt.pst[e + 1] = pt.pst[e] + (int)((__builtin_amdgcn_readfirstlane(gcnt[e]) + 255u) >> 8);
}
__device__ __forceinline__ int pt_start(const PanelTab& pt, int e) { int ps = 0;
#pragma unroll
    for (int j = 0; j < 16; ++j) ps = (e == j) ? pt.pst[j] : ps;
    return ps; }
__device__ __forceinline__ void moe_rowtab(const Frame& F, int layer, const PanelTab& pt, int t_pad) {
    LAS unsigned* rowtab = (LAS unsigned*)(F.lds + eng::STAGE_BYTES + 1024);
    const unsigned* gcnt = (const unsigned*)(F.p.ws + WS_CTL + CTL_CNT) + layer * 64; const int* perm = WSP(const int, WS_PERM);
    const int NU = pt.pst[16] * 4;
    for (int i = 0; i < 4; ++i) { const int idx0 = F.bid + i * F.G; if (idx0 >= NU) break;
        const int p = xcd_remap(idx0, NU) >> 2; int e = 0;
#pragma unroll
        for (int k = 1; k < 16; ++k) e += (p >= pt.pst[k]) ? 1 : 0;
        if (F.tid < 256) { const int rk = (p - pt_start(pt, e)) * 256 + F.tid; const int tok = rk < (int)gcnt[e] ? perm[e * TT + rk] : t_pad; rowtab[i * 256 + F.tid] = (unsigned)tok * 2048u; } }
    __syncthreads();
}
__device__ __forceinline__ void row_moe_combine(const Frame& F, Row& r, int t, int layer, const bf16_t* Y, const PanelTab& pt) {
    const int* slot = WSP(const int, WS_SLOT); const float* gw = WSP(const float, WS_GW); const int* eid = WSP(const int, WS_EID);
    const int s0 = pt_start(pt, eid[2 * t]) * 256 + slot[2 * t], s1 = pt_start(pt, eid[2 * t + 1]) * 256 + slot[2 * t + 1]; const float w0 = gw[2 * t], w1 = gw[2 * t + 1];
    const float* g2 = modp(F, layer, t < CTXN) + 5120;
#pragma unroll
    for (int i = 0; i < 4; ++i) { const int c = 4 * F.lane + 256 * i;
        const u32x2 a = *(const u32x2*)(Y + (size_t)s0 * DM + c), b = *(const u32x2*)(Y + (size_t)s1 * DM + c); const f32x4 gv = *(const f32x4*)(g2 + c);
        f32x4 f; f[0] = w0 * bflo(a.x) + w1 * bflo(b.x); f[1] = w0 * bfhi(a.x) + w1 * bfhi(b.x); f[2] = w0 * bflo(a.y) + w1 * bflo(b.y); f[3] = w0 * bfhi(a.y) + w1 * bfhi(b.y);
        r.v[i] += gv * f; }
}
__device__ __forceinline__ void p_combine0(const Frame& F) {
    const bf16_t* Y = WSP(const bf16_t, A_XS); PanelTab pt; panel_tab(F, 0, pt);
    for (int t = F.bid * 8 + F.wid; t < TT; t += F.G * 8) {
        Row r; float* hp = hrow(F, t); row_load(r, hp, F.lane); row_moe_combine(F, r, t, 0, Y, pt); row_store(r, hp, F.lane);
        const float* m = modp(F, 1, t < CTXN); row_norm_mod(r, F.p.norm_g + 2 * DM, m, m + 1024, F.lane); row_store_bf16(r, (bf16_t*)xm1_panel(F.p.ws, t >> 8) + (size_t)(t & 255) * DM, F.lane);
    }
}
__device__ __forceinline__ void p_final(const Frame& F) {
    const bf16_t* Y = WSP(const bf16_t, B_XS); PanelTab pt; panel_tab(F, 1, pt);
    for (int t = CTXN + F.bid * 8 + F.wid; t < TT; t += F.G * 8) {
        Row r; float* hp = hrow(F, t); row_load(r, hp, F.lane); row_moe_combine(F, r, t, 1, Y, pt);
        const float rs = row_rstd(r);
#pragma unroll
        for (int i = 0; i < 4; ++i) { const f32x4 gv = *(const f32x4*)(F.p.final_g + 4 * F.lane + 256 * i); r.v[i] = (r.v[i] * rs) * gv; }
        row_store(r, hp, F.lane);
    }
}
__device__ __forceinline__ float log_gamma(const Frame& F, int dir, int h) { return log1pf(-expf(F.p.decay[dir * 4 + h])); }
__device__ __forceinline__ void p_scan(const Frame& F) {
    bf16_t* st = WSP(bf16_t, B_ST);
    const int item = F.bid * 512 + F.tid;
    for (int it = item; it < 8 * 16384; it += F.G * 512) {
        const int hd = it >> 14, grp = it & 16383, h = hd >> 1, dir = hd & 1;
        const float lg = log_gamma(F, dir, h), d256 = __expf(256.0f * lg), d512 = __expf(512.0f * lg);
        float s[8];
#pragma unroll
        for (int j = 0; j < 8; ++j) s[j] = 0.f;
#pragma unroll 4
        for (int step = 0; step < 33; ++step) {
            const int c = (dir == 0 || step == 0) ? step : 33 - step;
            u32x4* p = (u32x4*)(st + ((size_t)(c * 8 + hd) * 131072 + (size_t)grp * 8));
            const u32x4 uv = *p; const float dec = (c == 0) ? d256 : d512;
            u32x4 o; o.x = cvt_pk_bf16(s[0], s[1]); o.y = cvt_pk_bf16(s[2], s[3]); o.z = cvt_pk_bf16(s[4], s[5]); o.w = cvt_pk_bf16(s[6], s[7]);
            *p = o;
            s[0] = s[0] * dec + bflo(uv.x); s[1] = s[1] * dec + bfhi(uv.x); s[2] = s[2] * dec + bflo(uv.y); s[3] = s[3] * dec + bfhi(uv.y);
            s[4] = s[4] * dec + bflo(uv.z); s[5] = s[5] * dec + bfhi(uv.z); s[6] = s[6] * dec + bflo(uv.w); s[7] = s[7] * dec + bfhi(uv.w);
        }
    }
}
#define PH_COMMON const unsigned char* ws; int G, bid; static constexpr bool HOOKS = false, GATHER = false; \
    __device__ __forceinline__ void hook(int, Acc&, const UnitD&, int, int, int, int) const {}
#define WSC(T, off) ((T*)(ws + (off)))
__device__ __forceinline__ float sel4(f32x4 v, int h) { const float a = h == 0 ? v[0] : v[1], b = h == 2 ? v[2] : v[3]; return h < 2 ? a : b; }
#define SEL4(a, h) sel4(a, h)
#define EFENCE asm volatile("" ::: "memory")

struct PhG1 { PH_COMMON
    __device__ __forceinline__ bool get(int i, UnitD& u) const {
        const int idx = bid + i * G; if (idx >= 715) return false;
        const char* xm = (const char*)(ws + A_XM); const char* w = (const char*)(ws + WS_W0IN);
        if (idx < 390) { const int v = xcd_remap(idx, 390), pm = v / 6, pn = v % 6; eng::unit1(u, xm + (size_t)pm * 256 * 2048, 2048, w + (size_t)pn * 256 * 2048, 2048, 16); u.kind = 0; u.i0 = pm; u.i1 = pn; }
        else { const int j = xcd_remap(idx - 390, 325), ct = j / 5, rt = j % 5; eng::unit1(u, w + (size_t)(1536 + rt * 256) * 2048, 2048, xm + (size_t)ct * 256 * 2048, 2048, 16); u.kind = rt < 2 ? 1 : 2; u.i0 = rt; u.i1 = ct; }
        return true;
    }
    __device__ __forceinline__ void epi(EPI_ARGS) const {
        if (u.kind == 0) { bf16_t* o = WSC(bf16_t, A_QK0) + (size_t)(u.i0 * 256) * QK0_LD + u.i1 * 256;
            FOR_FRAG(ai, bj, m, n) st_bf16x4(o + (size_t)FRAG_ROW(ai, m) * QK0_LD + FRAG_COL(bj, n), acc[ai][bj][m][n]); }
        else if (u.kind == 2) { bf16_t* o = WSC(bf16_t, A_VT0) + (size_t)((u.i0 - 2) * 256) * TT + u.i1 * 256;
            FOR_FRAG(ai, bj, m, n) st_bf16x4(o + (size_t)FRAG_ROW(ai, m) * TT + FRAG_COL(bj, n), acc[ai][bj][m][n]); }
        else if (u.i1 == 0) { bf16_t* o = WSC(bf16_t, WS_XTC) + u.i0 * 256;
            FOR_FRAG(ai, bj, m, n) st_bf16x4(o + (size_t)FRAG_ROW(ai, m) * 512 + FRAG_COL(bj, n), acc[ai][bj][m][n]); }
        else { bf16_t* o = WSC(bf16_t, A_XT2) + u.i0 * 128;
            FOR_FRAG(ai, bj, m, n) { const int cc = FRAG_ROW(ai, m), nn = (u.i1 - 1) * 256 + FRAG_COL(bj, n), a = nn >> 7, b = nn & 127; const f32x4 v = acc[ai][bj][m][n];
#pragma unroll
                for (int e = 0; e < 4; ++e) o[(size_t)(cc * 128 + b + e) * 256 + a] = f2bf(v[e]);
                EFENCE; } }
    }
};
struct PhF1 { PH_COMMON
    __device__ __forceinline__ bool get(int i, UnitD& u) const {
        const int idx = bid + i * G; if (idx >= 129) return false;
        if (idx < 128) { eng::unit1(u, ws + A_XT2 + (size_t)idx * 256 * 512, 512, ws + WS_F1T, 512, 4); u.kind = 0; u.i0 = idx; }
        else { eng::unit1(u, ws + WS_CS256, 1024, ws + WS_XTC, 1024, 8); u.kind = 1; }
        return true;
    }
    __device__ __forceinline__ void epi(EPI_ARGS) const {
        if (u.kind == 1) { bf16_t* o = WSC(bf16_t, A_AO); FOR_FRAG(ai, bj, m, n) st_bf16x4(o + (size_t)FRAG_ROW(ai, m) * DM + FRAG_COL(bj, n), acc[ai][bj][m][n]); return; }
        const float* twc = WSC(const float, WS_TWC); const float* tws = WSC(const float, WS_TWS); bf16_t* o = WSC(bf16_t, A_T2);
#pragma unroll
        for (int m = 0; m < 4; ++m)
#pragma unroll
            for (int n = 0; n < 2; ++n) { const int b = 64 * wr + 16 * m + fr, k1 = 32 * wc + 16 * n + 4 * fq; const f32x4 cv = *(const f32x4*)(twc + b * 128 + k1), sv = *(const f32x4*)(tws + b * 128 + k1);
#pragma unroll
                for (int ai = 0; ai < 2; ++ai) { const int cc = 2 * u.i0 + ai; const f32x4 tr = acc[ai][0][m][n], ti = acc[ai][1][m][n];
#pragma unroll
                    for (int e = 0; e < 4; ++e) { bf16_t* q = o + (size_t)((k1 + e) * 256 + cc) * 256 + b; q[0] = f2bf(tr[e] * cv[e] + ti[e] * sv[e]); q[128] = f2bf(ti[e] * cv[e] - tr[e] * sv[e]); } } }
    }
};
struct PhF2 { PH_COMMON const float* ctx;
    __device__ __forceinline__ bool get(int i, UnitD& u) const {
        const int idx = bid + i * G; if (idx >= 132) return false;
        if (idx < 128) { eng::unit1(u, ws + WS_F2P, 512, ws + A_T2 + (size_t)idx * 256 * 512, 512, 4); u.i0 = idx; }
        else { const int pn = idx - 128; eng::unit1(u, ws + A_AO, 2048, ws + WS_W0OUT + (size_t)pn * 256 * 2048, 2048, 16); u.kind = 1; u.i1 = pn; }
        return true;
    }
    __device__ __forceinline__ void epi(EPI_ARGS) const {
        if (u.kind == 1) { const float* g1 = WSC(const float, WS_MOD) + 2 * 6144 + 2048 + u.i1 * 256; float* dst = WSC(float, WS_HC);
            FOR_FRAG(ai, bj, m, n) { const size_t off = (size_t)FRAG_ROW(ai, m) * DM + u.i1 * 256 + FRAG_COL(bj, n); const f32x4 gv = *(const f32x4*)(g1 + FRAG_COL(bj, n));
                *(f32x4*)(dst + off) = *(const f32x4*)(ctx + off) + gv * acc[ai][bj][m][n]; }
            return; }
        bf16_t* o = WSC(bf16_t, A_AO);
#pragma unroll
        for (int m = 0; m < 4; ++m)
#pragma unroll
            for (int bj = 0; bj < 2; ++bj)
#pragma unroll
                for (int n = 0; n < 2; ++n) { const int k2 = FRAG_ROW(0, m); st_bf16x4(o + (size_t)(CTXN + u.i0 + 128 * k2) * DM + FRAG_COL(bj, n), acc[0][bj][m][n]); }
    }
};
struct PhG2 { PH_COMMON const float* x; float* out;
    __device__ __forceinline__ bool get(int i, UnitD& u) const {
        const int idx0 = bid + i * G; if (idx0 >= 256) return false;
        const int idx = xcd_remap(idx0, 256), pm = 1 + (idx >> 2), pn = idx & 3; eng::unit1(u, ws + A_AO + (size_t)pm * 256 * 2048, 2048, ws + WS_W0OUT + (size_t)pn * 256 * 2048, 2048, 16); u.i0 = pm; u.i1 = pn; return true;
    }
    __device__ __forceinline__ void epi(EPI_ARGS) const {
        const float* g1 = WSC(const float, WS_MOD) + 2048 + u.i1 * 256;
        const float* src = x + (size_t)(u.i0 - 1) * 256 * DM; float* dst = out + (size_t)(u.i0 - 1) * 256 * DM;
        FOR_FRAG(ai, bj, m, n) { const size_t off = (size_t)FRAG_ROW(ai, m) * DM + u.i1 * 256 + FRAG_COL(bj, n); const f32x4 gv = *(const f32x4*)(g1 + FRAG_COL(bj, n));
            *(f32x4*)(dst + off) = *(const f32x4*)(src + off) + gv * acc[ai][bj][m][n]; }
    }
};
struct PhM1 { const unsigned char* ws; int G, bid; PanelTab pt; size_t xs, hd; static constexpr bool HOOKS = false, GATHER = true;
    __device__ __forceinline__ void hook(int, Acc&, const UnitD&, int, int, int, int) const {}
    __device__ __forceinline__ bool get(int i, UnitD& u) const {
        const int idx0 = bid + i * G, NU = pt.pst[16] * 4; if (idx0 >= NU) return false;
        const int idx = xcd_remap(idx0, NU), p = idx >> 2, j = idx & 3; int e = 0;
#pragma unroll
        for (int k = 1; k < 16; ++k) e += (p >= pt.pst[k]) ? 1 : 0;
        eng::unit1(u, ws + xs, 2048, ws + A_MOEW + ((size_t)e * 1024 + j * 256) * 2048, 2048, 16); u.i0 = p; u.i1 = j; return true;
    }
    __device__ __forceinline__ void epi(EPI_ARGS) const {
        bf16_t* o = (bf16_t*)(ws + hd) + (size_t)(u.i0 * 256) * 512 + u.i1 * 128;
#pragma unroll
        for (int ai = 0; ai < 2; ++ai)
#pragma unroll
            for (int m = 0; m < 4; ++m)
#pragma unroll
                for (int n = 0; n < 2; ++n) { const f32x4 a = acc[ai][0][m][n], b = acc[ai][1][m][n]; f32x4 v;
#pragma unroll
                    for (int e = 0; e < 4; ++e) v[e] = silu_f(a[e]) * b[e];
                    st_bf16x4(o + (size_t)FRAG_ROW(ai, m) * 512 + FRAG_COL(0, n), v); }
    }
};
struct PhM2 { PH_COMMON PanelTab pt; size_t hd, y;
    __device__ __forceinline__ bool get(int i, UnitD& u) const {
        const int idx0 = bid + i * G, NU = pt.pst[16] * 4; if (idx0 >= NU) return false;
        const int idx = xcd_remap(idx0, NU), p = idx >> 2, j = idx & 3; int e = 0;
#pragma unroll
        for (int k = 1; k < 16; ++k) e += (p >= pt.pst[k]) ? 1 : 0;
        eng::unit1(u, ws + hd + (size_t)p * 256 * 1024, 1024, ws + A_MOEW + 32 * MiB + ((size_t)e * 1024 + j * 256) * 1024, 1024, 8); u.i0 = p; u.i1 = j; return true;
    }
    __device__ __forceinline__ void epi(EPI_ARGS) const {
        bf16_t* o = (bf16_t*)(ws + y) + (size_t)(u.i0 * 256) * DM + u.i1 * 256;
        FOR_FRAG(ai, bj, m, n) st_bf16x4(o + (size_t)FRAG_ROW(ai, m) * DM + FRAG_COL(bj, n), acc[ai][bj][m][n]);
    }
};
struct PhG3 { PH_COMMON f32x4 lgf, lgb;
    __device__ __forceinline__ bool get(int i, UnitD& u) const {
        const int idx = bid + i * G; if (idx >= 512 + 780) return false;
        const char* w = (const char*)(ws + WS_W1IN);
        if (idx < 512) { const int v = xcd_remap(idx, 512), pm = 1 + (v >> 3), pn = v & 7; eng::unit1(u, xm1_panel(ws, pm), 2048, w + (size_t)pn * 256 * 2048, 2048, 16); u.kind = 0; u.i0 = pm; u.i1 = pn; }
        else { const int j = xcd_remap(idx - 512, 780), ct = j / 12, rt = j % 12; eng::unit1(u, w + (size_t)(1024 + rt * 256) * 2048, 2048, xm1_panel(ws, ct), 2048, 16); u.kind = rt < 4 ? 1 : 2; u.i0 = rt; u.i1 = ct; }
        return true;
    }
    __device__ __forceinline__ void epi(EPI_ARGS) const {
        const float* rc = WSC(const float, WS_ROPEC); const float* rs = WSC(const float, WS_ROPES);
        if (u.kind == 0) {
            bf16_t* o = (u.i1 < 4 ? WSC(bf16_t, B_Q) : WSC(bf16_t, B_K)) + (size_t)(u.i0 * 256) * DM + (u.i1 & 3) * 256;
#pragma unroll
            for (int ai = 0; ai < 2; ++ai)
#pragma unroll
                for (int m = 0; m < 4; ++m) { const int r = FRAG_ROW(ai, m), tl = (u.i0 - 1) * 256 + r;
#pragma unroll
                    for (int bj = 0; bj < 2; ++bj) { const int pos = bj == 0 ? (tl >> 6) : (tl & 63); const f32x4 cv = *(const f32x4*)(rc + pos * 64 + 16 * wc + 4 * fq), sv = *(const f32x4*)(rs + pos * 64 + 16 * wc + 4 * fq);
                        const f32x4 x1 = acc[ai][bj][m][0], x2 = acc[ai][bj][m][1];
                        st_bf16x4(o + (size_t)r * DM + FRAG_COL(bj, 0), x1 * cv - x2 * sv); st_bf16x4(o + (size_t)r * DM + FRAG_COL(bj, 1), x2 * cv + x1 * sv); } }
        } else if (u.kind == 2) { bf16_t* o = WSC(bf16_t, B_VT) + (size_t)((u.i0 - 4) * 256) * TT + u.i1 * 256;
            FOR_FRAG(ai, bj, m, n) st_bf16x4(o + (size_t)FRAG_ROW(ai, m) * TT + FRAG_COL(bj, n), acc[ai][bj][m][n]);
        } else {
            const int h = u.i0; const float lf = SEL4(lgf, h), lb = SEL4(lgb, h);
            bf16_t* of = WSC(bf16_t, B_KF) + (size_t)(h * 256) * TT + u.i1 * 256; bf16_t* ob = WSC(bf16_t, B_KB) + (size_t)(h * 256) * TT + u.i1 * 256;
#pragma unroll
            for (int bj = 0; bj < 2; ++bj)
#pragma unroll
                for (int n = 0; n < 2; ++n) { const int c0 = FRAG_COL(bj, n); f32x4 df, db;
                    if (u.i1 == 0) {
#pragma unroll
                        for (int e = 0; e < 4; ++e) { const int pos = c0 + e; df[e] = __expf(lf * (float)(255 - pos)); db[e] = __expf(lb * (float)pos); }
                    } else {
#pragma unroll
                        for (int e = 0; e < 4; ++e) { const int pos = ((u.i1 - 1) * 256 + c0 + e) & 511; df[e] = __expf(lf * (float)(511 - pos)); db[e] = __expf(lb * (float)pos); }
                    }
#pragma unroll
                    for (int ai = 0; ai < 2; ++ai)
#pragma unroll
                        for (int mp = 0; mp < 2; ++mp) { const int p = 32 * wr + 16 * mp + fr; f32x4 x1 = acc[ai][bj][2 * mp][n], x2 = acc[ai][bj][2 * mp + 1][n];
                            if (u.i1 != 0) { const int tl = (u.i1 - 1) * 256 + c0; f32x4 cv, sv;
                                if (ai == 0) { const float c = rc[(tl >> 6) * 64 + p], s = rs[(tl >> 6) * 64 + p]; cv = (f32x4){c, c, c, c}; sv = (f32x4){s, s, s, s}; }
                                else {
#pragma unroll
                                    for (int e = 0; e < 4; ++e) { cv[e] = rc[((tl + e) & 63) * 64 + p]; sv[e] = rs[((tl + e) & 63) * 64 + p]; } }
                                const f32x4 y1 = x1 * cv - x2 * sv, y2 = x2 * cv + x1 * sv; x1 = y1; x2 = y2; }
                            const size_t o1 = (size_t)FRAG_ROW(ai, 2 * mp) * TT + c0, o2 = (size_t)FRAG_ROW(ai, 2 * mp + 1) * TT + c0;
                            st_bf16x4(of + o1, x1 * df); st_bf16x4(of + o2, x2 * df); st_bf16x4(ob + o1, x1 * db); st_bf16x4(ob + o2, x2 * db); } }
        }
    }
};
__device__ __forceinline__ int chunk_tok0(int c) { return c == 0 ? 0 : 256 + 512 * (c - 1); }
struct PhU { PH_COMMON
    __device__ __forceinline__ bool get(int i, UnitD& u) const {
        const int idx0 = bid + i * G; if (idx0 >= 528) return false;
        const int idx = xcd_remap(idx0, 528), dvt = idx & 1, dir = (idx >> 1) & 1, h = (idx >> 2) & 3, c = idx >> 4; const size_t tk = (size_t)chunk_tok0(c) * 2;
        eng::unit1(u, ws + B_VT + (size_t)(h * 512 + dvt * 256) * TT * 2 + tk, TT * 2, ws + (dir ? B_KB : B_KF) + (size_t)(h * 256) * TT * 2 + tk, TT * 2, c == 0 ? 4 : 8);
        u.i0 = (c * 8 + h * 2 + dir); u.i1 = dvt; return true;
    }
    __device__ __forceinline__ void epi(EPI_ARGS) const {
        bf16_t* o = WSC(bf16_t, B_ST) + (size_t)u.i0 * 131072 + (size_t)(u.i1 * 256) * 256;
        FOR_FRAG(ai, bj, m, n) st_bf16x4(o + (size_t)FRAG_ROW(ai, m) * 256 + FRAG_COL(bj, n), acc[ai][bj][m][n]);
    }
};
struct PhSD { PH_COMMON f32x4 lgf, lgb;
    __device__ __forceinline__ bool get(int i, UnitD& u) const {
        const int idx0 = bid + i * G; if (idx0 >= 512) return false;
        const int idx = xcd_remap(idx0, 512), tj = idx & 1, ti = (idx >> 1) & 1, h = (idx >> 2) & 3, c = 1 + (idx >> 4); const int t0 = chunk_tok0(c);
        eng::unit1(u, ws + B_Q + (size_t)(t0 + 256 * ti) * 2048 + h * 512, 2048, ws + B_K + (size_t)(t0 + 256 * tj) * 2048 + h * 512, 2048, 4);
        u.i0 = t0; u.i1 = h; u.i2 = ti * 2 + tj; return true;
    }
    __device__ __forceinline__ void epi(EPI_ARGS) const {
        const int ti = u.i2 >> 1, tj = u.i2 & 1, h = u.i1; const float lf = SEL4(lgf, h), lb = SEL4(lgb, h);
        bf16_t* o = WSC(bf16_t, B_SD) + (size_t)(u.i0 + 256 * ti) * 2048 + h * 512 + 256 * tj;
        FOR_FRAG(ai, bj, m, n) { const int r = FRAG_ROW(ai, m), c0 = FRAG_COL(bj, n), i = 256 * ti + r; f32x4 v = acc[ai][bj][m][n];
#pragma unroll
            for (int e = 0; e < 4; ++e) { const int d = i - (256 * tj + c0 + e); const float w = d > 0 ? __expf(lf * (float)d) : d < 0 ? __expf(lb * (float)(-d)) : 2.0f; v[e] *= w; }
            st_bf16x4(o + (size_t)r * 2048 + c0, v); }
    }
};
struct PhO { const unsigned char* ws; int G, bid; f32x4 lgf, lgb; static constexpr bool HOOKS = true, GATHER = false;
    __device__ __forceinline__ bool get(int i, UnitD& u) const {
        const int idx0 = bid + i * G; if (idx0 >= 512) return false;
        const int idx = xcd_remap(idx0, 512), dvt = idx & 1, h = (idx >> 1) & 3, pm = idx >> 3, c = 1 + (pm >> 1), t0 = CTXN + 256 * pm;
        const char* q = (const char*)(ws + B_Q) + (size_t)t0 * 2048 + h * 512;
        const char* st = (const char*)(ws + B_ST) + ((size_t)(c * 8 + h * 2) * 131072 + (size_t)(dvt * 256) * 256) * 2;
        u.A0 = q; u.B0 = st; u.lda0 = 2048; u.ldb0 = 512; u.n0 = 4;
        u.A1 = q; u.B1 = st + (size_t)131072 * 2; u.lda1 = 2048; u.ldb1 = 512; u.n1 = 4;
        u.A2 = (const char*)(ws + B_SD) + (size_t)t0 * 4096 + h * 1024; u.B2 = (const char*)(ws + B_VT) + (size_t)(h * 512 + dvt * 256) * TT * 2 + (size_t)chunk_tok0(c) * 2; u.lda2 = 4096; u.ldb2 = TT * 2; u.n2 = 8;
        u.kind = 0; u.i0 = pm; u.i1 = h; u.i2 = dvt; return true;
    }
    __device__ __forceinline__ void hook(int tc, Acc& acc, const UnitD& u, int wr, int wc, int fr, int fq) const {
        if (tc != 4 && tc != 8) return;
        const float lf = SEL4(lgf, u.i1), lb = SEL4(lgb, u.i1);
#pragma unroll
        for (int ai = 0; ai < 2; ++ai)
#pragma unroll
            for (int m = 0; m < 4; ++m) { const int i = (u.i0 & 1) * 256 + FRAG_ROW(ai, m);
                const float s = tc == 4 ? __expf(lf * (float)(i + 1) - lb * (float)(512 - i)) : __expf(lb * (float)(512 - i));
#pragma unroll
                for (int bj = 0; bj < 2; ++bj)
#pragma unroll
                    for (int n = 0; n < 2; ++n) acc[ai][bj][m][n] *= s; }
    }
    __device__ __forceinline__ void epi(EPI_ARGS) const {
        const int tl = 256 * u.i0, h = u.i1, dvt = u.i2;
        bf16_t* o = WSC(bf16_t, B_O) + (size_t)(CTXN + tl) * 2048 + h * 512 + dvt * 256; float* ssq = WSC(float, WS_SSQ);
#pragma unroll
        for (int ai = 0; ai < 2; ++ai)
#pragma unroll
            for (int m = 0; m < 4; ++m) { const int r = FRAG_ROW(ai, m); float s = 0.f;
#pragma unroll
                for (int bj = 0; bj < 2; ++bj)
#pragma unroll
                    for (int n = 0; n < 2; ++n) { const f32x4 v = acc[ai][bj][m][n]; s += (v[0] * v[0] + v[1] * v[1]) + (v[2] * v[2] + v[3] * v[3]); st_bf16x4(o + (size_t)r * 2048 + FRAG_COL(bj, n), v); }
                s += __shfl_xor(s, 16); s += __shfl_xor(s, 32);
                if (fq == 0) ssq[((size_t)(tl + r) * 4 + h) * 8 + dvt * 4 + wc] = s; }
    }
};
struct PhGG { PH_COMMON
    __device__ __forceinline__ bool get(int i, UnitD& u) const {
        const int idx0 = bid + i * G; if (idx0 >= 512) return false;
        const int idx = xcd_remap(idx0, 512), pm = 1 + (idx >> 3), pn = idx & 7; eng::unit1(u, xm1_panel(ws, pm), 2048, ws + WS_W1IN + (size_t)(4096 + pn * 256) * 2048, 2048, 16); u.i0 = pm; u.i1 = pn; return true;
    }
    __device__ __forceinline__ void epi(EPI_ARGS) const {
        bf16_t* o = WSC(bf16_t, B_O) + (size_t)(u.i0 * 256) * 2048 + u.i1 * 256; const float* ssq = WSC(const float, WS_SSQ); const int h = u.i1 >> 1;
#pragma unroll
        for (int ai = 0; ai < 2; ++ai)
#pragma unroll
            for (int m = 0; m < 4; ++m) { const int r = FRAG_ROW(ai, m); const float* sp = ssq + ((size_t)((u.i0 - 1) * 256 + r) * 4 + h) * 8;
                const f32x4 s0 = *(const f32x4*)sp, s1 = *(const f32x4*)(sp + 4); const float rstd = rsqrtf((((s0[0] + s0[1]) + (s0[2] + s0[3])) + ((s1[0] + s1[1]) + (s1[2] + s1[3]))) * (1.0f / 512.0f) + RMS_EPS);
#pragma unroll
                for (int bj = 0; bj < 2; ++bj)
#pragma unroll
                    for (int n = 0; n < 2; ++n) { bf16_t* q = o + (size_t)r * 2048 + FRAG_COL(bj, n); const u32x2 ov = *(const u32x2*)q; const f32x4 g = acc[ai][bj][m][n]; f32x4 v;
                        v[0] = silu_f(g[0]) * (bflo(ov.x) * rstd); v[1] = silu_f(g[1]) * (bfhi(ov.x) * rstd); v[2] = silu_f(g[2]) * (bflo(ov.y) * rstd); v[3] = silu_f(g[3]) * (bfhi(ov.y) * rstd);
                        st_bf16x4(q, v); } }
    }
};
struct PhG4 { PH_COMMON float* out;
    __device__ __forceinline__ bool get(int i, UnitD& u) const {
        const int idx0 = bid + i * G; if (idx0 >= 256) return false;
        const int idx = xcd_remap(idx0, 256), pm = idx >> 2, pn = idx & 3; eng::unit1(u, ws + B_O + (size_t)(CTXN + pm * 256) * 4096, 4096, ws + WS_W1OUT + (size_t)pn * 256 * 4096, 4096, 32); u.i0 = pm; u.i1 = pn; return true;
    }
    __device__ __forceinline__ void epi(EPI_ARGS) const {
        const float* g1 = WSC(const float, WS_MOD) + 6144 + 2048 + u.i1 * 256; float* dst = out + (size_t)(u.i0 * 256) * DM + u.i1 * 256;
        FOR_FRAG(ai, bj, m, n) { float* q = dst + (size_t)FRAG_ROW(ai, m) * DM + FRAG_COL(bj, n); const f32x4 gv = *(const f32x4*)(g1 + FRAG_COL(bj, n)); *(f32x4*)q = *(const f32x4*)q + gv * acc[ai][bj][m][n]; }
    }
};

constexpr int NA_KC = 0, NA_VC = 32768, NA_RPB = 65536;
__device__ __forceinline__ int na_ksw(int tok) { return ((tok >> 1) & 1) | (((tok >> 3) & 3) << 1); }
__device__ __forceinline__ void na_load_ctx(const Frame& F, int h) {
    const bf16_t* qk = WSP(const bf16_t, A_QK0); const bf16_t* vt = WSP(const bf16_t, A_VT0);
#pragma unroll
    for (int i = 0; i < 4; ++i) { const int cid = F.tid + 512 * i, tok = cid >> 3, c = cid & 7;
        *(LAS u32x4*)(F.lds + NA_KC + tok * 128 + ((c ^ na_ksw(tok)) << 4)) = *(const u32x4*)(qk + (size_t)tok * QK0_LD + 768 + h * 64 + c * 8); }
#pragma unroll
    for (int i = 0; i < 4; ++i) { const int cid = F.tid + 512 * i, d = cid >> 5, ch = cid & 31;
        *(LAS u32x4*)(F.lds + NA_VC + d * 512 + ((ch ^ (d & 15)) << 4)) = *(const u32x4*)(vt + (size_t)(h * 64 + d) * TT + ch * 8); }
}
template <bool LOCAL>
__device__ __forceinline__ void na_unit(const Frame& F, int r, int j, int h, int qb) {
    const bf16_t* qk = WSP(const bf16_t, A_QK0); const bf16_t* vt = WSP(const bf16_t, A_VT0); bf16_t* ao = WSP(bf16_t, A_AO);
    const LAS float* rpb_l = (const LAS float*)(F.lds + NA_RPB);
    int lane = F.lane; asm volatile("" : "+v"(lane));
    const int q16 = lane & 15, g = lane >> 4;
    const int tq = LOCAL ? CTXN + r * GW + 16 * j + q16 : 16 * qb + q16;
    bf16x8 qf[2];
#pragma unroll
    for (int ks = 0; ks < 2; ++ks) qf[ks] = *(const bf16x8*)(qk + (size_t)tq * QK0_LD + h * 64 + 32 * ks + 8 * g);
    constexpr int NT = LOCAL ? 32 : 16, NL = LOCAL ? 16 : 0;
    f32x4 s[NT];
    const int rs = LOCAL ? min(max(r - 4, 0), 248) : 0, kst = LOCAL ? min(max(16 * j - 8, 0), 32) : 0;
    const int krow = 8 * (q16 >> 2) + (q16 & 3);
#pragma unroll
    for (int t = 0; t < NT; ++t) {
        bf16x8 k0, k1;
        if (t < NL) { const int tok = CTXN + (rs + (t >> 1)) * GW + kst + krow + 4 * (t & 1); const bf16_t* kp = qk + (size_t)tok * QK0_LD + 768 + h * 64 + 8 * g; k0 = *(const bf16x8*)kp; k1 = *(const bf16x8*)(kp + 32); }
        else { const int tok = 32 * ((t - NL) >> 1) + krow + 4 * (t & 1), sw = na_ksw(tok); const LAS unsigned char* kp = F.lds + NA_KC + tok * 128;
            k0 = *(const LAS bf16x8*)(kp + ((g ^ sw) << 4)); k1 = *(const LAS bf16x8*)(kp + (((4 + g) ^ sw) << 4)); }
        f32x4 a = {0.f, 0.f, 0.f, 0.f};
        a = __builtin_amdgcn_mfma_f32_16x16x32_bf16(k0, qf[0], a, 0, 0, 0); a = __builtin_amdgcn_mfma_f32_16x16x32_bf16(k1, qf[1], a, 0, 0, 0);
        s[t] = a;
        if ((t & 3) == 3) asm volatile("" ::: "memory");
    }
    float mx = -1e30f;
    if (LOCAL) { const int qc = 16 * j + q16, wst = min(max(qc - 8, 0), 48);
#pragma unroll
        for (int t = 0; t < NL; ++t) { const int dr = rs + (t >> 1) - r + 7;
#pragma unroll
            for (int e = 0; e < 4; ++e) { const int kc = kst + 8 * g + 4 * (t & 1) + e; const bool ok = kc >= wst && kc < wst + 16; const int dc = min(max(kc - qc + 15, 0), 30);
                const float v = ok ? s[t][e] * 0.125f + rpb_l[(h * 15 + dr) * 31 + dc] : -1e30f; s[t][e] = v; mx = fmaxf(mx, v); } } }
#pragma unroll
    for (int t = NL; t < NT; ++t)
#pragma unroll
        for (int e = 0; e < 4; ++e) { const float v = s[t][e] * 0.125f; s[t][e] = v; mx = fmaxf(mx, v); }
    mx = fmaxf(mx, __shfl_xor(mx, 16)); mx = fmaxf(mx, __shfl_xor(mx, 32));
    float sum = 0.f; u32x4 pw[NT / 2];
#pragma unroll
    for (int b = 0; b < NT / 2; ++b) { float p[8];
#pragma unroll
        for (int e = 0; e < 4; ++e) { p[e] = __expf(s[2 * b][e] - mx); p[4 + e] = __expf(s[2 * b + 1][e] - mx); }
        sum += ((p[0] + p[1]) + (p[2] + p[3])) + ((p[4] + p[5]) + (p[6] + p[7]));
        pw[b].x = cvt_pk_bf16(p[0], p[1]); pw[b].y = cvt_pk_bf16(p[2], p[3]); pw[b].z = cvt_pk_bf16(p[4], p[5]); pw[b].w = cvt_pk_bf16(p[6], p[7]); }
    sum += __shfl_xor(sum, 16); sum += __shfl_xor(sum, 32);
    f32x4 o[4];
#pragma unroll
    for (int dt = 0; dt < 4; ++dt) o[dt] = (f32x4){0.f, 0.f, 0.f, 0.f};
#pragma unroll
    for (int b = 0; b < NT / 2; ++b) {
        const bf16x8 pf = __builtin_bit_cast(bf16x8, pw[b]);
#pragma unroll
        for (int dt = 0; dt < 4; ++dt) { bf16x8 vf;
            if (b < NL / 2) vf = *(const bf16x8*)(vt + (size_t)(h * 64 + 16 * dt + q16) * TT + CTXN + (rs + b) * GW + kst + 8 * g);
            else vf = *(const LAS bf16x8*)(F.lds + NA_VC + (16 * dt + q16) * 512 + (((4 * (b - NL / 2) + g) ^ q16) << 4));
            o[dt] = __builtin_amdgcn_mfma_f32_16x16x32_bf16(vf, pf, o[dt], 0, 0, 0); }
        if ((b & 1) == 1) asm volatile("" ::: "memory");
    }
    const float inv = 1.0f / sum;
#pragma unroll
    for (int dt = 0; dt < 4; ++dt) st_bf16x4(ao + (size_t)tq * DM + 256 + h * 64 + 16 * dt + 4 * g, o[dt] * inv);
}
__device__ __forceinline__ void p_attention(const Frame& F) {
    LAS float* rpb_l = (LAS float*)(F.lds + NA_RPB); volatile LAS int* tick = (volatile LAS int*)(F.lds + NA_RPB + 24576);
    for (int i = F.tid; i < 12 * 15 * 31; i += 512) rpb_l[i] = F.p.rpb[i];
    unsigned* heads = (unsigned*)(F.p.ws + WS_CTL + CTL_QUEUE);
    const int h0 = (12 * F.bid) >> 8;
    for (int hh = 0; hh < 12; ++hh) {
        const int h = (h0 + hh) % 12; bool loaded = false;
        for (;;) {
            __syncthreads();
            if (F.tid == 0) tick[0] = (int)__hip_atomic_fetch_add(heads + h * 64, 1u, __ATOMIC_RELAXED, __HIP_MEMORY_SCOPE_AGENT);
            __syncthreads();
            const int k = __builtin_amdgcn_readfirstlane(tick[0]);
            if (k > 128) break;
            if (!loaded) { na_load_ctx(F, h); __syncthreads(); loaded = true; }
            if (k < 128) na_unit<true>(F, 2 * k + (F.wid >> 2), F.wid & 3, h, 0);
            else { na_unit<false>(F, 0, 0, h, F.wid); na_unit<false>(F, 0, 0, h, F.wid + 8); }
        }
    }
    __syncthreads();
}
constexpr int LDS_BYTES = eng::STAGE_BYTES + 1024 + 4096;
#ifndef MK_PER_PHASE
#define MK_PER_PHASE 0
#endif

__global__ __launch_bounds__(512, 2) void mk_fwd(Params p) {
    extern __shared__ __attribute__((aligned(16))) unsigned char shm[];
    Frame F; F.p = p; F.lds = (LAS unsigned char*)shm; F.tid = threadIdx.x; F.lane = F.tid & 63; F.wid = __builtin_amdgcn_readfirstlane(F.tid >> 6); F.G = gridDim.x; F.bid = blockIdx.x;
    volatile LAS unsigned* xb = (volatile LAS unsigned*)(F.lds + eng::STAGE_BYTES);
    if (F.tid < 4) xb[F.tid] = 0u;
    __syncthreads();
    const int lo = p.ph_lo, hi = p.ph_hi;
    XcdBarrier bar; bar.bar = (unsigned*)(p.ws + WS_CTL); bar.x = 0; bar.st = xb;
    if (hi - lo > 1) bar = xcd_barrier_post((unsigned*)(p.ws + WS_CTL), xb);
#ifndef PHMASK
#define PHMASK 0xFFFFFFu
#endif
#define IN(k) (((PHMASK >> (k)) & 1u) && lo <= (k) && (k) < hi)
#ifndef PROBE_MASK
#define PROBE_MASK 0u
#endif
#ifndef PROBE_MULT
#define PROBE_MULT 1
#endif
    unsigned long long pr_acc = 0, pr_prev = PROBE_MASK ? wall_clock64() : 0ull;
#define SEAM(k) do { if (IN(k) && hi > (k) + 1) xcd_barrier(bar); if (PROBE_MASK) { const unsigned long long _n = wall_clock64(); if ((PROBE_MASK >> (k)) & 1u) pr_acc += _n - pr_prev; pr_prev = _n; } } while (0)
    const unsigned char* ws = p.ws;

    if (IN(0)) { p0_prologue(F); } SEAM(0);
    if (IN(1)) { p_norm_in(F); } SEAM(1);
    if (IN(2)) { PhG1 ph{ws, F.G, F.bid}; eng::gemm_run(F.lds, ph); } SEAM(2);
    if (IN(3)) { PhF1 ph{ws, F.G, F.bid}; eng::gemm_run(F.lds, ph); p_attention(F); } SEAM(3);
    if (IN(4)) { PhF2 ph{ws, F.G, F.bid, p.ctx}; eng::gemm_run(F.lds, ph); } SEAM(4);
    if (IN(5)) { PhG2 ph{ws, F.G, F.bid, p.x, p.out}; eng::gemm_run(F.lds, ph); } SEAM(5);
    if (IN(6)) { p_router(F, 0, 0, WSP(bf16_t, A_XM)); } SEAM(6);
    if (IN(8)) { PhM1 ph{ws, F.G, F.bid}; panel_tab(F, 0, ph.pt); ph.xs = A_XM; ph.hd = A_HD; moe_rowtab(F, 0, ph.pt, 0); eng::gemm_run(F.lds, ph); } SEAM(8);
    if (IN(9)) { PhM2 ph{ws, F.G, F.bid}; panel_tab(F, 0, ph.pt); ph.hd = A_HD; ph.y = A_XS; eng::gemm_run(F.lds, ph); } SEAM(9);
    if (IN(10)) { p_combine0(F); } SEAM(10);
    if (IN(11)) { PhG3 ph{ws, F.G, F.bid};
        ph.lgf = (f32x4){log_gamma(F, 0, 0), log_gamma(F, 0, 1), log_gamma(F, 0, 2), log_gamma(F, 0, 3)}; ph.lgb = (f32x4){log_gamma(F, 1, 0), log_gamma(F, 1, 1), log_gamma(F, 1, 2), log_gamma(F, 1, 3)};
        eng::gemm_run(F.lds, ph); } SEAM(11);
    if (IN(12)) { PhU ph{ws, F.G, F.bid}; eng::gemm_run(F.lds, ph); } SEAM(12);
    if (IN(13)) { p_scan(F); } SEAM(13);
    if (IN(14)) { PhSD ph{ws, F.G, F.bid};
        ph.lgf = (f32x4){log_gamma(F, 0, 0), log_gamma(F, 0, 1), log_gamma(F, 0, 2), log_gamma(F, 0, 3)}; ph.lgb = (f32x4){log_gamma(F, 1, 0), log_gamma(F, 1, 1), log_gamma(F, 1, 2), log_gamma(F, 1, 3)};
        eng::gemm_run(F.lds, ph); } SEAM(14);
    if (IN(15)) { PhO ph{ws, F.G, F.bid};
        ph.lgf = (f32x4){log_gamma(F, 0, 0), log_gamma(F, 0, 1), log_gamma(F, 0, 2), log_gamma(F, 0, 3)}; ph.lgb = (f32x4){log_gamma(F, 1, 0), log_gamma(F, 1, 1), log_gamma(F, 1, 2), log_gamma(F, 1, 3)};
        eng::gemm_run(F.lds, ph); } SEAM(15);
    if (IN(17)) { PhGG ph{ws, F.G, F.bid}; eng::gemm_run(F.lds, ph); } SEAM(17);
    if (IN(18)) { PhG4 ph{ws, F.G, F.bid, p.out}; eng::gemm_run(F.lds, ph); conv_moe(F, 1); } SEAM(18);
    if (IN(19)) { p_router(F, 1, CTXN, WSP(bf16_t, B_XM2)); } SEAM(19);
    if (IN(21)) { PhM1 ph{ws, F.G, F.bid}; panel_tab(F, 1, ph.pt); ph.xs = B_XM2; ph.hd = B_HD; moe_rowtab(F, 1, ph.pt, CTXN); eng::gemm_run(F.lds, ph); } SEAM(21);
    if (IN(22)) { PhM2 ph{ws, F.G, F.bid}; panel_tab(F, 1, ph.pt); ph.hd = B_HD; ph.y = B_XS; eng::gemm_run(F.lds, ph); } SEAM(22);
    if (IN(23)) { p_final(F); }
    if (PROBE_MASK) { SEAM(23); if (F.bid == 0) { const unsigned long long t0 = wall_clock64(); while (wall_clock64() - t0 < pr_acc * PROBE_MULT) __builtin_amdgcn_s_sleep(8); } }
#undef IN
#undef SEAM
}

extern "C" void kernel_launch(void* const* d_in, const int* in_sizes, int n_in, void* d_out, int out_size, void* d_ws, size_t ws_size, hipStream_t stream) {
    static int grid = 0;
    if (grid == 0) {
        if (n_in != 19 || out_size != SEQ * DM || ws_size < WS_END) { fprintf(stderr, "kernel_launch: unexpected shapes (n_in %d, out %d, ws %zu < %zu)\n", n_in, out_size, ws_size, (size_t)WS_END); grid = -1; return; }
        int dev = 0, cus = 0, per_cu = 0;
        if (hipGetDevice(&dev) != hipSuccess || hipDeviceGetAttribute(&cus, hipDeviceAttributeMultiprocessorCount, dev) != hipSuccess) { grid = -1; return; }
        if (hipFuncSetAttribute((const void*)mk_fwd, hipFuncAttributeMaxDynamicSharedMemorySize, LDS_BYTES) != hipSuccess) { fprintf(stderr, "kernel_launch: hipFuncSetAttribute failed\n"); grid = -1; return; }
        if (hipOccupancyMaxActiveBlocksPerMultiprocessor(&per_cu, (const void*)mk_fwd, 512, LDS_BYTES) != hipSuccess || per_cu < 1) { fprintf(stderr, "kernel_launch: occupancy query says %d\n", per_cu); per_cu = 1; }
        (void)hipGetLastError();
        grid = cus;
        if (grid > 256) grid = 256;
    }
    if (grid < 0) return;
    (void)hipMemsetAsync((char*)d_ws + WS_CTL, 0, CTL_BYTES, stream);
    Params p{};
    const float** pp = (const float**)&p;
    for (int i = 0; i < 19; ++i) pp[i] = (const float*)d_in[i];
    p.out = (float*)d_out; p.ws = (unsigned char*)d_ws;
#if MK_PER_PHASE
    for (int ph = 0; ph < NPHASE; ++ph) { p.ph_lo = ph; p.ph_hi = ph + 1; hipLaunchKernelGGL(mk_fwd, dim3(grid), dim3(512), LDS_BYTES, stream, p); }
#else
    p.ph_lo = 0; p.ph_hi = NPHASE; hipLaunchKernelGGL(mk_fwd, dim3(grid), dim3(512), LDS_BYTES, stream, p);
#endif
}
```

```cpp
#include <hip/hip_runtime.h>
#include <cstdio>
#include <cstdint>

typedef unsigned short bf16_t;
typedef short bf16x8 __attribute__((ext_vector_type(8)));
typedef float f32x4 __attribute__((ext_vector_type(4)));
typedef float f32x2 __attribute__((ext_vector_type(2)));
typedef unsigned u32x2 __attribute__((ext_vector_type(2)));
typedef unsigned u32x4 __attribute__((ext_vector_type(4)));
#define LAS __attribute__((address_space(3)))

constexpr int DM = 1024, SEQ = 16384, CTXN = 256, TT = SEQ + CTXN  , GW = 64;
constexpr int NH0 = 12, QK0_LD = 1536, W0IN_ROWS = 2816;
constexpr int NPMAX = 146;
constexpr float RMS_EPS = 1e-6f;
constexpr int NPHASE = 24;

constexpr size_t KiB = 1024, MiB = 1024 * 1024, HMiB = 512 * 1024;
constexpr size_t WS_CTL = 0;
constexpr size_t CTL_BYTES = 64 * KiB;
constexpr size_t CTL_CNT = 16 * KiB;
constexpr size_t CTL_QUEUE = 20 * KiB;
constexpr size_t WS_MOD = 64 * KiB;
constexpr size_t WS_TWC = 256 * KiB, WS_TWS = 320 * KiB;
constexpr size_t WS_ROPEC = 384 * KiB, WS_ROPES = 448 * KiB;
constexpr size_t WS_F1T = 512 * KiB, WS_F2P = 640 * KiB;
constexpr size_t WS_CS256 = 768 * KiB;
constexpr size_t WS_HC = 1 * MiB;
constexpr size_t WS_EID = 2 * MiB;
constexpr size_t WS_GW = 2 * MiB + 256 * KiB;
constexpr size_t WS_SLOT = 2 * MiB + 512 * KiB;
constexpr size_t WS_SSQ = 3 * MiB;
constexpr size_t WS_XTC = 5 * MiB;
constexpr size_t WS_PERM = 6 * MiB;
constexpr size_t WS_W0IN = 8 * MiB, WS_W0OUT = 14 * MiB, WS_W1IN = 16 * MiB, WS_W1OUT = 28 * MiB;
constexpr size_t AR = 32 * MiB;
constexpr size_t A_XM = AR + 0, A_QK0 = AR + 65 * HMiB, A_VT0 = AR + 81 * MiB + 256 * KiB, A_XT2 = AR + 106 * MiB, A_T2 = AR + 122 * MiB + HMiB, A_AO = AR + 139 * MiB;
constexpr size_t A_XS = AR + 65 * HMiB, A_HD = AR + 106 * MiB, A_MOEW = AR + 245 * MiB;
constexpr size_t B_Q = AR + 0, B_K = AR + 65 * HMiB, B_O = AR + 65 * HMiB, B_KF = AR + 195 * HMiB, B_KB = AR + 130 * MiB, B_SD = AR + 195 * HMiB, B_VT = AR + 325 * HMiB;
constexpr size_t B_XM1 = AR + 455 * HMiB, B_ST = AR + 455 * HMiB, B_XM1B = AR + 0, B_XM2 = AR + 0, B_XS = AR + 195 * HMiB, B_HD = AR + 341 * HMiB;
constexpr size_t B_XM1A = AR + 587 * HMiB;
constexpr size_t WS_END = AR + 319 * MiB;

struct Params {
    const float *x, *c, *ctx, *c_ctx, *ada_w, *ada_b, *norm_g, *final_g, *w0in, *w0out, *rpb, *w1in, *w1out, *decay, *router_w, *router_b, *moe_w1, *moe_w3, *moe_w2;
    float* out; unsigned char* ws; int ph_lo, ph_hi;
};

__device__ __forceinline__ unsigned cvt_pk_bf16(float lo, float hi) { unsigned r; asm volatile("v_cvt_pk_bf16_f32 %0, %1, %2" : "=v"(r) : "v"(lo), "v"(hi)); return r; }
__device__ __forceinline__ bf16_t f2bf(float f) { return (bf16_t)(cvt_pk_bf16(f, 0.f) & 0xffffu); }
__device__ __forceinline__ float bf2f(unsigned short b) { return __uint_as_float(((unsigned)b) << 16); }
__device__ __forceinline__ float bflo(unsigned w) { return __uint_as_float(w << 16); }
__device__ __forceinline__ float bfhi(unsigned w) { return __uint_as_float(w & 0xffff0000u); }
__device__ __forceinline__ float silu_f(float v) { return v / (1.0f + __expf(-v)); }
__device__ __forceinline__ float wave_sum(float v) {
#pragma unroll
    for (int o = 32; o >= 1; o >>= 1) v += __shfl_xor(v, o);
    return v;
}
__device__ __forceinline__ float wave_max(float v) {
#pragma unroll
    for (int o = 32; o >= 1; o >>= 1) v = fmaxf(v, __shfl_xor(v, o));
    return v;
}
#define XB_TMO      128
#define XB_XCNT(j)  (256  + 64 * (j))
#define XB_XSUB(j)  (1280 + 64 * (j))
#define XB_XGEN(j)  (2304 + 64 * (j))
#define XB_TOP      3328
#define XB_TOPGEN   3392
#define XCD_BAR_WORDS 3456
#define XB_SPIN_CAP (1u << 18)

__device__ __forceinline__ unsigned xb_ld(unsigned* p)              { return __hip_atomic_load(p, __ATOMIC_RELAXED, __HIP_MEMORY_SCOPE_AGENT); }
__device__ __forceinline__ unsigned xb_add(unsigned* p, unsigned v) { return __hip_atomic_fetch_add(p, v, __ATOMIC_RELAXED, __HIP_MEMORY_SCOPE_AGENT); }
__device__ __forceinline__ unsigned xb_xcc_id() { return (unsigned)__builtin_amdgcn_s_getreg((3 << 11) | 20) & 0xFu; }
#define XB_SPIN(cond, bar) do { unsigned _sp = 0; while (cond) { __builtin_amdgcn_s_sleep(1); \
    if ((++_sp & 255u) == 0u) { if (xb_ld(&(bar)[XB_TMO])) break; if (_sp > XB_SPIN_CAP) { atomicAdd(&(bar)[XB_TMO], 1u); break; } } } } while (0)

struct XcdBarrier {
    unsigned* bar; unsigned x;
    volatile LAS unsigned* st;
};

__device__ __forceinline__ XcdBarrier xcd_barrier_post(unsigned* bar, volatile LAS unsigned* st) {
    XcdBarrier b; b.bar = bar; b.x = xb_xcc_id(); b.st = st;
    if (threadIdx.x == 0) (void)xb_add(&bar[XB_XCNT(b.x)], 1u);
    return b;
}
__device__ __forceinline__ void xcd_barrier_complete(unsigned* bar, unsigned x, unsigned& nloc, unsigned& nx) {
    const unsigned G = gridDim.x * gridDim.y * gridDim.z;
    unsigned sum, cnt, mine, sp = 0u;
    for (;;) {
        sum = 0u; cnt = 0u; mine = 0u;
#pragma unroll
        for (unsigned j = 0; j < 16; ++j) { const unsigned c = xb_ld(&bar[XB_XCNT(j)]); sum += c; cnt += (c > 0u) ? 1u : 0u; mine = (j == x) ? c : mine; }
        if (sum == G) break;
        __builtin_amdgcn_s_sleep(1);
        if ((++sp & 255u) == 0u) { if (xb_ld(&bar[XB_TMO])) break; if (sp > XB_SPIN_CAP) { atomicAdd(&bar[XB_TMO], 1u); break; } }
    }
    nloc = mine > 0u ? mine : 1u; nx = cnt > 0u ? cnt : 1u;
}

__device__ __forceinline__ void xcd_barrier(const XcdBarrier& b) {
    asm volatile("s_waitcnt vmcnt(0)" ::: "memory");
    __syncthreads();
    if (threadIdx.x == 0) {
        unsigned* bar = b.bar;
        __builtin_amdgcn_s_waitcnt(0);
        unsigned nloc = b.st[0], nx = b.st[1];
        if (nloc == 0u) { xcd_barrier_complete(bar, b.x, nloc, nx); b.st[0] = nloc; b.st[1] = nx; }
        const unsigned old = xb_add(&bar[XB_XSUB(b.x)], 1u);
        const unsigned gen = old / nloc;
        if (old + 1u == (gen + 1u) * nloc) {
            __builtin_amdgcn_fence(__ATOMIC_RELEASE, "agent");
            asm volatile("s_waitcnt vmcnt(0)" ::: "memory");
            const unsigned og = xb_add(&bar[XB_TOP], 1u);
            const unsigned tg = og / nx;
            if (og + 1u == (tg + 1u) * nx) xb_add(&bar[XB_TOPGEN], 1u);
            else XB_SPIN(xb_ld(&bar[XB_TOPGEN]) == tg, bar);
            __builtin_amdgcn_fence(__ATOMIC_ACQUIRE, "agent");
            xb_add(&bar[XB_XGEN(b.x)], 1u);
            asm volatile("s_waitcnt vmcnt(0)" ::: "memory");
        } else {
            XB_SPIN(xb_ld(&bar[XB_XGEN(b.x)]) == gen, bar);
            __builtin_amdgcn_fence(__ATOMIC_ACQUIRE, "agent");
            asm volatile("s_waitcnt vmcnt(0)" ::: "memory");
        }
    }
    __syncthreads();
}
namespace eng {
constexpr int BM = 256, BK = 64, HALF = 128, HTB = HALF * BK * 2, STAGE_BYTES = 8 * HTB;
__device__ __forceinline__ int lds_byte(int r, int c) { const int st = (r >> 4) * 2 + (c >> 5), rr = r & 15, cc = c & 31, ob = rr * 64 + cc * 2; return st * 1024 + (ob ^ (((ob >> 9) & 1) << 5)); }
__device__ __forceinline__ void stage_rc(int b, int& R, int& C) { const int st = b / 1024, sb = b % 1024, swz = sb ^ (((sb >> 9) & 1) << 5); R = (st >> 1) * 16 + swz / 64; C = (st & 1) * 32 + (swz % 64) / 2; }

struct UnitD {
    const char* A0; const char* B0; unsigned lda0, ldb0; int n0;
    const char* A1; const char* B1; unsigned lda1, ldb1; int n1;
    const char* A2; const char* B2; unsigned lda2, ldb2; int n2;
    int kind, i0, i1, i2;
};
struct TD { const char* a; const char* b; unsigned lda, ldb; int gpar; };
__device__ __forceinline__ TD tile_at(const UnitD& u, int t) {
    TD d;
    if (t < u.n0) { d.a = u.A0 + (size_t)t * 128; d.b = u.B0 + (size_t)t * 128; d.lda = u.lda0; d.ldb = u.ldb0; }
    else if (t < u.n0 + u.n1) { const int s = t - u.n0; d.a = u.A1 + (size_t)s * 128; d.b = u.B1 + (size_t)s * 128; d.lda = u.lda1; d.ldb = u.ldb1; }
    else { const int s = t - u.n0 - u.n1; d.a = u.A2 + (size_t)s * 128; d.b = u.B2 + (size_t)s * 128; d.lda = u.lda2; d.ldb = u.ldb2; }
    return d;
}
typedef f32x4 Acc[2][2][4][2];

template <class P>
__device__ __forceinline__ void gemm_run(LAS unsigned char* lds, const P& ph) {
    const int tid = threadIdx.x, wid = __builtin_amdgcn_readfirstlane(tid >> 6), lane = tid & 63, wr = wid >> 2, wc = wid & 3, fr = lane & 15, fq = lane >> 4;
    int R0, C0; stage_rc(tid * 16, R0, C0);
    const unsigned vR = (unsigned)R0, vC2 = (unsigned)C0 * 2u;
    const unsigned ldsw = (unsigned)wid * 1024u;
    const int aoff = lds_byte(wr * 64 + fr, fq * 8), boff = lds_byte(wc * 32 + fr, fq * 8);
#define EG_SA(b, h) (((b) * 2 + (h)) * HTB)
#define EG_SB(b, h) ((4 + (b) * 2 + (h)) * HTB)
#define EG_STAGE(bufoff, gbase, ld) do { const unsigned _ld = (ld); const char* _g = (gbase) + (size_t)(vR * _ld + vC2); \
        __builtin_amdgcn_global_load_lds((const unsigned*)_g, (LAS unsigned*)(lds + (bufoff) + ldsw), 16, 0, 0); \
        __builtin_amdgcn_global_load_lds((const unsigned*)(_g + (size_t)(64u * _ld)), (LAS unsigned*)(lds + (bufoff) + ldsw + 8192), 16, 0, 0); } while (0)
#define EG_STAGEA(bufoff, d, h) do { if constexpr (P::GATHER) { const char* _g = (d).a + vC2; const unsigned _o0 = (d).gpar ? gB[(h) * 2] : gA[(h) * 2], _o1 = (d).gpar ? gB[(h) * 2 + 1] : gA[(h) * 2 + 1]; \
        __builtin_amdgcn_global_load_lds((const unsigned*)(_g + _o0), (LAS unsigned*)(lds + (bufoff) + ldsw), 16, 0, 0); \
        __builtin_amdgcn_global_load_lds((const unsigned*)(_g + _o1), (LAS unsigned*)(lds + (bufoff) + ldsw + 8192), 16, 0, 0); } \
        else EG_STAGE(bufoff, (d).a + (size_t)((h) * 128u * (d).lda), (d).lda); } while (0)
#define EG_LDA(dst, b, h) do { _Pragma("unroll") for (int m = 0; m < 4; ++m) _Pragma("unroll") for (int k = 0; k < 2; ++k) dst[m][k] = *(const LAS bf16x8*)(lds + EG_SA(b, h) + aoff + m * 2048 + k * 1024); } while (0)
#define EG_LDB(dst, b, h) do { _Pragma("unroll") for (int n = 0; n < 2; ++n) _Pragma("unroll") for (int k = 0; k < 2; ++k) dst[n][k] = *(const LAS bf16x8*)(lds + EG_SB(b, h) + boff + n * 2048 + k * 1024); } while (0)
#define EG_MMA(ai, bj, At, Bt) do { __builtin_amdgcn_s_setprio(1); _Pragma("unroll") for (int m = 0; m < 4; ++m) _Pragma("unroll") for (int n = 0; n < 2; ++n) _Pragma("unroll") for (int k = 0; k < 2; ++k) \
        acc[ai][bj][m][n] = __builtin_amdgcn_mfma_f32_16x16x32_bf16(Bt[n][k], At[m][k], acc[ai][bj][m][n], 0, 0, 0); __builtin_amdgcn_s_setprio(0); } while (0)
#define EG_WAIT_V(n) asm volatile("s_waitcnt vmcnt(" #n ")" ::: "memory")
#define EG_WAIT_L(n) asm volatile("s_waitcnt lgkmcnt(" #n ")" ::: "memory")
#define EG_BAR __builtin_amdgcn_s_barrier()
#define EG_SCHED __builtin_amdgcn_sched_barrier(0)
    UnitD cur; int ui = 0;
    if (!ph.get(0, cur)) return;
    UnitD cu = cur; int cui = 0, ct = 0; bool cvalid = true; TD lastTD = tile_at(cur, 0); lastTD.gpar = 0;
    unsigned gA[4] = {0u, 0u, 0u, 0u}, gB[4] = {0u, 0u, 0u, 0u};
    const LAS unsigned* rowtab = (const LAS unsigned*)(lds + STAGE_BYTES + 1024);
#define EG_GLOAD(ord) do { if constexpr (P::GATHER) { if ((ord) & 1) { _Pragma("unroll") for (int _k = 0; _k < 4; ++_k) gB[_k] = rowtab[(ord) * 256 + (_k >> 1) * 128 + (_k & 1) * 64 + vR]; } \
        else { _Pragma("unroll") for (int _k = 0; _k < 4; ++_k) gA[_k] = rowtab[(ord) * 256 + (_k >> 1) * 128 + (_k & 1) * 64 + vR]; } } } while (0)
    EG_GLOAD(0);
#define EG_NEXT(dst) do { if (cvalid) { dst = tile_at(cu, ct); dst.gpar = cui & 1; lastTD = dst; ++ct; if (ct == cu.n0 + cu.n1 + cu.n2) { ++cui; ct = 0; cvalid = ph.get(cui, cu); if (cvalid) EG_GLOAD(cui); } } else dst = lastTD; } while (0)
    Acc acc;
#pragma unroll
    for (int a = 0; a < 2; ++a)
#pragma unroll
        for (int b = 0; b < 2; ++b)
#pragma unroll
            for (int m = 0; m < 4; ++m)
#pragma unroll
                for (int n = 0; n < 2; ++n) acc[a][b][m][n] = (f32x4){0.f, 0.f, 0.f, 0.f};
    bf16x8 At[4][2], B0[2][2], B1[2][2];
    TD d1, d2, d3;
    { TD d0; EG_NEXT(d0); EG_NEXT(d1);
      EG_STAGE(EG_SB(0, 0), d0.b, d0.ldb); EG_STAGEA(EG_SA(0, 0), d0, 0); EG_STAGE(EG_SB(0, 1), d0.b + (size_t)(128u * d0.ldb), d0.ldb); EG_STAGEA(EG_SA(0, 1), d0, 1); }
    if (wr == 1) EG_BAR;
    EG_WAIT_V(4); EG_BAR;
    EG_STAGE(EG_SB(1, 0), d1.b, d1.ldb); EG_STAGEA(EG_SA(1, 0), d1, 0); EG_STAGE(EG_SB(1, 1), d1.b + (size_t)(128u * d1.ldb), d1.ldb);
    EG_WAIT_V(6); EG_BAR;
    int tc = 0;
    for (;;) {
        EG_NEXT(d2); EG_NEXT(d3);
        if constexpr (P::HOOKS) { int fr_o = fr; asm volatile("" : "+v"(fr_o)); ph.hook(tc, acc, cur, wr, wc, fr_o, fq); }
        EG_LDB(B0, 0, 0); EG_SCHED; EG_LDA(At, 0, 0); EG_STAGEA(EG_SA(1, 1), d1, 1);
        EG_WAIT_L(8); EG_BAR; EG_WAIT_L(0); EG_MMA(0, 0, At, B0); EG_BAR; EG_SCHED;
        EG_LDB(B1, 0, 1); EG_STAGE(EG_SB(0, 0), d2.b, d2.ldb);
        EG_BAR; EG_WAIT_L(0); EG_MMA(0, 1, At, B1); EG_BAR;
        EG_LDA(At, 0, 1); EG_STAGEA(EG_SA(0, 0), d2, 0);
        EG_BAR; EG_WAIT_L(0); EG_MMA(1, 0, At, B0); EG_BAR; EG_SCHED;
        EG_STAGE(EG_SB(0, 1), d2.b + (size_t)(128u * d2.ldb), d2.ldb);
        EG_WAIT_V(6); EG_BAR; EG_MMA(1, 1, At, B1); EG_BAR;
        EG_LDB(B0, 1, 0); EG_SCHED; EG_LDA(At, 1, 0); EG_STAGEA(EG_SA(0, 1), d2, 1);
        EG_WAIT_L(8); EG_BAR; EG_WAIT_L(0); EG_MMA(0, 0, At, B0); EG_BAR; EG_SCHED;
        EG_LDB(B1, 1, 1); EG_STAGE(EG_SB(1, 0), d3.b, d3.ldb);
        EG_BAR; EG_WAIT_L(0); EG_MMA(0, 1, At, B1); EG_BAR;
        EG_LDA(At, 1, 1); EG_STAGEA(EG_SA(1, 0), d3, 0);
        EG_BAR; EG_WAIT_L(0); EG_MMA(1, 0, At, B0); EG_BAR; EG_SCHED;
        EG_STAGE(EG_SB(1, 1), d3.b + (size_t)(128u * d3.ldb), d3.ldb);
        EG_WAIT_V(6); EG_BAR; EG_MMA(1, 1, At, B1); EG_BAR;
        d1 = d3; tc += 2;
        if (tc == cur.n0 + cur.n1 + cur.n2) {
            { int fr_o = fr, fq_o = fq; asm volatile("" : "+v"(fr_o), "+v"(fq_o));
              ph.epi(acc, cur, wr, wc, fr_o, fq_o); }
            ++ui; tc = 0;
            if (!ph.get(ui, cur)) break;
#pragma unroll
            for (int a = 0; a < 2; ++a)
#pragma unroll
                for (int b = 0; b < 2; ++b)
#pragma unroll
                    for (int m = 0; m < 4; ++m)
#pragma unroll
                        for (int n = 0; n < 2; ++n) acc[a][b][m][n] = (f32x4){0.f, 0.f, 0.f, 0.f};
        }
    }
    EG_WAIT_V(0);
    if (wr == 0) EG_BAR;
    EG_BAR;
#undef EG_NEXT
#undef EG_GLOAD
}
__device__ __forceinline__ void unit1(UnitD& u, const void* A, unsigned lda, const void* B, unsigned ldb, int nt) {
    u.A0 = (const char*)A; u.B0 = (const char*)B; u.lda0 = lda; u.ldb0 = ldb; u.n0 = nt;
    u.A1 = u.A0; u.B1 = u.B0; u.lda1 = lda; u.ldb1 = ldb; u.n1 = 0; u.A2 = u.A0; u.B2 = u.B0; u.lda2 = lda; u.ldb2 = ldb; u.n2 = 0;
    u.kind = 0; u.i0 = 0; u.i1 = 0; u.i2 = 0;
}
}
using eng::UnitD; using eng::Acc;
__device__ __forceinline__ int xcd_remap(int idx, int N) { const int q = N >> 3, r = N & 7, x = idx & 7, off = idx >> 3; return (x < r ? x * (q + 1) : r * (q + 1) + (x - r) * q) + off; }
__device__ __forceinline__ void efence() { asm volatile("" ::: "memory"); }
#define EPI_ARGS const Acc& acc, const UnitD& u, int wr, int wc, int fr, int fq
#define FOR_FRAG(ai, bj, m, n) _Pragma("unroll") for (int ai = 0; ai < 2; ++ai) _Pragma("unroll") for (int m = 0; m < 4; ++m) _Pragma("unroll") for (int bj = 0; bj < 2; efence(), ++bj) _Pragma("unroll") for (int n = 0; n < 2; ++n)
#define FRAG_ROW(ai, m) (128 * (ai) + 64 * wr + 16 * (m) + fr)
#define FRAG_COL(bj, n) (128 * (bj) + 32 * wc + 16 * (n) + 4 * fq)
__device__ __forceinline__ void st_bf16x4(bf16_t* p, f32x4 v) { u32x2 w; w.x = cvt_pk_bf16(v[0], v[1]); w.y = cvt_pk_bf16(v[2], v[3]); *(u32x2*)p = w; }
struct Frame { Params p; LAS unsigned char* lds; int tid, lane, wid, G, bid; };
#define WSP(T, off) ((T*)(F.p.ws + (off)))

template <class RowSrc>
__device__ __forceinline__ void conv_tile(const Frame& F, bf16_t* dst, int K, int ld, float scale, int r0, int k0, const RowSrc& rs) {
    LAS float* tile = (LAS float*)F.lds;
    const int n4 = (F.tid & 15) * 4, kq = F.tid >> 4;
    const float* sp = rs(r0 + n4) + (size_t)(k0 + kq) * ld;
#pragma unroll
    for (int p = 0; p < 8; ++p) { const f32x4 v = *(const f32x4*)(sp + (size_t)(p * 32) * ld); LAS float* q = tile + (p * 32 + kq) * 65 + n4; q[0] = v[0]; q[1] = v[1]; q[2] = v[2]; q[3] = v[3]; }
    __syncthreads();
    const int i2 = (F.tid & 127) * 2, jb = F.tid >> 7;
#pragma unroll
    for (int p = 0; p < 16; ++p) { const int j = p * 4 + jb; *(unsigned*)(dst + (size_t)(r0 + j) * K + k0 + i2) = cvt_pk_bf16(tile[i2 * 65 + j] * scale, tile[(i2 + 1) * 65 + j] * scale); }
    __syncthreads();
}
__device__ __forceinline__ int sigma_orig(int s) {
    const int half = s >> 7, s2 = s & 127, uu = s2 >> 5, b = (s2 >> 4) & 1, f = s2 & 15; return half * 128 + 16 * uu + f + 64 * b;
}
__device__ __forceinline__ void conv_moe_tile(const Frame& F, int layer, int t) {
    bf16_t* w13 = WSP(bf16_t, A_MOEW); bf16_t* w2t = WSP(bf16_t, A_MOEW + 32 * MiB);
    if (t < 1024) { const int e = t >> 6, rt = (t >> 2) & 15, kt = t & 3;
        const float* w1 = F.p.moe_w1 + ((size_t)layer * 16 + e) * 1024 * 512; const float* w3 = F.p.moe_w3 + ((size_t)layer * 16 + e) * 1024 * 512;
        conv_tile(F, w13 + (size_t)e * 1024 * 1024, 1024, 512, 1.0f, rt * 64, kt * 256, [=](int r) { const int j = r >> 8, rr = r & 255; return rr < 128 ? w1 + 128 * j + rr : w3 + 128 * j + rr - 128; });
    } else { const int u = t - 1024, e = u >> 5, rt = (u >> 1) & 15, kt = u & 1;
        const float* w2 = F.p.moe_w2 + ((size_t)layer * 16 + e) * 512 * 1024;
        conv_tile(F, w2t + (size_t)e * 1024 * 512, 512, 1024, 1.0f, rt * 64, kt * 256, [=](int r) { return w2 + r; }); }
}
__device__ __forceinline__ void conv_moe(const Frame& F, int layer) { for (int t = F.bid; t < 1536; t += F.G) conv_moe_tile(F, layer, t); }
__device__ __forceinline__ void conv_small_tile(const Frame& F, int t) {
    if (t < 96) { const float* w = F.p.w0in; conv_tile(F, WSP(bf16_t, WS_W0IN), 1024, 2560, 1.0f, (t >> 2) * 64, (t & 3) * 256, [=](int r) { return w + 256 + r; }); }
    else if (t < 144) { const int u = t - 96; const float* w = F.p.w0in; conv_tile(F, WSP(bf16_t, WS_W0IN) + (size_t)2048 * 1024, 1024, 2560, 1.0f, (u >> 2) * 64, (u & 3) * 256, [=](int r) { return w + 1792 + r; }); }
    else if (t < 208) { const int u = t - 144; const float* w = F.p.w0out; conv_tile(F, WSP(bf16_t, WS_W0OUT), 1024, 1024, 1.0f, (u >> 2) * 64, (u & 3) * 256, [=](int r) { return w + r; }); }
    else if (t < 272) { const int u = t - 208; const float* w = F.p.w1in; conv_tile(F, WSP(bf16_t, WS_W1IN), 1024, 6144, 1.0f, (u >> 2) * 64, (u & 3) * 256, [=](int r) { return w + (r & ~255) + sigma_orig(r & 255); }); }
    else if (t < 336) { const int u = t - 272; const float* w = F.p.w1in; conv_tile(F, WSP(bf16_t, WS_W1IN) + (size_t)1024 * 1024, 1024, 6144, 0.0625f, (u >> 2) * 64, (u & 3) * 256, [=](int r) { return w + 1024 + (r & ~255) + sigma_orig(r & 255); }); }
    else if (t < 592) { const int u = t - 336; const float* w = F.p.w1in; conv_tile(F, WSP(bf16_t, WS_W1IN) + (size_t)2048 * 1024, 1024, 6144, 1.0f, (u >> 2) * 64, (u & 3) * 256, [=](int r) { return w + 2048 + r; }); }
    else { const int u = t - 592; const float* w = F.p.w1out; conv_tile(F, WSP(bf16_t, WS_W1OUT), 2048, 1024, 1.0f, (u >> 3) * 64, (u & 7) * 256, [=](int r) { return w + r; }); }
}
__device__ __forceinline__ void p0_prologue(const Frame& F) {
    const float TWO_PI = 6.283185307179586f;
    {
        LAS float* sc0 = (LAS float*)F.lds; LAS float* sc1 = sc0 + 1024; LAS float* red = sc1 + 1024;
        for (int k = F.tid; k < 1024; k += 512) { sc0[k] = silu_f(F.p.c[k]); sc1[k] = silu_f(F.p.c_ctx[k]); }
        __syncthreads();
        float* mod = WSP(float, WS_MOD);
        for (int item = F.bid; item < 192; item += F.G) {
            const int l = item / 96, col0 = (item % 96) * 64, l16 = F.tid & 15, kg = F.tid >> 4;
            f32x4 a0 = {0.f, 0.f, 0.f, 0.f}, a1 = {0.f, 0.f, 0.f, 0.f};
#pragma unroll 8
            for (int i = 0; i < 32; ++i) { const int k = kg + 32 * i; const f32x4 w = *(const f32x4*)(F.p.ada_w + ((size_t)l * 1024 + k) * 6144 + col0 + l16 * 4); a0 += sc0[k] * w; a1 += sc1[k] * w; }
#pragma unroll
            for (int e = 0; e < 4; ++e) { red[(kg * 64 + l16 * 4 + e) * 2 + 0] = a0[e]; red[(kg * 64 + l16 * 4 + e) * 2 + 1] = a1[e]; }
            __syncthreads();
            if (F.tid < 128) { const int col = F.tid & 63, which = F.tid >> 6; float s = 0.f; for (int g = 0; g < 32; ++g) s += red[(g * 64 + col) * 2 + which];
                mod[(size_t)which * 2 * 6144 + l * 6144 + col0 + col] = s + F.p.ada_b[l * 6144 + col0 + col]; }
            __syncthreads();
        }
    }
    {
        const int gt = F.bid * 512 + F.tid, gn = F.G * 512;
        float* twc = WSP(float, WS_TWC); float* tws = WSP(float, WS_TWS);
        for (int i = gt; i < 128 * 128; i += gn) { const int b = i >> 7, k1 = i & 127; const float a = (float)((b * k1) & 16383) * (TWO_PI / 16384.0f); twc[i] = cosf(a); tws[i] = sinf(a); }
        float* rc = WSP(float, WS_ROPEC); float* rs = WSP(float, WS_ROPES);
        for (int i = gt; i < 256 * 64; i += gn) { const int pos = i >> 6, fi = i & 63; const float inv = powf(10000.0f, -(float)fi / 64.0f); const float a = (float)pos * inv; rc[i] = cosf(a); rs[i] = sinf(a); }
        bf16_t* f1 = WSP(bf16_t, WS_F1T); bf16_t* f2 = WSP(bf16_t, WS_F2P);
        for (int i = gt; i < 256 * 256; i += gn) { const int n = i >> 8, k = i & 255, k1 = n & 127, a = k & 127; const float ang = (float)((a * k1) & 127) * (TWO_PI / 128.0f); const float cs = cosf(ang), sn = sinf(ang);
            float v1; if (n < 128) v1 = (k < 128) ? cs : sn; else v1 = (k < 128) ? -sn : cs;
            f1[i] = f2bf(v1);
            f2[i] = f2bf(n < 128 ? ((k < 128) ? cs : sn) * (1.0f / 128.0f) : 0.0f); }
        bf16_t* cs256 = WSP(bf16_t, WS_CS256);
        for (int i = gt; i < 256 * 512; i += gn) { const int k = i >> 9, j = i & 511, n = j & 255; const float ang = (float)((n * k) & 255) * (TWO_PI / 256.0f); cs256[i] = f2bf((j < 256 ? cosf(ang) : sinf(ang)) * (1.0f / 16.0f)); }
    }
    {
        LAS float* ct = (LAS float*)F.lds; LAS float* wrow = ct + 64 + F.wid * 64;
        __syncthreads();
        if (F.tid < 64) ct[F.tid] = cosf((float)F.tid * (TWO_PI / 64.0f));
        __syncthreads();
        bf16_t* dst = WSP(bf16_t, WS_W0IN);
        for (int it = F.bid * 8 + F.wid; it < 4096; it += F.G * 8) {
            const int k = it >> 2, g = it & 3;
            wrow[F.lane] = F.p.w0in[(size_t)k * 2560 + g * 64 + F.lane];
            float re = 0.f, im = 0.f;
#pragma unroll 16
            for (int c = 0; c < 64; ++c) { const float w = wrow[c]; const int ph = (c * F.lane) & 63; re += w * ct[ph]; im -= w * ct[(ph + 48) & 63]; }
            dst[(size_t)(1536 + g * 64 + F.lane) * 1024 + k] = f2bf(re * 0.125f); dst[(size_t)(1536 + 256 + g * 64 + F.lane) * 1024 + k] = f2bf(im * 0.125f);
        }
        __syncthreads();
    }
    for (int t = F.bid; t < 720; t += F.G) conv_small_tile(F, t);
}

struct Row { f32x4 v[4]; };
__device__ __forceinline__ void row_load(Row& r, const float* p, int lane) {
#pragma unroll
    for (int i = 0; i < 4; ++i) r.v[i] = *(const f32x4*)(p + 4 * lane + 256 * i);
}
__device__ __forceinline__ void row_store(const Row& r, float* p, int lane) {
#pragma unroll
    for (int i = 0; i < 4; ++i) *(f32x4*)(p + 4 * lane + 256 * i) = r.v[i];
}
__device__ __forceinline__ float row_rstd(const Row& r) {
    float s = 0.f;
#pragma unroll
    for (int i = 0; i < 4; ++i) s += (r.v[i][0] * r.v[i][0] + r.v[i][1] * r.v[i][1]) + (r.v[i][2] * r.v[i][2] + r.v[i][3] * r.v[i][3]);
    s = wave_sum(s);
    return rsqrtf(s * (1.0f / 1024.0f) + RMS_EPS);
}
__device__ __forceinline__ void row_norm_mod(Row& r, const float* g, const float* sh, const float* sc, int lane) {
    const float rs = row_rstd(r);
#pragma unroll
    for (int i = 0; i < 4; ++i) { const int c = 4 * lane + 256 * i; const f32x4 gv = *(const f32x4*)(g + c), shv = *(const f32x4*)(sh + c), scv = *(const f32x4*)(sc + c);
        r.v[i] = (r.v[i] * rs) * gv * (1.0f + scv) + shv; }
}
__device__ __forceinline__ void row_store_bf16(const Row& r, bf16_t* p, int lane) {
#pragma unroll
    for (int i = 0; i < 4; ++i) st_bf16x4(p + 4 * lane + 256 * i, r.v[i]);
}
__device__ __forceinline__ const float* modp(const Frame& F, int layer, bool is_ctx) { return WSP(const float, WS_MOD) + (size_t)(is_ctx ? 2 : 0) * 6144 + layer * 6144; }
__device__ __forceinline__ unsigned char* xm1_panel(const unsigned char* ws, int pm) { return (unsigned char*)ws + (pm < 51 ? B_XM1A + (size_t)pm * HMiB : WS_W0IN + (size_t)(pm - 51) * HMiB); }
__device__ __forceinline__ float* hrow(const Frame& F, int t) { return t < CTXN ? WSP(float, WS_HC) + (size_t)t * DM : F.p.out + (size_t)(t - CTXN) * DM; }

__device__ __forceinline__ void p_norm_in(const Frame& F) {
    bf16_t* xm = WSP(bf16_t, A_XM);
    for (int t = F.bid * 8 + F.wid; t < TT; t += F.G * 8) {
        const bool ic = t < CTXN; const float* src = ic ? F.p.ctx + (size_t)t * DM : F.p.x + (size_t)(t - CTXN) * DM; const float* m = modp(F, 0, ic);
        Row r; row_load(r, src, F.lane); row_norm_mod(r, F.p.norm_g, m, m + 1024, F.lane); row_store_bf16(r, xm + (size_t)t * DM, F.lane);
    }
}
__device__ __forceinline__ void p_router(const Frame& F, int layer, int t0, bf16_t* dst) {
    LAS float* rwT = (LAS float*)F.lds;
    LAS unsigned* lcnt = (LAS unsigned*)(F.lds + 65536);
    for (int i = F.tid; i < 16 * 1024; i += 512) { const int e = i >> 10, c = i & 1023; rwT[i] = F.p.router_w[c * 16 + e]; }
    if (F.tid < 32) lcnt[F.tid] = 0u;
    __syncthreads();
    int* eid = WSP(int, WS_EID); float* gw = WSP(float, WS_GW); int* slot = WSP(int, WS_SLOT);
    unsigned* gcnt = (unsigned*)(F.p.ws + WS_CTL + CTL_CNT) + layer * 64;
    for (int t = t0 + F.bid * 8 + F.wid; t < TT; t += F.G * 8) {
        const bool ic = t < CTXN; const float* m = modp(F, layer, ic);
        Row r; row_load(r, hrow(F, t), F.lane); row_norm_mod(r, F.p.norm_g + (size_t)(layer * 2 + 1) * DM, m + 3072, m + 4096, F.lane); row_store_bf16(r, dst + (size_t)t * DM, F.lane);
        float lg[16];
#pragma unroll
        for (int e = 0; e < 16; ++e) { float s = 0.f;
#pragma unroll
            for (int i = 0; i < 4; ++i) { const f32x4 w = *(const LAS f32x4*)(rwT + e * 1024 + 4 * F.lane + 256 * i); s += (r.v[i][0] * w[0] + r.v[i][1] * w[1]) + (r.v[i][2] * w[2] + r.v[i][3] * w[3]); }
            lg[e] = wave_sum(s); }
        float scv[16], bi[16];
#pragma unroll
        for (int e = 0; e < 16; ++e) { scv[e] = 1.0f / (1.0f + __expf(-lg[e])); bi[e] = scv[e] + F.p.router_b[e]; }
        int gsel = 0; float best = -1e30f;
#pragma unroll
        for (int g = 0; g < 4; ++g) { const float a = bi[4 * g], b = bi[4 * g + 1], c = bi[4 * g + 2], d = bi[4 * g + 3];
            const float h1 = fmaxf(a, b), l1 = fminf(a, b), h2 = fmaxf(c, d), l2 = fminf(c, d); const float gs = fmaxf(h1, h2) + fmaxf(fminf(h1, h2), fmaxf(l1, l2));
            if (gs > best) { best = gs; gsel = g; } }
        float vb[4], vs[4];
#pragma unroll
        for (int i = 0; i < 4; ++i) { vb[i] = gsel == 0 ? bi[i] : gsel == 1 ? bi[4 + i] : gsel == 2 ? bi[8 + i] : bi[12 + i]; vs[i] = gsel == 0 ? scv[i] : gsel == 1 ? scv[4 + i] : gsel == 2 ? scv[8 + i] : scv[12 + i]; }
        int i0 = 0; float b0 = vb[0];
#pragma unroll
        for (int i = 1; i < 4; ++i) if (vb[i] > b0) { b0 = vb[i]; i0 = i; }
        int i1 = -1; float b1 = -1e30f;
#pragma unroll
        for (int i = 0; i < 4; ++i) if (i != i0 && vb[i] > b1) { b1 = vb[i]; i1 = i; }
        const float s0 = i0 == 0 ? vs[0] : i0 == 1 ? vs[1] : i0 == 2 ? vs[2] : vs[3], s1 = i1 == 0 ? vs[0] : i1 == 1 ? vs[1] : i1 == 2 ? vs[2] : vs[3];
        const float inv = 1.0f / (s0 + s1);
        if (F.lane == 0) {
            const int e0 = gsel * 4 + i0, e1 = gsel * 4 + i1;
            const unsigned r0 = __hip_atomic_fetch_add(lcnt + e0, 1u, __ATOMIC_RELAXED, __HIP_MEMORY_SCOPE_WORKGROUP), r1 = __hip_atomic_fetch_add(lcnt + e1, 1u, __ATOMIC_RELAXED, __HIP_MEMORY_SCOPE_WORKGROUP);
            eid[2 * t] = e0; eid[2 * t + 1] = e1; gw[2 * t] = s0 * inv; gw[2 * t + 1] = s1 * inv; slot[2 * t] = (int)r0; slot[2 * t + 1] = (int)r1;
        }
    }
    __syncthreads();
    if (F.tid < 16) lcnt[16 + F.tid] = __hip_atomic_fetch_add(gcnt + F.tid, lcnt[F.tid], __ATOMIC_RELAXED, __HIP_MEMORY_SCOPE_AGENT);
    __syncthreads();
    int* perm = WSP(int, WS_PERM);
    for (int t = t0 + F.bid * 8 + F.wid; t < TT; t += F.G * 8)
        if (F.lane < 2) { const int e = eid[2 * t + F.lane], rk = slot[2 * t + F.lane] + (int)lcnt[16 + e]; slot[2 * t + F.lane] = rk; perm[e * TT + rk] = t; }
    __syncthreads();
}
struct PanelTab { int pst[17]; };
__device__ __forceinline__ void panel_tab(const Frame& F, int layer, PanelTab& pt) {
    const unsigned* gcnt = (const unsigned*)(F.p.ws + WS_CTL + CTL_CNT) + layer * 64;
    pt.pst[0] = 0;
#pragma unroll
    for (int e = 0; e < 16; ++e) pt.pst[e + 1] = pt.pst[e] + (int)((__builtin_amdgcn_readfirstlane(gcnt[e]) + 255u) >> 8);
}
__device__ __forceinline__ int pt_start(const PanelTab& pt, int e) { int ps = 0;
#pragma unroll
    for (int j = 0; j < 16; ++j) ps = (e == j) ? pt.pst[j] : ps;
    return ps; }
__device__ __forceinline__ void moe_rowtab(const Frame& F, int layer, const PanelTab& pt, int t_pad) {
    LAS unsigned* rowtab = (LAS unsigned*)(F.lds + eng::STAGE_BYTES + 1024);
    const unsigned* gcnt = (const unsigned*)(F.p.ws + WS_CTL + CTL_CNT) + layer * 64; const int* perm = WSP(const int, WS_PERM);
    const int NU = pt.pst[16] * 4;
    for (int i = 0; i < 4; ++i) { const int idx0 = F.bid + i * F.G; if (idx0 >= NU) break;
        const int p = xcd_remap(idx0, NU) >> 2; int e = 0;
#pragma unroll
        for (int k = 1; k < 16; ++k) e += (p >= pt.pst[k]) ? 1 : 0;
        if (F.tid < 256) { const int rk = (p - pt_start(pt, e)) * 256 + F.tid; const int tok = rk < (int)gcnt[e] ? perm[e * TT + rk] : t_pad; rowtab[i * 256 + F.tid] = (unsigned)tok * 2048u; } }
    __syncthreads();
}
__device__ __forceinline__ void row_moe_combine(const Frame& F, Row& r, int t, int layer, const bf16_t* Y, const PanelTab& pt) {
    const int* slot = WSP(const int, WS_SLOT); const float* gw = WSP(const float, WS_GW); const int* eid = WSP(const int, WS_EID);
    const int s0 = pt_start(pt, eid[2 * t]) * 256 + slot[2 * t], s1 = pt_start(pt, eid[2 * t + 1]) * 256 + slot[2 * t + 1]; const float w0 = gw[2 * t], w1 = gw[2 * t + 1];
    const float* g2 = modp(F, layer, t < CTXN) + 5120;
#pragma unroll
    for (int i = 0; i < 4; ++i) { const int c = 4 * F.lane + 256 * i;
        const u32x2 a = *(const u32x2*)(Y + (size_t)s0 * DM + c), b = *(const u32x2*)(Y + (size_t)s1 * DM + c); const f32x4 gv = *(const f32x4*)(g2 + c);
        f32x4 f; f[0] = w0 * bflo(a.x) + w1 * bflo(b.x); f[1] = w0 * bfhi(a.x) + w1 * bfhi(b.x); f[2] = w0 * bflo(a.y) + w1 * bflo(b.y); f[3] = w0 * bfhi(a.y) + w1 * bfhi(b.y);
        r.v[i] += gv * f; }
}
__device__ __forceinline__ void p_combine0(const Frame& F) {
    const bf16_t* Y = WSP(const bf16_t, A_XS); PanelTab pt; panel_tab(F, 0, pt);
    for (int t = F.bid * 8 + F.wid; t < TT; t += F.G * 8) {
        Row r; float* hp = hrow(F, t); row_load(r, hp, F.lane); row_moe_combine(F, r, t, 0, Y, pt); row_store(r, hp, F.lane);
        const float* m = modp(F, 1, t < CTXN); row_norm_mod(r, F.p.norm_g + 2 * DM, m, m + 1024, F.lane); row_store_bf16(r, (bf16_t*)xm1_panel(F.p.ws, t >> 8) + (size_t)(t & 255) * DM, F.lane);
    }
}
__device__ __forceinline__ void p_final(const Frame& F) {
    const bf16_t* Y = WSP(const bf16_t, B_XS); PanelTab pt; panel_tab(F, 1, pt);
    for (int t = CTXN + F.bid * 8 + F.wid; t < TT; t += F.G * 8) {
        Row r; float* hp = hrow(F, t); row_load(r, hp, F.lane); row_moe_combine(F, r, t, 1, Y, pt);
        const float rs = row_rstd(r);
#pragma unroll
        for (int i = 0; i < 4; ++i) { const f32x4 gv = *(const f32x4*)(F.p.final_g + 4 * F.lane + 256 * i); r.v[i] = (r.v[i] * rs) * gv; }
        row_store(r, hp, F.lane);
    }
}
__device__ __forceinline__ float log_gamma(const Frame& F, int dir, int h) { return log1pf(-expf(F.p.decay[dir * 4 + h])); }
__device__ __forceinline__ void p_scan(const Frame& F) {
    bf16_t* st = WSP(bf16_t, B_ST);
    const int item = F.bid * 512 + F.tid;
    for (int it = item; it < 8 * 16384; it += F.G * 512) {
        const int hd = it >> 14, grp = it & 16383, h = hd >> 1, dir = hd & 1;
        const float lg = log_gamma(F, dir, h), d256 = __expf(256.0f * lg), d512 = __expf(512.0f * lg);
        float s[8];
#pragma unroll
        for (int j = 0; j < 8; ++j) s[j] = 0.f;
#pragma unroll 4
        for (int step = 0; step < 33; ++step) {
            const int c = (dir == 0 || step == 0) ? step : 33 - step;
            u32x4* p = (u32x4*)(st + ((size_t)(c * 8 + hd) * 131072 + (size_t)grp * 8));
            const u32x4 uv = *p; const float dec = (c == 0) ? d256 : d512;
            u32x4 o; o.x = cvt_pk_bf16(s[0], s[1]); o.y = cvt_pk_bf16(s[2], s[3]); o.z = cvt_pk_bf16(s[4], s[5]); o.w = cvt_pk_bf16(s[6], s[7]);
            *p = o;
            s[0] = s[0] * dec + bflo(uv.x); s[1] = s[1] * dec + bfhi(uv.x); s[2] = s[2] * dec + bflo(uv.y); s[3] = s[3] * dec + bfhi(uv.y);
            s[4] = s[4] * dec + bflo(uv.z); s[5] = s[5] * dec + bfhi(uv.z); s[6] = s[6] * dec + bflo(uv.w); s[7] = s[7] * dec + bfhi(uv.w);
        }
    }
}
#define PH_COMMON const unsigned char* ws; int G, bid; static constexpr bool HOOKS = false, GATHER = false; \
    __device__ __forceinline__ void hook(int, Acc&, const UnitD&, int, int, int, int) const {}
#define WSC(T, off) ((T*)(ws + (off)))
__device__ __forceinline__ float sel4(f32x4 v, int h) { const float a = h == 0 ? v[0] : v[1], b = h == 2 ? v[2] : v[3]; return h < 2 ? a : b; }
#define SEL4(a, h) sel4(a, h)
#define EFENCE asm volatile("" ::: "memory")

struct PhG1 { PH_COMMON
    __device__ __forceinline__ bool get(int i, UnitD& u) const {
        const int idx = bid + i * G; if (idx >= 715) return false;
        const char* xm = (const char*)(ws + A_XM); const char* w = (const char*)(ws + WS_W0IN);
        if (idx < 390) { const int v = xcd_remap(idx, 390), pm = v / 6, pn = v % 6; eng::unit1(u, xm + (size_t)pm * 256 * 2048, 2048, w + (size_t)pn * 256 * 2048, 2048, 16); u.kind = 0; u.i0 = pm; u.i1 = pn; }
        else { const int j = xcd_remap(idx - 390, 325), ct = j / 5, rt = j % 5; eng::unit1(u, w + (size_t)(1536 + rt * 256) * 2048, 2048, xm + (size_t)ct * 256 * 2048, 2048, 16); u.kind = rt < 2 ? 1 : 2; u.i0 = rt; u.i1 = ct; }
        return true;
    }
    __device__ __forceinline__ void epi(EPI_ARGS) const {
        if (u.kind == 0) { bf16_t* o = WSC(bf16_t, A_QK0) + (size_t)(u.i0 * 256) * QK0_LD + u.i1 * 256;
            FOR_FRAG(ai, bj, m, n) st_bf16x4(o + (size_t)FRAG_ROW(ai, m) * QK0_LD + FRAG_COL(bj, n), acc[ai][bj][m][n]); }
        else if (u.kind == 2) { bf16_t* o = WSC(bf16_t, A_VT0) + (size_t)((u.i0 - 2) * 256) * TT + u.i1 * 256;
            FOR_FRAG(ai, bj, m, n) st_bf16x4(o + (size_t)FRAG_ROW(ai, m) * TT + FRAG_COL(bj, n), acc[ai][bj][m][n]); }
        else if (u.i1 == 0) { bf16_t* o = WSC(bf16_t, WS_XTC) + u.i0 * 256;
            FOR_FRAG(ai, bj, m, n) st_bf16x4(o + (size_t)FRAG_ROW(ai, m) * 512 + FRAG_COL(bj, n), acc[ai][bj][m][n]); }
        else { bf16_t* o = WSC(bf16_t, A_XT2) + u.i0 * 128;
            FOR_FRAG(ai, bj, m, n) { const int cc = FRAG_ROW(ai, m), nn = (u.i1 - 1) * 256 + FRAG_COL(bj, n), a = nn >> 7, b = nn & 127; const f32x4 v = acc[ai][bj][m][n];
#pragma unroll
                for (int e = 0; e < 4; ++e) o[(size_t)(cc * 128 + b + e) * 256 + a] = f2bf(v[e]);
                EFENCE; } }
    }
};
struct PhF1 { PH_COMMON
    __device__ __forceinline__ bool get(int i, UnitD& u) const {
        const int idx = bid + i * G; if (idx >= 129) return false;
        if (idx < 128) { eng::unit1(u, ws + A_XT2 + (size_t)idx * 256 * 512, 512, ws + WS_F1T, 512, 4); u.kind = 0; u.i0 = idx; }
        else { eng::unit1(u, ws + WS_CS256, 1024, ws + WS_XTC, 1024, 8); u.kind = 1; }
        return true;
    }
    __device__ __forceinline__ void epi(EPI_ARGS) const {
        if (u.kind == 1) { bf16_t* o = WSC(bf16_t, A_AO); FOR_FRAG(ai, bj, m, n) st_bf16x4(o + (size_t)FRAG_ROW(ai, m) * DM + FRAG_COL(bj, n), acc[ai][bj][m][n]); return; }
        const float* twc = WSC(const float, WS_TWC); const float* tws = WSC(const float, WS_TWS); bf16_t* o = WSC(bf16_t, A_T2);
#pragma unroll
        for (int m = 0; m < 4; ++m)
#pragma unroll
            for (int n = 0; n < 2; ++n) { const int b = 64 * wr + 16 * m + fr, k1 = 32 * wc + 16 * n + 4 * fq; const f32x4 cv = *(const f32x4*)(twc + b * 128 + k1), sv = *(const f32x4*)(tws + b * 128 + k1);
#pragma unroll
                for (int ai = 0; ai < 2; ++ai) { const int cc = 2 * u.i0 + ai; const f32x4 tr = acc[ai][0][m][n], ti = acc[ai][1][m][n];
#pragma unroll
                    for (int e = 0; e < 4; ++e) { bf16_t* q = o + (size_t)((k1 + e) * 256 + cc) * 256 + b; q[0] = f2bf(tr[e] * cv[e] + ti[e] * sv[e]); q[128] = f2bf(ti[e] * cv[e] - tr[e] * sv[e]); } } }
    }
};
struct PhF2 { PH_COMMON const float* ctx;
    __device__ __forceinline__ bool get(int i, UnitD& u) const {
        const int idx = bid + i * G; if (idx >= 132) return false;
        if (idx < 128) { eng::unit1(u, ws + WS_F2P, 512, ws + A_T2 + (size_t)idx * 256 * 512, 512, 4); u.i0 = idx; }
        else { const int pn = idx - 128; eng::unit1(u, ws + A_AO, 2048, ws + WS_W0OUT + (size_t)pn * 256 * 2048, 2048, 16); u.kind = 1; u.i1 = pn; }
        return true;
    }
    __device__ __forceinline__ void epi(EPI_ARGS) const {
        if (u.kind == 1) { const float* g1 = WSC(const float, WS_MOD) + 2 * 6144 + 2048 + u.i1 * 256; float* dst = WSC(float, WS_HC);
            FOR_FRAG(ai, bj, m, n) { const size_t off = (size_t)FRAG_ROW(ai, m) * DM + u.i1 * 256 + FRAG_COL(bj, n); const f32x4 gv = *(const f32x4*)(g1 + FRAG_COL(bj, n));
                *(f32x4*)(dst + off) = *(const f32x4*)(ctx + off) + gv * acc[ai][bj][m][n]; }
            return; }
        bf16_t* o = WSC(bf16_t, A_AO);
#pragma unroll
        for (int m = 0; m < 4; ++m)
#pragma unroll
            for (int bj = 0; bj < 2; ++bj)
#pragma unroll
                for (int n = 0; n < 2; ++n) { const int k2 = FRAG_ROW(0, m); st_bf16x4(o + (size_t)(CTXN + u.i0 + 128 * k2) * DM + FRAG_COL(bj, n), acc[0][bj][m][n]); }
    }
};
struct PhG2 { PH_COMMON const float* x; float* out;
    __device__ __forceinline__ bool get(int i, UnitD& u) const {
        const int idx0 = bid + i * G; if (idx0 >= 256) return false;
        const int idx = xcd_remap(idx0, 256), pm = 1 + (idx >> 2), pn = idx & 3; eng::unit1(u, ws + A_AO + (size_t)pm * 256 * 2048, 2048, ws + WS_W0OUT + (size_t)pn * 256 * 2048, 2048, 16); u.i0 = pm; u.i1 = pn; return true;
    }
    __device__ __forceinline__ void epi(EPI_ARGS) const {
        const float* g1 = WSC(const float, WS_MOD) + 2048 + u.i1 * 256;
        const float* src = x + (size_t)(u.i0 - 1) * 256 * DM; float* dst = out + (size_t)(u.i0 - 1) * 256 * DM;
        FOR_FRAG(ai, bj, m, n) { const size_t off = (size_t)FRAG_ROW(ai, m) * DM + u.i1 * 256 + FRAG_COL(bj, n); const f32x4 gv = *(const f32x4*)(g1 + FRAG_COL(bj, n));
            *(f32x4*)(dst + off) = *(const f32x4*)(src + off) + gv * acc[ai][bj][m][n]; }
    }
};
struct PhM1 { const unsigned char* ws; int G, bid; PanelTab pt; size_t xs, hd; static constexpr bool HOOKS = false, GATHER = true;
    __device__ __forceinline__ void hook(int, Acc&, const UnitD&, int, int, int, int) const {}
    __device__ __forceinline__ bool get(int i, UnitD& u) const {
        const int idx0 = bid + i * G, NU = pt.pst[16] * 4; if (idx0 >= NU) return false;
        const int idx = xcd_remap(idx0, NU), p = idx >> 2, j = idx & 3; int e = 0;
#pragma unroll
        for (int k = 1; k < 16; ++k) e += (p >= pt.pst[k]) ? 1 : 0;
        eng::unit1(u, ws + xs, 2048, ws + A_MOEW + ((size_t)e * 1024 + j * 256) * 2048, 2048, 16); u.i0 = p; u.i1 = j; return true;
    }
    __device__ __forceinline__ void epi(EPI_ARGS) const {
        bf16_t* o = (bf16_t*)(ws + hd) + (size_t)(u.i0 * 256) * 512 + u.i1 * 128;
#pragma unroll
        for (int ai = 0; ai < 2; ++ai)
#pragma unroll
            for (int m = 0; m < 4; ++m)
#pragma unroll
                for (int n = 0; n < 2; ++n) { const f32x4 a = acc[ai][0][m][n], b = acc[ai][1][m][n]; f32x4 v;
#pragma unroll
                    for (int e = 0; e < 4; ++e) v[e] = silu_f(a[e]) * b[e];
                    st_bf16x4(o + (size_t)FRAG_ROW(ai, m) * 512 + FRAG_COL(0, n), v); }
    }
};
struct PhM2 { PH_COMMON PanelTab pt; size_t hd, y;
    __device__ __forceinline__ bool get(int i, UnitD& u) const {
        const int idx0 = bid + i * G, NU = pt.pst[16] * 4; if (idx0 >= NU) return false;
        const int idx = xcd_remap(idx0, NU), p = idx >> 2, j = idx & 3; int e = 0;
#pragma unroll
        for (int k = 1; k < 16; ++k) e += (p >= pt.pst[k]) ? 1 : 0;
        eng::unit1(u, ws + hd + (size_t)p * 256 * 1024, 1024, ws + A_MOEW + 32 * MiB + ((size_t)e * 1024 + j * 256) * 1024, 1024, 8); u.i0 = p; u.i1 = j; return true;
    }
    __device__ __forceinline__ void epi(EPI_ARGS) const {
        bf16_t* o = (bf16_t*)(ws + y) + (size_t)(u.i0 * 256) * DM + u.i1 * 256;
        FOR_FRAG(ai, bj, m, n) st_bf16x4(o + (size_t)FRAG_ROW(ai, m) * DM + FRAG_COL(bj, n), acc[ai][bj][m][n]);
    }
};
struct PhG3 { PH_COMMON f32x4 lgf, lgb;
    __device__ __forceinline__ bool get(int i, UnitD& u) const {
        const int idx = bid + i * G; if (idx >= 512 + 780) return false;
        const char* w = (const char*)(ws + WS_W1IN);
        if (idx < 512) { const int v = xcd_remap(idx, 512), pm = 1 + (v >> 3), pn = v & 7; eng::unit1(u, xm1_panel(ws, pm), 2048, w + (size_t)pn * 256 * 2048, 2048, 16); u.kind = 0; u.i0 = pm; u.i1 = pn; }
        else { const int j = xcd_remap(idx - 512, 780), ct = j / 12, rt = j % 12; eng::unit1(u, w + (size_t)(1024 + rt * 256) * 2048, 2048, xm1_panel(ws, ct), 2048, 16); u.kind = rt < 4 ? 1 : 2; u.i0 = rt; u.i1 = ct; }
        return true;
    }
    __device__ __forceinline__ void epi(EPI_ARGS) const {
        const float* rc = WSC(const float, WS_ROPEC); const float* rs = WSC(const float, WS_ROPES);
        if (u.kind == 0) {
            bf16_t* o = (u.i1 < 4 ? WSC(bf16_t, B_Q) : WSC(bf16_t, B_K)) + (size_t)(u.i0 * 256) * DM + (u.i1 & 3) * 256;
#pragma unroll
            for (int ai = 0; ai < 2; ++ai)
#pragma unroll
                for (int m = 0; m < 4; ++m) { const int r = FRAG_ROW(ai, m), tl = (u.i0 - 1) * 256 + r;
#pragma unroll
                    for (int bj = 0; bj < 2; ++bj) { const int pos = bj == 0 ? (tl >> 6) : (tl & 63); const f32x4 cv = *(const f32x4*)(rc + pos * 64 + 16 * wc + 4 * fq), sv = *(const f32x4*)(rs + pos * 64 + 16 * wc + 4 * fq);
                        const f32x4 x1 = acc[ai][bj][m][0], x2 = acc[ai][bj][m][1];
                        st_bf16x4(o + (size_t)r * DM + FRAG_COL(bj, 0), x1 * cv - x2 * sv); st_bf16x4(o + (size_t)r * DM + FRAG_COL(bj, 1), x2 * cv + x1 * sv); } }
        } else if (u.kind == 2) { bf16_t* o = WSC(bf16_t, B_VT) + (size_t)((u.i0 - 4) * 256) * TT + u.i1 * 256;
            FOR_FRAG(ai, bj, m, n) st_bf16x4(o + (size_t)FRAG_ROW(ai, m) * TT + FRAG_COL(bj, n), acc[ai][bj][m][n]);
        } else {
            const int h = u.i0; const float lf = SEL4(lgf, h), lb = SEL4(lgb, h);
            bf16_t* of = WSC(bf16_t, B_KF) + (size_t)(h * 256) * TT + u.i1 * 256; bf16_t* ob = WSC(bf16_t, B_KB) + (size_t)(h * 256) * TT + u.i1 * 256;
#pragma unroll
            for (int bj = 0; bj < 2; ++bj)
#pragma unroll
                for (int n = 0; n < 2; ++n) { const int c0 = FRAG_COL(bj, n); f32x4 df, db;
                    if (u.i1 == 0) {
#pragma unroll
                        for (int e = 0; e < 4; ++e) { const int pos = c0 + e; df[e] = __expf(lf * (float)(255 - pos)); db[e] = __expf(lb * (float)pos); }
                    } else {
#pragma unroll
                        for (int e = 0; e < 4; ++e) { const int pos = ((u.i1 - 1) * 256 + c0 + e) & 511; df[e] = __expf(lf * (float)(511 - pos)); db[e] = __expf(lb * (float)pos); }
                    }
#pragma unroll
                    for (int ai = 0; ai < 2; ++ai)
#pragma unroll
                        for (int mp = 0; mp < 2; ++mp) { const int p = 32 * wr + 16 * mp + fr; f32x4 x1 = acc[ai][bj][2 * mp][n], x2 = acc[ai][bj][2 * mp + 1][n];
                            if (u.i1 != 0) { const int tl = (u.i1 - 1) * 256 + c0; f32x4 cv, sv;
                                if (ai == 0) { const float c = rc[(tl >> 6) * 64 + p], s = rs[(tl >> 6) * 64 + p]; cv = (f32x4){c, c, c, c}; sv = (f32x4){s, s, s, s}; }
                                else {
#pragma unroll
                                    for (int e = 0; e < 4; ++e) { cv[e] = rc[((tl + e) & 63) * 64 + p]; sv[e] = rs[((tl + e) & 63) * 64 + p]; } }
                                const f32x4 y1 = x1 * cv - x2 * sv, y2 = x2 * cv + x1 * sv; x1 = y1; x2 = y2; }
                            const size_t o1 = (size_t)FRAG_ROW(ai, 2 * mp) * TT + c0, o2 = (size_t)FRAG_ROW(ai, 2 * mp + 1) * TT + c0;
                            st_bf16x4(of + o1, x1 * df); st_bf16x4(of + o2, x2 * df); st_bf16x4(ob + o1, x1 * db); st_bf16x4(ob + o2, x2 * db); } }
        }
    }
};
__device__ __forceinline__ int chunk_tok0(int c) { return c == 0 ? 0 : 256 + 512 * (c - 1); }
struct PhU { PH_COMMON
    __device__ __forceinline__ bool get(int i, UnitD& u) const {
        const int idx0 = bid + i * G; if (idx0 >= 528) return false;
        const int idx = xcd_remap(idx0, 528), dvt = idx & 1, dir = (idx >> 1) & 1, h = (idx >> 2) & 3, c = idx >> 4; const size_t tk = (size_t)chunk_tok0(c) * 2;
        eng::unit1(u, ws + B_VT + (size_t)(h * 512 + dvt * 256) * TT * 2 + tk, TT * 2, ws + (dir ? B_KB : B_KF) + (size_t)(h * 256) * TT * 2 + tk, TT * 2, c == 0 ? 4 : 8);
        u.i0 = (c * 8 + h * 2 + dir); u.i1 = dvt; return true;
    }
    __device__ __forceinline__ void epi(EPI_ARGS) const {
        bf16_t* o = WSC(bf16_t, B_ST) + (size_t)u.i0 * 131072 + (size_t)(u.i1 * 256) * 256;
        FOR_FRAG(ai, bj, m, n) st_bf16x4(o + (size_t)FRAG_ROW(ai, m) * 256 + FRAG_COL(bj, n), acc[ai][bj][m][n]);
    }
};
struct PhSD { PH_COMMON f32x4 lgf, lgb;
    __device__ __forceinline__ bool get(int i, UnitD& u) const {
        const int idx0 = bid + i * G; if (idx0 >= 512) return false;
        const int idx = xcd_remap(idx0, 512), tj = idx & 1, ti = (idx >> 1) & 1, h = (idx >> 2) & 3, c = 1 + (idx >> 4); const int t0 = chunk_tok0(c);
        eng::unit1(u, ws + B_Q + (size_t)(t0 + 256 * ti) * 2048 + h * 512, 2048, ws + B_K + (size_t)(t0 + 256 * tj) * 2048 + h * 512, 2048, 4);
        u.i0 = t0; u.i1 = h; u.i2 = ti * 2 + tj; return true;
    }
    __device__ __forceinline__ void epi(EPI_ARGS) const {
        const int ti = u.i2 >> 1, tj = u.i2 & 1, h = u.i1; const float lf = SEL4(lgf, h), lb = SEL4(lgb, h);
        bf16_t* o = WSC(bf16_t, B_SD) + (size_t)(u.i0 + 256 * ti) * 2048 + h * 512 + 256 * tj;
        FOR_FRAG(ai, bj, m, n) { const int r = FRAG_ROW(ai, m), c0 = FRAG_COL(bj, n), i = 256 * ti + r; f32x4 v = acc[ai][bj][m][n];
#pragma unroll
            for (int e = 0; e < 4; ++e) { const int d = i - (256 * tj + c0 + e); const float w = d > 0 ? __expf(lf * (float)d) : d < 0 ? __expf(lb * (float)(-d)) : 2.0f; v[e] *= w; }
            st_bf16x4(o + (size_t)r * 2048 + c0, v); }
    }
};
struct PhO { const unsigned char* ws; int G, bid; f32x4 lgf, lgb; static constexpr bool HOOKS = true, GATHER = false;
    __device__ __forceinline__ bool get(int i, UnitD& u) const {
        const int idx0 = bid + i * G; if (idx0 >= 512) return false;
        const int idx = xcd_remap(idx0, 512), dvt = idx & 1, h = (idx >> 1) & 3, pm = idx >> 3, c = 1 + (pm >> 1), t0 = CTXN + 256 * pm;
        const char* q = (const char*)(ws + B_Q) + (size_t)t0 * 2048 + h * 512;
        const char* st = (const char*)(ws + B_ST) + ((size_t)(c * 8 + h * 2) * 131072 + (size_t)(dvt * 256) * 256) * 2;
        u.A0 = q; u.B0 = st; u.lda0 = 2048; u.ldb0 = 512; u.n0 = 4;
        u.A1 = q; u.B1 = st + (size_t)131072 * 2; u.lda1 = 2048; u.ldb1 = 512; u.n1 = 4;
        u.A2 = (const char*)(ws + B_SD) + (size_t)t0 * 4096 + h * 1024; u.B2 = (const char*)(ws + B_VT) + (size_t)(h * 512 + dvt * 256) * TT * 2 + (size_t)chunk_tok0(c) * 2; u.lda2 = 4096; u.ldb2 = TT * 2; u.n2 = 8;
        u.kind = 0; u.i0 = pm; u.i1 = h; u.i2 = dvt; return true;
    }
    __device__ __forceinline__ void hook(int tc, Acc& acc, const UnitD& u, int wr, int wc, int fr, int fq) const {
        if (tc != 4 && tc != 8) return;
        const float lf = SEL4(lgf, u.i1), lb = SEL4(lgb, u.i1);
#pragma unroll
        for (int ai = 0; ai < 2; ++ai)
#pragma unroll
            for (int m = 0; m < 4; ++m) { const int i = (u.i0 & 1) * 256 + FRAG_ROW(ai, m);
                const float s = tc == 4 ? __expf(lf * (float)(i + 1) - lb * (float)(512 - i)) : __expf(lb * (float)(512 - i));
#pragma unroll
                for (int bj = 0; bj < 2; ++bj)
#pragma unroll
                    for (int n = 0; n < 2; ++n) acc[ai][bj][m][n] *= s; }
    }
    __device__ __forceinline__ void epi(EPI_ARGS) const {
        const int tl = 256 * u.i0, h = u.i1, dvt = u.i2;
        bf16_t* o = WSC(bf16_t, B_O) + (size_t)(CTXN + tl) * 2048 + h * 512 + dvt * 256; float* ssq = WSC(float, WS_SSQ);
#pragma unroll
        for (int ai = 0; ai < 2; ++ai)
#pragma unroll
            for (int m = 0; m < 4; ++m) { const int r = FRAG_ROW(ai, m); float s = 0.f;
#pragma unroll
                for (int bj = 0; bj < 2; ++bj)
#pragma unroll
                    for (int n = 0; n < 2; ++n) { const f32x4 v = acc[ai][bj][m][n]; s += (v[0] * v[0] + v[1] * v[1]) + (v[2] * v[2] + v[3] * v[3]); st_bf16x4(o + (size_t)r * 2048 + FRAG_COL(bj, n), v); }
                s += __shfl_xor(s, 16); s += __shfl_xor(s, 32);
                if (fq == 0) ssq[((size_t)(tl + r) * 4 + h) * 8 + dvt * 4 + wc] = s; }
    }
};
struct PhGG { PH_COMMON
    __device__ __forceinline__ bool get(int i, UnitD& u) const {
        const int idx0 = bid + i * G; if (idx0 >= 512) return false;
        const int idx = xcd_remap(idx0, 512), pm = 1 + (idx >> 3), pn = idx & 7; eng::unit1(u, xm1_panel(ws, pm), 2048, ws + WS_W1IN + (size_t)(4096 + pn * 256) * 2048, 2048, 16); u.i0 = pm; u.i1 = pn; return true;
    }
    __device__ __forceinline__ void epi(EPI_ARGS) const {
        bf16_t* o = WSC(bf16_t, B_O) + (size_t)(u.i0 * 256) * 2048 + u.i1 * 256; const float* ssq = WSC(const float, WS_SSQ); const int h = u.i1 >> 1;
#pragma unroll
        for (int ai = 0; ai < 2; ++ai)
#pragma unroll
            for (int m = 0; m < 4; ++m) { const int r = FRAG_ROW(ai, m); const float* sp = ssq + ((size_t)((u.i0 - 1) * 256 + r) * 4 + h) * 8;
                const f32x4 s0 = *(const f32x4*)sp, s1 = *(const f32x4*)(sp + 4); const float rstd = rsqrtf((((s0[0] + s0[1]) + (s0[2] + s0[3])) + ((s1[0] + s1[1]) + (s1[2] + s1[3]))) * (1.0f / 512.0f) + RMS_EPS);
#pragma unroll
                for (int bj = 0; bj < 2; ++bj)
#pragma unroll
                    for (int n = 0; n < 2; ++n) { bf16_t* q = o + (size_t)r * 2048 + FRAG_COL(bj, n); const u32x2 ov = *(const u32x2*)q; const f32x4 g = acc[ai][bj][m][n]; f32x4 v;
                        v[0] = silu_f(g[0]) * (bflo(ov.x) * rstd); v[1] = silu_f(g[1]) * (bfhi(ov.x) * rstd); v[2] = silu_f(g[2]) * (bflo(ov.y) * rstd); v[3] = silu_f(g[3]) * (bfhi(ov.y) * rstd);
                        st_bf16x4(q, v); } }
    }
};
struct PhG4 { PH_COMMON float* out;
    __device__ __forceinline__ bool get(int i, UnitD& u) const {
        const int idx0 = bid + i * G; if (idx0 >= 256) return false;
        const int idx = xcd_remap(idx0, 256), pm = idx >> 2, pn = idx & 3; eng::unit1(u, ws + B_O + (size_t)(CTXN + pm * 256) * 4096, 4096, ws + WS_W1OUT + (size_t)pn * 256 * 4096, 4096, 32); u.i0 = pm; u.i1 = pn; return true;
    }
    __device__ __forceinline__ void epi(EPI_ARGS) const {
        const float* g1 = WSC(const float, WS_MOD) + 6144 + 2048 + u.i1 * 256; float* dst = out + (size_t)(u.i0 * 256) * DM + u.i1 * 256;
        FOR_FRAG(ai, bj, m, n) { float* q = dst + (size_t)FRAG_ROW(ai, m) * DM + FRAG_COL(bj, n); const f32x4 gv = *(const f32x4*)(g1 + FRAG_COL(bj, n)); *(f32x4*)q = *(const f32x4*)q + gv * acc[ai][bj][m][n]; }
    }
};

constexpr int NA_KC = 0, NA_VC = 32768, NA_RPB = 65536;
__device__ __forceinline__ int na_ksw(int tok) { return ((tok >> 1) & 1) | (((tok >> 3) & 3) << 1); }
__device__ __forceinline__ void na_load_ctx(const Frame& F, int h) {
    const bf16_t* qk = WSP(const bf16_t, A_QK0); const bf16_t* vt = WSP(const bf16_t, A_VT0);
#pragma unroll
    for (int i = 0; i < 4; ++i) { const int cid = F.tid + 512 * i, tok = cid >> 3, c = cid & 7;
        *(LAS u32x4*)(F.lds + NA_KC + tok * 128 + ((c ^ na_ksw(tok)) << 4)) = *(const u32x4*)(qk + (size_t)tok * QK0_LD + 768 + h * 64 + c * 8); }
#pragma unroll
    for (int i = 0; i < 4; ++i) { const int cid = F.tid + 512 * i, d = cid >> 5, ch = cid & 31;
        *(LAS u32x4*)(F.lds + NA_VC + d * 512 + ((ch ^ (d & 15)) << 4)) = *(const u32x4*)(vt + (size_t)(h * 64 + d) * TT + ch * 8); }
}
template <bool LOCAL>
__device__ __forceinline__ void na_unit(const Frame& F, int r, int j, int h, int qb) {
    const bf16_t* qk = WSP(const bf16_t, A_QK0); const bf16_t* vt = WSP(const bf16_t, A_VT0); bf16_t* ao = WSP(bf16_t, A_AO);
    const LAS float* rpb_l = (const LAS float*)(F.lds + NA_RPB);
    int lane = F.lane; asm volatile("" : "+v"(lane));
    const int q16 = lane & 15, g = lane >> 4;
    const int tq = LOCAL ? CTXN + r * GW + 16 * j + q16 : 16 * qb + q16;
    bf16x8 qf[2];
#pragma unroll
    for (int ks = 0; ks < 2; ++ks) qf[ks] = *(const bf16x8*)(qk + (size_t)tq * QK0_LD + h * 64 + 32 * ks + 8 * g);
    constexpr int NT = LOCAL ? 32 : 16, NL = LOCAL ? 16 : 0;
    f32x4 s[NT];
    const int rs = LOCAL ? min(max(r - 4, 0), 248) : 0, kst = LOCAL ? min(max(16 * j - 8, 0), 32) : 0;
    const int krow = 8 * (q16 >> 2) + (q16 & 3);
#pragma unroll
    for (int t = 0; t < NT; ++t) {
        bf16x8 k0, k1;
        if (t < NL) { const int tok = CTXN + (rs + (t >> 1)) * GW + kst + krow + 4 * (t & 1); const bf16_t* kp = qk + (size_t)tok * QK0_LD + 768 + h * 64 + 8 * g; k0 = *(const bf16x8*)kp; k1 = *(const bf16x8*)(kp + 32); }
        else { const int tok = 32 * ((t - NL) >> 1) + krow + 4 * (t & 1), sw = na_ksw(tok); const LAS unsigned char* kp = F.lds + NA_KC + tok * 128;
            k0 = *(const LAS bf16x8*)(kp + ((g ^ sw) << 4)); k1 = *(const LAS bf16x8*)(kp + (((4 + g) ^ sw) << 4)); }
        f32x4 a = {0.f, 0.f, 0.f, 0.f};
        a = __builtin_amdgcn_mfma_f32_16x16x32_bf16(k0, qf[0], a, 0, 0, 0); a = __builtin_amdgcn_mfma_f32_16x16x32_bf16(k1, qf[1], a, 0, 0, 0);
        s[t] = a;
        if ((t & 3) == 3) asm volatile("" ::: "memory");
    }
    float mx = -1e30f;
    if (LOCAL) { const int qc = 16 * j + q16, wst = min(max(qc - 8, 0), 48);
#pragma unroll
        for (int t = 0; t < NL; ++t) { const int dr = rs + (t >> 1) - r + 7;
#pragma unroll
            for (int e = 0; e < 4; ++e) { const int kc = kst + 8 * g + 4 * (t & 1) + e; const bool ok = kc >= wst && kc < wst + 16; const int dc = min(max(kc - qc + 15, 0), 30);
                const float v = ok ? s[t][e] * 0.125f + rpb_l[(h * 15 + dr) * 31 + dc] : -1e30f; s[t][e] = v; mx = fmaxf(mx, v); } } }
#pragma unroll
    for (int t = NL; t < NT; ++t)
#pragma unroll
        for (int e = 0; e < 4; ++e) { const float v = s[t][e] * 0.125f; s[t][e] = v; mx = fmaxf(mx, v); }
    mx = fmaxf(mx, __shfl_xor(mx, 16)); mx = fmaxf(mx, __shfl_xor(mx, 32));
    float sum = 0.f; u32x4 pw[NT / 2];
#pragma unroll
    for (int b = 0; b < NT / 2; ++b) { float p[8];
#pragma unroll
        for (int e = 0; e < 4; ++e) { p[e] = __expf(s[2 * b][e] - mx); p[4 + e] = __expf(s[2 * b + 1][e] - mx); }
        sum += ((p[0] + p[1]) + (p[2] + p[3])) + ((p[4] + p[5]) + (p[6] + p[7]));
        pw[b].x = cvt_pk_bf16(p[0], p[1]); pw[b].y = cvt_pk_bf16(p[2], p[3]); pw[b].z = cvt_pk_bf16(p[4], p[5]); pw[b].w = cvt_pk_bf16(p[6], p[7]); }
    sum += __shfl_xor(sum, 16); sum += __shfl_xor(sum, 32);
    f32x4 o[4];
#pragma unroll
    for (int dt = 0; dt < 4; ++dt) o[dt] = (f32x4){0.f, 0.f, 0.f, 0.f};
#pragma unroll
    for (int b = 0; b < NT / 2; ++b) {
        const bf16x8 pf = __builtin_bit_cast(bf16x8, pw[b]);
#pragma unroll
        for (int dt = 0; dt < 4; ++dt) { bf16x8 vf;
            if (b < NL / 2) vf = *(const bf16x8*)(vt + (size_t)(h * 64 + 16 * dt + q16) * TT + CTXN + (rs + b) * GW + kst + 8 * g);
            else vf = *(const LAS bf16x8*)(F.lds + NA_VC + (16 * dt + q16) * 512 + (((4 * (b - NL / 2) + g) ^ q16) << 4));
            o[dt] = __builtin_amdgcn_mfma_f32_16x16x32_bf16(vf, pf, o[dt], 0, 0, 0); }
        if ((b & 1) == 1) asm volatile("" ::: "memory");
    }
    const float inv = 1.0f / sum;
#pragma unroll
    for (int dt = 0; dt < 4; ++dt) st_bf16x4(ao + (size_t)tq * DM + 256 + h * 64 + 16 * dt + 4 * g, o[dt] * inv);
}
__device__ __forceinline__ void p_attention(const Frame& F) {
    if ((F.bid & 3) == 3) { for (int t = F.bid >> 2; t < 1536; t += (F.G >> 2)) conv_moe_tile(F, 0, t); }
    __syncthreads();
    LAS float* rpb_l = (LAS float*)(F.lds + NA_RPB); volatile LAS int* tick = (volatile LAS int*)(F.lds + NA_RPB + 24576);
    for (int i = F.tid; i < 12 * 15 * 31; i += 512) rpb_l[i] = F.p.rpb[i];
    unsigned* heads = (unsigned*)(F.p.ws + WS_CTL + CTL_QUEUE);
    const int h0 = (12 * F.bid) >> 8;
    for (int hh = 0; hh < 12; ++hh) {
        const int h = (h0 + hh) % 12; bool loaded = false;
        for (;;) {
            __syncthreads();
            if (F.tid == 0) tick[0] = (int)__hip_atomic_fetch_add(heads + h * 64, 1u, __ATOMIC_RELAXED, __HIP_MEMORY_SCOPE_AGENT);
            __syncthreads();
            const int k = __builtin_amdgcn_readfirstlane(tick[0]);
            if (k > 128) break;
            if (!loaded) { na_load_ctx(F, h); __syncthreads(); loaded = true; }
            if (k < 128) na_unit<true>(F, 2 * k + (F.wid >> 2), F.wid & 3, h, 0);
            else { na_unit<false>(F, 0, 0, h, F.wid); na_unit<false>(F, 0, 0, h, F.wid + 8); }
        }
    }
    __syncthreads();
}
constexpr int LDS_BYTES = eng::STAGE_BYTES + 1024 + 4096;
#ifndef MK_PER_PHASE
#define MK_PER_PHASE 0
#endif

__global__ __launch_bounds__(512, 2) void mk_fwd(Params p) {
    extern __shared__ __attribute__((aligned(16))) unsigned char shm[];
    Frame F; F.p = p; F.lds = (LAS unsigned char*)shm; F.tid = threadIdx.x; F.lane = F.tid & 63; F.wid = __builtin_amdgcn_readfirstlane(F.tid >> 6); F.G = gridDim.x; F.bid = blockIdx.x;
    volatile LAS unsigned* xb = (volatile LAS unsigned*)(F.lds + eng::STAGE_BYTES);
    if (F.tid < 4) xb[F.tid] = 0u;
    __syncthreads();
    const int lo = p.ph_lo, hi = p.ph_hi;
    XcdBarrier bar; bar.bar = (unsigned*)(p.ws + WS_CTL); bar.x = 0; bar.st = xb;
    if (hi - lo > 1) bar = xcd_barrier_post((unsigned*)(p.ws + WS_CTL), xb);
#ifndef PHMASK
#define PHMASK 0xFFFFFFu
#endif
#define IN(k) (((PHMASK >> (k)) & 1u) && lo <= (k) && (k) < hi)
#ifndef PROBE_MASK
#define PROBE_MASK 0u
#endif
#ifndef PROBE_MULT
#define PROBE_MULT 1
#endif
    unsigned long long pr_acc = 0, pr_prev = PROBE_MASK ? wall_clock64() : 0ull;
#define SEAM(k) do { if (IN(k) && hi > (k) + 1) xcd_barrier(bar); if (PROBE_MASK) { const unsigned long long _n = wall_clock64(); if ((PROBE_MASK >> (k)) & 1u) pr_acc += _n - pr_prev; pr_prev = _n; } } while (0)
    const unsigned char* ws = p.ws;

    if (IN(0)) { p0_prologue(F); } SEAM(0);
    if (IN(1)) { p_norm_in(F); } SEAM(1);
    if (IN(2)) { PhG1 ph{ws, F.G, F.bid}; eng::gemm_run(F.lds, ph); } SEAM(2);
    if (IN(3)) { PhF1 ph{ws, F.G, F.bid}; eng::gemm_run(F.lds, ph); p_attention(F); } SEAM(3);
    if (IN(4)) { PhF2 ph{ws, F.G, F.bid, p.ctx}; eng::gemm_run(F.lds, ph); } SEAM(4);
    if (IN(5)) { PhG2 ph{ws, F.G, F.bid, p.x, p.out}; eng::gemm_run(F.lds, ph); } SEAM(5);
    if (IN(6)) { p_router(F, 0, 0, WSP(bf16_t, A_XM)); } SEAM(6);
    if (IN(8)) { PhM1 ph{ws, F.G, F.bid}; panel_tab(F, 0, ph.pt); ph.xs = A_XM; ph.hd = A_HD; moe_rowtab(F, 0, ph.pt, 0); eng::gemm_run(F.lds, ph); } SEAM(8);
    if (IN(9)) { PhM2 ph{ws, F.G, F.bid}; panel_tab(F, 0, ph.pt); ph.hd = A_HD; ph.y = A_XS; eng::gemm_run(F.lds, ph); } SEAM(9);
    if (IN(10)) { p_combine0(F); } SEAM(10);
    if (IN(11)) { PhG3 ph{ws, F.G, F.bid};
        ph.lgf = (f32x4){log_gamma(F, 0, 0), log_gamma(F, 0, 1), log_gamma(F, 0, 2), log_gamma(F, 0, 3)}; ph.lgb = (f32x4){log_gamma(F, 1, 0), log_gamma(F, 1, 1), log_gamma(F, 1, 2), log_gamma(F, 1, 3)};
        eng::gemm_run(F.lds, ph); } SEAM(11);
    if (IN(12)) { PhU ph{ws, F.G, F.bid}; eng::gemm_run(F.lds, ph); } SEAM(13);
    if (IN(14)) { p_scan(F); PhSD ph{ws, F.G, F.bid};
        ph.lgf = (f32x4){log_gamma(F, 0, 0), log_gamma(F, 0, 1), log_gamma(F, 0, 2), log_gamma(F, 0, 3)}; ph.lgb = (f32x4){log_gamma(F, 1, 0), log_gamma(F, 1, 1), log_gamma(F, 1, 2), log_gamma(F, 1, 3)};
        eng::gemm_run(F.lds, ph); } SEAM(14);
    if (IN(15)) { PhO ph{ws, F.G, F.bid};
        ph.lgf = (f32x4){log_gamma(F, 0, 0), log_gamma(F, 0, 1), log_gamma(F, 0, 2), log_gamma(F, 0, 3)}; ph.lgb = (f32x4){log_gamma(F, 1, 0), log_gamma(F, 1, 1), log_gamma(F, 1, 2), log_gamma(F, 1, 3)};
        eng::gemm_run(F.lds, ph); } SEAM(15);
    if (IN(17)) { PhGG ph{ws, F.G, F.bid}; eng::gemm_run(F.lds, ph); } SEAM(17);
    if (IN(18)) { PhG4 ph{ws, F.G, F.bid, p.out}; eng::gemm_run(F.lds, ph); conv_moe(F, 1); } SEAM(18);
    if (IN(19)) { p_router(F, 1, CTXN, WSP(bf16_t, B_XM2)); } SEAM(19);
    if (IN(21)) { PhM1 ph{ws, F.G, F.bid}; panel_tab(F, 1, ph.pt); ph.xs = B_XM2; ph.hd = B_HD; moe_rowtab(F, 1, ph.pt, CTXN); eng::gemm_run(F.lds, ph); } SEAM(21);
    if (IN(22)) { PhM2 ph{ws, F.G, F.bid}; panel_tab(F, 1, ph.pt); ph.hd = B_HD; ph.y = B_XS; eng::gemm_run(F.lds, ph); } SEAM(22);
    if (IN(23)) { p_final(F); }
    if (PROBE_MASK) { SEAM(23); if (F.bid == 0) { const unsigned long long t0 = wall_clock64(); while (wall_clock64() - t0 < pr_acc * PROBE_MULT) __builtin_amdgcn_s_sleep(8); } }
#undef IN
#undef SEAM
}

extern "C" void kernel_launch(void* const* d_in, const int* in_sizes, int n_in, void* d_out, int out_size, void* d_ws, size_t ws_size, hipStream_t stream) {
    static int grid = 0;
    if (grid == 0) {
        if (n_in != 19 || out_size != SEQ * DM || ws_size < WS_END) { fprintf(stderr, "kernel_launch: unexpected shapes (n_in %d, out %d, ws %zu < %zu)\n", n_in, out_size, ws_size, (size_t)WS_END); grid = -1; return; }
        int dev = 0, cus = 0, per_cu = 0;
        if (hipGetDevice(&dev) != hipSuccess || hipDeviceGetAttribute(&cus, hipDeviceAttributeMultiprocessorCount, dev) != hipSuccess) { grid = -1; return; }
        if (hipFuncSetAttribute((const void*)mk_fwd, hipFuncAttributeMaxDynamicSharedMemorySize, LDS_BYTES) != hipSuccess) { fprintf(stderr, "kernel_launch: hipFuncSetAttribute failed\n"); grid = -1; return; }
        if (hipOccupancyMaxActiveBlocksPerMultiprocessor(&per_cu, (const void*)mk_fwd, 512, LDS_BYTES) != hipSuccess || per_cu < 1) { fprintf(stderr, "kernel_launch: occupancy query says %d\n", per_cu); per_cu = 1; }
        (void)hipGetLastError();
        grid = cus;
        if (grid > 256) grid = 256;
    }
    if (grid < 0) return;
    (void)hipMemsetAsync((char*)d_ws + WS_CTL, 0, CTL_BYTES, stream);
    Params p{};
    const float** pp = (const float**)&p;
    for (int i = 0; i < 19; ++i) pp[i] = (const float*)d_in[i];
    p.out = (float*)d_out; p.ws = (unsigned char*)d_ws;
#if MK_PER_PHASE
    for (int ph = 0; ph < NPHASE; ++ph) { p.ph_lo = ph; p.ph_hi = ph + 1; hipLaunchKernelGGL(mk_fwd, dim3(grid), dim3(512), LDS_BYTES, stream, p); }
#else
    p.ph_lo = 0; p.ph_hi = NPHASE; hipLaunchKernelGGL(mk_fwd, dim3(grid), dim3(512), LDS_BYTES, stream, p);
#endif
}
```

```cpp
#include <hip/hip_runtime.h>
#include <cstdio>
#include <cstdint>

typedef unsigned short bf16_t;
typedef short bf16x8 __attribute__((ext_vector_type(8)));
typedef float f32x4 __attribute__((ext_vector_type(4)));
typedef float f32x2 __attribute__((ext_vector_type(2)));
typedef unsigned u32x2 __attribute__((ext_vector_type(2)));
typedef unsigned u32x4 __attribute__((ext_vector_type(4)));
#define LAS __attribute__((address_space(3)))

constexpr int DM = 1024, SEQ = 16384, CTXN = 256, TT = SEQ + CTXN  , GW = 64;
constexpr int NH0 = 12, QK0_LD = 1536, W0IN_ROWS = 2816;
constexpr int NPMAX = 146;
constexpr float RMS_EPS = 1e-6f;
constexpr int NPHASE = 24;

constexpr size_t KiB = 1024, MiB = 1024 * 1024, HMiB = 512 * 1024;
constexpr size_t WS_CTL = 0;
constexpr size_t CTL_BYTES = 64 * KiB;
constexpr size_t CTL_CNT = 16 * KiB;
constexpr size_t CTL_QUEUE = 20 * KiB;
constexpr size_t WS_MOD = 64 * KiB;
constexpr size_t WS_TWC = 256 * KiB, WS_TWS = 320 * KiB;
constexpr size_t WS_ROPEC = 384 * KiB, WS_ROPES = 448 * KiB;
constexpr size_t WS_F1T = 512 * KiB, WS_F2P = 640 * KiB;
constexpr size_t WS_CS256 = 768 * KiB;
constexpr size_t WS_HC = 1 * MiB;
constexpr size_t WS_EID = 2 * MiB;
constexpr size_t WS_GW = 2 * MiB + 256 * KiB;
constexpr size_t WS_SLOT = 2 * MiB + 512 * KiB;
constexpr size_t WS_SSQ = 3 * MiB;
constexpr size_t WS_XTC = 5 * MiB;
constexpr size_t WS_PERM = 6 * MiB;
constexpr size_t WS_W0IN = 8 * MiB, WS_W0OUT = 14 * MiB, WS_W1IN = 16 * MiB, WS_W1OUT = 28 * MiB;
constexpr size_t AR = 32 * MiB;
constexpr size_t A_XM = AR + 0, A_QK0 = AR + 65 * HMiB, A_VT0 = AR + 81 * MiB + 256 * KiB, A_XT2 = AR + 106 * MiB, A_T2 = AR + 122 * MiB + HMiB, A_AO = AR + 139 * MiB;
constexpr size_t A_XS = AR + 65 * HMiB, A_HD = AR + 106 * MiB, A_MOEW = AR + 245 * MiB;
constexpr size_t B_Q = AR + 0, B_K = AR + 65 * HMiB, B_O = AR + 65 * HMiB, B_KF = AR + 195 * HMiB, B_KB = AR + 130 * MiB, B_SD = AR + 195 * HMiB, B_VT = AR + 325 * HMiB;
constexpr size_t B_XM1 = AR + 455 * HMiB, B_ST = AR + 455 * HMiB, B_XM1B = AR + 0, B_XM2 = AR + 0, B_XS = AR + 195 * HMiB, B_HD = AR + 341 * HMiB;
constexpr size_t B_XM1A = AR + 587 * HMiB;
constexpr size_t WS_END = AR + 319 * MiB;

struct Params {
    const float *x, *c, *ctx, *c_ctx, *ada_w, *ada_b, *norm_g, *final_g, *w0in, *w0out, *rpb, *w1in, *w1out, *decay, *router_w, *router_b, *moe_w1, *moe_w3, *moe_w2;
    float* out; unsigned char* ws; int ph_lo, ph_hi;
};

__device__ __forceinline__ unsigned cvt_pk_bf16(float lo, float hi) { unsigned r; asm volatile("v_cvt_pk_bf16_f32 %0, %1, %2" : "=v"(r) : "v"(lo), "v"(hi)); return r; }
__device__ __forceinline__ bf16_t f2bf(float f) { return (bf16_t)(cvt_pk_bf16(f, 0.f) & 0xffffu); }
__device__ __forceinline__ float bf2f(unsigned short b) { return __uint_as_float(((unsigned)b) << 16); }
__device__ __forceinline__ float bflo(unsigned w) { return __uint_as_float(w << 16); }
__device__ __forceinline__ float bfhi(unsigned w) { return __uint_as_float(w & 0xffff0000u); }
__device__ __forceinline__ float silu_f(float v) { return v / (1.0f + __expf(-v)); }
__device__ __forceinline__ float wave_sum(float v) {
#pragma unroll
    for (int o = 32; o >= 1; o >>= 1) v += __shfl_xor(v, o);
    return v;
}
__device__ __forceinline__ float wave_max(float v) {
#pragma unroll
    for (int o = 32; o >= 1; o >>= 1) v = fmaxf(v, __shfl_xor(v, o));
    return v;
}
#define XB_TMO      128
#define XB_XCNT(j)  (256  + 64 * (j))
#define XB_XSUB(j)  (1280 + 64 * (j))
#define XB_XGEN(j)  (2304 + 64 * (j))
#define XB_TOP      3328
#define XB_TOPGEN   3392
#define XCD_BAR_WORDS 3456
#define XB_SPIN_CAP (1u << 18)

__device__ __forceinline__ unsigned xb_ld(unsigned* p)              { return __hip_atomic_load(p, __ATOMIC_RELAXED, __HIP_MEMORY_SCOPE_AGENT); }
__device__ __forceinline__ unsigned xb_add(unsigned* p, unsigned v) { return __hip_atomic_fetch_add(p, v, __ATOMIC_RELAXED, __HIP_MEMORY_SCOPE_AGENT); }
__device__ __forceinline__ unsigned xb_xcc_id() { return (unsigned)__builtin_amdgcn_s_getreg((3 << 11) | 20) & 0xFu; }
#define XB_SPIN(cond, bar) do { unsigned _sp = 0; while (cond) { __builtin_amdgcn_s_sleep(1); \
    if ((++_sp & 255u) == 0u) { if (xb_ld(&(bar)[XB_TMO])) break; if (_sp > XB_SPIN_CAP) { atomicAdd(&(bar)[XB_TMO], 1u); break; } } } } while (0)

struct XcdBarrier {
    unsigned* bar; unsigned x;
    volatile LAS unsigned* st;
};

__device__ __forceinline__ XcdBarrier xcd_barrier_post(unsigned* bar, volatile LAS unsigned* st) {
    XcdBarrier b; b.bar = bar; b.x = xb_xcc_id(); b.st = st;
    if (threadIdx.x == 0) (void)xb_add(&bar[XB_XCNT(b.x)], 1u);
    return b;
}
__device__ __forceinline__ void xcd_barrier_complete(unsigned* bar, unsigned x, unsigned& nloc, unsigned& nx) {
    const unsigned G = gridDim.x * gridDim.y * gridDim.z;
    unsigned sum, cnt, mine, sp = 0u;
    for (;;) {
        sum = 0u; cnt = 0u; mine = 0u;
#pragma unroll
        for (unsigned j = 0; j < 16; ++j) { const unsigned c = xb_ld(&bar[XB_XCNT(j)]); sum += c; cnt += (c > 0u) ? 1u : 0u; mine = (j == x) ? c : mine; }
        if (sum == G) break;
        __builtin_amdgcn_s_sleep(1);
        if ((++sp & 255u) == 0u) { if (xb_ld(&bar[XB_TMO])) break; if (sp > XB_SPIN_CAP) { atomicAdd(&bar[XB_TMO], 1u); break; } }
    }
    nloc = mine > 0u ? mine : 1u; nx = cnt > 0u ? cnt : 1u;
}

__device__ __forceinline__ void xcd_barrier(const XcdBarrier& b) {
    asm volatile("s_waitcnt vmcnt(0)" ::: "memory");
    __syncthreads();
    if (threadIdx.x == 0) {
        unsigned* bar = b.bar;
        __builtin_amdgcn_s_waitcnt(0);
        unsigned nloc = b.st[0], nx = b.st[1];
        if (nloc == 0u) { xcd_barrier_complete(bar, b.x, nloc, nx); b.st[0] = nloc; b.st[1] = nx; }
        const unsigned old = xb_add(&bar[XB_XSUB(b.x)], 1u);
        const unsigned gen = old / nloc;
        if (old + 1u == (gen + 1u) * nloc) {
            __builtin_amdgcn_fence(__ATOMIC_RELEASE, "agent");
            asm volatile("s_waitcnt vmcnt(0)" ::: "memory");
            const unsigned og = xb_add(&bar[XB_TOP], 1u);
            const unsigned tg = og / nx;
            if (og + 1u == (tg + 1u) * nx) xb_add(&bar[XB_TOPGEN], 1u);
            else XB_SPIN(xb_ld(&bar[XB_TOPGEN]) == tg, bar);
            __builtin_amdgcn_fence(__ATOMIC_ACQUIRE, "agent");
            xb_add(&bar[XB_XGEN(b.x)], 1u);
            asm volatile("s_waitcnt vmcnt(0)" ::: "memory");
        } else {
            XB_SPIN(xb_ld(&bar[XB_XGEN(b.x)]) == gen, bar);
            __builtin_amdgcn_fence(__ATOMIC_ACQUIRE, "agent");
            asm volatile("s_waitcnt vmcnt(0)" ::: "memory");
        }
    }
    __syncthreads();
}
namespace eng {
constexpr int BM = 256, BK = 64, HALF = 128, HTB = HALF * BK * 2, STAGE_BYTES = 8 * HTB;
__device__ __forceinline__ int lds_byte(int r, int c) { const int st = (r >> 4) * 2 + (c >> 5), rr = r & 15, cc = c & 31, ob = rr * 64 + cc * 2; return st * 1024 + (ob ^ (((ob >> 9) & 1) << 5)); }
__device__ __forceinline__ int perm32(int rho) { const int n = rho >> 4, i = rho & 15; return 8 * (i >> 2) + 4 * n + (i & 3); }
__device__ __forceinline__ void stage_rc(int b, int& R, int& C) { const int st = b / 1024, sb = b % 1024, swz = sb ^ (((sb >> 9) & 1) << 5); R = (st >> 1) * 16 + swz / 64; C = (st & 1) * 32 + (swz % 64) / 2; }

struct UnitD {
    const char* A0; const char* B0; unsigned lda0, ldb0; int n0;
    const char* A1; const char* B1; unsigned lda1, ldb1; int n1;
    const char* A2; const char* B2; unsigned lda2, ldb2; int n2;
    int kind, i0, i1, i2;
};
struct TD { const char* a; const char* b; unsigned lda, ldb; int gpar; };
__device__ __forceinline__ TD tile_at(const UnitD& u, int t) {
    TD d;
    if (t < u.n0) { d.a = u.A0 + (size_t)t * 128; d.b = u.B0 + (size_t)t * 128; d.lda = u.lda0; d.ldb = u.ldb0; }
    else if (t < u.n0 + u.n1) { const int s = t - u.n0; d.a = u.A1 + (size_t)s * 128; d.b = u.B1 + (size_t)s * 128; d.lda = u.lda1; d.ldb = u.ldb1; }
    else { const int s = t - u.n0 - u.n1; d.a = u.A2 + (size_t)s * 128; d.b = u.B2 + (size_t)s * 128; d.lda = u.lda2; d.ldb = u.ldb2; }
    return d;
}
typedef f32x4 Acc[2][2][4][2];

template <class P>
__device__ __forceinline__ void gemm_run(LAS unsigned char* lds, const P& ph) {
    const int tid = threadIdx.x, wid = __builtin_amdgcn_readfirstlane(tid >> 6), lane = tid & 63, wr = wid >> 2, wc = wid & 3, fr = lane & 15, fq = lane >> 4;
    int R0, C0; stage_rc(tid * 16, R0, C0);
    const unsigned vR = (unsigned)R0, vC2 = (unsigned)C0 * 2u, vRB = P::PERM ? (unsigned)((R0 & ~31) + perm32(R0 & 31)) : (unsigned)R0;
    const unsigned ldsw = (unsigned)wid * 1024u;
    const int aoff = lds_byte(wr * 64 + fr, fq * 8), boff = lds_byte(wc * 32 + fr, fq * 8);
#define EG_SA(b, h) (((b) * 2 + (h)) * HTB)
#define EG_SB(b, h) ((4 + (b) * 2 + (h)) * HTB)
#define EG_STAGE(bufoff, gbase, ld) EG_STAGER(bufoff, gbase, ld, vR)
#define EG_STAGEB(bufoff, gbase, ld) EG_STAGER(bufoff, gbase, ld, vRB)
#define EG_STAGER(bufoff, gbase, ld, vrow) do { const unsigned _ld = (ld); const char* _g = (gbase) + (size_t)((vrow) * _ld + vC2); \
        __builtin_amdgcn_global_load_lds((const unsigned*)_g, (LAS unsigned*)(lds + (bufoff) + ldsw), 16, 0, 0); \
        __builtin_amdgcn_global_load_lds((const unsigned*)(_g + (size_t)(64u * _ld)), (LAS unsigned*)(lds + (bufoff) + ldsw + 8192), 16, 0, 0); } while (0)
#define EG_STAGEA(bufoff, d, h) do { if constexpr (P::GATHER) { const char* _g = (d).a + vC2; const unsigned _o0 = (d).gpar ? gB[(h) * 2] : gA[(h) * 2], _o1 = (d).gpar ? gB[(h) * 2 + 1] : gA[(h) * 2 + 1]; \
        __builtin_amdgcn_global_load_lds((const unsigned*)(_g + _o0), (LAS unsigned*)(lds + (bufoff) + ldsw), 16, 0, 0); \
        __builtin_amdgcn_global_load_lds((const unsigned*)(_g + _o1), (LAS unsigned*)(lds + (bufoff) + ldsw + 8192), 16, 0, 0); } \
        else EG_STAGE(bufoff, (d).a + (size_t)((h) * 128u * (d).lda), (d).lda); } while (0)
#define EG_LDA(dst, b, h) do { _Pragma("unroll") for (int m = 0; m < 4; ++m) _Pragma("unroll") for (int k = 0; k < 2; ++k) dst[m][k] = *(const LAS bf16x8*)(lds + EG_SA(b, h) + aoff + m * 2048 + k * 1024); } while (0)
#define EG_LDB(dst, b, h) do { _Pragma("unroll") for (int n = 0; n < 2; ++n) _Pragma("unroll") for (int k = 0; k < 2; ++k) dst[n][k] = *(const LAS bf16x8*)(lds + EG_SB(b, h) + boff + n * 2048 + k * 1024); } while (0)
#define EG_MMA(ai, bj, At, Bt) do { __builtin_amdgcn_s_setprio(1); _Pragma("unroll") for (int m = 0; m < 4; ++m) _Pragma("unroll") for (int n = 0; n < 2; ++n) _Pragma("unroll") for (int k = 0; k < 2; ++k) \
        acc[ai][bj][m][n] = __builtin_amdgcn_mfma_f32_16x16x32_bf16(Bt[n][k], At[m][k], acc[ai][bj][m][n], 0, 0, 0); __builtin_amdgcn_s_setprio(0); } while (0)
#define EG_WAIT_V(n) asm volatile("s_waitcnt vmcnt(" #n ")" ::: "memory")
#define EG_WAIT_L(n) asm volatile("s_waitcnt lgkmcnt(" #n ")" ::: "memory")
#define EG_BAR __builtin_amdgcn_s_barrier()
#define EG_SCHED __builtin_amdgcn_sched_barrier(0)
    UnitD cur; int ui = 0;
    if (!ph.get(0, cur)) return;
    UnitD cu = cur; int cui = 0, ct = 0; bool cvalid = true; TD lastTD = tile_at(cur, 0); lastTD.gpar = 0;
    unsigned gA[4] = {0u, 0u, 0u, 0u}, gB[4] = {0u, 0u, 0u, 0u};
    const LAS unsigned* rowtab = (const LAS unsigned*)(lds + STAGE_BYTES + 1024);
#define EG_GLOAD(ord) do { if constexpr (P::GATHER) { if ((ord) & 1) { _Pragma("unroll") for (int _k = 0; _k < 4; ++_k) gB[_k] = rowtab[(ord) * 256 + (_k >> 1) * 128 + (_k & 1) * 64 + vR]; } \
        else { _Pragma("unroll") for (int _k = 0; _k < 4; ++_k) gA[_k] = rowtab[(ord) * 256 + (_k >> 1) * 128 + (_k & 1) * 64 + vR]; } } } while (0)
    EG_GLOAD(0);
#define EG_NEXT(dst) do { if (cvalid) { dst = tile_at(cu, ct); dst.gpar = cui & 1; lastTD = dst; ++ct; if (ct == cu.n0 + cu.n1 + cu.n2) { ++cui; ct = 0; cvalid = ph.get(cui, cu); if (cvalid) EG_GLOAD(cui); } } else dst = lastTD; } while (0)
    Acc acc;
#pragma unroll
    for (int a = 0; a < 2; ++a)
#pragma unroll
        for (int b = 0; b < 2; ++b)
#pragma unroll
            for (int m = 0; m < 4; ++m)
#pragma unroll
                for (int n = 0; n < 2; ++n) acc[a][b][m][n] = (f32x4){0.f, 0.f, 0.f, 0.f};
    bf16x8 At[4][2], B0[2][2], B1[2][2];
    TD d1, d2, d3;
    { TD d0; EG_NEXT(d0); EG_NEXT(d1);
      EG_STAGEB(EG_SB(0, 0), d0.b, d0.ldb); EG_STAGEA(EG_SA(0, 0), d0, 0); EG_STAGEB(EG_SB(0, 1), d0.b + (size_t)(128u * d0.ldb), d0.ldb); EG_STAGEA(EG_SA(0, 1), d0, 1); }
    if (wr == 1) EG_BAR;
    EG_WAIT_V(4); EG_BAR;
    EG_STAGEB(EG_SB(1, 0), d1.b, d1.ldb); EG_STAGEA(EG_SA(1, 0), d1, 0); EG_STAGEB(EG_SB(1, 1), d1.b + (size_t)(128u * d1.ldb), d1.ldb);
    EG_WAIT_V(6); EG_BAR;
    int tc = 0;
    for (;;) {
        EG_NEXT(d2); EG_NEXT(d3);
        if constexpr (P::HOOKS) { int fr_o = fr; asm volatile("" : "+v"(fr_o)); ph.hook(tc, acc, cur, wr, wc, fr_o, fq); }
        EG_LDB(B0, 0, 0); EG_SCHED; EG_LDA(At, 0, 0); EG_STAGEA(EG_SA(1, 1), d1, 1);
        EG_WAIT_L(8); EG_BAR; EG_WAIT_L(0); EG_MMA(0, 0, At, B0); EG_BAR; EG_SCHED;
        EG_LDB(B1, 0, 1); EG_STAGEB(EG_SB(0, 0), d2.b, d2.ldb);
        EG_BAR; EG_WAIT_L(0); EG_MMA(0, 1, At, B1); EG_BAR;
        EG_LDA(At, 0, 1); EG_STAGEA(EG_SA(0, 0), d2, 0);
        EG_BAR; EG_WAIT_L(0); EG_MMA(1, 0, At, B0); EG_BAR; EG_SCHED;
        EG_STAGEB(EG_SB(0, 1), d2.b + (size_t)(128u * d2.ldb), d2.ldb);
        EG_WAIT_V(6); EG_BAR; EG_MMA(1, 1, At, B1); EG_BAR;
        EG_LDB(B0, 1, 0); EG_SCHED; EG_LDA(At, 1, 0); EG_STAGEA(EG_SA(0, 1), d2, 1);
        EG_WAIT_L(8); EG_BAR; EG_WAIT_L(0); EG_MMA(0, 0, At, B0); EG_BAR; EG_SCHED;
        EG_LDB(B1, 1, 1); EG_STAGEB(EG_SB(1, 0), d3.b, d3.ldb);
        EG_BAR; EG_WAIT_L(0); EG_MMA(0, 1, At, B1); EG_BAR;
        EG_LDA(At, 1, 1); EG_STAGEA(EG_SA(1, 0), d3, 0);
        EG_BAR; EG_WAIT_L(0); EG_MMA(1, 0, At, B0); EG_BAR; EG_SCHED;
        EG_STAGEB(EG_SB(1, 1), d3.b + (size_t)(128u * d3.ldb), d3.ldb);
        EG_WAIT_V(6); EG_BAR; EG_MMA(1, 1, At, B1); EG_BAR;
        d1 = d3; tc += 2;
        if (tc == cur.n0 + cur.n1 + cur.n2) {
            { int fr_o = fr, fq_o = fq; asm volatile("" : "+v"(fr_o), "+v"(fq_o));
              ph.epi(acc, cur, wr, wc, fr_o, fq_o); }
            ++ui; tc = 0;
            if (!ph.get(ui, cur)) break;
#pragma unroll
            for (int a = 0; a < 2; ++a)
#pragma unroll
                for (int b = 0; b < 2; ++b)
#pragma unroll
                    for (int m = 0; m < 4; ++m)
#pragma unroll
                        for (int n = 0; n < 2; ++n) acc[a][b][m][n] = (f32x4){0.f, 0.f, 0.f, 0.f};
        }
    }
    EG_WAIT_V(0);
    if (wr == 0) EG_BAR;
    EG_BAR;
#undef EG_NEXT
#undef EG_GLOAD
}
__device__ __forceinline__ void unit1(UnitD& u, const void* A, unsigned lda, const void* B, unsigned ldb, int nt) {
    u.A0 = (const char*)A; u.B0 = (const char*)B; u.lda0 = lda; u.ldb0 = ldb; u.n0 = nt;
    u.A1 = u.A0; u.B1 = u.B0; u.lda1 = lda; u.ldb1 = ldb; u.n1 = 0; u.A2 = u.A0; u.B2 = u.B0; u.lda2 = lda; u.ldb2 = ldb; u.n2 = 0;
    u.kind = 0; u.i0 = 0; u.i1 = 0; u.i2 = 0;
}
}
using eng::UnitD; using eng::Acc;
__device__ __forceinline__ int xcd_remap(int idx, int N) { const int q = N >> 3, r = N & 7, x = idx & 7, off = idx >> 3; return (x < r ? x * (q + 1) : r * (q + 1) + (x - r) * q) + off; }
__device__ __forceinline__ void efence() { asm volatile("" ::: "memory"); }
#define EPI_ARGS const Acc& acc, const UnitD& u, int wr, int wc, int fr, int fq
#define FOR_FRAG(ai, bj, m, n) _Pragma("unroll") for (int ai = 0; ai < 2; ++ai) _Pragma("unroll") for (int m = 0; m < 4; ++m) _Pragma("unroll") for (int bj = 0; bj < 2; efence(), ++bj) _Pragma("unroll") for (int n = 0; n < 2; ++n)
#define FRAG_ROW(ai, m) (128 * (ai) + 64 * wr + 16 * (m) + fr)
#define FRAG_COL(bj, n) (128 * (bj) + 32 * wc + 16 * (n) + 4 * fq)
#define FRAG_COLP(bj) (128 * (bj) + 32 * wc + 8 * fq)
#define FOR_FRAGP(ai, bj, m) _Pragma("unroll") for (int ai = 0; ai < 2; ++ai) _Pragma("unroll") for (int m = 0; m < 4; ++m) _Pragma("unroll") for (int bj = 0; bj < 2; efence(), ++bj)
__device__ __forceinline__ void st_bf16x8(bf16_t* p, f32x4 a, f32x4 b) { u32x4 w; w.x = cvt_pk_bf16(a[0], a[1]); w.y = cvt_pk_bf16(a[2], a[3]); w.z = cvt_pk_bf16(b[0], b[1]); w.w = cvt_pk_bf16(b[2], b[3]); *(u32x4*)p = w; }
__device__ __forceinline__ void st_bf16x4(bf16_t* p, f32x4 v) { u32x2 w; w.x = cvt_pk_bf16(v[0], v[1]); w.y = cvt_pk_bf16(v[2], v[3]); *(u32x2*)p = w; }
struct Frame { Params p; LAS unsigned char* lds; int tid, lane, wid, G, bid; };
#define WSP(T, off) ((T*)(F.p.ws + (off)))

template <class RowSrc>
__device__ __forceinline__ void conv_tile(const Frame& F, bf16_t* dst, int K, int ld, float scale, int r0, int k0, const RowSrc& rs) {
    LAS float* tile = (LAS float*)F.lds;
    const int n4 = (F.tid & 15) * 4, kq = F.tid >> 4;
    const float* sp = rs(r0 + n4) + (size_t)(k0 + kq) * ld;
#pragma unroll
    for (int p = 0; p < 8; ++p) { const f32x4 v = *(const f32x4*)(sp + (size_t)(p * 32) * ld); LAS float* q = tile + (p * 32 + kq) * 65 + n4; q[0] = v[0]; q[1] = v[1]; q[2] = v[2]; q[3] = v[3]; }
    __syncthreads();
    const int i2 = (F.tid & 127) * 2, jb = F.tid >> 7;
#pragma unroll
    for (int p = 0; p < 16; ++p) { const int j = p * 4 + jb; *(unsigned*)(dst + (size_t)(r0 + j) * K + k0 + i2) = cvt_pk_bf16(tile[i2 * 65 + j] * scale, tile[(i2 + 1) * 65 + j] * scale); }
    __syncthreads();
}
__device__ __forceinline__ int sigma_orig(int s) {
    const int half = s >> 7, s2 = s & 127, uu = s2 >> 5, b = (s2 >> 4) & 1, f = s2 & 15; return half * 128 + 16 * uu + f + 64 * b;
}
__device__ __forceinline__ void conv_moe_tile(const Frame& F, int layer, int t) {
    bf16_t* w13 = WSP(bf16_t, A_MOEW); bf16_t* w2t = WSP(bf16_t, A_MOEW + 32 * MiB);
    if (t < 1024) { const int e = t >> 6, rt = (t >> 2) & 15, kt = t & 3;
        const float* w1 = F.p.moe_w1 + ((size_t)layer * 16 + e) * 1024 * 512; const float* w3 = F.p.moe_w3 + ((size_t)layer * 16 + e) * 1024 * 512;
        conv_tile(F, w13 + (size_t)e * 1024 * 1024, 1024, 512, 1.0f, rt * 64, kt * 256, [=](int r) { const int j = r >> 8, rr = r & 255; return rr < 128 ? w1 + 128 * j + rr : w3 + 128 * j + rr - 128; });
    } else { const int u = t - 1024, e = u >> 5, rt = (u >> 1) & 15, kt = u & 1;
        const float* w2 = F.p.moe_w2 + ((size_t)layer * 16 + e) * 512 * 1024;
        conv_tile(F, w2t + (size_t)e * 1024 * 512, 512, 1024, 1.0f, rt * 64, kt * 256, [=](int r) { return w2 + r; }); }
}
__device__ __forceinline__ void conv_moe(const Frame& F, int layer) { for (int t = F.bid; t < 1536; t += F.G) conv_moe_tile(F, layer, t); }
__device__ __forceinline__ void conv_small_tile(const Frame& F, int t) {
    if (t < 96) { const float* w = F.p.w0in; conv_tile(F, WSP(bf16_t, WS_W0IN), 1024, 2560, 1.0f, (t >> 2) * 64, (t & 3) * 256, [=](int r) { return w + 256 + r; }); }
    else if (t < 144) { const int u = t - 96; const float* w = F.p.w0in; conv_tile(F, WSP(bf16_t, WS_W0IN) + (size_t)2048 * 1024, 1024, 2560, 1.0f, (u >> 2) * 64, (u & 3) * 256, [=](int r) { return w + 1792 + r; }); }
    else if (t < 208) { const int u = t - 144; const float* w = F.p.w0out; conv_tile(F, WSP(bf16_t, WS_W0OUT), 1024, 1024, 1.0f, (u >> 2) * 64, (u & 3) * 256, [=](int r) { return w + r; }); }
    else if (t < 272) { const int u = t - 208; const float* w = F.p.w1in; conv_tile(F, WSP(bf16_t, WS_W1IN), 1024, 6144, 1.0f, (u >> 2) * 64, (u & 3) * 256, [=](int r) { return w + (r & ~255) + sigma_orig(r & 255); }); }
    else if (t < 336) { const int u = t - 272; const float* w = F.p.w1in; conv_tile(F, WSP(bf16_t, WS_W1IN) + (size_t)1024 * 1024, 1024, 6144, 0.0625f, (u >> 2) * 64, (u & 3) * 256, [=](int r) { return w + 1024 + (r & ~255) + sigma_orig(r & 255); }); }
    else if (t < 592) { const int u = t - 336; const float* w = F.p.w1in; conv_tile(F, WSP(bf16_t, WS_W1IN) + (size_t)2048 * 1024, 1024, 6144, 1.0f, (u >> 2) * 64, (u & 3) * 256, [=](int r) { return w + 2048 + r; }); }
    else { const int u = t - 592; const float* w = F.p.w1out; conv_tile(F, WSP(bf16_t, WS_W1OUT), 2048, 1024, 1.0f, (u >> 3) * 64, (u & 7) * 256, [=](int r) { return w + r; }); }
}
__device__ __forceinline__ void p0_prologue(const Frame& F) {
    const float TWO_PI = 6.283185307179586f;
    {
        LAS float* sc0 = (LAS float*)F.lds; LAS float* sc1 = sc0 + 1024; LAS float* red = sc1 + 1024;
        for (int k = F.tid; k < 1024; k += 512) { sc0[k] = silu_f(F.p.c[k]); sc1[k] = silu_f(F.p.c_ctx[k]); }
        __syncthreads();
        float* mod = WSP(float, WS_MOD);
        for (int item = F.bid; item < 192; item += F.G) {
            const int l = item / 96, col0 = (item % 96) * 64, l16 = F.tid & 15, kg = F.tid >> 4;
            f32x4 a0 = {0.f, 0.f, 0.f, 0.f}, a1 = {0.f, 0.f, 0.f, 0.f};
#pragma unroll 8
            for (int i = 0; i < 32; ++i) { const int k = kg + 32 * i; const f32x4 w = *(const f32x4*)(F.p.ada_w + ((size_t)l * 1024 + k) * 6144 + col0 + l16 * 4); a0 += sc0[k] * w; a1 += sc1[k] * w; }
#pragma unroll
            for (int e = 0; e < 4; ++e) { red[(kg * 64 + l16 * 4 + e) * 2 + 0] = a0[e]; red[(kg * 64 + l16 * 4 + e) * 2 + 1] = a1[e]; }
            __syncthreads();
            if (F.tid < 128) { const int col = F.tid & 63, which = F.tid >> 6; float s = 0.f; for (int g = 0; g < 32; ++g) s += red[(g * 64 + col) * 2 + which];
                mod[(size_t)which * 2 * 6144 + l * 6144 + col0 + col] = s + F.p.ada_b[l * 6144 + col0 + col]; }
            __syncthreads();
        }
    }
    {
        const int gt = F.bid * 512 + F.tid, gn = F.G * 512;
        float* twc = WSP(float, WS_TWC); float* tws = WSP(float, WS_TWS);
        for (int i = gt; i < 128 * 128; i += gn) { const int b = i >> 7, k1 = i & 127; const float a = (float)((b * k1) & 16383) * (TWO_PI / 16384.0f); twc[i] = cosf(a); tws[i] = sinf(a); }
        float* rc = WSP(float, WS_ROPEC); float* rs = WSP(float, WS_ROPES);
        for (int i = gt; i < 256 * 64; i += gn) { const int pos = i >> 6, fi = i & 63; const float inv = powf(10000.0f, -(float)fi / 64.0f); const float a = (float)pos * inv; rc[i] = cosf(a); rs[i] = sinf(a); }
        bf16_t* f1 = WSP(bf16_t, WS_F1T); bf16_t* f2 = WSP(bf16_t, WS_F2P);
        for (int i = gt; i < 256 * 256; i += gn) { const int n = i >> 8, k = i & 255, k1 = n & 127, a = k & 127; const float ang = (float)((a * k1) & 127) * (TWO_PI / 128.0f); const float cs = cosf(ang), sn = sinf(ang);
            float v1; if (n < 128) v1 = (k < 128) ? cs : sn; else v1 = (k < 128) ? -sn : cs;
            f1[i] = f2bf(v1);
            f2[i] = f2bf(n < 128 ? ((k < 128) ? cs : sn) * (1.0f / 128.0f) : 0.0f); }
        bf16_t* cs256 = WSP(bf16_t, WS_CS256);
        for (int i = gt; i < 256 * 512; i += gn) { const int k = i >> 9, j = i & 511, n = j & 255; const float ang = (float)((n * k) & 255) * (TWO_PI / 256.0f); cs256[i] = f2bf((j < 256 ? cosf(ang) : sinf(ang)) * (1.0f / 16.0f)); }
    }
    {
        LAS float* ct = (LAS float*)F.lds; LAS float* wrow = ct + 64 + F.wid * 64;
        __syncthreads();
        if (F.tid < 64) ct[F.tid] = cosf((float)F.tid * (TWO_PI / 64.0f));
        __syncthreads();
        bf16_t* dst = WSP(bf16_t, WS_W0IN);
        for (int it = F.bid * 8 + F.wid; it < 4096; it += F.G * 8) {
            const int k = it >> 2, g = it & 3;
            wrow[F.lane] = F.p.w0in[(size_t)k * 2560 + g * 64 + F.lane];
            float re = 0.f, im = 0.f;
#pragma unroll 16
            for (int c = 0; c < 64; ++c) { const float w = wrow[c]; const int ph = (c * F.lane) & 63; re += w * ct[ph]; im -= w * ct[(ph + 48) & 63]; }
            dst[(size_t)(1536 + g * 64 + F.lane) * 1024 + k] = f2bf(re * 0.125f); dst[(size_t)(1536 + 256 + g * 64 + F.lane) * 1024 + k] = f2bf(im * 0.125f);
        }
        __syncthreads();
    }
    for (int t = F.bid; t < 720; t += F.G) conv_small_tile(F, t);
}

struct Row { f32x4 v[4]; };
__device__ __forceinline__ void row_load(Row& r, const float* p, int lane) {
#pragma unroll
    for (int i = 0; i < 4; ++i) r.v[i] = *(const f32x4*)(p + 4 * lane + 256 * i);
}
__device__ __forceinline__ void row_store(const Row& r, float* p, int lane) {
#pragma unroll
    for (int i = 0; i < 4; ++i) *(f32x4*)(p + 4 * lane + 256 * i) = r.v[i];
}
__device__ __forceinline__ float row_rstd(const Row& r) {
    float s = 0.f;
#pragma unroll
    for (int i = 0; i < 4; ++i) s += (r.v[i][0] * r.v[i][0] + r.v[i][1] * r.v[i][1]) + (r.v[i][2] * r.v[i][2] + r.v[i][3] * r.v[i][3]);
    s = wave_sum(s);
    return rsqrtf(s * (1.0f / 1024.0f) + RMS_EPS);
}
__device__ __forceinline__ void row_norm_mod(Row& r, const float* g, const float* sh, const float* sc, int lane) {
    const float rs = row_rstd(r);
#pragma unroll
    for (int i = 0; i < 4; ++i) { const int c = 4 * lane + 256 * i; const f32x4 gv = *(const f32x4*)(g + c), shv = *(const f32x4*)(sh + c), scv = *(const f32x4*)(sc + c);
        r.v[i] = (r.v[i] * rs) * gv * (1.0f + scv) + shv; }
}
__device__ __forceinline__ void row_store_bf16(const Row& r, bf16_t* p, int lane) {
#pragma unroll
    for (int i = 0; i < 4; ++i) st_bf16x4(p + 4 * lane + 256 * i, r.v[i]);
}
__device__ __forceinline__ const float* modp(const Frame& F, int layer, bool is_ctx) { return WSP(const float, WS_MOD) + (size_t)(is_ctx ? 2 : 0) * 6144 + layer * 6144; }
__device__ __forceinline__ unsigned char* xm1_panel(const unsigned char* ws, int pm) { return (unsigned char*)ws + (pm < 51 ? B_XM1A + (size_t)pm * HMiB : WS_W0IN + (size_t)(pm - 51) * HMiB); }
__device__ __forceinline__ float* hrow(const Frame& F, int t) { return t < CTXN ? WSP(float, WS_HC) + (size_t)t * DM : F.p.out + (size_t)(t - CTXN) * DM; }

__device__ __forceinline__ void p_norm_in(const Frame& F) {
    bf16_t* xm = WSP(bf16_t, A_XM);
    for (int t = F.bid * 8 + F.wid; t < TT; t += F.G * 8) {
        const bool ic = t < CTXN; const float* src = ic ? F.p.ctx + (size_t)t * DM : F.p.x + (size_t)(t - CTXN) * DM; const float* m = modp(F, 0, ic);
        Row r; row_load(r, src, F.lane); row_norm_mod(r, F.p.norm_g, m, m + 1024, F.lane); row_store_bf16(r, xm + (size_t)t * DM, F.lane);
    }
}
__device__ __forceinline__ void p_router(const Frame& F, int layer, int t0, bf16_t* dst) {
    LAS float* rwT = (LAS float*)F.lds;
    LAS unsigned* lcnt = (LAS unsigned*)(F.lds + 65536);
    for (int i = F.tid; i < 16 * 1024; i += 512) { const int e = i >> 10, c = i & 1023; rwT[i] = F.p.router_w[c * 16 + e]; }
    if (F.tid < 32) lcnt[F.tid] = 0u;
    __syncthreads();
    int* eid = WSP(int, WS_EID); float* gw = WSP(float, WS_GW); int* slot = WSP(int, WS_SLOT);
    unsigned* gcnt = (unsigned*)(F.p.ws + WS_CTL + CTL_CNT) + layer * 64;
    for (int t = t0 + F.bid * 8 + F.wid; t < TT; t += F.G * 8) {
        const bool ic = t < CTXN; const float* m = modp(F, layer, ic);
        Row r; row_load(r, hrow(F, t), F.lane); row_norm_mod(r, F.p.norm_g + (size_t)(layer * 2 + 1) * DM, m + 3072, m + 4096, F.lane); row_store_bf16(r, dst + (size_t)t * DM, F.lane);
        float lg[16];
#pragma unroll
        for (int e = 0; e < 16; ++e) { float s = 0.f;
#pragma unroll
            for (int i = 0; i < 4; ++i) { const f32x4 w = *(const LAS f32x4*)(rwT + e * 1024 + 4 * F.lane + 256 * i); s += (r.v[i][0] * w[0] + r.v[i][1] * w[1]) + (r.v[i][2] * w[2] + r.v[i][3] * w[3]); }
            lg[e] = wave_sum(s); }
        float scv[16], bi[16];
#pragma unroll
        for (int e = 0; e < 16; ++e) { scv[e] = 1.0f / (1.0f + __expf(-lg[e])); bi[e] = scv[e] + F.p.router_b[e]; }
        int gsel = 0; float best = -1e30f;
#pragma unroll
        for (int g = 0; g < 4; ++g) { const float a = bi[4 * g], b = bi[4 * g + 1], c = bi[4 * g + 2], d = bi[4 * g + 3];
            const float h1 = fmaxf(a, b), l1 = fminf(a, b), h2 = fmaxf(c, d), l2 = fminf(c, d); const float gs = fmaxf(h1, h2) + fmaxf(fminf(h1, h2), fmaxf(l1, l2));
            if (gs > best) { best = gs; gsel = g; } }
        float vb[4], vs[4];
#pragma unroll
        for (int i = 0; i < 4; ++i) { vb[i] = gsel == 0 ? bi[i] : gsel == 1 ? bi[4 + i] : gsel == 2 ? bi[8 + i] : bi[12 + i]; vs[i] = gsel == 0 ? scv[i] : gsel == 1 ? scv[4 + i] : gsel == 2 ? scv[8 + i] : scv[12 + i]; }
        int i0 = 0; float b0 = vb[0];
#pragma unroll
        for (int i = 1; i < 4; ++i) if (vb[i] > b0) { b0 = vb[i]; i0 = i; }
        int i1 = -1; float b1 = -1e30f;
#pragma unroll
        for (int i = 0; i < 4; ++i) if (i != i0 && vb[i] > b1) { b1 = vb[i]; i1 = i; }
        const float s0 = i0 == 0 ? vs[0] : i0 == 1 ? vs[1] : i0 == 2 ? vs[2] : vs[3], s1 = i1 == 0 ? vs[0] : i1 == 1 ? vs[1] : i1 == 2 ? vs[2] : vs[3];
        const float inv = 1.0f / (s0 + s1);
        if (F.lane == 0) {
            const int e0 = gsel * 4 + i0, e1 = gsel * 4 + i1;
            const unsigned r0 = __hip_atomic_fetch_add(lcnt + e0, 1u, __ATOMIC_RELAXED, __HIP_MEMORY_SCOPE_WORKGROUP), r1 = __hip_atomic_fetch_add(lcnt + e1, 1u, __ATOMIC_RELAXED, __HIP_MEMORY_SCOPE_WORKGROUP);
            eid[2 * t] = e0; eid[2 * t + 1] = e1; gw[2 * t] = s0 * inv; gw[2 * t + 1] = s1 * inv; slot[2 * t] = (int)r0; slot[2 * t + 1] = (int)r1;
        }
    }
    __syncthreads();
    if (F.tid < 16) lcnt[16 + F.tid] = __hip_atomic_fetch_add(gcnt + F.tid, lcnt[F.tid], __ATOMIC_RELAXED, __HIP_MEMORY_SCOPE_AGENT);
    __syncthreads();
    int* perm = WSP(int, WS_PERM);
    for (int t = t0 + F.bid * 8 + F.wid; t < TT; t += F.G * 8)
        if (F.lane < 2) { const int e = eid[2 * t + F.lane], rk = slot[2 * t + F.lane] + (int)lcnt[16 + e]; slot[2 * t + F.lane] = rk; perm[e * TT + rk] = t; }
    __syncthreads();
}
struct PanelTab { int pst[17]; };
__device__ __forceinline__ void panel_tab(const Frame& F, int layer, PanelTab& pt) {
    const unsigned* gcnt = (const unsigned*)(F.p.ws + WS_CTL + CTL_CNT) + layer * 64;
    pt.pst[0] = 0;
#pragma unroll
    for (int e = 0; e < 16; ++e) pt.pst[e + 1] = pt.pst[e] + (int)((__builtin_amdgcn_readfirstlane(gcnt[e]) + 255u) >> 8);
}
__device__ __forceinline__ int pt_start(const PanelTab& pt, int e) { int ps = 0;
#pragma unroll
    for (int j = 0; j < 16; ++j) ps = (e == j) ? pt.pst[j] : ps;
    return ps; }
__device__ __forceinline__ void moe_rowtab(const Frame& F, int layer, const PanelTab& pt, int t_pad) {
    LAS unsigned* rowtab = (LAS unsigned*)(F.lds + eng::STAGE_BYTES + 1024);
    const unsigned* gcnt = (const unsigned*)(F.p.ws + WS_CTL + CTL_CNT) + layer * 64; const int* perm = WSP(const int, WS_PERM);
    const int NU = pt.pst[16] * 4;
    for (int i = 0; i < 4; ++i) { const int idx0 = F.bid + i * F.G; if (idx0 >= NU) break;
        const int p = xcd_remap(idx0, NU) >> 2; int e = 0;
#pragma unroll
        for (int k = 1; k < 16; ++k) e += (p >= pt.pst[k]) ? 1 : 0;
        if (F.tid < 256) { const int rk = (p - pt_start(pt, e)) * 256 + F.tid; const int tok = rk < (int)gcnt[e] ? perm[e * TT + rk] : t_pad; rowtab[i * 256 + F.tid] = (unsigned)tok * 2048u; } }
    __syncthreads();
}
__device__ __forceinline__ void row_moe_combine(const Frame& F, Row& r, int t, int layer, const bf16_t* Y, const PanelTab& pt) {
    const int* slot = WSP(const int, WS_SLOT); const float* gw = WSP(const float, WS_GW); const int* eid = WSP(const int, WS_EID);
    const int s0 = pt_start(pt, eid[2 * t]) * 256 + slot[2 * t], s1 = pt_start(pt, eid[2 * t + 1]) * 256 + slot[2 * t + 1]; const float w0 = gw[2 * t], w1 = gw[2 * t + 1];
    const float* g2 = modp(F, layer, t < CTXN) + 5120;
#pragma unroll
    for (int i = 0; i < 4; ++i) { const int c = 4 * F.lane + 256 * i;
        const u32x2 a = *(const u32x2*)(Y + (size_t)s0 * DM + c), b = *(const u32x2*)(Y + (size_t)s1 * DM + c); const f32x4 gv = *(const f32x4*)(g2 + c);
        f32x4 f; f[0] = w0 * bflo(a.x) + w1 * bflo(b.x); f[1] = w0 * bfhi(a.x) + w1 * bfhi(b.x); f[2] = w0 * bflo(a.y) + w1 * bflo(b.y); f[3] = w0 * bfhi(a.y) + w1 * bfhi(b.y);
        r.v[i] += gv * f; }
}
__device__ __forceinline__ void p_combine0(const Frame& F) {
    const bf16_t* Y = WSP(const bf16_t, A_XS); PanelTab pt; panel_tab(F, 0, pt);
    for (int t = F.bid * 8 + F.wid; t < TT; t += F.G * 8) {
        Row r; float* hp = hrow(F, t); row_load(r, hp, F.lane); row_moe_combine(F, r, t, 0, Y, pt); row_store(r, hp, F.lane);
        const float* m = modp(F, 1, t < CTXN); row_norm_mod(r, F.p.norm_g + 2 * DM, m, m + 1024, F.lane); row_store_bf16(r, (bf16_t*)xm1_panel(F.p.ws, t >> 8) + (size_t)(t & 255) * DM, F.lane);
    }
}
__device__ __forceinline__ void p_final(const Frame& F) {
    const bf16_t* Y = WSP(const bf16_t, B_XS); PanelTab pt; panel_tab(F, 1, pt);
    for (int t = CTXN + F.bid * 8 + F.wid; t < TT; t += F.G * 8) {
        Row r; float* hp = hrow(F, t); row_load(r, hp, F.lane); row_moe_combine(F, r, t, 1, Y, pt);
        const float rs = row_rstd(r);
#pragma unroll
        for (int i = 0; i < 4; ++i) { const f32x4 gv = *(const f32x4*)(F.p.final_g + 4 * F.lane + 256 * i); r.v[i] = (r.v[i] * rs) * gv; }
        row_store(r, hp, F.lane);
    }
}
__device__ __forceinline__ float log_gamma(const Frame& F, int dir, int h) { return log1pf(-expf(F.p.decay[dir * 4 + h])); }
__device__ __forceinline__ void p_scan(const Frame& F) {
    bf16_t* st = WSP(bf16_t, B_ST);
    const int item = F.bid * 512 + F.tid;
    for (int it = item; it < 8 * 16384; it += F.G * 512) {
        const int hd = it >> 14, grp = it & 16383, h = hd >> 1, dir = hd & 1;
        const float lg = log_gamma(F, dir, h), d256 = __expf(256.0f * lg), d512 = __expf(512.0f * lg);
        float s[8];
#pragma unroll
        for (int j = 0; j < 8; ++j) s[j] = 0.f;
#pragma unroll 4
        for (int step = 0; step < 33; ++step) {
            const int c = (dir == 0 || step == 0) ? step : 33 - step;
            u32x4* p = (u32x4*)(st + ((size_t)(c * 8 + hd) * 131072 + (size_t)grp * 8));
            const u32x4 uv = *p; const float dec = (c == 0) ? d256 : d512;
            u32x4 o; o.x = cvt_pk_bf16(s[0], s[1]); o.y = cvt_pk_bf16(s[2], s[3]); o.z = cvt_pk_bf16(s[4], s[5]); o.w = cvt_pk_bf16(s[6], s[7]);
            *p = o;
            s[0] = s[0] * dec + bflo(uv.x); s[1] = s[1] * dec + bfhi(uv.x); s[2] = s[2] * dec + bflo(uv.y); s[3] = s[3] * dec + bfhi(uv.y);
            s[4] = s[4] * dec + bflo(uv.z); s[5] = s[5] * dec + bfhi(uv.z); s[6] = s[6] * dec + bflo(uv.w); s[7] = s[7] * dec + bfhi(uv.w);
        }
    }
}
#define PH_COMMON const unsigned char* ws; int G, bid; static constexpr bool HOOKS = false, GATHER = false, PERM = false; \
    __device__ __forceinline__ void hook(int, Acc&, const UnitD&, int, int, int, int) const {}
#define PH_COMMONP const unsigned char* ws; int G, bid; static constexpr bool HOOKS = false, GATHER = false, PERM = true; \
    __device__ __forceinline__ void hook(int, Acc&, const UnitD&, int, int, int, int) const {}
#define WSC(T, off) ((T*)(ws + (off)))
__device__ __forceinline__ float sel4(f32x4 v, int h) { const float a = h == 0 ? v[0] : v[1], b = h == 2 ? v[2] : v[3]; return h < 2 ? a : b; }
#define SEL4(a, h) sel4(a, h)
#define EFENCE asm volatile("" ::: "memory")

struct PhG1 { PH_COMMONP
    __device__ __forceinline__ bool get(int i, UnitD& u) const {
        const int idx = bid + i * G; if (idx >= 715) return false;
        const char* xm = (const char*)(ws + A_XM); const char* w = (const char*)(ws + WS_W0IN);
        if (idx < 390) { const int v = xcd_remap(idx, 390), pm = v / 6, pn = v % 6; eng::unit1(u, xm + (size_t)pm * 256 * 2048, 2048, w + (size_t)pn * 256 * 2048, 2048, 16); u.kind = 0; u.i0 = pm; u.i1 = pn; }
        else { const int j = xcd_remap(idx - 390, 325), ct = j / 5, rt = j % 5; eng::unit1(u, w + (size_t)(1536 + rt * 256) * 2048, 2048, xm + (size_t)ct * 256 * 2048, 2048, 16); u.kind = rt < 2 ? 1 : 2; u.i0 = rt; u.i1 = ct; }
        return true;
    }
    __device__ __forceinline__ void epi(EPI_ARGS) const {
        if (u.kind == 0) { bf16_t* o = WSC(bf16_t, A_QK0) + (size_t)(u.i0 * 256) * QK0_LD + u.i1 * 256;
            FOR_FRAGP(ai, bj, m) st_bf16x8(o + (size_t)FRAG_ROW(ai, m) * QK0_LD + FRAG_COLP(bj), acc[ai][bj][m][0], acc[ai][bj][m][1]); }
        else if (u.kind == 2) { bf16_t* o = WSC(bf16_t, A_VT0) + (size_t)((u.i0 - 2) * 256) * TT + u.i1 * 256;
            FOR_FRAGP(ai, bj, m) st_bf16x8(o + (size_t)FRAG_ROW(ai, m) * TT + FRAG_COLP(bj), acc[ai][bj][m][0], acc[ai][bj][m][1]); }
        else if (u.i1 == 0) { bf16_t* o = WSC(bf16_t, WS_XTC) + u.i0 * 256;
            FOR_FRAGP(ai, bj, m) st_bf16x8(o + (size_t)FRAG_ROW(ai, m) * 512 + FRAG_COLP(bj), acc[ai][bj][m][0], acc[ai][bj][m][1]); }
        else { bf16_t* o = WSC(bf16_t, A_XT2) + u.i0 * 128;
            FOR_FRAG(ai, bj, m, n) { const int cc = FRAG_ROW(ai, m), nn = (u.i1 - 1) * 256 + FRAG_COLP(bj) + 4 * n, a = nn >> 7, b = nn & 127; const f32x4 v = acc[ai][bj][m][n];
#pragma unroll
                for (int e = 0; e < 4; ++e) o[(size_t)(cc * 128 + b + e) * 256 + a] = f2bf(v[e]);
                EFENCE; } }
    }
};
struct PhF1 { PH_COMMON
    __device__ __forceinline__ bool get(int i, UnitD& u) const {
        const int idx = bid + i * G; if (idx >= 129) return false;
        if (idx < 128) { eng::unit1(u, ws + A_XT2 + (size_t)idx * 256 * 512, 512, ws + WS_F1T, 512, 4); u.kind = 0; u.i0 = idx; }
        else { eng::unit1(u, ws + WS_CS256, 1024, ws + WS_XTC, 1024, 8); u.kind = 1; }
        return true;
    }
    __device__ __forceinline__ void epi(EPI_ARGS) const {
        if (u.kind == 1) { bf16_t* o = WSC(bf16_t, A_AO); FOR_FRAG(ai, bj, m, n) st_bf16x4(o + (size_t)FRAG_ROW(ai, m) * DM + FRAG_COL(bj, n), acc[ai][bj][m][n]); return; }
        const float* twc = WSC(const float, WS_TWC); const float* tws = WSC(const float, WS_TWS); bf16_t* o = WSC(bf16_t, A_T2);
#pragma unroll
        for (int m = 0; m < 4; ++m)
#pragma unroll
            for (int n = 0; n < 2; ++n) { const int b = 64 * wr + 16 * m + fr, k1 = 32 * wc + 16 * n + 4 * fq; const f32x4 cv = *(const f32x4*)(twc + b * 128 + k1), sv = *(const f32x4*)(tws + b * 128 + k1);
#pragma unroll
                for (int ai = 0; ai < 2; ++ai) { const int cc = 2 * u.i0 + ai; const f32x4 tr = acc[ai][0][m][n], ti = acc[ai][1][m][n];
#pragma unroll
                    for (int e = 0; e < 4; ++e) { bf16_t* q = o + (size_t)((k1 + e) * 256 + cc) * 256 + b; q[0] = f2bf(tr[e] * cv[e] + ti[e] * sv[e]); q[128] = f2bf(ti[e] * cv[e] - tr[e] * sv[e]); } } }
    }
};
struct PhF2 { PH_COMMONP const float* ctx;
    __device__ __forceinline__ bool get(int i, UnitD& u) const {
        const int idx = bid + i * G; if (idx >= 132) return false;
        if (idx < 128) { eng::unit1(u, ws + WS_F2P, 512, ws + A_T2 + (size_t)idx * 256 * 512, 512, 4); u.i0 = idx; }
        else { const int pn = idx - 128; eng::unit1(u, ws + A_AO, 2048, ws + WS_W0OUT + (size_t)pn * 256 * 2048, 2048, 16); u.kind = 1; u.i1 = pn; }
        return true;
    }
    __device__ __forceinline__ void epi(EPI_ARGS) const {
        if (u.kind == 1) { const float* g1 = WSC(const float, WS_MOD) + 2 * 6144 + 2048 + u.i1 * 256; float* dst = WSC(float, WS_HC);
            FOR_FRAG(ai, bj, m, n) { const int c = FRAG_COLP(bj) + 4 * n; const size_t off = (size_t)FRAG_ROW(ai, m) * DM + u.i1 * 256 + c; const f32x4 gv = *(const f32x4*)(g1 + c);
                *(f32x4*)(dst + off) = *(const f32x4*)(ctx + off) + gv * acc[ai][bj][m][n]; }
            return; }
        bf16_t* o = WSC(bf16_t, A_AO);
#pragma unroll
        for (int m = 0; m < 4; ++m)
#pragma unroll
            for (int bj = 0; bj < 2; ++bj) { const int k2 = FRAG_ROW(0, m); st_bf16x8(o + (size_t)(CTXN + u.i0 + 128 * k2) * DM + FRAG_COLP(bj), acc[0][bj][m][0], acc[0][bj][m][1]); }
    }
};
struct PhG2 { PH_COMMON const float* x; float* out;
    __device__ __forceinline__ bool get(int i, UnitD& u) const {
        const int idx0 = bid + i * G; if (idx0 >= 256) return false;
        const int idx = xcd_remap(idx0, 256), pm = 1 + (idx >> 2), pn = idx & 3; eng::unit1(u, ws + A_AO + (size_t)pm * 256 * 2048, 2048, ws + WS_W0OUT + (size_t)pn * 256 * 2048, 2048, 16); u.i0 = pm; u.i1 = pn; return true;
    }
    __device__ __forceinline__ void epi(EPI_ARGS) const {
        const float* g1 = WSC(const float, WS_MOD) + 2048 + u.i1 * 256;
        const float* src = x + (size_t)(u.i0 - 1) * 256 * DM; float* dst = out + (size_t)(u.i0 - 1) * 256 * DM;
        FOR_FRAG(ai, bj, m, n) { const size_t off = (size_t)FRAG_ROW(ai, m) * DM + u.i1 * 256 + FRAG_COL(bj, n); const f32x4 gv = *(const f32x4*)(g1 + FRAG_COL(bj, n));
            *(f32x4*)(dst + off) = *(const f32x4*)(src + off) + gv * acc[ai][bj][m][n]; }
    }
};
struct PhM1 { const unsigned char* ws; int G, bid; PanelTab pt; size_t xs, hd; static constexpr bool HOOKS = false, GATHER = true, PERM = true;
    __device__ __forceinline__ void hook(int, Acc&, const UnitD&, int, int, int, int) const {}
    __device__ __forceinline__ bool get(int i, UnitD& u) const {
        const int idx0 = bid + i * G, NU = pt.pst[16] * 4; if (idx0 >= NU) return false;
        const int idx = xcd_remap(idx0, NU), p = idx >> 2, j = idx & 3; int e = 0;
#pragma unroll
        for (int k = 1; k < 16; ++k) e += (p >= pt.pst[k]) ? 1 : 0;
        eng::unit1(u, ws + xs, 2048, ws + A_MOEW + ((size_t)e * 1024 + j * 256) * 2048, 2048, 16); u.i0 = p; u.i1 = j; return true;
    }
    __device__ __forceinline__ void epi(EPI_ARGS) const {
        bf16_t* o = (bf16_t*)(ws + hd) + (size_t)(u.i0 * 256) * 512 + u.i1 * 128;
#pragma unroll
        for (int ai = 0; ai < 2; ++ai)
#pragma unroll
            for (int m = 0; m < 4; ++m) { f32x4 v[2];
#pragma unroll
                for (int n = 0; n < 2; ++n) { const f32x4 a = acc[ai][0][m][n], b = acc[ai][1][m][n];
#pragma unroll
                    for (int e = 0; e < 4; ++e) v[n][e] = silu_f(a[e]) * b[e]; }
                st_bf16x8(o + (size_t)FRAG_ROW(ai, m) * 512 + FRAG_COLP(0), v[0], v[1]); efence(); }
    }
};
struct PhM2 { PH_COMMONP PanelTab pt; size_t hd, y;
    __device__ __forceinline__ bool get(int i, UnitD& u) const {
        const int idx0 = bid + i * G, NU = pt.pst[16] * 4; if (idx0 >= NU) return false;
        const int idx = xcd_remap(idx0, NU), p = idx >> 2, j = idx & 3; int e = 0;
#pragma unroll
        for (int k = 1; k < 16; ++k) e += (p >= pt.pst[k]) ? 1 : 0;
        eng::unit1(u, ws + hd + (size_t)p * 256 * 1024, 1024, ws + A_MOEW + 32 * MiB + ((size_t)e * 1024 + j * 256) * 1024, 1024, 8); u.i0 = p; u.i1 = j; return true;
    }
    __device__ __forceinline__ void epi(EPI_ARGS) const {
        bf16_t* o = (bf16_t*)(ws + y) + (size_t)(u.i0 * 256) * DM + u.i1 * 256;
        FOR_FRAGP(ai, bj, m) st_bf16x8(o + (size_t)FRAG_ROW(ai, m) * DM + FRAG_COLP(bj), acc[ai][bj][m][0], acc[ai][bj][m][1]);
    }
};
struct PhG3 { PH_COMMON f32x4 lgf, lgb;
    __device__ __forceinline__ bool get(int i, UnitD& u) const {
        const int idx = bid + i * G; if (idx >= 512 + 780) return false;
        const char* w = (const char*)(ws + WS_W1IN);
        if (idx < 512) { const int v = xcd_remap(idx, 512), pm = 1 + (v >> 3), pn = v & 7; eng::unit1(u, xm1_panel(ws, pm), 2048, w + (size_t)pn * 256 * 2048, 2048, 16); u.kind = 0; u.i0 = pm; u.i1 = pn; }
        else { const int j = xcd_remap(idx - 512, 780), ct = j / 12, rt = j % 12; eng::unit1(u, w + (size_t)(1024 + rt * 256) * 2048, 2048, xm1_panel(ws, ct), 2048, 16); u.kind = rt < 4 ? 1 : 2; u.i0 = rt; u.i1 = ct; }
        return true;
    }
    __device__ __forceinline__ void epi(EPI_ARGS) const {
        const float* rc = WSC(const float, WS_ROPEC); const float* rs = WSC(const float, WS_ROPES);
        if (u.kind == 0) {
            bf16_t* o = (u.i1 < 4 ? WSC(bf16_t, B_Q) : WSC(bf16_t, B_K)) + (size_t)(u.i0 * 256) * DM + (u.i1 & 3) * 256;
#pragma unroll
            for (int ai = 0; ai < 2; ++ai)
#pragma unroll
                for (int m = 0; m < 4; ++m) { const int r = FRAG_ROW(ai, m), tl = (u.i0 - 1) * 256 + r;
#pragma unroll
                    for (int bj = 0; bj < 2; ++bj) { const int pos = bj == 0 ? (tl >> 6) : (tl & 63); const f32x4 cv = *(const f32x4*)(rc + pos * 64 + 16 * wc + 4 * fq), sv = *(const f32x4*)(rs + pos * 64 + 16 * wc + 4 * fq);
                        const f32x4 x1 = acc[ai][bj][m][0], x2 = acc[ai][bj][m][1];
                        st_bf16x4(o + (size_t)r * DM + FRAG_COL(bj, 0), x1 * cv - x2 * sv); st_bf16x4(o + (size_t)r * DM + FRAG_COL(bj, 1), x2 * cv + x1 * sv); } }
        } else if (u.kind == 2) { bf16_t* o = WSC(bf16_t, B_VT) + (size_t)((u.i0 - 4) * 256) * TT + u.i1 * 256;
            FOR_FRAG(ai, bj, m, n) st_bf16x4(o + (size_t)FRAG_ROW(ai, m) * TT + FRAG_COL(bj, n), acc[ai][bj][m][n]);
        } else {
            const int h = u.i0; const float lf = SEL4(lgf, h), lb = SEL4(lgb, h);
            bf16_t* of = WSC(bf16_t, B_KF) + (size_t)(h * 256) * TT + u.i1 * 256; bf16_t* ob = WSC(bf16_t, B_KB) + (size_t)(h * 256) * TT + u.i1 * 256;
#pragma unroll
            for (int bj = 0; bj < 2; ++bj)
#pragma unroll
                for (int n = 0; n < 2; ++n) { const int c0 = FRAG_COL(bj, n); f32x4 df, db;
                    if (u.i1 == 0) {
#pragma unroll
                        for (int e = 0; e < 4; ++e) { const int pos = c0 + e; df[e] = __expf(lf * (float)(255 - pos)); db[e] = __expf(lb * (float)pos); }
                    } else {
#pragma unroll
                        for (int e = 0; e < 4; ++e) { const int pos = ((u.i1 - 1) * 256 + c0 + e) & 511; df[e] = __expf(lf * (float)(511 - pos)); db[e] = __expf(lb * (float)pos); }
                    }
#pragma unroll
                    for (int ai = 0; ai < 2; ++ai)
#pragma unroll
                        for (int mp = 0; mp < 2; ++mp) { const int p = 32 * wr + 16 * mp + fr; f32x4 x1 = acc[ai][bj][2 * mp][n], x2 = acc[ai][bj][2 * mp + 1][n];
                            if (u.i1 != 0) { const int tl = (u.i1 - 1) * 256 + c0; f32x4 cv, sv;
                                if (ai == 0) { const float c = rc[(tl >> 6) * 64 + p], s = rs[(tl >> 6) * 64 + p]; cv = (f32x4){c, c, c, c}; sv = (f32x4){s, s, s, s}; }
                                else {
#pragma unroll
                                    for (int e = 0; e < 4; ++e) { cv[e] = rc[((tl + e) & 63) * 64 + p]; sv[e] = rs[((tl + e) & 63) * 64 + p]; } }
                                const f32x4 y1 = x1 * cv - x2 * sv, y2 = x2 * cv + x1 * sv; x1 = y1; x2 = y2; }
                            const size_t o1 = (size_t)FRAG_ROW(ai, 2 * mp) * TT + c0, o2 = (size_t)FRAG_ROW(ai, 2 * mp + 1) * TT + c0;
                            st_bf16x4(of + o1, x1 * df); st_bf16x4(of + o2, x2 * df); st_bf16x4(ob + o1, x1 * db); st_bf16x4(ob + o2, x2 * db); } }
        }
    }
};
__device__ __forceinline__ int chunk_tok0(int c) { return c == 0 ? 0 : 256 + 512 * (c - 1); }
struct PhU { PH_COMMONP
    __device__ __forceinline__ bool get(int i, UnitD& u) const {
        const int idx0 = bid + i * G; if (idx0 >= 528) return false;
        const int idx = xcd_remap(idx0, 528), dvt = idx & 1, dir = (idx >> 1) & 1, h = (idx >> 2) & 3, c = idx >> 4; const size_t tk = (size_t)chunk_tok0(c) * 2;
        eng::unit1(u, ws + B_VT + (size_t)(h * 512 + dvt * 256) * TT * 2 + tk, TT * 2, ws + (dir ? B_KB : B_KF) + (size_t)(h * 256) * TT * 2 + tk, TT * 2, c == 0 ? 4 : 8);
        u.i0 = (c * 8 + h * 2 + dir); u.i1 = dvt; return true;
    }
    __device__ __forceinline__ void epi(EPI_ARGS) const {
        bf16_t* o = WSC(bf16_t, B_ST) + (size_t)u.i0 * 131072 + (size_t)(u.i1 * 256) * 256;
        FOR_FRAGP(ai, bj, m) st_bf16x8(o + (size_t)FRAG_ROW(ai, m) * 256 + FRAG_COLP(bj), acc[ai][bj][m][0], acc[ai][bj][m][1]);
    }
};
struct PhSD { PH_COMMONP f32x4 lgf, lgb;
    __device__ __forceinline__ bool get(int i, UnitD& u) const {
        const int idx0 = bid + i * G; if (idx0 >= 512) return false;
        const int idx = xcd_remap(idx0, 512), tj = idx & 1, ti = (idx >> 1) & 1, h = (idx >> 2) & 3, c = 1 + (idx >> 4); const int t0 = chunk_tok0(c);
        eng::unit1(u, ws + B_Q + (size_t)(t0 + 256 * ti) * 2048 + h * 512, 2048, ws + B_K + (size_t)(t0 + 256 * tj) * 2048 + h * 512, 2048, 4);
        u.i0 = t0; u.i1 = h; u.i2 = ti * 2 + tj; return true;
    }
    __device__ __forceinline__ void epi(EPI_ARGS) const {
        const int ti = u.i2 >> 1, tj = u.i2 & 1, h = u.i1; const float lf = SEL4(lgf, h), lb = SEL4(lgb, h);
        bf16_t* o = WSC(bf16_t, B_SD) + (size_t)(u.i0 + 256 * ti) * 2048 + h * 512 + 256 * tj;
        FOR_FRAGP(ai, bj, m) { const int r = FRAG_ROW(ai, m), c0 = FRAG_COLP(bj), i = 256 * ti + r; f32x4 v[2];
#pragma unroll
            for (int n = 0; n < 2; ++n) { v[n] = acc[ai][bj][m][n];
#pragma unroll
                for (int e = 0; e < 4; ++e) { const int d = i - (256 * tj + c0 + 4 * n + e); const float w = d > 0 ? __expf(lf * (float)d) : d < 0 ? __expf(lb * (float)(-d)) : 2.0f; v[n][e] *= w; } }
            st_bf16x8(o + (size_t)r * 2048 + c0, v[0], v[1]); }
    }
};
struct PhO { const unsigned char* ws; int G, bid; f32x4 lgf, lgb; static constexpr bool HOOKS = true, GATHER = false, PERM = true;
    __device__ __forceinline__ bool get(int i, UnitD& u) const {
        const int idx0 = bid + i * G; if (idx0 >= 512) return false;
        const int idx = xcd_remap(idx0, 512), dvt = idx & 1, h = (idx >> 1) & 3, pm = idx >> 3, c = 1 + (pm >> 1), t0 = CTXN + 256 * pm;
        const char* q = (const char*)(ws + B_Q) + (size_t)t0 * 2048 + h * 512;
        const char* st = (const char*)(ws + B_ST) + ((size_t)(c * 8 + h * 2) * 131072 + (size_t)(dvt * 256) * 256) * 2;
        u.A0 = q; u.B0 = st; u.lda0 = 2048; u.ldb0 = 512; u.n0 = 4;
        u.A1 = q; u.B1 = st + (size_t)131072 * 2; u.lda1 = 2048; u.ldb1 = 512; u.n1 = 4;
        u.A2 = (const char*)(ws + B_SD) + (size_t)t0 * 4096 + h * 1024; u.B2 = (const char*)(ws + B_VT) + (size_t)(h * 512 + dvt * 256) * TT * 2 + (size_t)chunk_tok0(c) * 2; u.lda2 = 4096; u.ldb2 = TT * 2; u.n2 = 8;
        u.kind = 0; u.i0 = pm; u.i1 = h; u.i2 = dvt; return true;
    }
    __device__ __forceinline__ void hook(int tc, Acc& acc, const UnitD& u, int wr, int wc, int fr, int fq) const {
        if (tc != 4 && tc != 8) return;
        const float lf = SEL4(lgf, u.i1), lb = SEL4(lgb, u.i1);
#pragma unroll
        for (int ai = 0; ai < 2; ++ai)
#pragma unroll
            for (int m = 0; m < 4; ++m) { const int i = (u.i0 & 1) * 256 + FRAG_ROW(ai, m);
                const float s = tc == 4 ? __expf(lf * (float)(i + 1) - lb * (float)(512 - i)) : __expf(lb * (float)(512 - i));
#pragma unroll
                for (int bj = 0; bj < 2; ++bj)
#pragma unroll
                    for (int n = 0; n < 2; ++n) acc[ai][bj][m][n] *= s; }
    }
    __device__ __forceinline__ void epi(EPI_ARGS) const {
        const int tl = 256 * u.i0, h = u.i1, dvt = u.i2;
        bf16_t* o = WSC(bf16_t, B_O) + (size_t)(CTXN + tl) * 2048 + h * 512 + dvt * 256; float* ssq = WSC(float, WS_SSQ);
#pragma unroll
        for (int ai = 0; ai < 2; ++ai)
#pragma unroll
            for (int m = 0; m < 4; ++m) { const int r = FRAG_ROW(ai, m); float s = 0.f;
#pragma unroll
                for (int bj = 0; bj < 2; ++bj) {
#pragma unroll
                    for (int n = 0; n < 2; ++n) { const f32x4 v = acc[ai][bj][m][n]; s += (v[0] * v[0] + v[1] * v[1]) + (v[2] * v[2] + v[3] * v[3]); }
                    st_bf16x8(o + (size_t)r * 2048 + FRAG_COLP(bj), acc[ai][bj][m][0], acc[ai][bj][m][1]); }
                s += __shfl_xor(s, 16); s += __shfl_xor(s, 32);
                if (fq == 0) ssq[((size_t)(tl + r) * 4 + h) * 8 + dvt * 4 + wc] = s; }
    }
};
struct PhGG { PH_COMMONP
    __device__ __forceinline__ bool get(int i, UnitD& u) const {
        const int idx0 = bid + i * G; if (idx0 >= 512) return false;
        const int idx = xcd_remap(idx0, 512), pm = 1 + (idx >> 3), pn = idx & 7; eng::unit1(u, xm1_panel(ws, pm), 2048, ws + WS_W1IN + (size_t)(4096 + pn * 256) * 2048, 2048, 16); u.i0 = pm; u.i1 = pn; return true;
    }
    __device__ __forceinline__ void epi(EPI_ARGS) const {
        bf16_t* o = WSC(bf16_t, B_O) + (size_t)(u.i0 * 256) * 2048 + u.i1 * 256; const float* ssq = WSC(const float, WS_SSQ); const int h = u.i1 >> 1;
#pragma unroll
        for (int ai = 0; ai < 2; ++ai)
#pragma unroll
            for (int m = 0; m < 4; ++m) { const int r = FRAG_ROW(ai, m); const float* sp = ssq + ((size_t)((u.i0 - 1) * 256 + r) * 4 + h) * 8;
                const f32x4 s0 = *(const f32x4*)sp, s1 = *(const f32x4*)(sp + 4); const float rstd = rsqrtf((((s0[0] + s0[1]) + (s0[2] + s0[3])) + ((s1[0] + s1[1]) + (s1[2] + s1[3]))) * (1.0f / 512.0f) + RMS_EPS);
#pragma unroll
                for (int bj = 0; bj < 2; ++bj) { bf16_t* q = o + (size_t)r * 2048 + FRAG_COLP(bj); const u32x4 ov = *(const u32x4*)q; const f32x4 g0 = acc[ai][bj][m][0], g1 = acc[ai][bj][m][1]; f32x4 v0, v1;
                    v0[0] = silu_f(g0[0]) * (bflo(ov.x) * rstd); v0[1] = silu_f(g0[1]) * (bfhi(ov.x) * rstd); v0[2] = silu_f(g0[2]) * (bflo(ov.y) * rstd); v0[3] = silu_f(g0[3]) * (bfhi(ov.y) * rstd);
                    v1[0] = silu_f(g1[0]) * (bflo(ov.z) * rstd); v1[1] = silu_f(g1[1]) * (bfhi(ov.z) * rstd); v1[2] = silu_f(g1[2]) * (bflo(ov.w) * rstd); v1[3] = silu_f(g1[3]) * (bfhi(ov.w) * rstd);
                    st_bf16x8(q, v0, v1); } }
    }
};
struct PhG4 { PH_COMMON float* out;
    __device__ __forceinline__ bool get(int i, UnitD& u) const {
        const int idx0 = bid + i * G; if (idx0 >= 256) return false;
        const int idx = xcd_remap(idx0, 256), pm = idx >> 2, pn = idx & 3; eng::unit1(u, ws + B_O + (size_t)(CTXN + pm * 256) * 4096, 4096, ws + WS_W1OUT + (size_t)pn * 256 * 4096, 4096, 32); u.i0 = pm; u.i1 = pn; return true;
    }
    __device__ __forceinline__ void epi(EPI_ARGS) const {
        const float* g1 = WSC(const float, WS_MOD) + 6144 + 2048 + u.i1 * 256; float* dst = out + (size_t)(u.i0 * 256) * DM + u.i1 * 256;
        FOR_FRAG(ai, bj, m, n) { float* q = dst + (size_t)FRAG_ROW(ai, m) * DM + FRAG_COL(bj, n); const f32x4 gv = *(const f32x4*)(g1 + FRAG_COL(bj, n)); *(f32x4*)q = *(const f32x4*)q + gv * acc[ai][bj][m][n]; }
    }
};

constexpr int NA_KC = 0, NA_VC = 32768, NA_RPB = 65536;
__device__ __forceinline__ int na_ksw(int tok) { return ((tok >> 1) & 1) | (((tok >> 3) & 3) << 1); }
__device__ __forceinline__ void na_load_ctx(const Frame& F, int h) {
    const bf16_t* qk = WSP(const bf16_t, A_QK0); const bf16_t* vt = WSP(const bf16_t, A_VT0);
#pragma unroll
    for (int i = 0; i < 4; ++i) { const int cid = F.tid + 512 * i, tok = cid >> 3, c = cid & 7;
        *(LAS u32x4*)(F.lds + NA_KC + tok * 128 + ((c ^ na_ksw(tok)) << 4)) = *(const u32x4*)(qk + (size_t)tok * QK0_LD + 768 + h * 64 + c * 8); }
#pragma unroll
    for (int i = 0; i < 4; ++i) { const int cid = F.tid + 512 * i, d = cid >> 5, ch = cid & 31;
        *(LAS u32x4*)(F.lds + NA_VC + d * 512 + ((ch ^ (d & 15)) << 4)) = *(const u32x4*)(vt + (size_t)(h * 64 + d) * TT + ch * 8); }
}
template <bool LOCAL>
__device__ __forceinline__ void na_unit(const Frame& F, int r, int j, int h, int qb) {
    const bf16_t* qk = WSP(const bf16_t, A_QK0); const bf16_t* vt = WSP(const bf16_t, A_VT0); bf16_t* ao = WSP(bf16_t, A_AO);
    const LAS float* rpb_l = (const LAS float*)(F.lds + NA_RPB);
    int lane = F.lane; asm volatile("" : "+v"(lane));
    const int q16 = lane & 15, g = lane >> 4;
    const int tq = LOCAL ? CTXN + r * GW + 16 * j + q16 : 16 * qb + q16;
    bf16x8 qf[2];
#pragma unroll
    for (int ks = 0; ks < 2; ++ks) qf[ks] = *(const bf16x8*)(qk + (size_t)tq * QK0_LD + h * 64 + 32 * ks + 8 * g);
    constexpr int NT = LOCAL ? 32 : 16, NL = LOCAL ? 16 : 0;
    f32x4 s[NT];
    const int rs = LOCAL ? min(max(r - 4, 0), 248) : 0, kst = LOCAL ? min(max(16 * j - 8, 0), 32) : 0;
    const int krow = 8 * (q16 >> 2) + (q16 & 3);
#pragma unroll
    for (int t = 0; t < NT; ++t) {
        bf16x8 k0, k1;
        if (t < NL) { const int tok = CTXN + (rs + (t >> 1)) * GW + kst + krow + 4 * (t & 1); const bf16_t* kp = qk + (size_t)tok * QK0_LD + 768 + h * 64 + 8 * g; k0 = *(const bf16x8*)kp; k1 = *(const bf16x8*)(kp + 32); }
        else { const int tok = 32 * ((t - NL) >> 1) + krow + 4 * (t & 1), sw = na_ksw(tok); const LAS unsigned char* kp = F.lds + NA_KC + tok * 128;
            k0 = *(const LAS bf16x8*)(kp + ((g ^ sw) << 4)); k1 = *(const LAS bf16x8*)(kp + (((4 + g) ^ sw) << 4)); }
        f32x4 a = {0.f, 0.f, 0.f, 0.f};
        a = __builtin_amdgcn_mfma_f32_16x16x32_bf16(k0, qf[0], a, 0, 0, 0); a = __builtin_amdgcn_mfma_f32_16x16x32_bf16(k1, qf[1], a, 0, 0, 0);
        s[t] = a;
        if ((t & 3) == 3) asm volatile("" ::: "memory");
    }
    float mx = -1e30f;
    if (LOCAL) { const int qc = 16 * j + q16, wst = min(max(qc - 8, 0), 48);
#pragma unroll
        for (int t = 0; t < NL; ++t) { const int dr = rs + (t >> 1) - r + 7;
#pragma unroll
            for (int e = 0; e < 4; ++e) { const int kc = kst + 8 * g + 4 * (t & 1) + e; const bool ok = kc >= wst && kc < wst + 16; const int dc = min(max(kc - qc + 15, 0), 30);
                const float v = ok ? s[t][e] * 0.125f + rpb_l[(h * 15 + dr) * 31 + dc] : -1e30f; s[t][e] = v; mx = fmaxf(mx, v); } } }
#pragma unroll
    for (int t = NL; t < NT; ++t)
#pragma unroll
        for (int e = 0; e < 4; ++e) { const float v = s[t][e] * 0.125f; s[t][e] = v; mx = fmaxf(mx, v); }
    mx = fmaxf(mx, __shfl_xor(mx, 16)); mx = fmaxf(mx, __shfl_xor(mx, 32));
    float sum = 0.f; u32x4 pw[NT / 2];
#pragma unroll
    for (int b = 0; b < NT / 2; ++b) { float p[8];
#pragma unroll
        for (int e = 0; e < 4; ++e) { p[e] = __expf(s[2 * b][e] - mx); p[4 + e] = __expf(s[2 * b + 1][e] - mx); }
        sum += ((p[0] + p[1]) + (p[2] + p[3])) + ((p[4] + p[5]) + (p[6] + p[7]));
        pw[b].x = cvt_pk_bf16(p[0], p[1]); pw[b].y = cvt_pk_bf16(p[2], p[3]); pw[b].z = cvt_pk_bf16(p[4], p[5]); pw[b].w = cvt_pk_bf16(p[6], p[7]); }
    sum += __shfl_xor(sum, 16); sum += __shfl_xor(sum, 32);
    f32x4 o[4];
#pragma unroll
    for (int dt = 0; dt < 4; ++dt) o[dt] = (f32x4){0.f, 0.f, 0.f, 0.f};
#pragma unroll
    for (int b = 0; b < NT / 2; ++b) {
        const bf16x8 pf = __builtin_bit_cast(bf16x8, pw[b]);
#pragma unroll
        for (int dt = 0; dt < 4; ++dt) { bf16x8 vf;
            if (b < NL / 2) vf = *(const bf16x8*)(vt + (size_t)(h * 64 + 16 * dt + q16) * TT + CTXN + (rs + b) * GW + kst + 8 * g);
            else vf = *(const LAS bf16x8*)(F.lds + NA_VC + (16 * dt + q16) * 512 + (((4 * (b - NL / 2) + g) ^ q16) << 4));
            o[dt] = __builtin_amdgcn_mfma_f32_16x16x32_bf16(vf, pf, o[dt], 0, 0, 0); }
        if ((b & 1) == 1) asm volatile("" ::: "memory");
    }
    const float inv = 1.0f / sum;
#pragma unroll
    for (int dt = 0; dt < 4; ++dt) st_bf16x4(ao + (size_t)tq * DM + 256 + h * 64 + 16 * dt + 4 * g, o[dt] * inv);
}
__device__ __forceinline__ void p_attention(const Frame& F) {
    if ((F.bid & 3) == 3) { for (int t = F.bid >> 2; t < 1536; t += (F.G >> 2)) conv_moe_tile(F, 0, t); }
    __syncthreads();
    LAS float* rpb_l = (LAS float*)(F.lds + NA_RPB); volatile LAS int* tick = (volatile LAS int*)(F.lds + NA_RPB + 24576);
    for (int i = F.tid; i < 12 * 15 * 31; i += 512) rpb_l[i] = F.p.rpb[i];
    unsigned* heads = (unsigned*)(F.p.ws + WS_CTL + CTL_QUEUE);
    const int h0 = (12 * F.bid) >> 8;
    for (int hh = 0; hh < 12; ++hh) {
        const int h = (h0 + hh) % 12; bool loaded = false;
        for (;;) {
            __syncthreads();
            if (F.tid == 0) tick[0] = (int)__hip_atomic_fetch_add(heads + h * 64, 1u, __ATOMIC_RELAXED, __HIP_MEMORY_SCOPE_AGENT);
            __syncthreads();
            const int k = __builtin_amdgcn_readfirstlane(tick[0]);
            if (k > 128) break;
            if (!loaded) { na_load_ctx(F, h); __syncthreads(); loaded = true; }
            if (k < 128) na_unit<true>(F, 2 * k + (F.wid >> 2), F.wid & 3, h, 0);
            else { na_unit<false>(F, 0, 0, h, F.wid); na_unit<false>(F, 0, 0, h, F.wid + 8); }
        }
    }
    __syncthreads();
}
constexpr int LDS_BYTES = eng::STAGE_BYTES + 1024 + 4096;
#ifndef MK_PER_PHASE
#define MK_PER_PHASE 0
#endif

__global__ __launch_bounds__(512, 2) void mk_fwd(Params p) {
    extern __shared__ __attribute__((aligned(16))) unsigned char shm[];
    Frame F; F.p = p; F.lds = (LAS unsigned char*)shm; F.tid = threadIdx.x; F.lane = F.tid & 63; F.wid = __builtin_amdgcn_readfirstlane(F.tid >> 6); F.G = gridDim.x; F.bid = blockIdx.x;
    volatile LAS unsigned* xb = (volatile LAS unsigned*)(F.lds + eng::STAGE_BYTES);
    if (F.tid < 4) xb[F.tid] = 0u;
    __syncthreads();
    const int lo = p.ph_lo, hi = p.ph_hi;
    XcdBarrier bar; bar.bar = (unsigned*)(p.ws + WS_CTL); bar.x = 0; bar.st = xb;
    if (hi - lo > 1) bar = xcd_barrier_post((unsigned*)(p.ws + WS_CTL), xb);
#ifndef PHMASK
#define PHMASK 0xFFFFFFu
#endif
#define IN(k) (((PHMASK >> (k)) & 1u) && lo <= (k) && (k) < hi)
#ifndef PROBE_MASK
#define PROBE_MASK 0u
#endif
#ifndef PROBE_MULT
#define PROBE_MULT 1
#endif
    unsigned long long pr_acc = 0, pr_prev = PROBE_MASK ? wall_clock64() : 0ull;
#define SEAM(k) do { if (IN(k) && hi > (k) + 1) xcd_barrier(bar); if (PROBE_MASK) { const unsigned long long _n = wall_clock64(); if ((PROBE_MASK >> (k)) & 1u) pr_acc += _n - pr_prev; pr_prev = _n; } } while (0)
    const unsigned char* ws = p.ws;

    if (IN(0)) { p0_prologue(F); } SEAM(0);
    if (IN(1)) { p_norm_in(F); } SEAM(1);
    if (IN(2)) { PhG1 ph{ws, F.G, F.bid}; eng::gemm_run(F.lds, ph); } SEAM(2);
    if (IN(3)) { PhF1 ph{ws, F.G, F.bid}; eng::gemm_run(F.lds, ph); p_attention(F); } SEAM(3);
    if (IN(4)) { PhF2 ph{ws, F.G, F.bid, p.ctx}; eng::gemm_run(F.lds, ph); } SEAM(4);
    if (IN(5)) { PhG2 ph{ws, F.G, F.bid, p.x, p.out}; eng::gemm_run(F.lds, ph); } SEAM(5);
    if (IN(6)) { p_router(F, 0, 0, WSP(bf16_t, A_XM)); } SEAM(6);
    if (IN(8)) { PhM1 ph{ws, F.G, F.bid}; panel_tab(F, 0, ph.pt); ph.xs = A_XM; ph.hd = A_HD; moe_rowtab(F, 0, ph.pt, 0); eng::gemm_run(F.lds, ph); } SEAM(8);
    if (IN(9)) { PhM2 ph{ws, F.G, F.bid}; panel_tab(F, 0, ph.pt); ph.hd = A_HD; ph.y = A_XS; eng::gemm_run(F.lds, ph); } SEAM(9);
    if (IN(10)) { p_combine0(F); } SEAM(10);
    if (IN(11)) { PhG3 ph{ws, F.G, F.bid};
        ph.lgf = (f32x4){log_gamma(F, 0, 0), log_gamma(F, 0, 1), log_gamma(F, 0, 2), log_gamma(F, 0, 3)}; ph.lgb = (f32x4){log_gamma(F, 1, 0), log_gamma(F, 1, 1), log_gamma(F, 1, 2), log_gamma(F, 1, 3)};
        eng::gemm_run(F.lds, ph); } SEAM(11);
    if (IN(12)) { PhU ph{ws, F.G, F.bid}; eng::gemm_run(F.lds, ph); } SEAM(13);
    if (IN(14)) { PhSD ph{ws, F.G, F.bid};
        ph.lgf = (f32x4){log_gamma(F, 0, 0), log_gamma(F, 0, 1), log_gamma(F, 0, 2), log_gamma(F, 0, 3)}; ph.lgb = (f32x4){log_gamma(F, 1, 0), log_gamma(F, 1, 1), log_gamma(F, 1, 2), log_gamma(F, 1, 3)};
        if (F.bid & 8) { p_scan(F); eng::gemm_run(F.lds, ph); } else { eng::gemm_run(F.lds, ph); p_scan(F); } } SEAM(14);
    if (IN(15)) { PhO ph{ws, F.G, F.bid};
        ph.lgf = (f32x4){log_gamma(F, 0, 0), log_gamma(F, 0, 1), log_gamma(F, 0, 2), log_gamma(F, 0, 3)}; ph.lgb = (f32x4){log_gamma(F, 1, 0), log_gamma(F, 1, 1), log_gamma(F, 1, 2), log_gamma(F, 1, 3)};
        eng::gemm_run(F.lds, ph); } SEAM(15);
    if (IN(17)) { PhGG ph{ws, F.G, F.bid}; eng::gemm_run(F.lds, ph); } SEAM(17);
    if (IN(18)) { PhG4 ph{ws, F.G, F.bid, p.out};
        if (F.bid & 8) { conv_moe(F, 1); eng::gemm_run(F.lds, ph); } else { eng::gemm_run(F.lds, ph); conv_moe(F, 1); } } SEAM(18);
    if (IN(19)) { p_router(F, 1, CTXN, WSP(bf16_t, B_XM2)); } SEAM(19);
    if (IN(21)) { PhM1 ph{ws, F.G, F.bid}; panel_tab(F, 1, ph.pt); ph.xs = B_XM2; ph.hd = B_HD; moe_rowtab(F, 1, ph.pt, CTXN); eng::gemm_run(F.lds, ph); } SEAM(21);
    if (IN(22)) { PhM2 ph{ws, F.G, F.bid}; panel_tab(F, 1, ph.pt); ph.hd = B_HD; ph.y = B_XS; eng::gemm_run(F.lds, ph); } SEAM(22);
    if (IN(23)) { p_final(F); }
    if (PROBE_MASK) { SEAM(23); if (F.bid == 0) { const unsigned long long t0 = wall_clock64(); while (wall_clock64() - t0 < pr_acc * PROBE_MULT) __builtin_amdgcn_s_sleep(8); } }
#undef IN
#undef SEAM
}

extern "C" void kernel_launch(void* const* d_in, const int* in_sizes, int n_in, void* d_out, int out_size, void* d_ws, size_t ws_size, hipStream_t stream) {
    static int grid = 0;
    if (grid == 0) {
        if (n_in != 19 || out_size != SEQ * DM || ws_size < WS_END) { fprintf(stderr, "kernel_launch: unexpected shapes (n_in %d, out %d, ws %zu < %zu)\n", n_in, out_size, ws_size, (size_t)WS_END); grid = -1; return; }
        int dev = 0, cus = 0, per_cu = 0;
        if (hipGetDevice(&dev) != hipSuccess || hipDeviceGetAttribute(&cus, hipDeviceAttributeMultiprocessorCount, dev) != hipSuccess) { grid = -1; return; }
        if (hipFuncSetAttribute((const void*)mk_fwd, hipFuncAttributeMaxDynamicSharedMemorySize, LDS_BYTES) != hipSuccess) { fprintf(stderr, "kernel_launch: hipFuncSetAttribute failed\n"); grid = -1; return; }
        if (hipOccupancyMaxActiveBlocksPerMultiprocessor(&per_cu, (const void*)mk_fwd, 512, LDS_BYTES) != hipSuccess || per_cu < 1) { fprintf(stderr, "kernel_launch: occupancy query says %d\n", per_cu); per_cu = 1; }
        (void)hipGetLastError();
        grid = cus;
        if (grid > 256) grid = 256;
    }
    if (grid < 0) return;
    (void)hipMemsetAsync((char*)d_ws + WS_CTL, 0, CTL_BYTES, stream);
    Params p{};
    const float** pp = (const float**)&p;
    for (int i = 0; i < 19; ++i) pp[i] = (const float*)d_in[i];
    p.out = (float*)d_out; p.ws = (unsigned char*)d_ws;
#if MK_PER_PHASE
    for (int ph = 0; ph < NPHASE; ++ph) { p.ph_lo = ph; p.ph_hi = ph + 1; hipLaunchKernelGGL(mk_fwd, dim3(grid), dim3(512), LDS_BYTES, stream, p); }
#else
    p.ph_lo = 0; p.ph_hi = NPHASE; hipLaunchKernelGGL(mk_fwd, dim3(grid), dim3(512), LDS_BYTES, stream, p);
#endif
}
```

```cpp
#include <hip/hip_runtime.h>
#include <cstdio>
#include <cstdint>

typedef unsigned short bf16_t;
typedef short bf16x8 __attribute__((ext_vector_type(8)));
typedef float f32x4 __attribute__((ext_vector_type(4)));
typedef float f32x2 __attribute__((ext_vector_type(2)));
typedef unsigned u32x2 __attribute__((ext_vector_type(2)));
typedef unsigned u32x4 __attribute__((ext_vector_type(4)));
#define LAS __attribute__((address_space(3)))

constexpr int DM = 1024, SEQ = 16384, CTXN = 256, TT = SEQ + CTXN  , GW = 64;
constexpr int NH0 = 12, QK0_LD = 1536, W0IN_ROWS = 2816;
constexpr int NPMAX = 146;
constexpr float RMS_EPS = 1e-6f;
constexpr int NPHASE = 24;

constexpr size_t KiB = 1024, MiB = 1024 * 1024, HMiB = 512 * 1024;
constexpr size_t WS_CTL = 0;
constexpr size_t CTL_BYTES = 64 * KiB;
constexpr size_t CTL_CNT = 16 * KiB;
constexpr size_t CTL_QUEUE = 20 * KiB;
constexpr size_t WS_MOD = 64 * KiB;
constexpr size_t WS_TWC = 256 * KiB, WS_TWS = 320 * KiB;
constexpr size_t WS_ROPEC = 384 * KiB, WS_ROPES = 448 * KiB;
constexpr size_t WS_F1T = 512 * KiB, WS_F2P = 640 * KiB;
constexpr size_t WS_CS256 = 768 * KiB;
constexpr size_t WS_HC = 1 * MiB;
constexpr size_t WS_EID = 2 * MiB;
constexpr size_t WS_GW = 2 * MiB + 256 * KiB;
constexpr size_t WS_SLOT = 2 * MiB + 512 * KiB;
constexpr size_t WS_SSQ = 3 * MiB;
constexpr size_t WS_XTC = 5 * MiB;
constexpr size_t WS_PERM = 6 * MiB;
constexpr size_t WS_W0IN = 8 * MiB, WS_W0OUT = 14 * MiB, WS_W1IN = 16 * MiB, WS_W1OUT = 28 * MiB;
constexpr size_t AR = 32 * MiB;
constexpr size_t A_XM = AR + 0, A_QK0 = AR + 65 * HMiB, A_VT0 = AR + 81 * MiB + 256 * KiB, A_XT2 = AR + 106 * MiB, A_T2 = AR + 122 * MiB + HMiB, A_AO = AR + 139 * MiB;
constexpr size_t A_PART = AR + 172 * MiB;
constexpr size_t A_XS = AR + 65 * HMiB, A_HD = AR + 106 * MiB, A_MOEW = AR + 245 * MiB;
constexpr size_t B_Q = AR + 0, B_K = AR + 65 * HMiB, B_O = AR + 65 * HMiB, B_KF = AR + 195 * HMiB, B_KB = AR + 130 * MiB, B_SD = AR + 195 * HMiB, B_VT = AR + 325 * HMiB;
constexpr size_t B_XM1 = AR + 455 * HMiB, B_ST = AR + 455 * HMiB, B_XM1B = AR + 0, B_XM2 = AR + 0, B_XS = AR + 195 * HMiB, B_HD = AR + 341 * HMiB;
constexpr size_t B_XM1A = AR + 587 * HMiB;
constexpr size_t WS_END = AR + 319 * MiB;

struct Params {
    const float *x, *c, *ctx, *c_ctx, *ada_w, *ada_b, *norm_g, *final_g, *w0in, *w0out, *rpb, *w1in, *w1out, *decay, *router_w, *router_b, *moe_w1, *moe_w3, *moe_w2;
    float* out; unsigned char* ws; int ph_lo, ph_hi;
};

__device__ __forceinline__ unsigned cvt_pk_bf16(float lo, float hi) { unsigned r; asm volatile("v_cvt_pk_bf16_f32 %0, %1, %2" : "=v"(r) : "v"(lo), "v"(hi)); return r; }
__device__ __forceinline__ bf16_t f2bf(float f) { return (bf16_t)(cvt_pk_bf16(f, 0.f) & 0xffffu); }
__device__ __forceinline__ float bf2f(unsigned short b) { return __uint_as_float(((unsigned)b) << 16); }
__device__ __forceinline__ float bflo(unsigned w) { return __uint_as_float(w << 16); }
__device__ __forceinline__ float bfhi(unsigned w) { return __uint_as_float(w & 0xffff0000u); }
__device__ __forceinline__ float silu_f(float v) { return v / (1.0f + __expf(-v)); }
__device__ __forceinline__ float wave_sum(float v) {
#pragma unroll
    for (int o = 32; o >= 1; o >>= 1) v += __shfl_xor(v, o);
    return v;
}
__device__ __forceinline__ float wave_max(float v) {
#pragma unroll
    for (int o = 32; o >= 1; o >>= 1) v = fmaxf(v, __shfl_xor(v, o));
    return v;
}
#define XB_TMO      128
#define XB_XCNT(j)  (256  + 64 * (j))
#define XB_XSUB(j)  (1280 + 64 * (j))
#define XB_XGEN(j)  (2304 + 64 * (j))
#define XB_TOP      3328
#define XB_TOPGEN   3392
#define XCD_BAR_WORDS 3456
#define XB_SPIN_CAP (1u << 18)

__device__ __forceinline__ unsigned xb_ld(unsigned* p)              { return __hip_atomic_load(p, __ATOMIC_RELAXED, __HIP_MEMORY_SCOPE_AGENT); }
__device__ __forceinline__ unsigned xb_add(unsigned* p, unsigned v) { return __hip_atomic_fetch_add(p, v, __ATOMIC_RELAXED, __HIP_MEMORY_SCOPE_AGENT); }
__device__ __forceinline__ unsigned xb_xcc_id() { return (unsigned)__builtin_amdgcn_s_getreg((3 << 11) | 20) & 0xFu; }
#define XB_SPIN(cond, bar) do { unsigned _sp = 0; while (cond) { __builtin_amdgcn_s_sleep(1); \
    if ((++_sp & 255u) == 0u) { if (xb_ld(&(bar)[XB_TMO])) break; if (_sp > XB_SPIN_CAP) { atomicAdd(&(bar)[XB_TMO], 1u); break; } } } } while (0)

struct XcdBarrier {
    unsigned* bar; unsigned x;
    volatile LAS unsigned* st;
};

__device__ __forceinline__ XcdBarrier xcd_barrier_post(unsigned* bar, volatile LAS unsigned* st) {
    XcdBarrier b; b.bar = bar; b.x = xb_xcc_id(); b.st = st;
    if (threadIdx.x == 0) (void)xb_add(&bar[XB_XCNT(b.x)], 1u);
    return b;
}
__device__ __forceinline__ void xcd_barrier_complete(unsigned* bar, unsigned x, unsigned& nloc, unsigned& nx) {
    const unsigned G = gridDim.x * gridDim.y * gridDim.z;
    unsigned sum, cnt, mine, sp = 0u;
    for (;;) {
        sum = 0u; cnt = 0u; mine = 0u;
#pragma unroll
        for (unsigned j = 0; j < 16; ++j) { const unsigned c = xb_ld(&bar[XB_XCNT(j)]); sum += c; cnt += (c > 0u) ? 1u : 0u; mine = (j == x) ? c : mine; }
        if (sum == G) break;
        __builtin_amdgcn_s_sleep(1);
        if ((++sp & 255u) == 0u) { if (xb_ld(&bar[XB_TMO])) break; if (sp > XB_SPIN_CAP) { atomicAdd(&bar[XB_TMO], 1u); break; } }
    }
    nloc = mine > 0u ? mine : 1u; nx = cnt > 0u ? cnt : 1u;
}

__device__ __forceinline__ void xcd_barrier(const XcdBarrier& b) {
    asm volatile("s_waitcnt vmcnt(0)" ::: "memory");
    __syncthreads();
    if (threadIdx.x == 0) {
        unsigned* bar = b.bar;
        __builtin_amdgcn_s_waitcnt(0);
        unsigned nloc = b.st[0], nx = b.st[1];
        if (nloc == 0u) { xcd_barrier_complete(bar, b.x, nloc, nx); b.st[0] = nloc; b.st[1] = nx; }
        const unsigned old = xb_add(&bar[XB_XSUB(b.x)], 1u);
        const unsigned gen = old / nloc;
        if (old + 1u == (gen + 1u) * nloc) {
            __builtin_amdgcn_fence(__ATOMIC_RELEASE, "agent");
            asm volatile("s_waitcnt vmcnt(0)" ::: "memory");
            const unsigned og = xb_add(&bar[XB_TOP], 1u);
            const unsigned tg = og / nx;
            if (og + 1u == (tg + 1u) * nx) xb_add(&bar[XB_TOPGEN], 1u);
            else XB_SPIN(xb_ld(&bar[XB_TOPGEN]) == tg, bar);
            __builtin_amdgcn_fence(__ATOMIC_ACQUIRE, "agent");
            xb_add(&bar[XB_XGEN(b.x)], 1u);
            asm volatile("s_waitcnt vmcnt(0)" ::: "memory");
        } else {
            XB_SPIN(xb_ld(&bar[XB_XGEN(b.x)]) == gen, bar);
            __builtin_amdgcn_fence(__ATOMIC_ACQUIRE, "agent");
            asm volatile("s_waitcnt vmcnt(0)" ::: "memory");
        }
    }
    __syncthreads();
}
namespace eng {
constexpr int BM = 256, BK = 64, HALF = 128, HTB = HALF * BK * 2, STAGE_BYTES = 8 * HTB;
__device__ __forceinline__ int lds_byte(int r, int c) { const int st = (r >> 4) * 2 + (c >> 5), rr = r & 15, cc = c & 31, ob = rr * 64 + cc * 2; return st * 1024 + (ob ^ (((ob >> 9) & 1) << 5)); }
__device__ __forceinline__ int perm32(int rho) { const int n = rho >> 4, i = rho & 15; return 8 * (i >> 2) + 4 * n + (i & 3); }
__device__ __forceinline__ void stage_rc(int b, int& R, int& C) { const int st = b / 1024, sb = b % 1024, swz = sb ^ (((sb >> 9) & 1) << 5); R = (st >> 1) * 16 + swz / 64; C = (st & 1) * 32 + (swz % 64) / 2; }

struct UnitD {
    const char* A0; const char* B0; unsigned lda0, ldb0; int n0;
    const char* A1; const char* B1; unsigned lda1, ldb1; int n1;
    const char* A2; const char* B2; unsigned lda2, ldb2; int n2;
    int kind, i0, i1, i2;
};
struct TD { const char* a; const char* b; unsigned lda, ldb; int gpar; };
__device__ __forceinline__ TD tile_at(const UnitD& u, int t) {
    TD d;
    if (t < u.n0) { d.a = u.A0 + (size_t)t * 128; d.b = u.B0 + (size_t)t * 128; d.lda = u.lda0; d.ldb = u.ldb0; }
    else if (t < u.n0 + u.n1) { const int s = t - u.n0; d.a = u.A1 + (size_t)s * 128; d.b = u.B1 + (size_t)s * 128; d.lda = u.lda1; d.ldb = u.ldb1; }
    else { const int s = t - u.n0 - u.n1; d.a = u.A2 + (size_t)s * 128; d.b = u.B2 + (size_t)s * 128; d.lda = u.lda2; d.ldb = u.ldb2; }
    return d;
}
typedef f32x4 Acc[2][2][4][2];

template <class P>
__device__ __forceinline__ void gemm_run(LAS unsigned char* lds, const P& ph) {
    const int tid = threadIdx.x, wid = __builtin_amdgcn_readfirstlane(tid >> 6), lane = tid & 63, wr = wid >> 2, wc = wid & 3, fr = lane & 15, fq = lane >> 4;
    int R0, C0; stage_rc(tid * 16, R0, C0);
    const unsigned vR = (unsigned)R0, vC2 = (unsigned)C0 * 2u, vRB = P::PERM ? (unsigned)((R0 & ~31) + perm32(R0 & 31)) : (unsigned)R0;
    const unsigned ldsw = (unsigned)wid * 1024u;
    const int aoff = lds_byte(wr * 64 + fr, fq * 8), boff = lds_byte(wc * 32 + fr, fq * 8);
#define EG_SA(b, h) (((b) * 2 + (h)) * HTB)
#define EG_SB(b, h) ((4 + (b) * 2 + (h)) * HTB)
#define EG_STAGE(bufoff, gbase, ld) EG_STAGER(bufoff, gbase, ld, vR)
#define EG_STAGEB(bufoff, gbase, ld) EG_STAGER(bufoff, gbase, ld, vRB)
#define EG_STAGER(bufoff, gbase, ld, vrow) do { const unsigned _ld = (ld); const char* _g = (gbase) + (size_t)((vrow) * _ld + vC2); \
        __builtin_amdgcn_global_load_lds((const unsigned*)_g, (LAS unsigned*)(lds + (bufoff) + ldsw), 16, 0, 0); \
        __builtin_amdgcn_global_load_lds((const unsigned*)(_g + (size_t)(64u * _ld)), (LAS unsigned*)(lds + (bufoff) + ldsw + 8192), 16, 0, 0); } while (0)
#define EG_STAGEA(bufoff, d, h) do { if constexpr (P::GATHER) { const char* _g = (d).a + vC2; const unsigned _o0 = (d).gpar ? gB[(h) * 2] : gA[(h) * 2], _o1 = (d).gpar ? gB[(h) * 2 + 1] : gA[(h) * 2 + 1]; \
        __builtin_amdgcn_global_load_lds((const unsigned*)(_g + _o0), (LAS unsigned*)(lds + (bufoff) + ldsw), 16, 0, 0); \
        __builtin_amdgcn_global_load_lds((const unsigned*)(_g + _o1), (LAS unsigned*)(lds + (bufoff) + ldsw + 8192), 16, 0, 0); } \
        else EG_STAGE(bufoff, (d).a + (size_t)((h) * 128u * (d).lda), (d).lda); } while (0)
#define EG_LDA(dst, b, h) do { _Pragma("unroll") for (int m = 0; m < 4; ++m) _Pragma("unroll") for (int k = 0; k < 2; ++k) dst[m][k] = *(const LAS bf16x8*)(lds + EG_SA(b, h) + aoff + m * 2048 + k * 1024); } while (0)
#define EG_LDB(dst, b, h) do { _Pragma("unroll") for (int n = 0; n < 2; ++n) _Pragma("unroll") for (int k = 0; k < 2; ++k) dst[n][k] = *(const LAS bf16x8*)(lds + EG_SB(b, h) + boff + n * 2048 + k * 1024); } while (0)
#define EG_MMA(ai, bj, At, Bt) do { __builtin_amdgcn_s_setprio(1); _Pragma("unroll") for (int m = 0; m < 4; ++m) _Pragma("unroll") for (int n = 0; n < 2; ++n) _Pragma("unroll") for (int k = 0; k < 2; ++k) \
        acc[ai][bj][m][n] = __builtin_amdgcn_mfma_f32_16x16x32_bf16(Bt[n][k], At[m][k], acc[ai][bj][m][n], 0, 0, 0); __builtin_amdgcn_s_setprio(0); } while (0)
#define EG_WAIT_V(n) asm volatile("s_waitcnt vmcnt(" #n ")" ::: "memory")
#define EG_WAIT_L(n) asm volatile("s_waitcnt lgkmcnt(" #n ")" ::: "memory")
#define EG_BAR __builtin_amdgcn_s_barrier()
#define EG_SCHED __builtin_amdgcn_sched_barrier(0)
    UnitD cur; int ui = 0;
    if (!ph.get(0, cur)) return;
    UnitD cu = cur; int cui = 0, ct = 0; bool cvalid = true; TD lastTD = tile_at(cur, 0); lastTD.gpar = 0;
    unsigned gA[4] = {0u, 0u, 0u, 0u}, gB[4] = {0u, 0u, 0u, 0u};
    const LAS unsigned* rowtab = (const LAS unsigned*)(lds + STAGE_BYTES + 1024);
#define EG_GLOAD(ord) do { if constexpr (P::GATHER) { if ((ord) & 1) { _Pragma("unroll") for (int _k = 0; _k < 4; ++_k) gB[_k] = rowtab[(ord) * 256 + (_k >> 1) * 128 + (_k & 1) * 64 + vR]; } \
        else { _Pragma("unroll") for (int _k = 0; _k < 4; ++_k) gA[_k] = rowtab[(ord) * 256 + (_k >> 1) * 128 + (_k & 1) * 64 + vR]; } } } while (0)
    EG_GLOAD(0);
#define EG_NEXT(dst) do { if (cvalid) { dst = tile_at(cu, ct); dst.gpar = cui & 1; lastTD = dst; ++ct; if (ct == cu.n0 + cu.n1 + cu.n2) { ++cui; ct = 0; cvalid = ph.get(cui, cu); if (cvalid) EG_GLOAD(cui); } } else dst = lastTD; } while (0)
    Acc acc;
#pragma unroll
    for (int a = 0; a < 2; ++a)
#pragma unroll
        for (int b = 0; b < 2; ++b)
#pragma unroll
            for (int m = 0; m < 4; ++m)
#pragma unroll
                for (int n = 0; n < 2; ++n) acc[a][b][m][n] = (f32x4){0.f, 0.f, 0.f, 0.f};
    bf16x8 At[4][2], B0[2][2], B1[2][2];
    TD d1, d2, d3;
    { TD d0; EG_NEXT(d0); EG_NEXT(d1);
      EG_STAGEB(EG_SB(0, 0), d0.b, d0.ldb); EG_STAGEA(EG_SA(0, 0), d0, 0); EG_STAGEB(EG_SB(0, 1), d0.b + (size_t)(128u * d0.ldb), d0.ldb); EG_STAGEA(EG_SA(0, 1), d0, 1); }
    if (wr == 1) EG_BAR;
    EG_WAIT_V(4); EG_BAR;
    EG_STAGEB(EG_SB(1, 0), d1.b, d1.ldb); EG_STAGEA(EG_SA(1, 0), d1, 0); EG_STAGEB(EG_SB(1, 1), d1.b + (size_t)(128u * d1.ldb), d1.ldb);
    EG_WAIT_V(6); EG_BAR;
    int tc = 0;
    for (;;) {
        EG_NEXT(d2); EG_NEXT(d3);
        if constexpr (P::HOOKS) { int fr_o = fr; asm volatile("" : "+v"(fr_o)); ph.hook(tc, acc, cur, wr, wc, fr_o, fq); }
        EG_LDB(B0, 0, 0); EG_SCHED; EG_LDA(At, 0, 0); EG_STAGEA(EG_SA(1, 1), d1, 1);
        EG_WAIT_L(8); EG_BAR; EG_WAIT_L(0); EG_MMA(0, 0, At, B0); EG_BAR; EG_SCHED;
        EG_LDB(B1, 0, 1); EG_STAGEB(EG_SB(0, 0), d2.b, d2.ldb);
        EG_BAR; EG_WAIT_L(0); EG_MMA(0, 1, At, B1); EG_BAR;
        EG_LDA(At, 0, 1); EG_STAGEA(EG_SA(0, 0), d2, 0);
        EG_BAR; EG_WAIT_L(0); EG_MMA(1, 0, At, B0); EG_BAR; EG_SCHED;
        EG_STAGEB(EG_SB(0, 1), d2.b + (size_t)(128u * d2.ldb), d2.ldb);
        EG_WAIT_V(6); EG_BAR; EG_MMA(1, 1, At, B1); EG_BAR;
        EG_LDB(B0, 1, 0); EG_SCHED; EG_LDA(At, 1, 0); EG_STAGEA(EG_SA(0, 1), d2, 1);
        EG_WAIT_L(8); EG_BAR; EG_WAIT_L(0); EG_MMA(0, 0, At, B0); EG_BAR; EG_SCHED;
        EG_LDB(B1, 1, 1); EG_STAGEB(EG_SB(1, 0), d3.b, d3.ldb);
        EG_BAR; EG_WAIT_L(0); EG_MMA(0, 1, At, B1); EG_BAR;
        EG_LDA(At, 1, 1); EG_STAGEA(EG_SA(1, 0), d3, 0);
        EG_BAR; EG_WAIT_L(0); EG_MMA(1, 0, At, B0); EG_BAR; EG_SCHED;
        EG_STAGEB(EG_SB(1, 1), d3.b + (size_t)(128u * d3.ldb), d3.ldb);
        EG_WAIT_V(6); EG_BAR; EG_MMA(1, 1, At, B1); EG_BAR;
        d1 = d3; tc += 2;
        if (tc == cur.n0 + cur.n1 + cur.n2) {
            { int fr_o = fr, fq_o = fq; asm volatile("" : "+v"(fr_o), "+v"(fq_o));
              ph.epi(acc, cur, wr, wc, fr_o, fq_o); }
            ++ui; tc = 0;
            if (!ph.get(ui, cur)) break;
#pragma unroll
            for (int a = 0; a < 2; ++a)
#pragma unroll
                for (int b = 0; b < 2; ++b)
#pragma unroll
                    for (int m = 0; m < 4; ++m)
#pragma unroll
                        for (int n = 0; n < 2; ++n) acc[a][b][m][n] = (f32x4){0.f, 0.f, 0.f, 0.f};
        }
    }
    EG_WAIT_V(0);
    if (wr == 0) EG_BAR;
    EG_BAR;
#undef EG_NEXT
#undef EG_GLOAD
}
__device__ __forceinline__ void unit1(UnitD& u, const void* A, unsigned lda, const void* B, unsigned ldb, int nt) {
    u.A0 = (const char*)A; u.B0 = (const char*)B; u.lda0 = lda; u.ldb0 = ldb; u.n0 = nt;
    u.A1 = u.A0; u.B1 = u.B0; u.lda1 = lda; u.ldb1 = ldb; u.n1 = 0; u.A2 = u.A0; u.B2 = u.B0; u.lda2 = lda; u.ldb2 = ldb; u.n2 = 0;
    u.kind = 0; u.i0 = 0; u.i1 = 0; u.i2 = 0;
}
}
using eng::UnitD; using eng::Acc;
__device__ __forceinline__ int xcd_remap(int idx, int N) { const int q = N >> 3, r = N & 7, x = idx & 7, off = idx >> 3; return (x < r ? x * (q + 1) : r * (q + 1) + (x - r) * q) + off; }
__device__ __forceinline__ void efence() { asm volatile("" ::: "memory"); }
#define EPI_ARGS const Acc& acc, const UnitD& u, int wr, int wc, int fr, int fq
#define FOR_FRAG(ai, bj, m, n) _Pragma("unroll") for (int ai = 0; ai < 2; ++ai) _Pragma("unroll") for (int m = 0; m < 4; ++m) _Pragma("unroll") for (int bj = 0; bj < 2; efence(), ++bj) _Pragma("unroll") for (int n = 0; n < 2; ++n)
#define FRAG_ROW(ai, m) (128 * (ai) + 64 * wr + 16 * (m) + fr)
#define FRAG_COL(bj, n) (128 * (bj) + 32 * wc + 16 * (n) + 4 * fq)
#define FRAG_COLP(bj) (128 * (bj) + 32 * wc + 8 * fq)
#define FOR_FRAGP(ai, bj, m) _Pragma("unroll") for (int ai = 0; ai < 2; ++ai) _Pragma("unroll") for (int m = 0; m < 4; ++m) _Pragma("unroll") for (int bj = 0; bj < 2; efence(), ++bj)
__device__ __forceinline__ void st_bf16x8(bf16_t* p, f32x4 a, f32x4 b) { u32x4 w; w.x = cvt_pk_bf16(a[0], a[1]); w.y = cvt_pk_bf16(a[2], a[3]); w.z = cvt_pk_bf16(b[0], b[1]); w.w = cvt_pk_bf16(b[2], b[3]); *(u32x4*)p = w; }
__device__ __forceinline__ void st_bf16x4(bf16_t* p, f32x4 v) { u32x2 w; w.x = cvt_pk_bf16(v[0], v[1]); w.y = cvt_pk_bf16(v[2], v[3]); *(u32x2*)p = w; }
struct Frame { Params p; LAS unsigned char* lds; int tid, lane, wid, G, bid; };
#define WSP(T, off) ((T*)(F.p.ws + (off)))

template <class RowSrc>
__device__ __forceinline__ void conv_tile(const Frame& F, bf16_t* dst, int K, int ld, float scale, int r0, int k0, const RowSrc& rs) {
    LAS float* tile = (LAS float*)F.lds;
    const int n4 = (F.tid & 15) * 4, kq = F.tid >> 4;
    const float* sp = rs(r0 + n4) + (size_t)(k0 + kq) * ld;
#pragma unroll
    for (int p = 0; p < 8; ++p) { const f32x4 v = *(const f32x4*)(sp + (size_t)(p * 32) * ld); LAS float* q = tile + (p * 32 + kq) * 65 + n4; q[0] = v[0]; q[1] = v[1]; q[2] = v[2]; q[3] = v[3]; }
    __syncthreads();
    const int i2 = (F.tid & 127) * 2, jb = F.tid >> 7;
#pragma unroll
    for (int p = 0; p < 16; ++p) { const int j = p * 4 + jb; *(unsigned*)(dst + (size_t)(r0 + j) * K + k0 + i2) = cvt_pk_bf16(tile[i2 * 65 + j] * scale, tile[(i2 + 1) * 65 + j] * scale); }
    __syncthreads();
}
__device__ __forceinline__ int sigma_orig(int s) {
    const int half = s >> 7, s2 = s & 127, uu = s2 >> 5, b = (s2 >> 4) & 1, f = s2 & 15; return half * 128 + 16 * uu + f + 64 * b;
}
__device__ __forceinline__ void conv_moe_tile(const Frame& F, int layer, int t) {
    bf16_t* w13 = WSP(bf16_t, A_MOEW); bf16_t* w2t = WSP(bf16_t, A_MOEW + 32 * MiB);
    if (t < 1024) { const int e = t >> 6, rt = (t >> 2) & 15, kt = t & 3;
        const float* w1 = F.p.moe_w1 + ((size_t)layer * 16 + e) * 1024 * 512; const float* w3 = F.p.moe_w3 + ((size_t)layer * 16 + e) * 1024 * 512;
        conv_tile(F, w13 + (size_t)e * 1024 * 1024, 1024, 512, 1.0f, rt * 64, kt * 256, [=](int r) { const int j = r >> 8, rr = r & 255; return rr < 128 ? w1 + 128 * j + rr : w3 + 128 * j + rr - 128; });
    } else { const int u = t - 1024, e = u >> 5, rt = (u >> 1) & 15, kt = u & 1;
        const float* w2 = F.p.moe_w2 + ((size_t)layer * 16 + e) * 512 * 1024;
        conv_tile(F, w2t + (size_t)e * 1024 * 512, 512, 1024, 1.0f, rt * 64, kt * 256, [=](int r) { return w2 + r; }); }
}
__device__ __forceinline__ void conv_moe(const Frame& F, int layer, int t_lo, int t_hi) { for (int t = t_lo + F.bid; t < t_hi; t += F.G) conv_moe_tile(F, layer, t); }
__device__ __forceinline__ void conv_small_tile(const Frame& F, int t) {
    if (t < 96) { const float* w = F.p.w0in; conv_tile(F, WSP(bf16_t, WS_W0IN), 1024, 2560, 1.0f, (t >> 2) * 64, (t & 3) * 256, [=](int r) { return w + 256 + r; }); }
    else if (t < 144) { const int u = t - 96; const float* w = F.p.w0in; conv_tile(F, WSP(bf16_t, WS_W0IN) + (size_t)2048 * 1024, 1024, 2560, 1.0f, (u >> 2) * 64, (u & 3) * 256, [=](int r) { return w + 1792 + r; }); }
    else if (t < 208) { const int u = t - 144; const float* w = F.p.w0out; conv_tile(F, WSP(bf16_t, WS_W0OUT), 1024, 1024, 1.0f, (u >> 2) * 64, (u & 3) * 256, [=](int r) { return w + r; }); }
    else if (t < 272) { const int u = t - 208; const float* w = F.p.w1in; conv_tile(F, WSP(bf16_t, WS_W1IN), 1024, 6144, 1.0f, (u >> 2) * 64, (u & 3) * 256, [=](int r) { return w + (r & ~255) + sigma_orig(r & 255); }); }
    else if (t < 336) { const int u = t - 272; const float* w = F.p.w1in; conv_tile(F, WSP(bf16_t, WS_W1IN) + (size_t)1024 * 1024, 1024, 6144, 0.0625f, (u >> 2) * 64, (u & 3) * 256, [=](int r) { return w + 1024 + (r & ~255) + sigma_orig(r & 255); }); }
    else if (t < 592) { const int u = t - 336; const float* w = F.p.w1in; conv_tile(F, WSP(bf16_t, WS_W1IN) + (size_t)2048 * 1024, 1024, 6144, 1.0f, (u >> 2) * 64, (u & 3) * 256, [=](int r) { return w + 2048 + r; }); }
    else { const int u = t - 592; const float* w = F.p.w1out; conv_tile(F, WSP(bf16_t, WS_W1OUT), 2048, 1024, 1.0f, (u >> 3) * 64, (u & 7) * 256, [=](int r) { return w + r; }); }
}
__device__ __forceinline__ void p0_prologue(const Frame& F) {
    const float TWO_PI = 6.283185307179586f;
    {
        LAS float* sc0 = (LAS float*)F.lds; LAS float* sc1 = sc0 + 1024; LAS float* red = sc1 + 1024;
        for (int k = F.tid; k < 1024; k += 512) { sc0[k] = silu_f(F.p.c[k]); sc1[k] = silu_f(F.p.c_ctx[k]); }
        __syncthreads();
        float* mod = WSP(float, WS_MOD);
        for (int item = F.bid; item < 192; item += F.G) {
            const int l = item / 96, col0 = (item % 96) * 64, l16 = F.tid & 15, kg = F.tid >> 4;
            f32x4 a0 = {0.f, 0.f, 0.f, 0.f}, a1 = {0.f, 0.f, 0.f, 0.f};
#pragma unroll 8
            for (int i = 0; i < 32; ++i) { const int k = kg + 32 * i; const f32x4 w = *(const f32x4*)(F.p.ada_w + ((size_t)l * 1024 + k) * 6144 + col0 + l16 * 4); a0 += sc0[k] * w; a1 += sc1[k] * w; }
#pragma unroll
            for (int e = 0; e < 4; ++e) { red[(kg * 64 + l16 * 4 + e) * 2 + 0] = a0[e]; red[(kg * 64 + l16 * 4 + e) * 2 + 1] = a1[e]; }
            __syncthreads();
            if (F.tid < 128) { const int col = F.tid & 63, which = F.tid >> 6; float s = 0.f; for (int g = 0; g < 32; ++g) s += red[(g * 64 + col) * 2 + which];
                mod[(size_t)which * 2 * 6144 + l * 6144 + col0 + col] = s + F.p.ada_b[l * 6144 + col0 + col]; }
            __syncthreads();
        }
    }
    {
        const int gt = F.bid * 512 + F.tid, gn = F.G * 512;
        float* twc = WSP(float, WS_TWC); float* tws = WSP(float, WS_TWS);
        for (int i = gt; i < 128 * 128; i += gn) { const int b = i >> 7, k1 = i & 127; const float a = (float)((b * k1) & 16383) * (TWO_PI / 16384.0f); twc[i] = cosf(a); tws[i] = sinf(a); }
        float* rc = WSP(float, WS_ROPEC); float* rs = WSP(float, WS_ROPES);
        for (int i = gt; i < 256 * 64; i += gn) { const int pos = i >> 6, fi = i & 63; const float inv = powf(10000.0f, -(float)fi / 64.0f); const float a = (float)pos * inv; rc[i] = cosf(a); rs[i] = sinf(a); }
        bf16_t* f1 = WSP(bf16_t, WS_F1T); bf16_t* f2 = WSP(bf16_t, WS_F2P);
        for (int i = gt; i < 256 * 256; i += gn) { const int n = i >> 8, k = i & 255, k1 = n & 127, a = k & 127; const float ang = (float)((a * k1) & 127) * (TWO_PI / 128.0f); const float cs = cosf(ang), sn = sinf(ang);
            float v1; if (n < 128) v1 = (k < 128) ? cs : sn; else v1 = (k < 128) ? -sn : cs;
            f1[i] = f2bf(v1);
            f2[i] = f2bf(n < 128 ? ((k < 128) ? cs : sn) * (1.0f / 128.0f) : 0.0f); }
        bf16_t* cs256 = WSP(bf16_t, WS_CS256);
        for (int i = gt; i < 256 * 512; i += gn) { const int k = i >> 9, j = i & 511, n = j & 255; const float ang = (float)((n * k) & 255) * (TWO_PI / 256.0f); cs256[i] = f2bf((j < 256 ? cosf(ang) : sinf(ang)) * (1.0f / 16.0f)); }
    }
    {
        LAS float* ct = (LAS float*)F.lds; LAS float* wrow = ct + 64 + F.wid * 64;
        __syncthreads();
        if (F.tid < 64) ct[F.tid] = cosf((float)F.tid * (TWO_PI / 64.0f));
        __syncthreads();
        bf16_t* dst = WSP(bf16_t, WS_W0IN);
        for (int it = F.bid * 8 + F.wid; it < 4096; it += F.G * 8) {
            const int k = it >> 2, g = it & 3;
            wrow[F.lane] = F.p.w0in[(size_t)k * 2560 + g * 64 + F.lane];
            float re = 0.f, im = 0.f;
#pragma unroll 16
            for (int c = 0; c < 64; ++c) { const float w = wrow[c]; const int ph = (c * F.lane) & 63; re += w * ct[ph]; im -= w * ct[(ph + 48) & 63]; }
            dst[(size_t)(1536 + g * 64 + F.lane) * 1024 + k] = f2bf(re * 0.125f); dst[(size_t)(1536 + 256 + g * 64 + F.lane) * 1024 + k] = f2bf(im * 0.125f);
        }
        __syncthreads();
    }
    for (int t = F.bid; t < 720; t += F.G) conv_small_tile(F, t);
}

struct Row { f32x4 v[4]; };
__device__ __forceinline__ void row_load(Row& r, const float* p, int lane) {
#pragma unroll
    for (int i = 0; i < 4; ++i) r.v[i] = *(const f32x4*)(p + 4 * lane + 256 * i);
}
__device__ __forceinline__ void row_store(const Row& r, float* p, int lane) {
#pragma unroll
    for (int i = 0; i < 4; ++i) *(f32x4*)(p + 4 * lane + 256 * i) = r.v[i];
}
__device__ __forceinline__ float row_rstd(const Row& r) {
    float s = 0.f;
#pragma unroll
    for (int i = 0; i < 4; ++i) s += (r.v[i][0] * r.v[i][0] + r.v[i][1] * r.v[i][1]) + (r.v[i][2] * r.v[i][2] + r.v[i][3] * r.v[i][3]);
    s = wave_sum(s);
    return rsqrtf(s * (1.0f / 1024.0f) + RMS_EPS);
}
__device__ __forceinline__ void row_norm_mod(Row& r, const float* g, const float* sh, const float* sc, int lane) {
    const float rs = row_rstd(r);
#pragma unroll
    for (int i = 0; i < 4; ++i) { const int c = 4 * lane + 256 * i; const f32x4 gv = *(const f32x4*)(g + c), shv = *(const f32x4*)(sh + c), scv = *(const f32x4*)(sc + c);
        r.v[i] = (r.v[i] * rs) * gv * (1.0f + scv) + shv; }
}
__device__ __forceinline__ void row_store_bf16(const Row& r, bf16_t* p, int lane) {
#pragma unroll
    for (int i = 0; i < 4; ++i) st_bf16x4(p + 4 * lane + 256 * i, r.v[i]);
}
__device__ __forceinline__ const float* modp(const Frame& F, int layer, bool is_ctx) { return WSP(const float, WS_MOD) + (size_t)(is_ctx ? 2 : 0) * 6144 + layer * 6144; }
__device__ __forceinline__ unsigned char* xm1_panel(const unsigned char* ws, int pm) { return (unsigned char*)ws + (pm < 51 ? B_XM1A + (size_t)pm * HMiB : WS_W0IN + (size_t)(pm - 51) * HMiB); }
__device__ __forceinline__ float* hrow(const Frame& F, int t) { return t < CTXN ? WSP(float, WS_HC) + (size_t)t * DM : F.p.out + (size_t)(t - CTXN) * DM; }

__device__ __forceinline__ void p_norm_in(const Frame& F) {
    bf16_t* xm = WSP(bf16_t, A_XM);
    for (int t = F.bid * 8 + F.wid; t < TT; t += F.G * 8) {
        const bool ic = t < CTXN; const float* src = ic ? F.p.ctx + (size_t)t * DM : F.p.x + (size_t)(t - CTXN) * DM; const float* m = modp(F, 0, ic);
        Row r; row_load(r, src, F.lane); row_norm_mod(r, F.p.norm_g, m, m + 1024, F.lane); row_store_bf16(r, xm + (size_t)t * DM, F.lane);
    }
}
__device__ __forceinline__ void p_router(const Frame& F, int layer, int t0, bf16_t* dst) {
    LAS float* rwT = (LAS float*)F.lds;
    LAS unsigned* lcnt = (LAS unsigned*)(F.lds + 65536);
    for (int i = F.tid; i < 16 * 1024; i += 512) { const int e = i >> 10, c = i & 1023; rwT[i] = F.p.router_w[c * 16 + e]; }
    if (F.tid < 32) lcnt[F.tid] = 0u;
    __syncthreads();
    int* eid = WSP(int, WS_EID); float* gw = WSP(float, WS_GW); int* slot = WSP(int, WS_SLOT);
    unsigned* gcnt = (unsigned*)(F.p.ws + WS_CTL + CTL_CNT) + layer * 64;
    for (int t = t0 + F.bid * 8 + F.wid; t < TT; t += F.G * 8) {
        const bool ic = t < CTXN; const float* m = modp(F, layer, ic);
        Row r;
        if (ic) {
            row_load(r, F.p.ctx + (size_t)t * DM, F.lane); const float* part = WSP(const float, A_PART) + (size_t)t * DM;
#pragma unroll
            for (int i = 0; i < 4; ++i) { const int c = 4 * F.lane + 256 * i; const f32x4 gv = *(const f32x4*)(m + 2048 + c);
                const f32x4 s = (*(const f32x4*)(part + c) + *(const f32x4*)(part + 256 * DM + c)) + (*(const f32x4*)(part + 512 * DM + c) + *(const f32x4*)(part + 768 * DM + c)); r.v[i] += gv * s; }
            row_store(r, hrow(F, t), F.lane);
        } else row_load(r, hrow(F, t), F.lane);
        row_norm_mod(r, F.p.norm_g + (size_t)(layer * 2 + 1) * DM, m + 3072, m + 4096, F.lane); row_store_bf16(r, dst + (size_t)t * DM, F.lane);
        float lg[16];
#pragma unroll
        for (int e = 0; e < 16; ++e) { float s = 0.f;
#pragma unroll
            for (int i = 0; i < 4; ++i) { const f32x4 w = *(const LAS f32x4*)(rwT + e * 1024 + 4 * F.lane + 256 * i); s += (r.v[i][0] * w[0] + r.v[i][1] * w[1]) + (r.v[i][2] * w[2] + r.v[i][3] * w[3]); }
            lg[e] = wave_sum(s); }
        float scv[16], bi[16];
#pragma unroll
        for (int e = 0; e < 16; ++e) { scv[e] = 1.0f / (1.0f + __expf(-lg[e])); bi[e] = scv[e] + F.p.router_b[e]; }
        int gsel = 0; float best = -1e30f;
#pragma unroll
        for (int g = 0; g < 4; ++g) { const float a = bi[4 * g], b = bi[4 * g + 1], c = bi[4 * g + 2], d = bi[4 * g + 3];
            const float h1 = fmaxf(a, b), l1 = fminf(a, b), h2 = fmaxf(c, d), l2 = fminf(c, d); const float gs = fmaxf(h1, h2) + fmaxf(fminf(h1, h2), fmaxf(l1, l2));
            if (gs > best) { best = gs; gsel = g; } }
        float vb[4], vs[4];
#pragma unroll
        for (int i = 0; i < 4; ++i) { vb[i] = gsel == 0 ? bi[i] : gsel == 1 ? bi[4 + i] : gsel == 2 ? bi[8 + i] : bi[12 + i]; vs[i] = gsel == 0 ? scv[i] : gsel == 1 ? scv[4 + i] : gsel == 2 ? scv[8 + i] : scv[12 + i]; }
        int i0 = 0; float b0 = vb[0];
#pragma unroll
        for (int i = 1; i < 4; ++i) if (vb[i] > b0) { b0 = vb[i]; i0 = i; }
        int i1 = -1; float b1 = -1e30f;
#pragma unroll
        for (int i = 0; i < 4; ++i) if (i != i0 && vb[i] > b1) { b1 = vb[i]; i1 = i; }
        const float s0 = i0 == 0 ? vs[0] : i0 == 1 ? vs[1] : i0 == 2 ? vs[2] : vs[3], s1 = i1 == 0 ? vs[0] : i1 == 1 ? vs[1] : i1 == 2 ? vs[2] : vs[3];
        const float inv = 1.0f / (s0 + s1);
        if (F.lane == 0) {
            const int e0 = gsel * 4 + i0, e1 = gsel * 4 + i1;
            const unsigned r0 = __hip_atomic_fetch_add(lcnt + e0, 1u, __ATOMIC_RELAXED, __HIP_MEMORY_SCOPE_WORKGROUP), r1 = __hip_atomic_fetch_add(lcnt + e1, 1u, __ATOMIC_RELAXED, __HIP_MEMORY_SCOPE_WORKGROUP);
            eid[2 * t] = e0; eid[2 * t + 1] = e1; gw[2 * t] = s0 * inv; gw[2 * t + 1] = s1 * inv; slot[2 * t] = (int)r0; slot[2 * t + 1] = (int)r1;
        }
    }
    __syncthreads();
    if (F.tid < 16) lcnt[16 + F.tid] = __hip_atomic_fetch_add(gcnt + F.tid, lcnt[F.tid], __ATOMIC_RELAXED, __HIP_MEMORY_SCOPE_AGENT);
    __syncthreads();
    int* perm = WSP(int, WS_PERM);
    for (int t = t0 + F.bid * 8 + F.wid; t < TT; t += F.G * 8)
        if (F.lane < 2) { const int e = eid[2 * t + F.lane], rk = slot[2 * t + F.lane] + (int)lcnt[16 + e]; slot[2 * t + F.lane] = rk; perm[e * TT + rk] = t; }
    __syncthreads();
}
struct PanelTab { int pst[17]; };
__device__ __forceinline__ void panel_tab(const Frame& F, int layer, PanelTab& pt) {
    const unsigned* gcnt = (const unsigned*)(F.p.ws + WS_CTL + CTL_CNT) + layer * 64;
    pt.pst[0] = 0;
#pragma unroll
    for (int e = 0; e < 16; ++e) pt.pst[e + 1] = pt.pst[e] + (int)((__builtin_amdgcn_readfirstlane(gcnt[e]) + 255u) >> 8);
}
__device__ __forceinline__ int pt_start(const PanelTab& pt, int e) { int ps = 0;
#pragma unroll
    for (int j = 0; j < 16; ++j) ps = (e == j) ? pt.pst[j] : ps;
    return ps; }
__device__ __forceinline__ void moe_rowtab(const Frame& F, int layer, const PanelTab& pt, int t_pad) {
    LAS unsigned* rowtab = (LAS unsigned*)(F.lds + eng::STAGE_BYTES + 1024);
    const unsigned* gcnt = (const unsigned*)(F.p.ws + WS_CTL + CTL_CNT) + layer * 64; const int* perm = WSP(const int, WS_PERM);
    const int NU = pt.pst[16] * 4;
    for (int i = 0; i < 4; ++i) { const int idx0 = F.bid + i * F.G; if (idx0 >= NU) break;
        const int p = xcd_remap(idx0, NU) >> 2; int e = 0;
#pragma unroll
        for (int k = 1; k < 16; ++k) e += (p >= pt.pst[k]) ? 1 : 0;
        if (F.tid < 256) { const int rk = (p - pt_start(pt, e)) * 256 + F.tid; const int tok = rk < (int)gcnt[e] ? perm[e * TT + rk] : t_pad; rowtab[i * 256 + F.tid] = (unsigned)tok * 2048u; } }
    __syncthreads();
}
__device__ __forceinline__ void row_moe_combine(const Frame& F, Row& r, int t, int layer, const bf16_t* Y, const PanelTab& pt) {
    const int* slot = WSP(const int, WS_SLOT); const float* gw = WSP(const float, WS_GW); const int* eid = WSP(const int, WS_EID);
    const int s0 = pt_start(pt, eid[2 * t]) * 256 + slot[2 * t], s1 = pt_start(pt, eid[2 * t + 1]) * 256 + slot[2 * t + 1]; const float w0 = gw[2 * t], w1 = gw[2 * t + 1];
    const float* g2 = modp(F, layer, t < CTXN) + 5120;
#pragma unroll
    for (int i = 0; i < 4; ++i) { const int c = 4 * F.lane + 256 * i;
        const u32x2 a = *(const u32x2*)(Y + (size_t)s0 * DM + c), b = *(const u32x2*)(Y + (size_t)s1 * DM + c); const f32x4 gv = *(const f32x4*)(g2 + c);
        f32x4 f; f[0] = w0 * bflo(a.x) + w1 * bflo(b.x); f[1] = w0 * bfhi(a.x) + w1 * bfhi(b.x); f[2] = w0 * bflo(a.y) + w1 * bflo(b.y); f[3] = w0 * bfhi(a.y) + w1 * bfhi(b.y);
        r.v[i] += gv * f; }
}
__device__ __forceinline__ void p_combine0(const Frame& F) {
    const bf16_t* Y = WSP(const bf16_t, A_XS); PanelTab pt; panel_tab(F, 0, pt);
    for (int t = F.bid * 8 + F.wid; t < TT; t += F.G * 8) {
        Row r; float* hp = hrow(F, t); row_load(r, hp, F.lane); row_moe_combine(F, r, t, 0, Y, pt); row_store(r, hp, F.lane);
        const float* m = modp(F, 1, t < CTXN); row_norm_mod(r, F.p.norm_g + 2 * DM, m, m + 1024, F.lane); row_store_bf16(r, (bf16_t*)xm1_panel(F.p.ws, t >> 8) + (size_t)(t & 255) * DM, F.lane);
    }
}
__device__ __forceinline__ void p_final(const Frame& F) {
    const bf16_t* Y = WSP(const bf16_t, B_XS); PanelTab pt; panel_tab(F, 1, pt);
    for (int t = CTXN + F.bid * 8 + F.wid; t < TT; t += F.G * 8) {
        Row r; float* hp = hrow(F, t); row_load(r, hp, F.lane); row_moe_combine(F, r, t, 1, Y, pt);
        const float rs = row_rstd(r);
#pragma unroll
        for (int i = 0; i < 4; ++i) { const f32x4 gv = *(const f32x4*)(F.p.final_g + 4 * F.lane + 256 * i); r.v[i] = (r.v[i] * rs) * gv; }
        row_store(r, hp, F.lane);
    }
}
__device__ __forceinline__ float log_gamma(const Frame& F, int dir, int h) { return log1pf(-expf(F.p.decay[dir * 4 + h])); }
__device__ __forceinline__ void p_scan(const Frame& F) {
    bf16_t* st = WSP(bf16_t, B_ST);
    const int item = F.bid * 512 + F.tid;
    for (int it = item; it < 8 * 16384; it += F.G * 512) {
        const int hd = it >> 14, grp = it & 16383, h = hd >> 1, dir = hd & 1;
        const float lg = log_gamma(F, dir, h), d256 = __expf(256.0f * lg), d512 = __expf(512.0f * lg);
        float s[8];
#pragma unroll
        for (int j = 0; j < 8; ++j) s[j] = 0.f;
#pragma unroll 4
        for (int step = 0; step < 33; ++step) {
            const int c = (dir == 0 || step == 0) ? step : 33 - step;
            u32x4* p = (u32x4*)(st + ((size_t)(c * 8 + hd) * 131072 + (size_t)grp * 8));
            const u32x4 uv = *p; const float dec = (c == 0) ? d256 : d512;
            u32x4 o; o.x = cvt_pk_bf16(s[0], s[1]); o.y = cvt_pk_bf16(s[2], s[3]); o.z = cvt_pk_bf16(s[4], s[5]); o.w = cvt_pk_bf16(s[6], s[7]);
            *p = o;
            s[0] = s[0] * dec + bflo(uv.x); s[1] = s[1] * dec + bfhi(uv.x); s[2] = s[2] * dec + bflo(uv.y); s[3] = s[3] * dec + bfhi(uv.y);
            s[4] = s[4] * dec + bflo(uv.z); s[5] = s[5] * dec + bfhi(uv.z); s[6] = s[6] * dec + bflo(uv.w); s[7] = s[7] * dec + bfhi(uv.w);
        }
    }
}
#define PH_COMMON const unsigned char* ws; int G, bid; static constexpr bool HOOKS = false, GATHER = false, PERM = false; \
    __device__ __forceinline__ void hook(int, Acc&, const UnitD&, int, int, int, int) const {}
#define PH_COMMONP const unsigned char* ws; int G, bid; static constexpr bool HOOKS = false, GATHER = false, PERM = true; \
    __device__ __forceinline__ void hook(int, Acc&, const UnitD&, int, int, int, int) const {}
#define WSC(T, off) ((T*)(ws + (off)))
__device__ __forceinline__ float sel4(f32x4 v, int h) { const float a = h == 0 ? v[0] : v[1], b = h == 2 ? v[2] : v[3]; return h < 2 ? a : b; }
#define SEL4(a, h) sel4(a, h)
#define EFENCE asm volatile("" ::: "memory")

struct PhG1 { PH_COMMONP
    __device__ __forceinline__ bool get(int i, UnitD& u) const {
        const int idx = bid + i * G; if (idx >= 715) return false;
        const char* xm = (const char*)(ws + A_XM); const char* w = (const char*)(ws + WS_W0IN);
        if (idx < 390) { const int v = xcd_remap(idx, 390), pm = v / 6, pn = v % 6; eng::unit1(u, xm + (size_t)pm * 256 * 2048, 2048, w + (size_t)pn * 256 * 2048, 2048, 16); u.kind = 0; u.i0 = pm; u.i1 = pn; }
        else { const int j = xcd_remap(idx - 390, 325), ct = j / 5, rt = j % 5; eng::unit1(u, w + (size_t)(1536 + rt * 256) * 2048, 2048, xm + (size_t)ct * 256 * 2048, 2048, 16); u.kind = rt < 2 ? 1 : 2; u.i0 = rt; u.i1 = ct; }
        return true;
    }
    __device__ __forceinline__ void epi(EPI_ARGS) const {
        if (u.kind == 0) { bf16_t* o = WSC(bf16_t, A_QK0) + (size_t)(u.i0 * 256) * QK0_LD + u.i1 * 256;
            FOR_FRAGP(ai, bj, m) st_bf16x8(o + (size_t)FRAG_ROW(ai, m) * QK0_LD + FRAG_COLP(bj), acc[ai][bj][m][0], acc[ai][bj][m][1]); }
        else if (u.kind == 2) { bf16_t* o = WSC(bf16_t, A_VT0) + (size_t)((u.i0 - 2) * 256) * TT + u.i1 * 256;
            FOR_FRAGP(ai, bj, m) st_bf16x8(o + (size_t)FRAG_ROW(ai, m) * TT + FRAG_COLP(bj), acc[ai][bj][m][0], acc[ai][bj][m][1]); }
        else if (u.i1 == 0) { bf16_t* o = WSC(bf16_t, WS_XTC) + u.i0 * 256;
            FOR_FRAGP(ai, bj, m) st_bf16x8(o + (size_t)FRAG_ROW(ai, m) * 512 + FRAG_COLP(bj), acc[ai][bj][m][0], acc[ai][bj][m][1]); }
        else { bf16_t* o = WSC(bf16_t, A_XT2) + u.i0 * 128;
            FOR_FRAG(ai, bj, m, n) { const int cc = FRAG_ROW(ai, m), nn = (u.i1 - 1) * 256 + FRAG_COLP(bj) + 4 * n, a = nn >> 7, b = nn & 127; const f32x4 v = acc[ai][bj][m][n];
#pragma unroll
                for (int e = 0; e < 4; ++e) o[(size_t)(cc * 128 + b + e) * 256 + a] = f2bf(v[e]);
                EFENCE; } }
    }
};
struct PhF1 { PH_COMMON
    __device__ __forceinline__ bool get(int i, UnitD& u) const {
        const int idx = bid + i * G; if (idx >= 129) return false;
        if (idx < 128) { eng::unit1(u, ws + A_XT2 + (size_t)idx * 256 * 512, 512, ws + WS_F1T, 512, 4); u.kind = 0; u.i0 = idx; }
        else { eng::unit1(u, ws + WS_CS256, 1024, ws + WS_XTC, 1024, 8); u.kind = 1; }
        return true;
    }
    __device__ __forceinline__ void epi(EPI_ARGS) const {
        if (u.kind == 1) { bf16_t* o = WSC(bf16_t, A_AO); FOR_FRAG(ai, bj, m, n) st_bf16x4(o + (size_t)FRAG_ROW(ai, m) * DM + FRAG_COL(bj, n), acc[ai][bj][m][n]); return; }
        const float* twc = WSC(const float, WS_TWC); const float* tws = WSC(const float, WS_TWS); bf16_t* o = WSC(bf16_t, A_T2);
#pragma unroll
        for (int m = 0; m < 4; ++m)
#pragma unroll
            for (int n = 0; n < 2; ++n) { const int b = 64 * wr + 16 * m + fr, k1 = 32 * wc + 16 * n + 4 * fq; const f32x4 cv = *(const f32x4*)(twc + b * 128 + k1), sv = *(const f32x4*)(tws + b * 128 + k1);
#pragma unroll
                for (int ai = 0; ai < 2; ++ai) { const int cc = 2 * u.i0 + ai; const f32x4 tr = acc[ai][0][m][n], ti = acc[ai][1][m][n];
#pragma unroll
                    for (int e = 0; e < 4; ++e) { bf16_t* q = o + (size_t)((k1 + e) * 256 + cc) * 256 + b; q[0] = f2bf(tr[e] * cv[e] + ti[e] * sv[e]); q[128] = f2bf(ti[e] * cv[e] - tr[e] * sv[e]); } } }
    }
};
struct PhF2 { PH_COMMONP
    __device__ __forceinline__ bool get(int i, UnitD& u) const {
        const int idx = bid + i * G; if (idx >= 144) return false;
        if (idx < 128) { eng::unit1(u, ws + WS_F2P, 512, ws + A_T2 + (size_t)idx * 256 * 512, 512, 4); u.i0 = idx; }
        else { const int pn = (idx - 128) & 3, kq = (idx - 128) >> 2;
            eng::unit1(u, ws + A_AO + (size_t)kq * 512, 2048, ws + WS_W0OUT + (size_t)pn * 256 * 2048 + (size_t)kq * 512, 2048, 4); u.kind = 1; u.i0 = kq; u.i1 = pn; }
        return true;
    }
    __device__ __forceinline__ void epi(EPI_ARGS) const {
        if (u.kind == 1) { float* dst = WSC(float, A_PART) + (size_t)u.i0 * 256 * DM + u.i1 * 256;
            FOR_FRAG(ai, bj, m, n) *(f32x4*)(dst + (size_t)FRAG_ROW(ai, m) * DM + FRAG_COLP(bj) + 4 * n) = acc[ai][bj][m][n];
            return; }
        bf16_t* o = WSC(bf16_t, A_AO);
#pragma unroll
        for (int m = 0; m < 4; ++m)
#pragma unroll
            for (int bj = 0; bj < 2; ++bj) { const int k2 = FRAG_ROW(0, m); st_bf16x8(o + (size_t)(CTXN + u.i0 + 128 * k2) * DM + FRAG_COLP(bj), acc[0][bj][m][0], acc[0][bj][m][1]); }
    }
};
struct PhG2 { PH_COMMON const float* x; float* out;
    __device__ __forceinline__ bool get(int i, UnitD& u) const {
        const int idx0 = bid + i * G; if (idx0 >= 256) return false;
        const int idx = xcd_remap(idx0, 256), pm = 1 + (idx >> 2), pn = idx & 3; eng::unit1(u, ws + A_AO + (size_t)pm * 256 * 2048, 2048, ws + WS_W0OUT + (size_t)pn * 256 * 2048, 2048, 16); u.i0 = pm; u.i1 = pn; return true;
    }
    __device__ __forceinline__ void epi(EPI_ARGS) const {
        const float* g1 = WSC(const float, WS_MOD) + 2048 + u.i1 * 256;
        const float* src = x + (size_t)(u.i0 - 1) * 256 * DM; float* dst = out + (size_t)(u.i0 - 1) * 256 * DM;
        FOR_FRAG(ai, bj, m, n) { const size_t off = (size_t)FRAG_ROW(ai, m) * DM + u.i1 * 256 + FRAG_COL(bj, n); const f32x4 gv = *(const f32x4*)(g1 + FRAG_COL(bj, n));
            *(f32x4*)(dst + off) = *(const f32x4*)(src + off) + gv * acc[ai][bj][m][n]; }
    }
};
struct PhM1 { const unsigned char* ws; int G, bid; PanelTab pt; size_t xs, hd; static constexpr bool HOOKS = false, GATHER = true, PERM = true;
    __device__ __forceinline__ void hook(int, Acc&, const UnitD&, int, int, int, int) const {}
    __device__ __forceinline__ bool get(int i, UnitD& u) const {
        const int idx0 = bid + i * G, NU = pt.pst[16] * 4; if (idx0 >= NU) return false;
        const int idx = xcd_remap(idx0, NU), p = idx >> 2, j = idx & 3; int e = 0;
#pragma unroll
        for (int k = 1; k < 16; ++k) e += (p >= pt.pst[k]) ? 1 : 0;
        eng::unit1(u, ws + xs, 2048, ws + A_MOEW + ((size_t)e * 1024 + j * 256) * 2048, 2048, 16); u.i0 = p; u.i1 = j; return true;
    }
    __device__ __forceinline__ void epi(EPI_ARGS) const {
        bf16_t* o = (bf16_t*)(ws + hd) + (size_t)(u.i0 * 256) * 512 + u.i1 * 128;
#pragma unroll
        for (int ai = 0; ai < 2; ++ai)
#pragma unroll
            for (int m = 0; m < 4; ++m) { f32x4 v[2];
#pragma unroll
                for (int n = 0; n < 2; ++n) { const f32x4 a = acc[ai][0][m][n], b = acc[ai][1][m][n];
#pragma unroll
                    for (int e = 0; e < 4; ++e) v[n][e] = silu_f(a[e]) * b[e]; }
                st_bf16x8(o + (size_t)FRAG_ROW(ai, m) * 512 + FRAG_COLP(0), v[0], v[1]); efence(); }
    }
};
struct PhM2 { PH_COMMONP PanelTab pt; size_t hd, y;
    __device__ __forceinline__ bool get(int i, UnitD& u) const {
        const int idx0 = bid + i * G, NU = pt.pst[16] * 4; if (idx0 >= NU) return false;
        const int idx = xcd_remap(idx0, NU), p = idx >> 2, j = idx & 3; int e = 0;
#pragma unroll
        for (int k = 1; k < 16; ++k) e += (p >= pt.pst[k]) ? 1 : 0;
        eng::unit1(u, ws + hd + (size_t)p * 256 * 1024, 1024, ws + A_MOEW + 32 * MiB + ((size_t)e * 1024 + j * 256) * 1024, 1024, 8); u.i0 = p; u.i1 = j; return true;
    }
    __device__ __forceinline__ void epi(EPI_ARGS) const {
        bf16_t* o = (bf16_t*)(ws + y) + (size_t)(u.i0 * 256) * DM + u.i1 * 256;
        FOR_FRAGP(ai, bj, m) st_bf16x8(o + (size_t)FRAG_ROW(ai, m) * DM + FRAG_COLP(bj), acc[ai][bj][m][0], acc[ai][bj][m][1]);
    }
};
__device__ __forceinline__ void epi_rope_qk(const Acc& acc, const unsigned char* ws, int pm, int pn, int wr, int wc, int fr, int fq) {
    const float* rc = WSC(const float, WS_ROPEC); const float* rs = WSC(const float, WS_ROPES);
    bf16_t* o = (pn < 4 ? WSC(bf16_t, B_Q) : WSC(bf16_t, B_K)) + (size_t)(pm * 256) * DM + (pn & 3) * 256;
#pragma unroll
    for (int ai = 0; ai < 2; ++ai)
#pragma unroll
        for (int m = 0; m < 4; ++m) { const int r = FRAG_ROW(ai, m), tl = (pm - 1) * 256 + r;
#pragma unroll
            for (int bj = 0; bj < 2; ++bj) { const int pos = bj == 0 ? (tl >> 6) : (tl & 63); const f32x4 cv = *(const f32x4*)(rc + pos * 64 + 16 * wc + 4 * fq), sv = *(const f32x4*)(rs + pos * 64 + 16 * wc + 4 * fq);
                const f32x4 x1 = acc[ai][bj][m][0], x2 = acc[ai][bj][m][1];
                st_bf16x4(o + (size_t)r * DM + FRAG_COL(bj, 0), x1 * cv - x2 * sv); st_bf16x4(o + (size_t)r * DM + FRAG_COL(bj, 1), x2 * cv + x1 * sv); }
            efence(); }
}
struct PhG3 { PH_COMMON f32x4 lgf, lgb;
    __device__ __forceinline__ bool get(int i, UnitD& u) const {
        const int idx = bid + i * G; if (idx >= 244 + 780) return false;
        const char* w = (const char*)(ws + WS_W1IN);
        if (idx < 244) { const int v = xcd_remap(idx, 244), pm = 1 + (v >> 2), pn = 4 + (v & 3); eng::unit1(u, xm1_panel(ws, pm), 2048, w + (size_t)pn * 256 * 2048, 2048, 16); u.kind = 0; u.i0 = pm; u.i1 = pn; }
        else { const int j = xcd_remap(idx - 244, 780), ct = j / 12, rt = j % 12; eng::unit1(u, w + (size_t)(1024 + rt * 256) * 2048, 2048, xm1_panel(ws, ct), 2048, 16); u.kind = rt < 4 ? 1 : 2; u.i0 = rt; u.i1 = ct; }
        return true;
    }
    __device__ __forceinline__ void epi(EPI_ARGS) const {
        const float* rc = WSC(const float, WS_ROPEC); const float* rs = WSC(const float, WS_ROPES);
        if (u.kind == 0) { epi_rope_qk(acc, ws, u.i0, u.i1, wr, wc, fr, fq);
        } else if (u.kind == 2) { bf16_t* o = WSC(bf16_t, B_VT) + (size_t)((u.i0 - 4) * 256) * TT + u.i1 * 256;
            FOR_FRAG(ai, bj, m, n) st_bf16x4(o + (size_t)FRAG_ROW(ai, m) * TT + FRAG_COL(bj, n), acc[ai][bj][m][n]);
        } else {
            const int h = u.i0; const float lf = SEL4(lgf, h), lb = SEL4(lgb, h);
            bf16_t* of = WSC(bf16_t, B_KF) + (size_t)(h * 256) * TT + u.i1 * 256; bf16_t* ob = WSC(bf16_t, B_KB) + (size_t)(h * 256) * TT + u.i1 * 256;
#pragma unroll
            for (int bj = 0; bj < 2; ++bj)
#pragma unroll
                for (int n = 0; n < 2; ++n) { const int c0 = FRAG_COL(bj, n); f32x4 df, db;
                    if (u.i1 == 0) {
#pragma unroll
                        for (int e = 0; e < 4; ++e) { const int pos = c0 + e; df[e] = __expf(lf * (float)(255 - pos)); db[e] = __expf(lb * (float)pos); }
                    } else {
#pragma unroll
                        for (int e = 0; e < 4; ++e) { const int pos = ((u.i1 - 1) * 256 + c0 + e) & 511; df[e] = __expf(lf * (float)(511 - pos)); db[e] = __expf(lb * (float)pos); }
                    }
#pragma unroll
                    for (int ai = 0; ai < 2; ++ai)
#pragma unroll
                        for (int mp = 0; mp < 2; ++mp) { const int p = 32 * wr + 16 * mp + fr; f32x4 x1 = acc[ai][bj][2 * mp][n], x2 = acc[ai][bj][2 * mp + 1][n];
                            if (u.i1 != 0) { const int tl = (u.i1 - 1) * 256 + c0; f32x4 cv, sv;
                                if (ai == 0) { const float c = rc[(tl >> 6) * 64 + p], s = rs[(tl >> 6) * 64 + p]; cv = (f32x4){c, c, c, c}; sv = (f32x4){s, s, s, s}; }
                                else {
#pragma unroll
                                    for (int e = 0; e < 4; ++e) { cv[e] = rc[((tl + e) & 63) * 64 + p]; sv[e] = rs[((tl + e) & 63) * 64 + p]; } }
                                const f32x4 y1 = x1 * cv - x2 * sv, y2 = x2 * cv + x1 * sv; x1 = y1; x2 = y2; }
                            const size_t o1 = (size_t)FRAG_ROW(ai, 2 * mp) * TT + c0, o2 = (size_t)FRAG_ROW(ai, 2 * mp + 1) * TT + c0;
                            st_bf16x4(of + o1, x1 * df); st_bf16x4(of + o2, x2 * df); st_bf16x4(ob + o1, x1 * db); st_bf16x4(ob + o2, x2 * db); } }
        }
    }
};
__device__ __forceinline__ int chunk_tok0(int c) { return c == 0 ? 0 : 256 + 512 * (c - 1); }
struct PhU { PH_COMMON
    __device__ __forceinline__ void unitF(UnitD& u, int pm, int pn) const { eng::unit1(u, xm1_panel(ws, pm), 2048, ws + WS_W1IN + (size_t)pn * 256 * 2048, 2048, 16); u.kind = 1; u.i0 = pm; u.i1 = pn; }
    __device__ __forceinline__ void unitH(UnitD& u, int idx) const {
        const int dvt = idx & 1, dir = (idx >> 1) & 1, h = (idx >> 2) & 3, c = idx < 512 ? 1 + (idx >> 4) : 0; const size_t tk = (size_t)chunk_tok0(c) * 2;
        eng::unit1(u, ws + B_VT + (size_t)(h * 512 + dvt * 256) * TT * 2 + tk, TT * 2, ws + (dir ? B_KB : B_KF) + (size_t)(h * 256) * TT * 2 + tk, TT * 2, c == 0 ? 4 : 8);
        u.i0 = (c * 8 + h * 2 + dir); u.i1 = dvt; }
    __device__ __forceinline__ bool get(int i, UnitD& u) const {
        const int b = bid; if (G != 256) { if (b != 0) return false;
            if (i < 268) { if (i < 256) unitF(u, 1 + (i >> 2), i & 3); else unitF(u, 1 + ((i - 12) >> 2), 4 + (i & 3)); return true; }
            if (i < 268 + 528) { unitH(u, i - 268); return true; } return false; }
        if (i == 0) { const int v = xcd_remap(b, 256); unitF(u, 1 + (v >> 2), v & 3); return true; }
        if (b < 12) { if (i == 1) { const int k = 244 + b; unitF(u, 1 + (k >> 2), 4 + (k & 3)); return true; } return false; }
        if (i == 1) { unitH(u, b); return true; }
        if (i == 2) { unitH(u, 256 + b); return true; }
        if (i == 3) { if (b < 36) { const int k = b - 12; unitH(u, k < 12 ? k : 256 + (k - 12)); return true; } if (b < 52) { unitH(u, 512 + (b - 36)); return true; } }
        return false;
    }
    __device__ __forceinline__ void epi(EPI_ARGS) const {
        if (u.kind == 1) { epi_rope_qk(acc, ws, u.i0, u.i1, wr, wc, fr, fq); return; }
        bf16_t* o = WSC(bf16_t, B_ST) + (size_t)u.i0 * 131072 + (size_t)(u.i1 * 256) * 256;
        FOR_FRAG(ai, bj, m, n) st_bf16x4(o + (size_t)FRAG_ROW(ai, m) * 256 + FRAG_COL(bj, n), acc[ai][bj][m][n]);
    }
};
struct PhSD { PH_COMMONP f32x4 lgf, lgb;
    __device__ __forceinline__ bool get(int i, UnitD& u) const {
        const int idx0 = bid + i * G; if (idx0 >= 512) return false;
        const int idx = xcd_remap(idx0, 512), tj = idx & 1, ti = (idx >> 1) & 1, h = (idx >> 2) & 3, c = 1 + (idx >> 4); const int t0 = chunk_tok0(c);
        eng::unit1(u, ws + B_Q + (size_t)(t0 + 256 * ti) * 2048 + h * 512, 2048, ws + B_K + (size_t)(t0 + 256 * tj) * 2048 + h * 512, 2048, 4);
        u.i0 = t0; u.i1 = h; u.i2 = ti * 2 + tj; return true;
    }
    __device__ __forceinline__ void epi(EPI_ARGS) const {
        const int ti = u.i2 >> 1, tj = u.i2 & 1, h = u.i1; const float lf = SEL4(lgf, h), lb = SEL4(lgb, h);
        bf16_t* o = WSC(bf16_t, B_SD) + (size_t)(u.i0 + 256 * ti) * 2048 + h * 512 + 256 * tj;
        FOR_FRAGP(ai, bj, m) { const int r = FRAG_ROW(ai, m), c0 = FRAG_COLP(bj), i = 256 * ti + r; f32x4 v[2];
#pragma unroll
            for (int n = 0; n < 2; ++n) { v[n] = acc[ai][bj][m][n];
#pragma unroll
                for (int e = 0; e < 4; ++e) { const int d = i - (256 * tj + c0 + 4 * n + e); const float w = d > 0 ? __expf(lf * (float)d) : d < 0 ? __expf(lb * (float)(-d)) : 2.0f; v[n][e] *= w; } }
            st_bf16x8(o + (size_t)r * 2048 + c0, v[0], v[1]); }
    }
};
struct PhO { const unsigned char* ws; int G, bid; f32x4 lgf, lgb; static constexpr bool HOOKS = true, GATHER = false, PERM = true;
    __device__ __forceinline__ bool get(int i, UnitD& u) const {
        const int idx0 = bid + i * G; if (idx0 >= 512) return false;
        const int idx = xcd_remap(idx0, 512), dvt = idx & 1, h = (idx >> 1) & 3, pm = idx >> 3, c = 1 + (pm >> 1), t0 = CTXN + 256 * pm;
        const char* q = (const char*)(ws + B_Q) + (size_t)t0 * 2048 + h * 512;
        const char* st = (const char*)(ws + B_ST) + ((size_t)(c * 8 + h * 2) * 131072 + (size_t)(dvt * 256) * 256) * 2;
        u.A0 = q; u.B0 = st; u.lda0 = 2048; u.ldb0 = 512; u.n0 = 4;
        u.A1 = q; u.B1 = st + (size_t)131072 * 2; u.lda1 = 2048; u.ldb1 = 512; u.n1 = 4;
        u.A2 = (const char*)(ws + B_SD) + (size_t)t0 * 4096 + h * 1024; u.B2 = (const char*)(ws + B_VT) + (size_t)(h * 512 + dvt * 256) * TT * 2 + (size_t)chunk_tok0(c) * 2; u.lda2 = 4096; u.ldb2 = TT * 2; u.n2 = 8;
        u.kind = 0; u.i0 = pm; u.i1 = h; u.i2 = dvt; return true;
    }
    __device__ __forceinline__ void hook(int tc, Acc& acc, const UnitD& u, int wr, int wc, int fr, int fq) const {
        if (tc != 4 && tc != 8) return;
        const float lf = SEL4(lgf, u.i1), lb = SEL4(lgb, u.i1);
#pragma unroll
        for (int ai = 0; ai < 2; ++ai)
#pragma unroll
            for (int m = 0; m < 4; ++m) { const int i = (u.i0 & 1) * 256 + FRAG_ROW(ai, m);
                const float s = tc == 4 ? __expf(lf * (float)(i + 1) - lb * (float)(512 - i)) : __expf(lb * (float)(512 - i));
#pragma unroll
                for (int bj = 0; bj < 2; ++bj)
#pragma unroll
                    for (int n = 0; n < 2; ++n) acc[ai][bj][m][n] *= s; }
    }
    __device__ __forceinline__ void epi(EPI_ARGS) const {
        const int tl = 256 * u.i0, h = u.i1, dvt = u.i2;
        bf16_t* o = WSC(bf16_t, B_O) + (size_t)(CTXN + tl) * 2048 + h * 512 + dvt * 256; float* ssq = WSC(float, WS_SSQ);
#pragma unroll
        for (int ai = 0; ai < 2; ++ai)
#pragma unroll
            for (int m = 0; m < 4; ++m) { const int r = FRAG_ROW(ai, m); float s = 0.f;
#pragma unroll
                for (int bj = 0; bj < 2; ++bj) {
#pragma unroll
                    for (int n = 0; n < 2; ++n) { const f32x4 v = acc[ai][bj][m][n]; s += (v[0] * v[0] + v[1] * v[1]) + (v[2] * v[2] + v[3] * v[3]); }
                    st_bf16x8(o + (size_t)r * 2048 + FRAG_COLP(bj), acc[ai][bj][m][0], acc[ai][bj][m][1]); }
                s += __shfl_xor(s, 16); s += __shfl_xor(s, 32);
                if (fq == 0) ssq[((size_t)(tl + r) * 4 + h) * 8 + dvt * 4 + wc] = s; }
    }
};
struct PhGG { PH_COMMONP
    __device__ __forceinline__ bool get(int i, UnitD& u) const {
        const int idx0 = bid + i * G; if (idx0 >= 512) return false;
        const int idx = xcd_remap(idx0, 512), pm = 1 + (idx >> 3), pn = idx & 7; eng::unit1(u, xm1_panel(ws, pm), 2048, ws + WS_W1IN + (size_t)(4096 + pn * 256) * 2048, 2048, 16); u.i0 = pm; u.i1 = pn; return true;
    }
    __device__ __forceinline__ void epi(EPI_ARGS) const {
        bf16_t* o = WSC(bf16_t, B_O) + (size_t)(u.i0 * 256) * 2048 + u.i1 * 256; const float* ssq = WSC(const float, WS_SSQ); const int h = u.i1 >> 1;
#pragma unroll
        for (int ai = 0; ai < 2; ++ai)
#pragma unroll
            for (int m = 0; m < 4; ++m) { const int r = FRAG_ROW(ai, m); const float* sp = ssq + ((size_t)((u.i0 - 1) * 256 + r) * 4 + h) * 8;
                const f32x4 s0 = *(const f32x4*)sp, s1 = *(const f32x4*)(sp + 4); const float rstd = rsqrtf((((s0[0] + s0[1]) + (s0[2] + s0[3])) + ((s1[0] + s1[1]) + (s1[2] + s1[3]))) * (1.0f / 512.0f) + RMS_EPS);
#pragma unroll
                for (int bj = 0; bj < 2; ++bj) { bf16_t* q = o + (size_t)r * 2048 + FRAG_COLP(bj); const u32x4 ov = *(const u32x4*)q; const f32x4 g0 = acc[ai][bj][m][0], g1 = acc[ai][bj][m][1]; f32x4 v0, v1;
                    v0[0] = silu_f(g0[0]) * (bflo(ov.x) * rstd); v0[1] = silu_f(g0[1]) * (bfhi(ov.x) * rstd); v0[2] = silu_f(g0[2]) * (bflo(ov.y) * rstd); v0[3] = silu_f(g0[3]) * (bfhi(ov.y) * rstd);
                    v1[0] = silu_f(g1[0]) * (bflo(ov.z) * rstd); v1[1] = silu_f(g1[1]) * (bfhi(ov.z) * rstd); v1[2] = silu_f(g1[2]) * (bflo(ov.w) * rstd); v1[3] = silu_f(g1[3]) * (bfhi(ov.w) * rstd);
                    st_bf16x8(q, v0, v1); } }
    }
};
struct PhG4 { PH_COMMON float* out;
    __device__ __forceinline__ bool get(int i, UnitD& u) const {
        const int idx0 = bid + i * G; if (idx0 >= 256) return false;
        const int idx = xcd_remap(idx0, 256), pm = idx >> 2, pn = idx & 3; eng::unit1(u, ws + B_O + (size_t)(CTXN + pm * 256) * 4096, 4096, ws + WS_W1OUT + (size_t)pn * 256 * 4096, 4096, 32); u.i0 = pm; u.i1 = pn; return true;
    }
    __device__ __forceinline__ void epi(EPI_ARGS) const {
        const float* g1 = WSC(const float, WS_MOD) + 6144 + 2048 + u.i1 * 256; float* dst = out + (size_t)(u.i0 * 256) * DM + u.i1 * 256;
        FOR_FRAG(ai, bj, m, n) { float* q = dst + (size_t)FRAG_ROW(ai, m) * DM + FRAG_COL(bj, n); const f32x4 gv = *(const f32x4*)(g1 + FRAG_COL(bj, n)); *(f32x4*)q = *(const f32x4*)q + gv * acc[ai][bj][m][n]; }
    }
};

constexpr int NA_KC = 0, NA_VC = 32768, NA_RPB = 65536;
__device__ __forceinline__ int na_ksw(int tok) { return ((tok >> 1) & 1) | (((tok >> 3) & 3) << 1); }
__device__ __forceinline__ void na_load_ctx(const Frame& F, int h) {
    const bf16_t* qk = WSP(const bf16_t, A_QK0); const bf16_t* vt = WSP(const bf16_t, A_VT0);
#pragma unroll
    for (int i = 0; i < 4; ++i) { const int cid = F.tid + 512 * i, tok = cid >> 3, c = cid & 7;
        *(LAS u32x4*)(F.lds + NA_KC + tok * 128 + ((c ^ na_ksw(tok)) << 4)) = *(const u32x4*)(qk + (size_t)tok * QK0_LD + 768 + h * 64 + c * 8); }
#pragma unroll
    for (int i = 0; i < 4; ++i) { const int cid = F.tid + 512 * i, d = cid >> 5, ch = cid & 31;
        *(LAS u32x4*)(F.lds + NA_VC + d * 512 + ((ch ^ (d & 15)) << 4)) = *(const u32x4*)(vt + (size_t)(h * 64 + d) * TT + ch * 8); }
}
template <bool LOCAL>
__device__ __forceinline__ void na_unit(const Frame& F, int r, int j, int h, int qb) {
    const bf16_t* qk = WSP(const bf16_t, A_QK0); const bf16_t* vt = WSP(const bf16_t, A_VT0); bf16_t* ao = WSP(bf16_t, A_AO);
    const LAS float* rpb_l = (const LAS float*)(F.lds + NA_RPB);
    int lane = F.lane; asm volatile("" : "+v"(lane));
    const int q16 = lane & 15, g = lane >> 4;
    const int tq = LOCAL ? CTXN + r * GW + 16 * j + q16 : 16 * qb + q16;
    bf16x8 qf[2];
#pragma unroll
    for (int ks = 0; ks < 2; ++ks) qf[ks] = *(const bf16x8*)(qk + (size_t)tq * QK0_LD + h * 64 + 32 * ks + 8 * g);
    constexpr int NT = LOCAL ? 32 : 16, NL = LOCAL ? 16 : 0;
    f32x4 s[NT];
    const int rs = LOCAL ? min(max(r - 4, 0), 248) : 0, kst = LOCAL ? min(max(16 * j - 8, 0), 32) : 0;
    const int krow = 8 * (q16 >> 2) + (q16 & 3);
#pragma unroll
    for (int t = 0; t < NT; ++t) {
        bf16x8 k0, k1;
        if (t < NL) { const int tok = CTXN + (rs + (t >> 1)) * GW + kst + krow + 4 * (t & 1); const bf16_t* kp = qk + (size_t)tok * QK0_LD + 768 + h * 64 + 8 * g; k0 = *(const bf16x8*)kp; k1 = *(const bf16x8*)(kp + 32); }
        else { const int tok = 32 * ((t - NL) >> 1) + krow + 4 * (t & 1), sw = na_ksw(tok); const LAS unsigned char* kp = F.lds + NA_KC + tok * 128;
            k0 = *(const LAS bf16x8*)(kp + ((g ^ sw) << 4)); k1 = *(const LAS bf16x8*)(kp + (((4 + g) ^ sw) << 4)); }
        f32x4 a = {0.f, 0.f, 0.f, 0.f};
        a = __builtin_amdgcn_mfma_f32_16x16x32_bf16(k0, qf[0], a, 0, 0, 0); a = __builtin_amdgcn_mfma_f32_16x16x32_bf16(k1, qf[1], a, 0, 0, 0);
        s[t] = a;
        if ((t & 3) == 3) asm volatile("" ::: "memory");
    }
    float mx = -1e30f;
    if (LOCAL) { const int qc = 16 * j + q16, wst = min(max(qc - 8, 0), 48);
#pragma unroll
        for (int t = 0; t < NL; ++t) { const int dr = rs + (t >> 1) - r + 7;
#pragma unroll
            for (int e = 0; e < 4; ++e) { const int kc = kst + 8 * g + 4 * (t & 1) + e; const bool ok = kc >= wst && kc < wst + 16; const int dc = min(max(kc - qc + 15, 0), 30);
                const float v = ok ? s[t][e] * 0.125f + rpb_l[(h * 15 + dr) * 31 + dc] : -1e30f; s[t][e] = v; mx = fmaxf(mx, v); } } }
#pragma unroll
    for (int t = NL; t < NT; ++t)
#pragma unroll
        for (int e = 0; e < 4; ++e) { const float v = s[t][e] * 0.125f; s[t][e] = v; mx = fmaxf(mx, v); }
    mx = fmaxf(mx, __shfl_xor(mx, 16)); mx = fmaxf(mx, __shfl_xor(mx, 32));
    float sum = 0.f; u32x4 pw[NT / 2];
#pragma unroll
    for (int b = 0; b < NT / 2; ++b) { float p[8];
#pragma unroll
        for (int e = 0; e < 4; ++e) { p[e] = __expf(s[2 * b][e] - mx); p[4 + e] = __expf(s[2 * b + 1][e] - mx); }
        sum += ((p[0] + p[1]) + (p[2] + p[3])) + ((p[4] + p[5]) + (p[6] + p[7]));
        pw[b].x = cvt_pk_bf16(p[0], p[1]); pw[b].y = cvt_pk_bf16(p[2], p[3]); pw[b].z = cvt_pk_bf16(p[4], p[5]); pw[b].w = cvt_pk_bf16(p[6], p[7]); }
    sum += __shfl_xor(sum, 16); sum += __shfl_xor(sum, 32);
    f32x4 o[4];
#pragma unroll
    for (int dt = 0; dt < 4; ++dt) o[dt] = (f32x4){0.f, 0.f, 0.f, 0.f};
#pragma unroll
    for (int b = 0; b < NT / 2; ++b) {
        const bf16x8 pf = __builtin_bit_cast(bf16x8, pw[b]);
#pragma unroll
        for (int dt = 0; dt < 4; ++dt) { bf16x8 vf;
            if (b < NL / 2) vf = *(const bf16x8*)(vt + (size_t)(h * 64 + 16 * dt + q16) * TT + CTXN + (rs + b) * GW + kst + 8 * g);
            else vf = *(const LAS bf16x8*)(F.lds + NA_VC + (16 * dt + q16) * 512 + (((4 * (b - NL / 2) + g) ^ q16) << 4));
            o[dt] = __builtin_amdgcn_mfma_f32_16x16x32_bf16(vf, pf, o[dt], 0, 0, 0); }
        if ((b & 1) == 1) asm volatile("" ::: "memory");
    }
    const float inv = 1.0f / sum;
#pragma unroll
    for (int dt = 0; dt < 4; ++dt) st_bf16x4(ao + (size_t)tq * DM + 256 + h * 64 + 16 * dt + 4 * g, o[dt] * inv);
}
__device__ __forceinline__ void p_attention(const Frame& F) {
    if ((F.bid & 3) == 3) { for (int t = F.bid >> 2; t < 1536; t += (F.G >> 2)) conv_moe_tile(F, 0, t); }
    __syncthreads();
    LAS float* rpb_l = (LAS float*)(F.lds + NA_RPB); volatile LAS int* tick = (volatile LAS int*)(F.lds + NA_RPB + 24576);
    for (int i = F.tid; i < 12 * 15 * 31; i += 512) rpb_l[i] = F.p.rpb[i];
    unsigned* heads = (unsigned*)(F.p.ws + WS_CTL + CTL_QUEUE);
    const int h0 = (12 * F.bid) >> 8;
    for (int hh = 0; hh < 12; ++hh) {
        const int h = (h0 + hh) % 12; bool loaded = false;
        for (;;) {
            __syncthreads();
            if (F.tid == 0) tick[0] = (int)__hip_atomic_fetch_add(heads + h * 64, 1u, __ATOMIC_RELAXED, __HIP_MEMORY_SCOPE_AGENT);
            __syncthreads();
            const int k = __builtin_amdgcn_readfirstlane(tick[0]);
            if (k > 128) break;
            if (!loaded) { na_load_ctx(F, h); __syncthreads(); loaded = true; }
            if (k < 128) na_unit<true>(F, 2 * k + (F.wid >> 2), F.wid & 3, h, 0);
            else { na_unit<false>(F, 0, 0, h, F.wid); na_unit<false>(F, 0, 0, h, F.wid + 8); }
        }
    }
    __syncthreads();
}
constexpr int LDS_BYTES = eng::STAGE_BYTES + 1024 + 4096;
#ifndef MK_PER_PHASE
#define MK_PER_PHASE 0
#endif

__global__ __launch_bounds__(512, 2) void mk_fwd(Params p) {
    extern __shared__ __attribute__((aligned(16))) unsigned char shm[];
    Frame F; F.p = p; F.lds = (LAS unsigned char*)shm; F.tid = threadIdx.x; F.lane = F.tid & 63; F.wid = __builtin_amdgcn_readfirstlane(F.tid >> 6); F.G = gridDim.x; F.bid = blockIdx.x;
    volatile LAS unsigned* xb = (volatile LAS unsigned*)(F.lds + eng::STAGE_BYTES);
    if (F.tid < 4) xb[F.tid] = 0u;
    __syncthreads();
    const int lo = p.ph_lo, hi = p.ph_hi;
    XcdBarrier bar; bar.bar = (unsigned*)(p.ws + WS_CTL); bar.x = 0; bar.st = xb;
    if (hi - lo > 1) bar = xcd_barrier_post((unsigned*)(p.ws + WS_CTL), xb);
#ifndef PHMASK
#define PHMASK 0xFFFFFFu
#endif
#define IN(k) (((PHMASK >> (k)) & 1u) && lo <= (k) && (k) < hi)
#ifndef PROBE_MASK
#define PROBE_MASK 0u
#endif
#ifndef PROBE_MULT
#define PROBE_MULT 1
#endif
    unsigned long long pr_acc = 0, pr_prev = PROBE_MASK ? wall_clock64() : 0ull;
#define SEAM(k) do { if (IN(k) && hi > (k) + 1) xcd_barrier(bar); if (PROBE_MASK) { const unsigned long long _n = wall_clock64(); if ((PROBE_MASK >> (k)) & 1u) pr_acc += _n - pr_prev; pr_prev = _n; } } while (0)
    const unsigned char* ws = p.ws;

    if (IN(0)) { p0_prologue(F); } SEAM(0);
    if (IN(1)) { p_norm_in(F); } SEAM(1);
    if (IN(2)) { PhG1 ph{ws, F.G, F.bid}; eng::gemm_run(F.lds, ph); } SEAM(2);
    if (IN(3)) { PhF1 ph{ws, F.G, F.bid}; eng::gemm_run(F.lds, ph); p_attention(F); } SEAM(3);
    if (IN(4)) { PhF2 ph{ws, F.G, F.bid}; eng::gemm_run(F.lds, ph); } SEAM(4);
    if (IN(5)) { PhG2 ph{ws, F.G, F.bid, p.x, p.out}; eng::gemm_run(F.lds, ph); } SEAM(5);
    if (IN(6)) { p_router(F, 0, 0, WSP(bf16_t, A_XM)); } SEAM(6);
    if (IN(8)) { PhM1 ph{ws, F.G, F.bid}; panel_tab(F, 0, ph.pt); ph.xs = A_XM; ph.hd = A_HD; moe_rowtab(F, 0, ph.pt, 0); eng::gemm_run(F.lds, ph); } SEAM(8);
    if (IN(9)) { PhM2 ph{ws, F.G, F.bid}; panel_tab(F, 0, ph.pt); ph.hd = A_HD; ph.y = A_XS; eng::gemm_run(F.lds, ph); } SEAM(9);
    if (IN(10)) { p_combine0(F); } SEAM(10);
    if (IN(11)) { PhG3 ph{ws, F.G, F.bid};
        ph.lgf = (f32x4){log_gamma(F, 0, 0), log_gamma(F, 0, 1), log_gamma(F, 0, 2), log_gamma(F, 0, 3)}; ph.lgb = (f32x4){log_gamma(F, 1, 0), log_gamma(F, 1, 1), log_gamma(F, 1, 2), log_gamma(F, 1, 3)};
        eng::gemm_run(F.lds, ph); } SEAM(11);
    if (IN(12)) { PhU ph{ws, F.G, F.bid}; eng::gemm_run(F.lds, ph); } SEAM(13);
    if (IN(14)) { PhSD ph{ws, F.G, F.bid};
        ph.lgf = (f32x4){log_gamma(F, 0, 0), log_gamma(F, 0, 1), log_gamma(F, 0, 2), log_gamma(F, 0, 3)}; ph.lgb = (f32x4){log_gamma(F, 1, 0), log_gamma(F, 1, 1), log_gamma(F, 1, 2), log_gamma(F, 1, 3)};
        if (F.bid & 8) { p_scan(F); eng::gemm_run(F.lds, ph); } else { eng::gemm_run(F.lds, ph); p_scan(F); } } SEAM(14);
    if (IN(15)) { PhO ph{ws, F.G, F.bid};
        ph.lgf = (f32x4){log_gamma(F, 0, 0), log_gamma(F, 0, 1), log_gamma(F, 0, 2), log_gamma(F, 0, 3)}; ph.lgb = (f32x4){log_gamma(F, 1, 0), log_gamma(F, 1, 1), log_gamma(F, 1, 2), log_gamma(F, 1, 3)};
        eng::gemm_run(F.lds, ph); } SEAM(15);
    if (IN(17)) { PhGG ph{ws, F.G, F.bid}; eng::gemm_run(F.lds, ph); } SEAM(17);
    if (IN(18)) { PhG4 ph{ws, F.G, F.bid, p.out};
        if (F.bid & 8) { conv_moe(F, 1, 0, 1024); eng::gemm_run(F.lds, ph); } else { eng::gemm_run(F.lds, ph); conv_moe(F, 1, 0, 1024); } } SEAM(18);
    if (IN(19)) { p_router(F, 1, CTXN, WSP(bf16_t, B_XM2)); } SEAM(19);
    if (IN(21)) { PhM1 ph{ws, F.G, F.bid}; panel_tab(F, 1, ph.pt); ph.xs = B_XM2; ph.hd = B_HD; moe_rowtab(F, 1, ph.pt, CTXN); eng::gemm_run(F.lds, ph); conv_moe(F, 1, 1024, 1536); } SEAM(21);
    if (IN(22)) { PhM2 ph{ws, F.G, F.bid}; panel_tab(F, 1, ph.pt); ph.hd = B_HD; ph.y = B_XS; eng::gemm_run(F.lds, ph); } SEAM(22);
    if (IN(23)) { p_final(F); }
    if (PROBE_MASK) { SEAM(23); if (F.bid == 0) { const unsigned long long t0 = wall_clock64(); while (wall_clock64() - t0 < pr_acc * PROBE_MULT) __builtin_amdgcn_s_sleep(8); } }
#undef IN
#undef SEAM
}

extern "C" void kernel_launch(void* const* d_in, const int* in_sizes, int n_in, void* d_out, int out_size, void* d_ws, size_t ws_size, hipStream_t stream) {
    static int grid = 0;
    if (grid == 0) {
        if (n_in != 19 || out_size != SEQ * DM || ws_size < WS_END) { fprintf(stderr, "kernel_launch: unexpected shapes (n_in %d, out %d, ws %zu < %zu)\n", n_in, out_size, ws_size, (size_t)WS_END); grid = -1; return; }
        int dev = 0, cus = 0, per_cu = 0;
        if (hipGetDevice(&dev) != hipSuccess || hipDeviceGetAttribute(&cus, hipDeviceAttributeMultiprocessorCount, dev) != hipSuccess) { grid = -1; return; }
        if (hipFuncSetAttribute((const void*)mk_fwd, hipFuncAttributeMaxDynamicSharedMemorySize, LDS_BYTES) != hipSuccess) { fprintf(stderr, "kernel_launch: hipFuncSetAttribute failed\n"); grid = -1; return; }
        if (hipOccupancyMaxActiveBlocksPerMultiprocessor(&per_cu, (const void*)mk_fwd, 512, LDS_BYTES) != hipSuccess || per_cu < 1) { fprintf(stderr, "kernel_launch: occupancy query says %d\n", per_cu); per_cu = 1; }
        (void)hipGetLastError();
        grid = cus;
        if (grid > 256) grid = 256;
    }
    if (grid < 0) return;
    (void)hipMemsetAsync((char*)d_ws + WS_CTL, 0, CTL_BYTES, stream);
    Params p{};
    const float** pp = (const float**)&p;
    for (int i = 0; i < 19; ++i) pp[i] = (const float*)d_in[i];
    p.out = (float*)d_out; p.ws = (unsigned char*)d_ws;
#if MK_PER_PHASE
    for (int ph = 0; ph < NPHASE; ++ph) { p.ph_lo = ph; p.ph_hi = ph + 1; hipLaunchKernelGGL(mk_fwd, dim3(grid), dim3(512), LDS_BYTES, stream, p); }
#else
    p.ph_lo = 0; p.ph_hi = NPHASE; hipLaunchKernelGGL(mk_fwd, dim3(grid), dim3(512), LDS_BYTES, stream, p);
#endif
}
```

```cpp
#include <hip/hip_runtime.h>
#include <cstdio>
#include <cstdint>

typedef unsigned short bf16_t;
typedef short bf16x8 __attribute__((ext_vector_type(8)));
typedef float f32x4 __attribute__((ext_vector_type(4)));
typedef float f32x2 __attribute__((ext_vector_type(2)));
typedef unsigned u32x2 __attribute__((ext_vector_type(2)));
typedef unsigned u32x4 __attribute__((ext_vector_type(4)));
#define LAS __attribute__((address_space(3)))

constexpr int DM = 1024, SEQ = 16384, CTXN = 256, TT = SEQ + CTXN  , GW = 64;
constexpr int NH0 = 12, QK0_LD = 1536, W0IN_ROWS = 2816;
constexpr int NPMAX = 146;
constexpr float RMS_EPS = 1e-6f;
constexpr int NPHASE = 24;

constexpr size_t KiB = 1024, MiB = 1024 * 1024, HMiB = 512 * 1024;
constexpr size_t WS_CTL = 0;
constexpr size_t CTL_BYTES = 64 * KiB;
constexpr size_t CTL_CNT = 16 * KiB;
constexpr size_t CTL_QUEUE = 20 * KiB;
constexpr size_t WS_MOD = 64 * KiB;
constexpr size_t WS_TWC = 256 * KiB, WS_TWS = 320 * KiB;
constexpr size_t WS_ROPEC = 384 * KiB, WS_ROPES = 448 * KiB;
constexpr size_t WS_F1T = 512 * KiB, WS_F2P = 640 * KiB;
constexpr size_t WS_CS256 = 768 * KiB;
constexpr size_t WS_HC = 1 * MiB;
constexpr size_t WS_EID = 2 * MiB;
constexpr size_t WS_GW = 2 * MiB + 256 * KiB;
constexpr size_t WS_SLOT = 2 * MiB + 512 * KiB;
constexpr size_t WS_SSQ = 3 * MiB;
constexpr size_t WS_XTC = 5 * MiB;
constexpr size_t WS_PERM = 6 * MiB;
constexpr size_t WS_W0IN = 8 * MiB, WS_W0OUT = 14 * MiB, WS_W1IN = 16 * MiB, WS_W1OUT = 28 * MiB;
constexpr size_t AR = 32 * MiB;
constexpr size_t A_XM = AR + 0, A_QK0 = AR + 65 * HMiB, A_VT0 = AR + 81 * MiB + 256 * KiB, A_XT2 = AR + 106 * MiB, A_T2 = AR + 122 * MiB + HMiB, A_AO = AR + 139 * MiB;
constexpr size_t A_PART = AR + 172 * MiB;
constexpr size_t A_XS = AR + 65 * HMiB, A_HD = AR + 106 * MiB, A_MOEW = AR + 245 * MiB;
constexpr size_t B_Q = AR + 0, B_K = AR + 65 * HMiB, B_O = AR + 65 * HMiB, B_KF = AR + 195 * HMiB, B_KB = AR + 130 * MiB, B_SD = AR + 195 * HMiB, B_VT = AR + 325 * HMiB;
constexpr size_t B_XM1 = AR + 455 * HMiB, B_ST = AR + 455 * HMiB, B_XM1B = AR + 0, B_XM2 = AR + 0, B_XS = AR + 195 * HMiB, B_HD = AR + 341 * HMiB;
constexpr size_t B_XM1A = AR + 587 * HMiB;
constexpr size_t WS_END = AR + 319 * MiB;

struct Params {
    const float *x, *c, *ctx, *c_ctx, *ada_w, *ada_b, *norm_g, *final_g, *w0in, *w0out, *rpb, *w1in, *w1out, *decay, *router_w, *router_b, *moe_w1, *moe_w3, *moe_w2;
    float* out; unsigned char* ws; int ph_lo, ph_hi;
};

__device__ __forceinline__ unsigned cvt_pk_bf16(float lo, float hi) { unsigned r; asm volatile("v_cvt_pk_bf16_f32 %0, %1, %2" : "=v"(r) : "v"(lo), "v"(hi)); return r; }
__device__ __forceinline__ bf16_t f2bf(float f) { return (bf16_t)(cvt_pk_bf16(f, 0.f) & 0xffffu); }
__device__ __forceinline__ float bf2f(unsigned short b) { return __uint_as_float(((unsigned)b) << 16); }
__device__ __forceinline__ float bflo(unsigned w) { return __uint_as_float(w << 16); }
__device__ __forceinline__ float bfhi(unsigned w) { return __uint_as_float(w & 0xffff0000u); }
__device__ __forceinline__ float silu_f(float v) { return v / (1.0f + __expf(-v)); }
__device__ __forceinline__ float wave_sum(float v) {
#pragma unroll
    for (int o = 32; o >= 1; o >>= 1) v += __shfl_xor(v, o);
    return v;
}
__device__ __forceinline__ float wave_max(float v) {
#pragma unroll
    for (int o = 32; o >= 1; o >>= 1) v = fmaxf(v, __shfl_xor(v, o));
    return v;
}
#define XB_TMO      128
#define XB_XCNT(j)  (256  + 64 * (j))
#define XB_XSUB(j)  (1280 + 64 * (j))
#define XB_XGEN(j)  (2304 + 64 * (j))
#define XB_TOP      3328
#define XB_TOPGEN   3392
#define XCD_BAR_WORDS 3456
#define XB_SPIN_CAP (1u << 18)

__device__ __forceinline__ unsigned xb_ld(unsigned* p)              { return __hip_atomic_load(p, __ATOMIC_RELAXED, __HIP_MEMORY_SCOPE_AGENT); }
__device__ __forceinline__ unsigned xb_add(unsigned* p, unsigned v) { return __hip_atomic_fetch_add(p, v, __ATOMIC_RELAXED, __HIP_MEMORY_SCOPE_AGENT); }
__device__ __forceinline__ unsigned xb_xcc_id() { return (unsigned)__builtin_amdgcn_s_getreg((3 << 11) | 20) & 0xFu; }
#define XB_SPIN(cond, bar) do { unsigned _sp = 0; while (cond) { __builtin_amdgcn_s_sleep(1); \
    if ((++_sp & 255u) == 0u) { if (xb_ld(&(bar)[XB_TMO])) break; if (_sp > XB_SPIN_CAP) { atomicAdd(&(bar)[XB_TMO], 1u); break; } } } } while (0)

struct XcdBarrier {
    unsigned* bar; unsigned x;
    volatile LAS unsigned* st;
};

__device__ __forceinline__ XcdBarrier xcd_barrier_post(unsigned* bar, volatile LAS unsigned* st) {
    XcdBarrier b; b.bar = bar; b.x = xb_xcc_id(); b.st = st;
    if (threadIdx.x == 0) (void)xb_add(&bar[XB_XCNT(b.x)], 1u);
    return b;
}
__device__ __forceinline__ void xcd_barrier_complete(unsigned* bar, unsigned x, unsigned& nloc, unsigned& nx) {
    const unsigned G = gridDim.x * gridDim.y * gridDim.z;
    unsigned sum, cnt, mine, sp = 0u;
    for (;;) {
        sum = 0u; cnt = 0u; mine = 0u;
#pragma unroll
        for (unsigned j = 0; j < 16; ++j) { const unsigned c = xb_ld(&bar[XB_XCNT(j)]); sum += c; cnt += (c > 0u) ? 1u : 0u; mine = (j == x) ? c : mine; }
        if (sum == G) break;
        __builtin_amdgcn_s_sleep(1);
        if ((++sp & 255u) == 0u) { if (xb_ld(&bar[XB_TMO])) break; if (sp > XB_SPIN_CAP) { atomicAdd(&bar[XB_TMO], 1u); break; } }
    }
    nloc = mine > 0u ? mine : 1u; nx = cnt > 0u ? cnt : 1u;
}

__device__ __forceinline__ void xcd_barrier(const XcdBarrier& b) {
    asm volatile("s_waitcnt vmcnt(0)" ::: "memory");
    __syncthreads();
    if (threadIdx.x == 0) {
        unsigned* bar = b.bar;
        __builtin_amdgcn_s_waitcnt(0);
        unsigned nloc = b.st[0], nx = b.st[1];
        if (nloc == 0u) { xcd_barrier_complete(bar, b.x, nloc, nx); b.st[0] = nloc; b.st[1] = nx; }
        const unsigned old = xb_add(&bar[XB_XSUB(b.x)], 1u);
        const unsigned gen = old / nloc;
        if (old + 1u == (gen + 1u) * nloc) {
            __builtin_amdgcn_fence(__ATOMIC_RELEASE, "agent");
            asm volatile("s_waitcnt vmcnt(0)" ::: "memory");
            const unsigned og = xb_add(&bar[XB_TOP], 1u);
            const unsigned tg = og / nx;
            if (og + 1u == (tg + 1u) * nx) xb_add(&bar[XB_TOPGEN], 1u);
            else XB_SPIN(xb_ld(&bar[XB_TOPGEN]) == tg, bar);
            __builtin_amdgcn_fence(__ATOMIC_ACQUIRE, "agent");
            xb_add(&bar[XB_XGEN(b.x)], 1u);
            asm volatile("s_waitcnt vmcnt(0)" ::: "memory");
        } else {
            XB_SPIN(xb_ld(&bar[XB_XGEN(b.x)]) == gen, bar);
            __builtin_amdgcn_fence(__ATOMIC_ACQUIRE, "agent");
            asm volatile("s_waitcnt vmcnt(0)" ::: "memory");
        }
    }
    __syncthreads();
}
namespace eng {
constexpr int BM = 256, BK = 64, HALF = 128, HTB = HALF * BK * 2, STAGE_BYTES = 8 * HTB;
__device__ __forceinline__ int lds_byte(int r, int c) { const int st = (r >> 4) * 2 + (c >> 5), rr = r & 15, cc = c & 31, ob = rr * 64 + cc * 2; return st * 1024 + (ob ^ (((ob >> 9) & 1) << 5)); }
__device__ __forceinline__ int perm32(int rho) { const int n = rho >> 4, i = rho & 15; return 8 * (i >> 2) + 4 * n + (i & 3); }
__device__ __forceinline__ void stage_rc(int b, int& R, int& C) { const int st = b / 1024, sb = b % 1024, swz = sb ^ (((sb >> 9) & 1) << 5); R = (st >> 1) * 16 + swz / 64; C = (st & 1) * 32 + (swz % 64) / 2; }

struct UnitD {
    const char* A0; const char* B0; unsigned lda0, ldb0; int n0;
    unsigned hb0;
    const char* A1; const char* B1; unsigned lda1, ldb1; int n1;
    const char* A2; const char* B2; unsigned lda2, ldb2; int n2;
    int kind, i0, i1, i2;
};
struct TD { const char* a; const char* b; unsigned lda, ldb; int gpar; unsigned hb; };
__device__ __forceinline__ TD tile_at(const UnitD& u, int t) {
    TD d;
    if (t < u.n0) { d.a = u.A0 + (size_t)t * 128; d.b = u.B0 + (size_t)t * 128; d.lda = u.lda0; d.ldb = u.ldb0; d.hb = u.hb0; }
    else if (t < u.n0 + u.n1) { const int s = t - u.n0; d.a = u.A1 + (size_t)s * 128; d.b = u.B1 + (size_t)s * 128; d.lda = u.lda1; d.ldb = u.ldb1; d.hb = 128u * u.ldb1; }
    else { const int s = t - u.n0 - u.n1; d.a = u.A2 + (size_t)s * 128; d.b = u.B2 + (size_t)s * 128; d.lda = u.lda2; d.ldb = u.ldb2; d.hb = 128u * u.ldb2; }
    return d;
}
typedef f32x4 Acc[2][2][4][2];

template <class P>
__device__ __forceinline__ void gemm_run(LAS unsigned char* lds, const P& ph) {
    const int tid = threadIdx.x, wid = __builtin_amdgcn_readfirstlane(tid >> 6), lane = tid & 63, wr = wid >> 2, wc = wid & 3, fr = lane & 15, fq = lane >> 4;
    int R0, C0; stage_rc(tid * 16, R0, C0);
    const unsigned vR = (unsigned)R0, vC2 = (unsigned)C0 * 2u, vRB = P::PERM ? (unsigned)((R0 & ~31) + perm32(R0 & 31)) : (unsigned)R0;
    const unsigned ldsw = (unsigned)wid * 1024u;
    const int aoff = lds_byte(wr * 64 + fr, fq * 8), boff = lds_byte(wc * 32 + fr, fq * 8);
#define EG_SA(b, h) (((b) * 2 + (h)) * HTB)
#define EG_SB(b, h) ((4 + (b) * 2 + (h)) * HTB)
#define EG_STAGE(bufoff, gbase, ld) EG_STAGER(bufoff, gbase, ld, vR)
#define EG_STAGEB(bufoff, gbase, ld) EG_STAGER(bufoff, gbase, ld, vRB)
#define EG_STAGER(bufoff, gbase, ld, vrow) do { const unsigned _ld = (ld); const char* _g = (gbase) + (size_t)((vrow) * _ld + vC2); \
        __builtin_amdgcn_global_load_lds((const unsigned*)_g, (LAS unsigned*)(lds + (bufoff) + ldsw), 16, 0, 0); \
        __builtin_amdgcn_global_load_lds((const unsigned*)(_g + (size_t)(64u * _ld)), (LAS unsigned*)(lds + (bufoff) + ldsw + 8192), 16, 0, 0); } while (0)
#define EG_STAGEA(bufoff, d, h) do { if constexpr (P::GATHER) { const char* _g = (d).a + vC2; const unsigned _o0 = (d).gpar ? gB[(h) * 2] : gA[(h) * 2], _o1 = (d).gpar ? gB[(h) * 2 + 1] : gA[(h) * 2 + 1]; \
        __builtin_amdgcn_global_load_lds((const unsigned*)(_g + _o0), (LAS unsigned*)(lds + (bufoff) + ldsw), 16, 0, 0); \
        __builtin_amdgcn_global_load_lds((const unsigned*)(_g + _o1), (LAS unsigned*)(lds + (bufoff) + ldsw + 8192), 16, 0, 0); } \
        else EG_STAGE(bufoff, (d).a + (size_t)((h) * 128u * (d).lda), (d).lda); } while (0)
#define EG_LDA(dst, b, h) do { _Pragma("unroll") for (int m = 0; m < 4; ++m) _Pragma("unroll") for (int k = 0; k < 2; ++k) dst[m][k] = *(const LAS bf16x8*)(lds + EG_SA(b, h) + aoff + m * 2048 + k * 1024); } while (0)
#define EG_LDB(dst, b, h) do { _Pragma("unroll") for (int n = 0; n < 2; ++n) _Pragma("unroll") for (int k = 0; k < 2; ++k) dst[n][k] = *(const LAS bf16x8*)(lds + EG_SB(b, h) + boff + n * 2048 + k * 1024); } while (0)
#define EG_MMA(ai, bj, At, Bt) do { __builtin_amdgcn_s_setprio(1); _Pragma("unroll") for (int m = 0; m < 4; ++m) _Pragma("unroll") for (int n = 0; n < 2; ++n) _Pragma("unroll") for (int k = 0; k < 2; ++k) \
        acc[ai][bj][m][n] = __builtin_amdgcn_mfma_f32_16x16x32_bf16(Bt[n][k], At[m][k], acc[ai][bj][m][n], 0, 0, 0); __builtin_amdgcn_s_setprio(0); } while (0)
#define EG_WAIT_V(n) asm volatile("s_waitcnt vmcnt(" #n ")" ::: "memory")
#define EG_WAIT_L(n) asm volatile("s_waitcnt lgkmcnt(" #n ")" ::: "memory")
#define EG_BAR __builtin_amdgcn_s_barrier()
#define EG_SCHED __builtin_amdgcn_sched_barrier(0)
    UnitD cur; int ui = 0;
    if (!ph.get(0, cur)) return;
    UnitD cu = cur; int cui = 0, ct = 0; bool cvalid = true; TD lastTD = tile_at(cur, 0); lastTD.gpar = 0;
    unsigned gA[4] = {0u, 0u, 0u, 0u}, gB[4] = {0u, 0u, 0u, 0u};
    const LAS unsigned* rowtab = (const LAS unsigned*)(lds + STAGE_BYTES + 1024);
#define EG_GLOAD(ord) do { if constexpr (P::GATHER) { if ((ord) & 1) { _Pragma("unroll") for (int _k = 0; _k < 4; ++_k) gB[_k] = rowtab[(ord) * 256 + (_k >> 1) * 128 + (_k & 1) * 64 + vR]; } \
        else { _Pragma("unroll") for (int _k = 0; _k < 4; ++_k) gA[_k] = rowtab[(ord) * 256 + (_k >> 1) * 128 + (_k & 1) * 64 + vR]; } } } while (0)
    EG_GLOAD(0);
#define EG_NEXT(dst) do { if (cvalid) { dst = tile_at(cu, ct); dst.gpar = cui & 1; lastTD = dst; ++ct; if (ct == cu.n0 + cu.n1 + cu.n2) { ++cui; ct = 0; cvalid = ph.get(cui, cu); if (cvalid) EG_GLOAD(cui); } } else dst = lastTD; } while (0)
    Acc acc;
#pragma unroll
    for (int a = 0; a < 2; ++a)
#pragma unroll
        for (int b = 0; b < 2; ++b)
#pragma unroll
            for (int m = 0; m < 4; ++m)
#pragma unroll
                for (int n = 0; n < 2; ++n) acc[a][b][m][n] = (f32x4){0.f, 0.f, 0.f, 0.f};
    bf16x8 At[4][2], B0[2][2], B1[2][2];
    TD d1, d2, d3;
    { TD d0; EG_NEXT(d0); EG_NEXT(d1);
      EG_STAGEB(EG_SB(0, 0), d0.b, d0.ldb); EG_STAGEA(EG_SA(0, 0), d0, 0); EG_STAGEB(EG_SB(0, 1), d0.b + (size_t)d0.hb, d0.ldb); EG_STAGEA(EG_SA(0, 1), d0, 1); }
    if (wr == 1) EG_BAR;
    EG_WAIT_V(4); EG_BAR;
    EG_STAGEB(EG_SB(1, 0), d1.b, d1.ldb); EG_STAGEA(EG_SA(1, 0), d1, 0); EG_STAGEB(EG_SB(1, 1), d1.b + (size_t)d1.hb, d1.ldb);
    EG_WAIT_V(6); EG_BAR;
    int tc = 0;
    for (;;) {
        EG_NEXT(d2); EG_NEXT(d3);
        if constexpr (P::HOOKS) { int fr_o = fr; asm volatile("" : "+v"(fr_o)); ph.hook(tc, acc, cur, wr, wc, fr_o, fq); }
        EG_LDB(B0, 0, 0); EG_SCHED; EG_LDA(At, 0, 0); EG_STAGEA(EG_SA(1, 1), d1, 1);
        EG_WAIT_L(8); EG_BAR; EG_WAIT_L(0); EG_MMA(0, 0, At, B0); EG_BAR; EG_SCHED;
        EG_LDB(B1, 0, 1); EG_STAGEB(EG_SB(0, 0), d2.b, d2.ldb);
        EG_BAR; EG_WAIT_L(0); EG_MMA(0, 1, At, B1); EG_BAR;
        EG_LDA(At, 0, 1); EG_STAGEA(EG_SA(0, 0), d2, 0);
        EG_BAR; EG_WAIT_L(0); EG_MMA(1, 0, At, B0); EG_BAR; EG_SCHED;
        EG_STAGEB(EG_SB(0, 1), d2.b + (size_t)d2.hb, d2.ldb);
        EG_WAIT_V(6); EG_BAR; EG_MMA(1, 1, At, B1); EG_BAR;
        EG_LDB(B0, 1, 0); EG_SCHED; EG_LDA(At, 1, 0); EG_STAGEA(EG_SA(0, 1), d2, 1);
        EG_WAIT_L(8); EG_BAR; EG_WAIT_L(0); EG_MMA(0, 0, At, B0); EG_BAR; EG_SCHED;
        EG_LDB(B1, 1, 1); EG_STAGEB(EG_SB(1, 0), d3.b, d3.ldb);
        EG_BAR; EG_WAIT_L(0); EG_MMA(0, 1, At, B1); EG_BAR;
        EG_LDA(At, 1, 1); EG_STAGEA(EG_SA(1, 0), d3, 0);
        EG_BAR; EG_WAIT_L(0); EG_MMA(1, 0, At, B0); EG_BAR; EG_SCHED;
        EG_STAGEB(EG_SB(1, 1), d3.b + (size_t)d3.hb, d3.ldb);
        EG_WAIT_V(6); EG_BAR; EG_MMA(1, 1, At, B1); EG_BAR;
        d1 = d3; tc += 2;
        if (tc == cur.n0 + cur.n1 + cur.n2) {
            { int fr_o = fr, fq_o = fq; asm volatile("" : "+v"(fr_o), "+v"(fq_o));
              ph.epi(acc, cur, wr, wc, fr_o, fq_o); }
            ++ui; tc = 0;
            if (!ph.get(ui, cur)) break;
#pragma unroll
            for (int a = 0; a < 2; ++a)
#pragma unroll
                for (int b = 0; b < 2; ++b)
#pragma unroll
                    for (int m = 0; m < 4; ++m)
#pragma unroll
                        for (int n = 0; n < 2; ++n) acc[a][b][m][n] = (f32x4){0.f, 0.f, 0.f, 0.f};
        }
    }
    EG_WAIT_V(0);
    if (wr == 0) EG_BAR;
    EG_BAR;
#undef EG_NEXT
#undef EG_GLOAD
}
__device__ __forceinline__ void unit1(UnitD& u, const void* A, unsigned lda, const void* B, unsigned ldb, int nt) {
    u.A0 = (const char*)A; u.B0 = (const char*)B; u.lda0 = lda; u.ldb0 = ldb; u.n0 = nt; u.hb0 = 128u * ldb;
    u.A1 = u.A0; u.B1 = u.B0; u.lda1 = lda; u.ldb1 = ldb; u.n1 = 0; u.A2 = u.A0; u.B2 = u.B0; u.lda2 = lda; u.ldb2 = ldb; u.n2 = 0;
    u.kind = 0; u.i0 = 0; u.i1 = 0; u.i2 = 0;
}
}
using eng::UnitD; using eng::Acc;
__device__ __forceinline__ int xcd_remap(int idx, int N) { const int q = N >> 3, r = N & 7, x = idx & 7, off = idx >> 3; return (x < r ? x * (q + 1) : r * (q + 1) + (x - r) * q) + off; }
__device__ __forceinline__ void efence() { asm volatile("" ::: "memory"); }
#define EPI_ARGS const Acc& acc, const UnitD& u, int wr, int wc, int fr, int fq
#define FOR_FRAG(ai, bj, m, n) _Pragma("unroll") for (int ai = 0; ai < 2; ++ai) _Pragma("unroll") for (int m = 0; m < 4; ++m) _Pragma("unroll") for (int bj = 0; bj < 2; efence(), ++bj) _Pragma("unroll") for (int n = 0; n < 2; ++n)
#define FRAG_ROW(ai, m) (128 * (ai) + 64 * wr + 16 * (m) + fr)
#define FRAG_COL(bj, n) (128 * (bj) + 32 * wc + 16 * (n) + 4 * fq)
#define FRAG_COLP(bj) (128 * (bj) + 32 * wc + 8 * fq)
#define FOR_FRAGP(ai, bj, m) _Pragma("unroll") for (int ai = 0; ai < 2; ++ai) _Pragma("unroll") for (int m = 0; m < 4; ++m) _Pragma("unroll") for (int bj = 0; bj < 2; efence(), ++bj)
__device__ __forceinline__ void st_bf16x8(bf16_t* p, f32x4 a, f32x4 b) { u32x4 w; w.x = cvt_pk_bf16(a[0], a[1]); w.y = cvt_pk_bf16(a[2], a[3]); w.z = cvt_pk_bf16(b[0], b[1]); w.w = cvt_pk_bf16(b[2], b[3]); *(u32x4*)p = w; }
__device__ __forceinline__ void st_bf16x4(bf16_t* p, f32x4 v) { u32x2 w; w.x = cvt_pk_bf16(v[0], v[1]); w.y = cvt_pk_bf16(v[2], v[3]); *(u32x2*)p = w; }
struct Frame { Params p; LAS unsigned char* lds; int tid, lane, wid, G, bid; };
#define WSP(T, off) ((T*)(F.p.ws + (off)))

template <class RowSrc>
__device__ __forceinline__ void conv_tile(const Frame& F, bf16_t* dst, int K, int ld, float scale, int r0, int k0, const RowSrc& rs) {
    LAS float* tile = (LAS float*)F.lds;
    const int n4 = (F.tid & 15) * 4, kq = F.tid >> 4;
    const float* sp = rs(r0 + n4) + (size_t)(k0 + kq) * ld;
#pragma unroll
    for (int p = 0; p < 8; ++p) { const f32x4 v = *(const f32x4*)(sp + (size_t)(p * 32) * ld); LAS float* q = tile + (p * 32 + kq) * 65 + n4; q[0] = v[0]; q[1] = v[1]; q[2] = v[2]; q[3] = v[3]; }
    __syncthreads();
    const int i2 = (F.tid & 127) * 2, jb = F.tid >> 7;
#pragma unroll
    for (int p = 0; p < 16; ++p) { const int j = p * 4 + jb; *(unsigned*)(dst + (size_t)(r0 + j) * K + k0 + i2) = cvt_pk_bf16(tile[i2 * 65 + j] * scale, tile[(i2 + 1) * 65 + j] * scale); }
    __syncthreads();
}
__device__ __forceinline__ int sigma_orig(int s) {
    const int half = s >> 7, s2 = s & 127, uu = s2 >> 5, b = (s2 >> 4) & 1, f = s2 & 15; return half * 128 + 16 * uu + f + 64 * b;
}
__device__ __forceinline__ void conv_moe_tile(const Frame& F, int layer, int t) {
    bf16_t* w13 = WSP(bf16_t, A_MOEW); bf16_t* w2t = WSP(bf16_t, A_MOEW + 32 * MiB);
    if (t < 1024) { const int e = t >> 6, rt = (t >> 2) & 15, kt = t & 3;
        const float* w1 = F.p.moe_w1 + ((size_t)layer * 16 + e) * 1024 * 512; const float* w3 = F.p.moe_w3 + ((size_t)layer * 16 + e) * 1024 * 512;
        conv_tile(F, w13 + (size_t)e * 1024 * 1024, 1024, 512, 1.0f, rt * 64, kt * 256, [=](int r) { const int j = r >> 8, rr = r & 255; return rr < 128 ? w1 + 128 * j + rr : w3 + 128 * j + rr - 128; });
    } else { const int u = t - 1024, e = u >> 5, rt = (u >> 1) & 15, kt = u & 1;
        const float* w2 = F.p.moe_w2 + ((size_t)layer * 16 + e) * 512 * 1024;
        conv_tile(F, w2t + (size_t)e * 1024 * 512, 512, 1024, 1.0f, rt * 64, kt * 256, [=](int r) { return w2 + r; }); }
}
__device__ __forceinline__ void conv_moe(const Frame& F, int layer, int t_lo, int t_hi) { for (int t = t_lo + F.bid; t < t_hi; t += F.G) conv_moe_tile(F, layer, t); }
__device__ __forceinline__ void conv_small_tile(const Frame& F, int t) {
    if (t < 96) { const float* w = F.p.w0in; conv_tile(F, WSP(bf16_t, WS_W0IN), 1024, 2560, 1.0f, (t >> 2) * 64, (t & 3) * 256, [=](int r) { return w + 256 + r; }); }
    else if (t < 144) { const int u = t - 96; const float* w = F.p.w0in; conv_tile(F, WSP(bf16_t, WS_W0IN) + (size_t)2048 * 1024, 1024, 2560, 1.0f, (u >> 2) * 64, (u & 3) * 256, [=](int r) { return w + 1792 + r; }); }
    else if (t < 208) { const int u = t - 144; const float* w = F.p.w0out; conv_tile(F, WSP(bf16_t, WS_W0OUT), 1024, 1024, 1.0f, (u >> 2) * 64, (u & 3) * 256, [=](int r) { return w + r; }); }
    else if (t < 272) { const int u = t - 208; const float* w = F.p.w1in; conv_tile(F, WSP(bf16_t, WS_W1IN), 1024, 6144, 1.0f, (u >> 2) * 64, (u & 3) * 256, [=](int r) { return w + (r & ~255) + sigma_orig(r & 255); }); }
    else if (t < 336) { const int u = t - 272; const float* w = F.p.w1in; conv_tile(F, WSP(bf16_t, WS_W1IN) + (size_t)1024 * 1024, 1024, 6144, 0.0625f, (u >> 2) * 64, (u & 3) * 256, [=](int r) { return w + 1024 + (r & ~255) + sigma_orig(r & 255); }); }
    else if (t < 592) { const int u = t - 336; const float* w = F.p.w1in; conv_tile(F, WSP(bf16_t, WS_W1IN) + (size_t)2048 * 1024, 1024, 6144, 1.0f, (u >> 2) * 64, (u & 3) * 256, [=](int r) { return w + 2048 + r; }); }
    else { const int u = t - 592; const float* w = F.p.w1out; conv_tile(F, WSP(bf16_t, WS_W1OUT), 2048, 1024, 1.0f, (u >> 3) * 64, (u & 7) * 256, [=](int r) { return w + r; }); }
}
__device__ __forceinline__ void p0_prologue(const Frame& F) {
    const float TWO_PI = 6.283185307179586f;
    {
        LAS float* sc0 = (LAS float*)F.lds; LAS float* sc1 = sc0 + 1024; LAS float* red = sc1 + 1024;
        for (int k = F.tid; k < 1024; k += 512) { sc0[k] = silu_f(F.p.c[k]); sc1[k] = silu_f(F.p.c_ctx[k]); }
        __syncthreads();
        float* mod = WSP(float, WS_MOD);
        for (int item = F.bid; item < 192; item += F.G) {
            const int l = item / 96, col0 = (item % 96) * 64, l16 = F.tid & 15, kg = F.tid >> 4;
            f32x4 a0 = {0.f, 0.f, 0.f, 0.f}, a1 = {0.f, 0.f, 0.f, 0.f};
#pragma unroll 8
            for (int i = 0; i < 32; ++i) { const int k = kg + 32 * i; const f32x4 w = *(const f32x4*)(F.p.ada_w + ((size_t)l * 1024 + k) * 6144 + col0 + l16 * 4); a0 += sc0[k] * w; a1 += sc1[k] * w; }
#pragma unroll
            for (int e = 0; e < 4; ++e) { red[(kg * 64 + l16 * 4 + e) * 2 + 0] = a0[e]; red[(kg * 64 + l16 * 4 + e) * 2 + 1] = a1[e]; }
            __syncthreads();
            if (F.tid < 128) { const int col = F.tid & 63, which = F.tid >> 6; float s = 0.f; for (int g = 0; g < 32; ++g) s += red[(g * 64 + col) * 2 + which];
                mod[(size_t)which * 2 * 6144 + l * 6144 + col0 + col] = s + F.p.ada_b[l * 6144 + col0 + col]; }
            __syncthreads();
        }
    }
    {
        const int gt = F.bid * 512 + F.tid, gn = F.G * 512;
        float* twc = WSP(float, WS_TWC); float* tws = WSP(float, WS_TWS);
        for (int i = gt; i < 128 * 128; i += gn) { const int b = i >> 7, k1 = i & 127; const float a = (float)((b * k1) & 16383) * (TWO_PI / 16384.0f); twc[i] = cosf(a); tws[i] = sinf(a); }
        float* rc = WSP(float, WS_ROPEC); float* rs = WSP(float, WS_ROPES);
        for (int i = gt; i < 256 * 64; i += gn) { const int pos = i >> 6, fi = i & 63; const float inv = powf(10000.0f, -(float)fi / 64.0f); const float a = (float)pos * inv; rc[i] = cosf(a); rs[i] = sinf(a); }
        bf16_t* f1 = WSP(bf16_t, WS_F1T); bf16_t* f2 = WSP(bf16_t, WS_F2P);
        for (int i = gt; i < 256 * 256; i += gn) { const int n = i >> 8, k = i & 255, k1 = n & 127, a = k & 127; const float ang = (float)((a * k1) & 127) * (TWO_PI / 128.0f); const float cs = cosf(ang), sn = sinf(ang);
            float v1; if (n < 128) v1 = (k < 128) ? cs : sn; else v1 = (k < 128) ? -sn : cs;
            f1[i] = f2bf(v1);
            f2[i] = f2bf(n < 128 ? ((k < 128) ? cs : sn) * (1.0f / 128.0f) : 0.0f); }
        bf16_t* cs256 = WSP(bf16_t, WS_CS256);
        for (int i = gt; i < 256 * 512; i += gn) { const int k = i >> 9, j = i & 511, n = j & 255; const float ang = (float)((n * k) & 255) * (TWO_PI / 256.0f); cs256[i] = f2bf((j < 256 ? cosf(ang) : sinf(ang)) * (1.0f / 16.0f)); }
    }
    {
        LAS float* ct = (LAS float*)F.lds; LAS float* wrow = ct + 64 + F.wid * 64;
        __syncthreads();
        if (F.tid < 64) ct[F.tid] = cosf((float)F.tid * (TWO_PI / 64.0f));
        __syncthreads();
        bf16_t* dst = WSP(bf16_t, WS_W0IN);
        for (int it = F.bid * 8 + F.wid; it < 4096; it += F.G * 8) {
            const int k = it >> 2, g = it & 3;
            wrow[F.lane] = F.p.w0in[(size_t)k * 2560 + g * 64 + F.lane];
            float re = 0.f, im = 0.f;
#pragma unroll 16
            for (int c = 0; c < 64; ++c) { const float w = wrow[c]; const int ph = (c * F.lane) & 63; re += w * ct[ph]; im -= w * ct[(ph + 48) & 63]; }
            dst[(size_t)(1536 + g * 64 + F.lane) * 1024 + k] = f2bf(re * 0.125f); dst[(size_t)(1536 + 256 + g * 64 + F.lane) * 1024 + k] = f2bf(im * 0.125f);
        }
        __syncthreads();
    }
    for (int t = F.bid; t < 720; t += F.G) conv_small_tile(F, t);
}

struct Row { f32x4 v[4]; };
__device__ __forceinline__ void row_load(Row& r, const float* p, int lane) {
#pragma unroll
    for (int i = 0; i < 4; ++i) r.v[i] = *(const f32x4*)(p + 4 * lane + 256 * i);
}
__device__ __forceinline__ void row_store(const Row& r, float* p, int lane) {
#pragma unroll
    for (int i = 0; i < 4; ++i) *(f32x4*)(p + 4 * lane + 256 * i) = r.v[i];
}
__device__ __forceinline__ float row_rstd(const Row& r) {
    float s = 0.f;
#pragma unroll
    for (int i = 0; i < 4; ++i) s += (r.v[i][0] * r.v[i][0] + r.v[i][1] * r.v[i][1]) + (r.v[i][2] * r.v[i][2] + r.v[i][3] * r.v[i][3]);
    s = wave_sum(s);
    return rsqrtf(s * (1.0f / 1024.0f) + RMS_EPS);
}
__device__ __forceinline__ void row_norm_mod(Row& r, const float* g, const float* sh, const float* sc, int lane) {
    const float rs = row_rstd(r);
#pragma unroll
    for (int i = 0; i < 4; ++i) { const int c = 4 * lane + 256 * i; const f32x4 gv = *(const f32x4*)(g + c), shv = *(const f32x4*)(sh + c), scv = *(const f32x4*)(sc + c);
        r.v[i] = (r.v[i] * rs) * gv * (1.0f + scv) + shv; }
}
__device__ __forceinline__ void row_store_bf16(const Row& r, bf16_t* p, int lane) {
#pragma unroll
    for (int i = 0; i < 4; ++i) st_bf16x4(p + 4 * lane + 256 * i, r.v[i]);
}
__device__ __forceinline__ const float* modp(const Frame& F, int layer, bool is_ctx) { return WSP(const float, WS_MOD) + (size_t)(is_ctx ? 2 : 0) * 6144 + layer * 6144; }
__device__ __forceinline__ unsigned char* xm1_panel(const unsigned char* ws, int pm) { return (unsigned char*)ws + (pm < 51 ? B_XM1A + (size_t)pm * HMiB : WS_W0IN + (size_t)(pm - 51) * HMiB); }
__device__ __forceinline__ float* hrow(const Frame& F, int t) { return t < CTXN ? WSP(float, WS_HC) + (size_t)t * DM : F.p.out + (size_t)(t - CTXN) * DM; }

__device__ __forceinline__ void p_norm_in(const Frame& F) {
    bf16_t* xm = WSP(bf16_t, A_XM);
    for (int t = F.bid * 8 + F.wid; t < TT; t += F.G * 8) {
        const bool ic = t < CTXN; const float* src = ic ? F.p.ctx + (size_t)t * DM : F.p.x + (size_t)(t - CTXN) * DM; const float* m = modp(F, 0, ic);
        Row r; row_load(r, src, F.lane); row_norm_mod(r, F.p.norm_g, m, m + 1024, F.lane); row_store_bf16(r, xm + (size_t)t * DM, F.lane);
    }
}
__device__ __forceinline__ void p_router(const Frame& F, int layer, int t0, bf16_t* dst) {
    LAS float* rwT = (LAS float*)F.lds;
    LAS unsigned* lcnt = (LAS unsigned*)(F.lds + 65536);
    for (int i = F.tid; i < 16 * 1024; i += 512) { const int e = i >> 10, c = i & 1023; rwT[i] = F.p.router_w[c * 16 + e]; }
    if (F.tid < 32) lcnt[F.tid] = 0u;
    __syncthreads();
    int* eid = WSP(int, WS_EID); float* gw = WSP(float, WS_GW); int* slot = WSP(int, WS_SLOT);
    unsigned* gcnt = (unsigned*)(F.p.ws + WS_CTL + CTL_CNT) + layer * 64;
    for (int t = t0 + F.bid * 8 + F.wid; t < TT; t += F.G * 8) {
        const bool ic = t < CTXN; const float* m = modp(F, layer, ic);
        Row r;
        if (ic) {
            row_load(r, F.p.ctx + (size_t)t * DM, F.lane); const float* part = WSP(const float, A_PART) + (size_t)t * DM;
#pragma unroll
            for (int i = 0; i < 4; ++i) { const int c = 4 * F.lane + 256 * i; const f32x4 gv = *(const f32x4*)(m + 2048 + c);
                const f32x4 s = (*(const f32x4*)(part + c) + *(const f32x4*)(part + 256 * DM + c)) + (*(const f32x4*)(part + 512 * DM + c) + *(const f32x4*)(part + 768 * DM + c)); r.v[i] += gv * s; }
            row_store(r, hrow(F, t), F.lane);
        } else row_load(r, hrow(F, t), F.lane);
        row_norm_mod(r, F.p.norm_g + (size_t)(layer * 2 + 1) * DM, m + 3072, m + 4096, F.lane); row_store_bf16(r, dst + (size_t)t * DM, F.lane);
        float pd[16];
#pragma unroll
        for (int e = 0; e < 16; ++e) { float s = 0.f;
#pragma unroll
            for (int i = 0; i < 4; ++i) { const f32x4 w = *(const LAS f32x4*)(rwT + e * 1024 + 4 * F.lane + 256 * i); s += (r.v[i][0] * w[0] + r.v[i][1] * w[1]) + (r.v[i][2] * w[2] + r.v[i][3] * w[3]); }
            pd[e] = s; }
        float q8[8], q4[4], q2[2], q1;
#pragma unroll
        for (int e = 0; e < 8; ++e) { const bool hi = (F.lane & 32) != 0; const float keep = hi ? pd[e + 8] : pd[e], send = hi ? pd[e] : pd[e + 8]; q8[e] = keep + __shfl_xor(send, 32); }
#pragma unroll
        for (int e = 0; e < 4; ++e) { const bool hi = (F.lane & 16) != 0; const float keep = hi ? q8[e + 4] : q8[e], send = hi ? q8[e] : q8[e + 4]; q4[e] = keep + __shfl_xor(send, 16); }
#pragma unroll
        for (int e = 0; e < 2; ++e) { const bool hi = (F.lane & 8) != 0; const float keep = hi ? q4[e + 2] : q4[e], send = hi ? q4[e] : q4[e + 2]; q2[e] = keep + __shfl_xor(send, 8); }
        { const bool hi = (F.lane & 4) != 0; const float keep = hi ? q2[1] : q2[0], send = hi ? q2[0] : q2[1]; q1 = keep + __shfl_xor(send, 4); }
        q1 += __shfl_xor(q1, 2); q1 += __shfl_xor(q1, 1);
        float lg[16];
#pragma unroll
        for (int e = 0; e < 16; ++e) { const int src = ((e >> 3) & 1) * 32 + ((e >> 2) & 1) * 16 + ((e >> 1) & 1) * 8 + (e & 1) * 4; lg[e] = __builtin_bit_cast(float, __builtin_amdgcn_readlane(__builtin_bit_cast(int, q1), src)); }
        float scv[16], bi[16];
#pragma unroll
        for (int e = 0; e < 16; ++e) { scv[e] = 1.0f / (1.0f + __expf(-lg[e])); bi[e] = scv[e] + F.p.router_b[e]; }
        int gsel = 0; float best = -1e30f;
#pragma unroll
        for (int g = 0; g < 4; ++g) { const float a = bi[4 * g], b = bi[4 * g + 1], c = bi[4 * g + 2], d = bi[4 * g + 3];
            const float h1 = fmaxf(a, b), l1 = fminf(a, b), h2 = fmaxf(c, d), l2 = fminf(c, d); const float gs = fmaxf(h1, h2) + fmaxf(fminf(h1, h2), fmaxf(l1, l2));
            if (gs > best) { best = gs; gsel = g; } }
        float vb[4], vs[4];
#pragma unroll
        for (int i = 0; i < 4; ++i) { vb[i] = gsel == 0 ? bi[i] : gsel == 1 ? bi[4 + i] : gsel == 2 ? bi[8 + i] : bi[12 + i]; vs[i] = gsel == 0 ? scv[i] : gsel == 1 ? scv[4 + i] : gsel == 2 ? scv[8 + i] : scv[12 + i]; }
        int i0 = 0; float b0 = vb[0];
#pragma unroll
        for (int i = 1; i < 4; ++i) if (vb[i] > b0) { b0 = vb[i]; i0 = i; }
        int i1 = -1; float b1 = -1e30f;
#pragma unroll
        for (int i = 0; i < 4; ++i) if (i != i0 && vb[i] > b1) { b1 = vb[i]; i1 = i; }
        const float s0 = i0 == 0 ? vs[0] : i0 == 1 ? vs[1] : i0 == 2 ? vs[2] : vs[3], s1 = i1 == 0 ? vs[0] : i1 == 1 ? vs[1] : i1 == 2 ? vs[2] : vs[3];
        const float inv = 1.0f / (s0 + s1);
        if (F.lane == 0) {
            const int e0 = gsel * 4 + i0, e1 = gsel * 4 + i1;
            const unsigned r0 = __hip_atomic_fetch_add(lcnt + e0, 1u, __ATOMIC_RELAXED, __HIP_MEMORY_SCOPE_WORKGROUP), r1 = __hip_atomic_fetch_add(lcnt + e1, 1u, __ATOMIC_RELAXED, __HIP_MEMORY_SCOPE_WORKGROUP);
            eid[2 * t] = e0; eid[2 * t + 1] = e1; gw[2 * t] = s0 * inv; gw[2 * t + 1] = s1 * inv; slot[2 * t] = (int)r0; slot[2 * t + 1] = (int)r1;
        }
    }
    __syncthreads();
    if (F.tid < 16) lcnt[16 + F.tid] = __hip_atomic_fetch_add(gcnt + F.tid, lcnt[F.tid], __ATOMIC_RELAXED, __HIP_MEMORY_SCOPE_AGENT);
    __syncthreads();
    int* perm = WSP(int, WS_PERM);
    for (int t = t0 + F.bid * 8 + F.wid; t < TT; t += F.G * 8)
        if (F.lane < 2) { const int e = eid[2 * t + F.lane], rk = slot[2 * t + F.lane] + (int)lcnt[16 + e]; slot[2 * t + F.lane] = rk; perm[e * TT + rk] = t; }
    __syncthreads();
}
struct PanelTab { int pst[17]; };
__device__ __forceinline__ void panel_tab(const Frame& F, int layer, PanelTab& pt) {
    const unsigned* gcnt = (const unsigned*)(F.p.ws + WS_CTL + CTL_CNT) + layer * 64;
    pt.pst[0] = 0;
#pragma unroll
    for (int e = 0; e < 16; ++e) pt.pst[e + 1] = pt.pst[e] + (int)((__builtin_amdgcn_readfirstlane(gcnt[e]) + 255u) >> 8);
}
__device__ __forceinline__ int pt_start(const PanelTab& pt, int e) { int ps = 0;
#pragma unroll
    for (int j = 0; j < 16; ++j) ps = (e == j) ? pt.pst[j] : ps;
    return ps; }
__device__ __forceinline__ void moe_rowtab(const Frame& F, int layer, const PanelTab& pt, int t_pad) {
    LAS unsigned* rowtab = (LAS unsigned*)(F.lds + eng::STAGE_BYTES + 1024);
    const unsigned* gcnt = (const unsigned*)(F.p.ws + WS_CTL + CTL_CNT) + layer * 64; const int* perm = WSP(const int, WS_PERM);
    const int NU = pt.pst[16] * 4;
    for (int i = 0; i < 4; ++i) { const int idx0 = F.bid + i * F.G; if (idx0 >= NU) break;
        const int p = xcd_remap(idx0, NU) >> 2; int e = 0;
#pragma unroll
        for (int k = 1; k < 16; ++k) e += (p >= pt.pst[k]) ? 1 : 0;
        if (F.tid < 256) { const int rk = (p - pt_start(pt, e)) * 256 + F.tid; const int tok = rk < (int)gcnt[e] ? perm[e * TT + rk] : t_pad; rowtab[i * 256 + F.tid] = (unsigned)tok * 2048u; } }
    __syncthreads();
}
__device__ __forceinline__ void row_moe_combine(const Frame& F, Row& r, int t, int layer, const bf16_t* Y, const PanelTab& pt) {
    const int* slot = WSP(const int, WS_SLOT); const float* gw = WSP(const float, WS_GW); const int* eid = WSP(const int, WS_EID);
    const int s0 = pt_start(pt, eid[2 * t]) * 256 + slot[2 * t], s1 = pt_start(pt, eid[2 * t + 1]) * 256 + slot[2 * t + 1]; const float w0 = gw[2 * t], w1 = gw[2 * t + 1];
    const float* g2 = modp(F, layer, t < CTXN) + 5120;
#pragma unroll
    for (int i = 0; i < 4; ++i) { const int c = 4 * F.lane + 256 * i;
        const u32x2 a = *(const u32x2*)(Y + (size_t)s0 * DM + c), b = *(const u32x2*)(Y + (size_t)s1 * DM + c); const f32x4 gv = *(const f32x4*)(g2 + c);
        f32x4 f; f[0] = w0 * bflo(a.x) + w1 * bflo(b.x); f[1] = w0 * bfhi(a.x) + w1 * bfhi(b.x); f[2] = w0 * bflo(a.y) + w1 * bflo(b.y); f[3] = w0 * bfhi(a.y) + w1 * bfhi(b.y);
        r.v[i] += gv * f; }
}
__device__ __forceinline__ void p_combine0(const Frame& F) {
    const bf16_t* Y = WSP(const bf16_t, A_XS); PanelTab pt; panel_tab(F, 0, pt);
    for (int t = F.bid * 8 + F.wid; t < TT; t += F.G * 8) {
        Row r; float* hp = hrow(F, t); row_load(r, hp, F.lane); row_moe_combine(F, r, t, 0, Y, pt); row_store(r, hp, F.lane);
        const float* m = modp(F, 1, t < CTXN); row_norm_mod(r, F.p.norm_g + 2 * DM, m, m + 1024, F.lane); row_store_bf16(r, (bf16_t*)xm1_panel(F.p.ws, t >> 8) + (size_t)(t & 255) * DM, F.lane);
    }
}
__device__ __forceinline__ void p_final(const Frame& F) {
    const bf16_t* Y = WSP(const bf16_t, B_XS); PanelTab pt; panel_tab(F, 1, pt);
    for (int t = CTXN + F.bid * 8 + F.wid; t < TT; t += F.G * 8) {
        Row r; float* hp = hrow(F, t); row_load(r, hp, F.lane); row_moe_combine(F, r, t, 1, Y, pt);
        const float rs = row_rstd(r);
#pragma unroll
        for (int i = 0; i < 4; ++i) { const f32x4 gv = *(const f32x4*)(F.p.final_g + 4 * F.lane + 256 * i); r.v[i] = (r.v[i] * rs) * gv; }
        row_store(r, hp, F.lane);
    }
}
__device__ __forceinline__ float log_gamma(const Frame& F, int dir, int h) { return log1pf(-expf(F.p.decay[dir * 4 + h])); }
__device__ __forceinline__ void p_scan(const Frame& F) {
    bf16_t* st = WSP(bf16_t, B_ST);
    const int item = F.bid * 512 + F.tid;
    for (int it = item; it < 8 * 16384; it += F.G * 512) {
        const int hd = it >> 14, grp = it & 16383, h = hd >> 1, dir = hd & 1;
        const float lg = log_gamma(F, dir, h), d256 = __expf(256.0f * lg), d512 = __expf(512.0f * lg);
        float s[8];
#pragma unroll
        for (int j = 0; j < 8; ++j) s[j] = 0.f;
#pragma unroll 4
        for (int step = 0; step < 33; ++step) {
            const int c = (dir == 0 || step == 0) ? step : 33 - step;
            u32x4* p = (u32x4*)(st + ((size_t)(c * 8 + hd) * 131072 + (size_t)grp * 8));
            const u32x4 uv = *p; const float dec = (c == 0) ? d256 : d512;
            u32x4 o; o.x = cvt_pk_bf16(s[0], s[1]); o.y = cvt_pk_bf16(s[2], s[3]); o.z = cvt_pk_bf16(s[4], s[5]); o.w = cvt_pk_bf16(s[6], s[7]);
            *p = o;
            s[0] = s[0] * dec + bflo(uv.x); s[1] = s[1] * dec + bfhi(uv.x); s[2] = s[2] * dec + bflo(uv.y); s[3] = s[3] * dec + bfhi(uv.y);
            s[4] = s[4] * dec + bflo(uv.z); s[5] = s[5] * dec + bfhi(uv.z); s[6] = s[6] * dec + bflo(uv.w); s[7] = s[7] * dec + bfhi(uv.w);
        }
    }
}
#define PH_COMMON const unsigned char* ws; int G, bid; static constexpr bool HOOKS = false, GATHER = false, PERM = false; \
    __device__ __forceinline__ void hook(int, Acc&, const UnitD&, int, int, int, int) const {}
#define PH_COMMONP const unsigned char* ws; int G, bid; static constexpr bool HOOKS = false, GATHER = false, PERM = true; \
    __device__ __forceinline__ void hook(int, Acc&, const UnitD&, int, int, int, int) const {}
#define WSC(T, off) ((T*)(ws + (off)))
__device__ __forceinline__ float sel4(f32x4 v, int h) { const float a = h == 0 ? v[0] : v[1], b = h == 2 ? v[2] : v[3]; return h < 2 ? a : b; }
#define SEL4(a, h) sel4(a, h)
#define EFENCE asm volatile("" ::: "memory")

struct PhG1 { PH_COMMONP
    __device__ __forceinline__ bool get(int i, UnitD& u) const {
        const int idx = bid + i * G; if (idx >= 715) return false;
        const char* xm = (const char*)(ws + A_XM); const char* w = (const char*)(ws + WS_W0IN);
        if (idx < 390) { const int v = xcd_remap(idx, 390), pm = v / 6, pn = v % 6; eng::unit1(u, xm + (size_t)pm * 256 * 2048, 2048, w + (size_t)pn * 256 * 2048, 2048, 16); u.kind = 0; u.i0 = pm; u.i1 = pn; }
        else { const int j = xcd_remap(idx - 390, 325), ct = j / 5, rt = j % 5; eng::unit1(u, w + (size_t)(1536 + rt * 256) * 2048, 2048, xm + (size_t)ct * 256 * 2048, 2048, 16); u.kind = rt < 2 ? 1 : 2; u.i0 = rt; u.i1 = ct;
            if (rt < 2 && ct > 0) { u.B0 = xm + (size_t)(CTXN + 2 * (ct - 1)) * 2048; u.ldb0 = 128u * 2048u; u.hb0 = 2048u; } }
        return true;
    }
    __device__ __forceinline__ void epi(EPI_ARGS) const {
        if (u.kind == 0) { bf16_t* o = WSC(bf16_t, A_QK0) + (size_t)(u.i0 * 256) * QK0_LD + u.i1 * 256;
            FOR_FRAGP(ai, bj, m) st_bf16x8(o + (size_t)FRAG_ROW(ai, m) * QK0_LD + FRAG_COLP(bj), acc[ai][bj][m][0], acc[ai][bj][m][1]); }
        else if (u.kind == 2) { bf16_t* o = WSC(bf16_t, A_VT0) + (size_t)((u.i0 - 2) * 256) * TT + u.i1 * 256;
            FOR_FRAGP(ai, bj, m) st_bf16x8(o + (size_t)FRAG_ROW(ai, m) * TT + FRAG_COLP(bj), acc[ai][bj][m][0], acc[ai][bj][m][1]); }
        else if (u.i1 == 0) { bf16_t* o = WSC(bf16_t, WS_XTC) + u.i0 * 256;
            FOR_FRAGP(ai, bj, m) st_bf16x8(o + (size_t)FRAG_ROW(ai, m) * 512 + FRAG_COLP(bj), acc[ai][bj][m][0], acc[ai][bj][m][1]); }
        else { bf16_t* o = WSC(bf16_t, A_XT2) + u.i0 * 128;
            FOR_FRAGP(ai, bj, m) { const int cc = FRAG_ROW(ai, m), c0 = FRAG_COLP(bj), b = 2 * (u.i1 - 1) + (c0 >> 7), a = c0 & 127;
                st_bf16x8(o + (size_t)(cc * 128 + b) * 256 + a, acc[ai][bj][m][0], acc[ai][bj][m][1]); } }
    }
};
struct PhF1 { PH_COMMONP
    __device__ __forceinline__ bool get(int i, UnitD& u) const {
        const int idx = bid + i * G; if (idx >= 129) return false;
        if (idx < 128) { eng::unit1(u, ws + WS_F1T, 512, ws + A_XT2 + (size_t)idx * 256 * 512, 512, 4); u.kind = 0; u.i0 = idx; }
        else { eng::unit1(u, ws + WS_CS256, 1024, ws + WS_XTC, 1024, 8); u.kind = 1; }
        return true;
    }
    __device__ __forceinline__ void epi(EPI_ARGS) const {
        if (u.kind == 1) { bf16_t* o = WSC(bf16_t, A_AO); FOR_FRAGP(ai, bj, m) st_bf16x8(o + (size_t)FRAG_ROW(ai, m) * DM + FRAG_COLP(bj), acc[ai][bj][m][0], acc[ai][bj][m][1]); return; }
        const float* twc = WSC(const float, WS_TWC); const float* tws = WSC(const float, WS_TWS); bf16_t* o = WSC(bf16_t, A_T2);
#pragma unroll
        for (int m = 0; m < 4; ++m) { const int k1 = 64 * wr + 16 * m + fr;
#pragma unroll
            for (int bj = 0; bj < 2; ++bj) { const int cc = 2 * u.i0 + bj, b0 = 32 * wc + 8 * fq; f32x4 re[2], im[2];
#pragma unroll
                for (int n = 0; n < 2; ++n) { const f32x4 cv = *(const f32x4*)(twc + k1 * 128 + b0 + 4 * n), sv = *(const f32x4*)(tws + k1 * 128 + b0 + 4 * n); const f32x4 tr = acc[0][bj][m][n], ti = acc[1][bj][m][n];
                    re[n] = tr * cv + ti * sv; im[n] = ti * cv - tr * sv; }
                bf16_t* q = o + (size_t)(k1 * 256 + cc) * 256 + b0; st_bf16x8(q, re[0], re[1]); st_bf16x8(q + 128, im[0], im[1]); efence(); } }
    }
};
struct PhF2 { PH_COMMONP
    __device__ __forceinline__ bool get(int i, UnitD& u) const {
        const int idx = bid + i * G; if (idx >= 144) return false;
        if (idx < 128) { eng::unit1(u, ws + WS_F2P, 512, ws + A_T2 + (size_t)idx * 256 * 512, 512, 4); u.i0 = idx; }
        else { const int pn = (idx - 128) & 3, kq = (idx - 128) >> 2;
            eng::unit1(u, ws + A_AO + (size_t)kq * 512, 2048, ws + WS_W0OUT + (size_t)pn * 256 * 2048 + (size_t)kq * 512, 2048, 4); u.kind = 1; u.i0 = kq; u.i1 = pn; }
        return true;
    }
    __device__ __forceinline__ void epi(EPI_ARGS) const {
        if (u.kind == 1) { float* dst = WSC(float, A_PART) + (size_t)u.i0 * 256 * DM + u.i1 * 256;
            FOR_FRAG(ai, bj, m, n) *(f32x4*)(dst + (size_t)FRAG_ROW(ai, m) * DM + FRAG_COLP(bj) + 4 * n) = acc[ai][bj][m][n];
            return; }
        bf16_t* o = WSC(bf16_t, A_AO);
#pragma unroll
        for (int m = 0; m < 4; ++m)
#pragma unroll
            for (int bj = 0; bj < 2; ++bj) { const int k2 = FRAG_ROW(0, m); st_bf16x8(o + (size_t)(CTXN + u.i0 + 128 * k2) * DM + FRAG_COLP(bj), acc[0][bj][m][0], acc[0][bj][m][1]); }
    }
};
struct PhG2 { PH_COMMON const float* x; float* out;
    __device__ __forceinline__ bool get(int i, UnitD& u) const {
        const int idx0 = bid + i * G; if (idx0 >= 256) return false;
        const int idx = xcd_remap(idx0, 256), pm = 1 + (idx >> 2), pn = idx & 3; eng::unit1(u, ws + A_AO + (size_t)pm * 256 * 2048, 2048, ws + WS_W0OUT + (size_t)pn * 256 * 2048, 2048, 16); u.i0 = pm; u.i1 = pn; return true;
    }
    __device__ __forceinline__ void epi(EPI_ARGS) const {
        const float* g1 = WSC(const float, WS_MOD) + 2048 + u.i1 * 256;
        const float* src = x + (size_t)(u.i0 - 1) * 256 * DM; float* dst = out + (size_t)(u.i0 - 1) * 256 * DM;
        FOR_FRAG(ai, bj, m, n) { const size_t off = (size_t)FRAG_ROW(ai, m) * DM + u.i1 * 256 + FRAG_COL(bj, n); const f32x4 gv = *(const f32x4*)(g1 + FRAG_COL(bj, n));
            *(f32x4*)(dst + off) = *(const f32x4*)(src + off) + gv * acc[ai][bj][m][n]; }
    }
};
struct PhM1 { const unsigned char* ws; int G, bid; PanelTab pt; size_t xs, hd; static constexpr bool HOOKS = false, GATHER = true, PERM = true;
    __device__ __forceinline__ void hook(int, Acc&, const UnitD&, int, int, int, int) const {}
    __device__ __forceinline__ bool get(int i, UnitD& u) const {
        const int idx0 = bid + i * G, NU = pt.pst[16] * 4; if (idx0 >= NU) return false;
        const int idx = xcd_remap(idx0, NU), p = idx >> 2, j = idx & 3; int e = 0;
#pragma unroll
        for (int k = 1; k < 16; ++k) e += (p >= pt.pst[k]) ? 1 : 0;
        eng::unit1(u, ws + xs, 2048, ws + A_MOEW + ((size_t)e * 1024 + j * 256) * 2048, 2048, 16); u.i0 = p; u.i1 = j; return true;
    }
    __device__ __forceinline__ void epi(EPI_ARGS) const {
        bf16_t* o = (bf16_t*)(ws + hd) + (size_t)(u.i0 * 256) * 512 + u.i1 * 128;
#pragma unroll
        for (int ai = 0; ai < 2; ++ai)
#pragma unroll
            for (int m = 0; m < 4; ++m) { f32x4 v[2];
#pragma unroll
                for (int n = 0; n < 2; ++n) { const f32x4 a = acc[ai][0][m][n], b = acc[ai][1][m][n];
#pragma unroll
                    for (int e = 0; e < 4; ++e) v[n][e] = silu_f(a[e]) * b[e]; }
                st_bf16x8(o + (size_t)FRAG_ROW(ai, m) * 512 + FRAG_COLP(0), v[0], v[1]); efence(); }
    }
};
struct PhM2 { PH_COMMONP PanelTab pt; size_t hd, y;
    __device__ __forceinline__ bool get(int i, UnitD& u) const {
        const int idx0 = bid + i * G, NU = pt.pst[16] * 4; if (idx0 >= NU) return false;
        const int idx = xcd_remap(idx0, NU), p = idx >> 2, j = idx & 3; int e = 0;
#pragma unroll
        for (int k = 1; k < 16; ++k) e += (p >= pt.pst[k]) ? 1 : 0;
        eng::unit1(u, ws + hd + (size_t)p * 256 * 1024, 1024, ws + A_MOEW + 32 * MiB + ((size_t)e * 1024 + j * 256) * 1024, 1024, 8); u.i0 = p; u.i1 = j; return true;
    }
    __device__ __forceinline__ void epi(EPI_ARGS) const {
        bf16_t* o = (bf16_t*)(ws + y) + (size_t)(u.i0 * 256) * DM + u.i1 * 256;
        FOR_FRAGP(ai, bj, m) st_bf16x8(o + (size_t)FRAG_ROW(ai, m) * DM + FRAG_COLP(bj), acc[ai][bj][m][0], acc[ai][bj][m][1]);
    }
};
__device__ __forceinline__ void epi_rope_qk(const Acc& acc, const unsigned char* ws, int pm, int pn, int wr, int wc, int fr, int fq) {
    const float* rc = WSC(const float, WS_ROPEC); const float* rs = WSC(const float, WS_ROPES);
    bf16_t* o = (pn < 4 ? WSC(bf16_t, B_Q) : WSC(bf16_t, B_K)) + (size_t)(pm * 256) * DM + (pn & 3) * 256;
#pragma unroll
    for (int ai = 0; ai < 2; ++ai)
#pragma unroll
        for (int m = 0; m < 4; ++m) { const int r = FRAG_ROW(ai, m), tl = (pm - 1) * 256 + r;
#pragma unroll
            for (int bj = 0; bj < 2; ++bj) { const int pos = bj == 0 ? (tl >> 6) : (tl & 63); const f32x4 cv = *(const f32x4*)(rc + pos * 64 + 16 * wc + 4 * fq), sv = *(const f32x4*)(rs + pos * 64 + 16 * wc + 4 * fq);
                const f32x4 x1 = acc[ai][bj][m][0], x2 = acc[ai][bj][m][1];
                st_bf16x4(o + (size_t)r * DM + FRAG_COL(bj, 0), x1 * cv - x2 * sv); st_bf16x4(o + (size_t)r * DM + FRAG_COL(bj, 1), x2 * cv + x1 * sv); }
            efence(); }
}
struct PhG3 { PH_COMMON f32x4 lgf, lgb;
    __device__ __forceinline__ bool get(int i, UnitD& u) const {
        const int idx = bid + i * G; if (idx >= 244 + 780) return false;
        const char* w = (const char*)(ws + WS_W1IN);
        if (idx < 244) { const int v = xcd_remap(idx, 244), pm = 1 + (v >> 2), pn = 4 + (v & 3); eng::unit1(u, xm1_panel(ws, pm), 2048, w + (size_t)pn * 256 * 2048, 2048, 16); u.kind = 0; u.i0 = pm; u.i1 = pn; }
        else { const int j = xcd_remap(idx - 244, 780), ct = j / 12, rt = j % 12; eng::unit1(u, w + (size_t)(1024 + rt * 256) * 2048, 2048, xm1_panel(ws, ct), 2048, 16); u.kind = rt < 4 ? 1 : 2; u.i0 = rt; u.i1 = ct; }
        return true;
    }
    __device__ __forceinline__ void epi(EPI_ARGS) const {
        const float* rc = WSC(const float, WS_ROPEC); const float* rs = WSC(const float, WS_ROPES);
        if (u.kind == 0) { epi_rope_qk(acc, ws, u.i0, u.i1, wr, wc, fr, fq);
        } else if (u.kind == 2) { bf16_t* o = WSC(bf16_t, B_VT) + (size_t)((u.i0 - 4) * 256) * TT + u.i1 * 256;
            FOR_FRAG(ai, bj, m, n) st_bf16x4(o + (size_t)FRAG_ROW(ai, m) * TT + FRAG_COL(bj, n), acc[ai][bj][m][n]);
        } else {
            const int h = u.i0; const float lf = SEL4(lgf, h), lb = SEL4(lgb, h);
            bf16_t* of = WSC(bf16_t, B_KF) + (size_t)(h * 256) * TT + u.i1 * 256; bf16_t* ob = WSC(bf16_t, B_KB) + (size_t)(h * 256) * TT + u.i1 * 256;
#pragma unroll
            for (int bj = 0; bj < 2; ++bj)
#pragma unroll
                for (int n = 0; n < 2; ++n) { const int c0 = FRAG_COL(bj, n); f32x4 df, db;
                    if (u.i1 == 0) {
#pragma unroll
                        for (int e = 0; e < 4; ++e) { const int pos = c0 + e; df[e] = __expf(lf * (float)(255 - pos)); db[e] = __expf(lb * (float)pos); }
                    } else {
#pragma unroll
                        for (int e = 0; e < 4; ++e) { const int pos = ((u.i1 - 1) * 256 + c0 + e) & 511; df[e] = __expf(lf * (float)(511 - pos)); db[e] = __expf(lb * (float)pos); }
                    }
#pragma unroll
                    for (int ai = 0; ai < 2; ++ai)
#pragma unroll
                        for (int mp = 0; mp < 2; ++mp) { const int p = 32 * wr + 16 * mp + fr; f32x4 x1 = acc[ai][bj][2 * mp][n], x2 = acc[ai][bj][2 * mp + 1][n];
                            if (u.i1 != 0) { const int tl = (u.i1 - 1) * 256 + c0; f32x4 cv, sv;
                                if (ai == 0) { const float c = rc[(tl >> 6) * 64 + p], s = rs[(tl >> 6) * 64 + p]; cv = (f32x4){c, c, c, c}; sv = (f32x4){s, s, s, s}; }
                                else {
#pragma unroll
                                    for (int e = 0; e < 4; ++e) { cv[e] = rc[((tl + e) & 63) * 64 + p]; sv[e] = rs[((tl + e) & 63) * 64 + p]; } }
                                const f32x4 y1 = x1 * cv - x2 * sv, y2 = x2 * cv + x1 * sv; x1 = y1; x2 = y2; }
                            const size_t o1 = (size_t)FRAG_ROW(ai, 2 * mp) * TT + c0, o2 = (size_t)FRAG_ROW(ai, 2 * mp + 1) * TT + c0;
                            st_bf16x4(of + o1, x1 * df); st_bf16x4(of + o2, x2 * df); st_bf16x4(ob + o1, x1 * db); st_bf16x4(ob + o2, x2 * db); } }
        }
    }
};
__device__ __forceinline__ int chunk_tok0(int c) { return c == 0 ? 0 : 256 + 512 * (c - 1); }
struct PhU { PH_COMMON
    __device__ __forceinline__ void unitF(UnitD& u, int pm, int pn) const { eng::unit1(u, xm1_panel(ws, pm), 2048, ws + WS_W1IN + (size_t)pn * 256 * 2048, 2048, 16); u.kind = 1; u.i0 = pm; u.i1 = pn; }
    __device__ __forceinline__ void unitH(UnitD& u, int idx) const {
        const int dvt = idx & 1, dir = (idx >> 1) & 1, h = (idx >> 2) & 3, c = idx < 512 ? 1 + (idx >> 4) : 0; const size_t tk = (size_t)chunk_tok0(c) * 2;
        eng::unit1(u, ws + B_VT + (size_t)(h * 512 + dvt * 256) * TT * 2 + tk, TT * 2, ws + (dir ? B_KB : B_KF) + (size_t)(h * 256) * TT * 2 + tk, TT * 2, c == 0 ? 4 : 8);
        u.i0 = (c * 8 + h * 2 + dir); u.i1 = dvt; }
    __device__ __forceinline__ bool get(int i, UnitD& u) const {
        const int b = bid; if (G != 256) { if (b != 0) return false;
            if (i < 268) { if (i < 256) unitF(u, 1 + (i >> 2), i & 3); else unitF(u, 1 + ((i - 12) >> 2), 4 + (i & 3)); return true; }
            if (i < 268 + 528) { unitH(u, i - 268); return true; } return false; }
        if (i == 0) { const int v = xcd_remap(b, 256); unitF(u, 1 + (v >> 2), v & 3); return true; }
        if (b < 12) { if (i == 1) { const int k = 244 + b; unitF(u, 1 + (k >> 2), 4 + (k & 3)); return true; } return false; }
        if (i == 1) { unitH(u, b); return true; }
        if (i == 2) { unitH(u, 256 + b); return true; }
        if (i == 3) { if (b < 36) { const int k = b - 12; unitH(u, k < 12 ? k : 256 + (k - 12)); return true; } if (b < 52) { unitH(u, 512 + (b - 36)); return true; } }
        return false;
    }
    __device__ __forceinline__ void epi(EPI_ARGS) const {
        if (u.kind == 1) { epi_rope_qk(acc, ws, u.i0, u.i1, wr, wc, fr, fq); return; }
        bf16_t* o = WSC(bf16_t, B_ST) + (size_t)u.i0 * 131072 + (size_t)(u.i1 * 256) * 256;
        FOR_FRAG(ai, bj, m, n) st_bf16x4(o + (size_t)FRAG_ROW(ai, m) * 256 + FRAG_COL(bj, n), acc[ai][bj][m][n]);
    }
};
struct PhSD { PH_COMMONP f32x4 lgf, lgb;
    __device__ __forceinline__ bool get(int i, UnitD& u) const {
        const int idx0 = bid + i * G; if (idx0 >= 512) return false;
        const int idx = xcd_remap(idx0, 512), tj = idx & 1, ti = (idx >> 1) & 1, h = (idx >> 2) & 3, c = 1 + (idx >> 4); const int t0 = chunk_tok0(c);
        eng::unit1(u, ws + B_Q + (size_t)(t0 + 256 * ti) * 2048 + h * 512, 2048, ws + B_K + (size_t)(t0 + 256 * tj) * 2048 + h * 512, 2048, 4);
        u.i0 = t0; u.i1 = h; u.i2 = ti * 2 + tj; return true;
    }
    __device__ __forceinline__ void epi(EPI_ARGS) const {
        const int ti = u.i2 >> 1, tj = u.i2 & 1, h = u.i1; const float lf = SEL4(lgf, h), lb = SEL4(lgb, h);
        bf16_t* o = WSC(bf16_t, B_SD) + (size_t)(u.i0 + 256 * ti) * 2048 + h * 512 + 256 * tj;
        FOR_FRAGP(ai, bj, m) { const int r = FRAG_ROW(ai, m), c0 = FRAG_COLP(bj), i = 256 * ti + r; f32x4 v[2];
#pragma unroll
            for (int n = 0; n < 2; ++n) { v[n] = acc[ai][bj][m][n];
#pragma unroll
                for (int e = 0; e < 4; ++e) { const int d = i - (256 * tj + c0 + 4 * n + e); const float w = d > 0 ? __expf(lf * (float)d) : d < 0 ? __expf(lb * (float)(-d)) : 2.0f; v[n][e] *= w; } }
            st_bf16x8(o + (size_t)r * 2048 + c0, v[0], v[1]); }
    }
};
struct PhO { const unsigned char* ws; int G, bid; f32x4 lgf, lgb; static constexpr bool HOOKS = true, GATHER = false, PERM = true;
    __device__ __forceinline__ bool get(int i, UnitD& u) const {
        const int idx0 = bid + i * G; if (idx0 >= 512) return false;
        const int idx = xcd_remap(idx0, 512), dvt = idx & 1, h = (idx >> 1) & 3, pm = idx >> 3, c = 1 + (pm >> 1), t0 = CTXN + 256 * pm;
        const char* q = (const char*)(ws + B_Q) + (size_t)t0 * 2048 + h * 512;
        const char* st = (const char*)(ws + B_ST) + ((size_t)(c * 8 + h * 2) * 131072 + (size_t)(dvt * 256) * 256) * 2;
        u.A0 = q; u.B0 = st; u.lda0 = 2048; u.ldb0 = 512; u.n0 = 4; u.hb0 = 128u * 512u;
        u.A1 = q; u.B1 = st + (size_t)131072 * 2; u.lda1 = 2048; u.ldb1 = 512; u.n1 = 4;
        u.A2 = (const char*)(ws + B_SD) + (size_t)t0 * 4096 + h * 1024; u.B2 = (const char*)(ws + B_VT) + (size_t)(h * 512 + dvt * 256) * TT * 2 + (size_t)chunk_tok0(c) * 2; u.lda2 = 4096; u.ldb2 = TT * 2; u.n2 = 8;
        u.kind = 0; u.i0 = pm; u.i1 = h; u.i2 = dvt; return true;
    }
    __device__ __forceinline__ void hook(int tc, Acc& acc, const UnitD& u, int wr, int wc, int fr, int fq) const {
        if (tc != 4 && tc != 8) return;
        const float lf = SEL4(lgf, u.i1), lb = SEL4(lgb, u.i1);
#pragma unroll
        for (int ai = 0; ai < 2; ++ai)
#pragma unroll
            for (int m = 0; m < 4; ++m) { const int i = (u.i0 & 1) * 256 + FRAG_ROW(ai, m);
                const float s = tc == 4 ? __expf(lf * (float)(i + 1) - lb * (float)(512 - i)) : __expf(lb * (float)(512 - i));
#pragma unroll
                for (int bj = 0; bj < 2; ++bj)
#pragma unroll
                    for (int n = 0; n < 2; ++n) acc[ai][bj][m][n] *= s; }
    }
    __device__ __forceinline__ void epi(EPI_ARGS) const {
        const int tl = 256 * u.i0, h = u.i1, dvt = u.i2;
        bf16_t* o = WSC(bf16_t, B_O) + (size_t)(CTXN + tl) * 2048 + h * 512 + dvt * 256; float* ssq = WSC(float, WS_SSQ);
#pragma unroll
        for (int ai = 0; ai < 2; ++ai)
#pragma unroll
            for (int m = 0; m < 4; ++m) { const int r = FRAG_ROW(ai, m); float s = 0.f;
#pragma unroll
                for (int bj = 0; bj < 2; ++bj) {
#pragma unroll
                    for (int n = 0; n < 2; ++n) { const f32x4 v = acc[ai][bj][m][n]; s += (v[0] * v[0] + v[1] * v[1]) + (v[2] * v[2] + v[3] * v[3]); }
                    st_bf16x8(o + (size_t)r * 2048 + FRAG_COLP(bj), acc[ai][bj][m][0], acc[ai][bj][m][1]); }
                s += __shfl_xor(s, 16); s += __shfl_xor(s, 32);
                if (fq == 0) ssq[((size_t)(tl + r) * 4 + h) * 8 + dvt * 4 + wc] = s; }
    }
};
struct PhGG { PH_COMMONP
    __device__ __forceinline__ bool get(int i, UnitD& u) const {
        const int idx0 = bid + i * G; if (idx0 >= 512) return false;
        const int idx = xcd_remap(idx0, 512), pm = 1 + (idx >> 3), pn = idx & 7; eng::unit1(u, xm1_panel(ws, pm), 2048, ws + WS_W1IN + (size_t)(4096 + pn * 256) * 2048, 2048, 16); u.i0 = pm; u.i1 = pn; return true;
    }
    __device__ __forceinline__ void epi(EPI_ARGS) const {
        bf16_t* o = WSC(bf16_t, B_O) + (size_t)(u.i0 * 256) * 2048 + u.i1 * 256; const float* ssq = WSC(const float, WS_SSQ); const int h = u.i1 >> 1;
#pragma unroll
        for (int ai = 0; ai < 2; ++ai)
#pragma unroll
            for (int m = 0; m < 4; ++m) { const int r = FRAG_ROW(ai, m); const float* sp = ssq + ((size_t)((u.i0 - 1) * 256 + r) * 4 + h) * 8;
                const f32x4 s0 = *(const f32x4*)sp, s1 = *(const f32x4*)(sp + 4); const float rstd = rsqrtf((((s0[0] + s0[1]) + (s0[2] + s0[3])) + ((s1[0] + s1[1]) + (s1[2] + s1[3]))) * (1.0f / 512.0f) + RMS_EPS);
#pragma unroll
                for (int bj = 0; bj < 2; ++bj) { bf16_t* q = o + (size_t)r * 2048 + FRAG_COLP(bj); const u32x4 ov = *(const u32x4*)q; const f32x4 g0 = acc[ai][bj][m][0], g1 = acc[ai][bj][m][1]; f32x4 v0, v1;
                    v0[0] = silu_f(g0[0]) * (bflo(ov.x) * rstd); v0[1] = silu_f(g0[1]) * (bfhi(ov.x) * rstd); v0[2] = silu_f(g0[2]) * (bflo(ov.y) * rstd); v0[3] = silu_f(g0[3]) * (bfhi(ov.y) * rstd);
                    v1[0] = silu_f(g1[0]) * (bflo(ov.z) * rstd); v1[1] = silu_f(g1[1]) * (bfhi(ov.z) * rstd); v1[2] = silu_f(g1[2]) * (bflo(ov.w) * rstd); v1[3] = silu_f(g1[3]) * (bfhi(ov.w) * rstd);
                    st_bf16x8(q, v0, v1); } }
    }
};
struct PhG4 { PH_COMMON float* out;
    __device__ __forceinline__ bool get(int i, UnitD& u) const {
        const int idx0 = bid + i * G; if (idx0 >= 256) return false;
        const int idx = xcd_remap(idx0, 256), pm = idx >> 2, pn = idx & 3; eng::unit1(u, ws + B_O + (size_t)(CTXN + pm * 256) * 4096, 4096, ws + WS_W1OUT + (size_t)pn * 256 * 4096, 4096, 32); u.i0 = pm; u.i1 = pn; return true;
    }
    __device__ __forceinline__ void epi(EPI_ARGS) const {
        const float* g1 = WSC(const float, WS_MOD) + 6144 + 2048 + u.i1 * 256; float* dst = out + (size_t)(u.i0 * 256) * DM + u.i1 * 256;
        FOR_FRAG(ai, bj, m, n) { float* q = dst + (size_t)FRAG_ROW(ai, m) * DM + FRAG_COL(bj, n); const f32x4 gv = *(const f32x4*)(g1 + FRAG_COL(bj, n)); *(f32x4*)q = *(const f32x4*)q + gv * acc[ai][bj][m][n]; }
    }
};

constexpr int NA_KC = 0, NA_VC = 32768, NA_RPB = 65536;
__device__ __forceinline__ int na_ksw(int tok) { return ((tok >> 1) & 1) | (((tok >> 3) & 3) << 1); }
__device__ __forceinline__ void na_load_ctx(const Frame& F, int h) {
    const bf16_t* qk = WSP(const bf16_t, A_QK0); const bf16_t* vt = WSP(const bf16_t, A_VT0);
#pragma unroll
    for (int i = 0; i < 4; ++i) { const int cid = F.tid + 512 * i, tok = cid >> 3, c = cid & 7;
        *(LAS u32x4*)(F.lds + NA_KC + tok * 128 + ((c ^ na_ksw(tok)) << 4)) = *(const u32x4*)(qk + (size_t)tok * QK0_LD + 768 + h * 64 + c * 8); }
#pragma unroll
    for (int i = 0; i < 4; ++i) { const int cid = F.tid + 512 * i, d = cid >> 5, ch = cid & 31;
        *(LAS u32x4*)(F.lds + NA_VC + d * 512 + ((ch ^ (d & 15)) << 4)) = *(const u32x4*)(vt + (size_t)(h * 64 + d) * TT + ch * 8); }
}
template <bool LOCAL>
__device__ __forceinline__ void na_unit(const Frame& F, int r, int j, int h, int qb) {
    const bf16_t* qk = WSP(const bf16_t, A_QK0); const bf16_t* vt = WSP(const bf16_t, A_VT0); bf16_t* ao = WSP(bf16_t, A_AO);
    const LAS float* rpb_l = (const LAS float*)(F.lds + NA_RPB);
    int lane = F.lane; asm volatile("" : "+v"(lane));
    const int q16 = lane & 15, g = lane >> 4;
    const int tq = LOCAL ? CTXN + r * GW + 16 * j + q16 : 16 * qb + q16;
    bf16x8 qf[2];
#pragma unroll
    for (int ks = 0; ks < 2; ++ks) qf[ks] = *(const bf16x8*)(qk + (size_t)tq * QK0_LD + h * 64 + 32 * ks + 8 * g);
    constexpr int NT = LOCAL ? 32 : 16, NL = LOCAL ? 16 : 0;
    f32x4 s[NT];
    const int rs = LOCAL ? min(max(r - 4, 0), 248) : 0, kst = LOCAL ? min(max(16 * j - 8, 0), 32) : 0;
    const int krow = 8 * (q16 >> 2) + (q16 & 3);
#pragma unroll
    for (int t = 0; t < NT; ++t) {
        bf16x8 k0, k1;
        if (t < NL) { const int tok = CTXN + (rs + (t >> 1)) * GW + kst + krow + 4 * (t & 1); const bf16_t* kp = qk + (size_t)tok * QK0_LD + 768 + h * 64 + 8 * g; k0 = *(const bf16x8*)kp; k1 = *(const bf16x8*)(kp + 32); }
        else { const int tok = 32 * ((t - NL) >> 1) + krow + 4 * (t & 1), sw = na_ksw(tok); const LAS unsigned char* kp = F.lds + NA_KC + tok * 128;
            k0 = *(const LAS bf16x8*)(kp + ((g ^ sw) << 4)); k1 = *(const LAS bf16x8*)(kp + (((4 + g) ^ sw) << 4)); }
        f32x4 a = {0.f, 0.f, 0.f, 0.f};
        a = __builtin_amdgcn_mfma_f32_16x16x32_bf16(k0, qf[0], a, 0, 0, 0); a = __builtin_amdgcn_mfma_f32_16x16x32_bf16(k1, qf[1], a, 0, 0, 0);
        s[t] = a;
        if ((t & 3) == 3) asm volatile("" ::: "memory");
    }
    constexpr int NPF = LOCAL ? 2 : 0;
    bf16x8 vpf[NPF > 0 ? NPF * 4 : 1];
    if (LOCAL) {
#pragma unroll
        for (int b = 0; b < NPF; ++b)
#pragma unroll
            for (int dt = 0; dt < 4; ++dt) vpf[b * 4 + dt] = *(const bf16x8*)(vt + (size_t)(h * 64 + 16 * dt + q16) * TT + CTXN + (rs + b) * GW + kst + 8 * g);
    }
    const float C1 = 0.125f * 1.44269504f, L2E = 1.44269504f;
    float mx = -1e30f;
    if (LOCAL) { const int qc = 16 * j + q16, wst = min(max(qc - 8, 0), 48);
        int boff[8]; bool ok[8];
#pragma unroll
        for (int k = 0; k < 8; ++k) { const int kc = kst + 8 * g + k; ok[k] = kc >= wst && kc < wst + 16; boff[k] = min(max(kc - qc + 15, 0), 30) * 4; }
#pragma unroll
        for (int t = 0; t < NL; ++t) { const int dr = rs + (t >> 1) - r + 7; const LAS unsigned char* brow = (const LAS unsigned char*)rpb_l + (h * 15 + dr) * 124;
#pragma unroll
            for (int e = 0; e < 4; ++e) { const int k = 4 * (t & 1) + e; const float bias = *(const LAS float*)(brow + boff[k]);
                const float v = ok[k] ? fmaf(s[t][e], C1, bias * L2E) : -1e30f; s[t][e] = v; mx = fmaxf(mx, v); } } }
    float mxc = -1e30f;
#pragma unroll
    for (int t = NL; t < NT; ++t)
#pragma unroll
        for (int e = 0; e < 4; ++e) mxc = fmaxf(mxc, s[t][e]);
    mx = fmaxf(mx, mxc * C1);
    mx = fmaxf(mx, __shfl_xor(mx, 16)); mx = fmaxf(mx, __shfl_xor(mx, 32));
    float sum = 0.f; u32x4 pw[NT / 2];
#pragma unroll
    for (int b = 0; b < NT / 2; ++b) { float p[8];
#pragma unroll
        for (int e = 0; e < 4; ++e) {
            if (b < NL / 2) { p[e] = __builtin_amdgcn_exp2f(s[2 * b][e] - mx); p[4 + e] = __builtin_amdgcn_exp2f(s[2 * b + 1][e] - mx); }
            else { p[e] = __builtin_amdgcn_exp2f(fmaf(s[2 * b][e], C1, -mx)); p[4 + e] = __builtin_amdgcn_exp2f(fmaf(s[2 * b + 1][e], C1, -mx)); } }
        sum += ((p[0] + p[1]) + (p[2] + p[3])) + ((p[4] + p[5]) + (p[6] + p[7]));
        pw[b].x = cvt_pk_bf16(p[0], p[1]); pw[b].y = cvt_pk_bf16(p[2], p[3]); pw[b].z = cvt_pk_bf16(p[4], p[5]); pw[b].w = cvt_pk_bf16(p[6], p[7]); }
    sum += __shfl_xor(sum, 16); sum += __shfl_xor(sum, 32);
    f32x4 o[4];
#pragma unroll
    for (int dt = 0; dt < 4; ++dt) o[dt] = (f32x4){0.f, 0.f, 0.f, 0.f};
#pragma unroll
    for (int b = 0; b < NT / 2; ++b) {
        const bf16x8 pf = __builtin_bit_cast(bf16x8, pw[b]);
#pragma unroll
        for (int dt = 0; dt < 4; ++dt) { bf16x8 vf;
            if (b < NPF) vf = vpf[b * 4 + dt];
            else if (b < NL / 2) vf = *(const bf16x8*)(vt + (size_t)(h * 64 + 16 * dt + q16) * TT + CTXN + (rs + b) * GW + kst + 8 * g);
            else vf = *(const LAS bf16x8*)(F.lds + NA_VC + (16 * dt + q16) * 512 + (((4 * (b - NL / 2) + g) ^ q16) << 4));
            o[dt] = __builtin_amdgcn_mfma_f32_16x16x32_bf16(vf, pf, o[dt], 0, 0, 0); }
        if ((b & 1) == 1) asm volatile("" ::: "memory");
    }
    const float inv = 1.0f / sum;
#pragma unroll
    for (int dt = 0; dt < 4; ++dt) st_bf16x4(ao + (size_t)tq * DM + 256 + h * 64 + 16 * dt + 4 * g, o[dt] * inv);
}
__device__ __forceinline__ void p_attention(const Frame& F) {
    if ((F.bid & 3) == 3) { for (int t = F.bid >> 2; t < 1536; t += (F.G >> 2)) conv_moe_tile(F, 0, t); }
    __syncthreads();
    LAS float* rpb_l = (LAS float*)(F.lds + NA_RPB); volatile LAS int* tick = (volatile LAS int*)(F.lds + NA_RPB + 24576);
    for (int i = F.tid; i < 12 * 15 * 31; i += 512) rpb_l[i] = F.p.rpb[i];
    unsigned* heads = (unsigned*)(F.p.ws + WS_CTL + CTL_QUEUE);
    const int h0 = (12 * F.bid) >> 8;
    for (int hh = 0; hh < 12; ++hh) {
        const int h = (h0 + hh) % 12; bool loaded = false;
        for (;;) {
            __syncthreads();
            if (F.tid == 0) tick[0] = (int)__hip_atomic_fetch_add(heads + h * 64, 1u, __ATOMIC_RELAXED, __HIP_MEMORY_SCOPE_AGENT);
            __syncthreads();
            const int k = __builtin_amdgcn_readfirstlane(tick[0]);
            if (k > 128) break;
            if (!loaded) { na_load_ctx(F, h); __syncthreads(); loaded = true; }
            if (k < 128) na_unit<true>(F, 2 * k + (F.wid >> 2), F.wid & 3, h, 0);
            else { na_unit<false>(F, 0, 0, h, F.wid); na_unit<false>(F, 0, 0, h, F.wid + 8); }
        }
    }
    __syncthreads();
}
constexpr int LDS_BYTES = eng::STAGE_BYTES + 1024 + 4096;
#ifndef MK_PER_PHASE
#define MK_PER_PHASE 0
#endif

__global__ __launch_bounds__(512, 2) void mk_fwd(Params p) {
    extern __shared__ __attribute__((aligned(16))) unsigned char shm[];
    Frame F; F.p = p; F.lds = (LAS unsigned char*)shm; F.tid = threadIdx.x; F.lane = F.tid & 63; F.wid = __builtin_amdgcn_readfirstlane(F.tid >> 6); F.G = gridDim.x; F.bid = blockIdx.x;
    volatile LAS unsigned* xb = (volatile LAS unsigned*)(F.lds + eng::STAGE_BYTES);
    if (F.tid < 4) xb[F.tid] = 0u;
    __syncthreads();
    const int lo = p.ph_lo, hi = p.ph_hi;
    XcdBarrier bar; bar.bar = (unsigned*)(p.ws + WS_CTL); bar.x = 0; bar.st = xb;
    if (hi - lo > 1) bar = xcd_barrier_post((unsigned*)(p.ws + WS_CTL), xb);
#ifndef PHMASK
#define PHMASK 0xFFFFFFu
#endif
#define IN(k) (((PHMASK >> (k)) & 1u) && lo <= (k) && (k) < hi)
#ifndef PROBE_MASK
#define PROBE_MASK 0u
#endif
#ifndef PROBE_MULT
#define PROBE_MULT 1
#endif
    unsigned long long pr_acc = 0, pr_prev = PROBE_MASK ? wall_clock64() : 0ull;
#define SEAM(k) do { if (IN(k) && hi > (k) + 1) xcd_barrier(bar); if (PROBE_MASK) { const unsigned long long _n = wall_clock64(); if ((PROBE_MASK >> (k)) & 1u) pr_acc += _n - pr_prev; pr_prev = _n; } } while (0)
    const unsigned char* ws = p.ws;

    if (IN(0)) { p0_prologue(F); } SEAM(0);
    if (IN(1)) { p_norm_in(F); } SEAM(1);
    if (IN(2)) { PhG1 ph{ws, F.G, F.bid}; eng::gemm_run(F.lds, ph); } SEAM(2);
    if (IN(3)) { PhF1 ph{ws, F.G, F.bid}; eng::gemm_run(F.lds, ph); p_attention(F); } SEAM(3);
    if (IN(4)) { PhF2 ph{ws, F.G, F.bid}; eng::gemm_run(F.lds, ph); } SEAM(4);
    if (IN(5)) { PhG2 ph{ws, F.G, F.bid, p.x, p.out}; eng::gemm_run(F.lds, ph); } SEAM(5);
    if (IN(6)) { p_router(F, 0, 0, WSP(bf16_t, A_XM)); } SEAM(6);
    if (IN(8)) { PhM1 ph{ws, F.G, F.bid}; panel_tab(F, 0, ph.pt); ph.xs = A_XM; ph.hd = A_HD; moe_rowtab(F, 0, ph.pt, 0); eng::gemm_run(F.lds, ph); } SEAM(8);
    if (IN(9)) { PhM2 ph{ws, F.G, F.bid}; panel_tab(F, 0, ph.pt); ph.hd = A_HD; ph.y = A_XS; eng::gemm_run(F.lds, ph); } SEAM(9);
    if (IN(10)) { p_combine0(F); } SEAM(10);
    if (IN(11)) { PhG3 ph{ws, F.G, F.bid};
        ph.lgf = (f32x4){log_gamma(F, 0, 0), log_gamma(F, 0, 1), log_gamma(F, 0, 2), log_gamma(F, 0, 3)}; ph.lgb = (f32x4){log_gamma(F, 1, 0), log_gamma(F, 1, 1), log_gamma(F, 1, 2), log_gamma(F, 1, 3)};
        eng::gemm_run(F.lds, ph); } SEAM(11);
    if (IN(12)) { PhU ph{ws, F.G, F.bid}; eng::gemm_run(F.lds, ph); } SEAM(13);
    if (IN(14)) { PhSD ph{ws, F.G, F.bid};
        ph.lgf = (f32x4){log_gamma(F, 0, 0), log_gamma(F, 0, 1), log_gamma(F, 0, 2), log_gamma(F, 0, 3)}; ph.lgb = (f32x4){log_gamma(F, 1, 0), log_gamma(F, 1, 1), log_gamma(F, 1, 2), log_gamma(F, 1, 3)};
        if (F.bid & 8) { p_scan(F); eng::gemm_run(F.lds, ph); } else { eng::gemm_run(F.lds, ph); p_scan(F); } } SEAM(14);
    if (IN(15)) { PhO ph{ws, F.G, F.bid};
        ph.lgf = (f32x4){log_gamma(F, 0, 0), log_gamma(F, 0, 1), log_gamma(F, 0, 2), log_gamma(F, 0, 3)}; ph.lgb = (f32x4){log_gamma(F, 1, 0), log_gamma(F, 1, 1), log_gamma(F, 1, 2), log_gamma(F, 1, 3)};
        eng::gemm_run(F.lds, ph); } SEAM(15);
    if (IN(17)) { PhGG ph{ws, F.G, F.bid}; eng::gemm_run(F.lds, ph); } SEAM(17);
    if (IN(18)) { PhG4 ph{ws, F.G, F.bid, p.out};
        if (F.bid & 8) { conv_moe(F, 1, 0, 1024); eng::gemm_run(F.lds, ph); } else { eng::gemm_run(F.lds, ph); conv_moe(F, 1, 0, 1024); } } SEAM(18);
    if (IN(19)) { p_router(F, 1, CTXN, WSP(bf16_t, B_XM2)); } SEAM(19);
    if (IN(21)) { PhM1 ph{ws, F.G, F.bid}; panel_tab(F, 1, ph.pt); ph.xs = B_XM2; ph.hd = B_HD; moe_rowtab(F, 1, ph.pt, CTXN); eng::gemm_run(F.lds, ph); conv_moe(F, 1, 1024, 1536); } SEAM(21);
    if (IN(22)) { PhM2 ph{ws, F.G, F.bid}; panel_tab(F, 1, ph.pt); ph.hd = B_HD; ph.y = B_XS; eng::gemm_run(F.lds, ph); } SEAM(22);
    if (IN(23)) { p_final(F); }
    if (PROBE_MASK) { SEAM(23); if (F.bid == 0) { const unsigned long long t0 = wall_clock64(); while (wall_clock64() - t0 < pr_acc * PROBE_MULT) __builtin_amdgcn_s_sleep(8); } }
#undef IN
#undef SEAM
}

extern "C" void kernel_launch(void* const* d_in, const int* in_sizes, int n_in, void* d_out, int out_size, void* d_ws, size_t ws_size, hipStream_t stream) {
    static int grid = 0;
    if (grid == 0) {
        if (n_in != 19 || out_size != SEQ * DM || ws_size < WS_END) { fprintf(stderr, "kernel_launch: unexpected shapes (n_in %d, out %d, ws %zu < %zu)\n", n_in, out_size, ws_size, (size_t)WS_END); grid = -1; return; }
        int dev = 0, cus = 0, per_cu = 0;
        if (hipGetDevice(&dev) != hipSuccess || hipDeviceGetAttribute(&cus, hipDeviceAttributeMultiprocessorCount, dev) != hipSuccess) { grid = -1; return; }
        if (hipFuncSetAttribute((const void*)mk_fwd, hipFuncAttributeMaxDynamicSharedMemorySize, LDS_BYTES) != hipSuccess) { fprintf(stderr, "kernel_launch: hipFuncSetAttribute failed\n"); grid = -1; return; }
        if (hipOccupancyMaxActiveBlocksPerMultiprocessor(&per_cu, (const void*)mk_fwd, 512, LDS_BYTES) != hipSuccess || per_cu < 1) { fprintf(stderr, "kernel_launch: occupancy query says %d\n", per_cu); per_cu = 1; }
        (void)hipGetLastError();
        grid = cus;
        if (grid > 256) grid = 256;
    }
    if (grid < 0) return;
    (void)hipMemsetAsync((char*)d_ws + WS_CTL, 0, CTL_BYTES, stream);
    Params p{};
    const float** pp = (const float**)&p;
    for (int i = 0; i < 19; ++i) pp[i] = (const float*)d_in[i];
    p.out = (float*)d_out; p.ws = (unsigned char*)d_ws;
#if MK_PER_PHASE
    for (int ph = 0; ph < NPHASE; ++ph) { p.ph_lo = ph; p.ph_hi = ph + 1; hipLaunchKernelGGL(mk_fwd, dim3(grid), dim3(512), LDS_BYTES, stream, p); }
#else
    p.ph_lo = 0; p.ph_hi = NPHASE; hipLaunchKernelGGL(mk_fwd, dim3(grid), dim3(512), LDS_BYTES, stream, p);
#endif
}
```
